# Optimizing an MI355X kernel written in HIP

```python
import math
import jax, jax.numpy as jnp
from jax import lax
import numpy as np

D_MODEL = 1024
BATCH = 4
SEQ = 8192
DEPTH = 4

GRID_W = 64
CTX_LEN = 256
N_MIXERS = 3
A_HEADS = 8
A_KV_HEADS = 2
A_HEAD_DIM = 128
ROPE_THETA = 10000.0
Q_BLOCK = 128
B_CHUNK = 128
B_GROUPS = 8
B_WIDTH = D_MODEL
C_HEADS = 8
C_HEAD_DIM = D_MODEL // C_HEADS
C_CONV = 3
C_CHUNK = 64
N_EXPERTS = 16
N_GROUPS = 4
TOPK_GROUPS = 1
TOP_K = 2
D_EXPERT = 512
MOE_BLOCK = 256

EPS = 1e-6
DN_ALPHA = (2 * DEPTH) ** 0.25
DN_BETA = (8 * DEPTH) ** -0.25

kernel_name = "hybrid_interleaved_flow_backbone"


def layer_norm(x, g, b):
    xf = x.astype(jnp.float32)
    mu = jnp.mean(xf, -1, keepdims=True)
    var = jnp.mean(jnp.square(xf - mu), -1, keepdims=True)
    return ((xf - mu) * lax.rsqrt(var + EPS) * g + b).astype(x.dtype)


def rms_norm(x, g):
    xf = x.astype(jnp.float32)
    return (xf * lax.rsqrt(jnp.mean(xf * xf, -1, keepdims=True) + EPS) * g).astype(x.dtype)


def l2norm(x):
    return x * lax.rsqrt(jnp.sum(x * x, -1, keepdims=True) + EPS)


def modulate(x, shift, scale):
    return x * (1 + scale[:, None, :]) + shift[:, None, :]


def axial_rope(n):
    rows = n // GRID_W
    half = A_HEAD_DIM // 2
    inv = 1.0 / (ROPE_THETA ** (jnp.arange(0, half, 2, dtype=jnp.float32) / half))
    r = jnp.broadcast_to(jnp.arange(rows, dtype=jnp.float32)[:, None], (rows, GRID_W)).reshape(-1)
    col = jnp.broadcast_to(jnp.arange(GRID_W, dtype=jnp.float32)[None, :], (rows, GRID_W)).reshape(-1)
    ang = jnp.concatenate([r[:, None] * inv, col[:, None] * inv], -1)
    return jnp.cos(ang), jnp.sin(ang)


def apply_rope(x, cos, sin):
    xf = x.astype(jnp.float32).reshape(*x.shape[:-1], -1, 2)
    x1, x2 = xf[..., 0], xf[..., 1]
    c = cos[None, :, None, :]
    s = sin[None, :, None, :]
    return jnp.stack([x1 * c - x2 * s, x1 * s + x2 * c], -1).reshape(x.shape).astype(x.dtype)


def attention_mixer(u_lat, u_ctx, w_qkv, q_g, k_g, w_o, cos, sin, need_ctx):
    b, n, _ = u_lat.shape
    grp = A_HEADS // A_KV_HEADS
    scale = A_HEAD_DIM ** -0.5

    def proj(h):
        qkv = h @ w_qkv
        q, k, v = jnp.split(qkv, [A_HEADS * A_HEAD_DIM, (A_HEADS + A_KV_HEADS) * A_HEAD_DIM], -1)
        q = rms_norm(q.reshape(*h.shape[:2], A_HEADS, A_HEAD_DIM), q_g)
        k = rms_norm(k.reshape(*h.shape[:2], A_KV_HEADS, A_HEAD_DIM), k_g)
        return q, k, v.reshape(*h.shape[:2], A_KV_HEADS, A_HEAD_DIM)

    def attend(q, k, v):
        nq = q.shape[1]
        qg = q.reshape(b, nq, A_KV_HEADS, grp, A_HEAD_DIM)
        s = jnp.einsum("bqkgd,bskd->bkgqs", qg, k, preferred_element_type=jnp.float32) * scale
        p = jax.nn.softmax(s, axis=-1).astype(v.dtype)
        o = jnp.einsum("bkgqs,bskd->bqkgd", p, v)
        return o.reshape(b, nq, A_HEADS * A_HEAD_DIM)

    q_l, k_l, v_l = proj(u_lat)
    q_c, k_c, v_c = proj(u_ctx)
    q_l = apply_rope(q_l, cos, sin)
    k_l = apply_rope(k_l, cos, sin)
    k_all = jnp.concatenate([k_c, k_l], 1)
    v_all = jnp.concatenate([v_c, v_l], 1)
    nb = n // Q_BLOCK
    q_blocks = jnp.moveaxis(q_l.reshape(b, nb, Q_BLOCK, A_HEADS, A_HEAD_DIM), 1, 0)
    o_l = lax.map(lambda qb: attend(qb, k_all, v_all), q_blocks)
    y_lat = jnp.moveaxis(o_l, 0, 1).reshape(b, n, A_HEADS * A_HEAD_DIM) @ w_o
    y_ctx = attend(q_c, k_c, v_c) @ w_o if need_ctx else None
    return y_lat, y_ctx


def chunk_mlp(h, w_in, v_g, v_b, w_s, b_s, w_out):
    b, n, _ = h.shape
    z = jax.nn.gelu(h @ w_in)
    u, v = jnp.split(z, 2, -1)
    v = layer_norm(v, v_g, v_b)
    vg = v.reshape(b, n // B_CHUNK, B_CHUNK, B_GROUPS, B_WIDTH // B_GROUPS)
    mixed = jnp.einsum("gts,bcsgd->bctgd", w_s, vg) + b_s.T[None, None, :, :, None]
    return (u * mixed.reshape(b, n, B_WIDTH)) @ w_out


def short_conv(x, w):
    pad = C_CONV // 2
    return lax.conv_general_dilated(x, w[:, None, :], window_strides=(1,), padding=[(pad, pad)],
                                    dimension_numbers=("NWC", "WIO", "NWC"), feature_group_count=x.shape[-1])


def gated_delta_chunked(q, k, v, g, beta, s0):
    b, n, nh, dk = k.shape
    dv = v.shape[-1]
    nc = n // C_CHUNK

    def to_chunks(t):
        return jnp.moveaxis(t.reshape(b, nc, C_CHUNK, nh, *t.shape[3:]), (1, 2), (0, 3))

    qc, kc, vc = to_chunks(q), to_chunks(k), to_chunks(v)
    gc = jnp.cumsum(to_chunks(g), -1)
    bc = to_chunks(beta)
    idx = jnp.arange(C_CHUNK)
    tril = idx[:, None] >= idx[None, :]
    strict = idx[:, None] > idx[None, :]
    decay = jnp.exp(jnp.where(tril, gc[..., :, None] - gc[..., None, :], -jnp.inf))
    kb = kc * bc[..., None]
    a_mat = jnp.where(strict, jnp.einsum("...id,...jd->...ij", kb, kc) * decay, 0.0)
    eye = jnp.eye(C_CHUNK, dtype=jnp.float32)
    t_inv = lax.linalg.triangular_solve(a_mat + eye, jnp.broadcast_to(eye, a_mat.shape),
                                        left_side=True, lower=True)
    u = t_inv @ (vc * bc[..., None])
    w = t_inv @ (kb * jnp.exp(gc)[..., None])
    attn = jnp.where(tril, jnp.einsum("...id,...jd->...ij", qc, kc) * decay, 0.0)
    q_dec = qc * jnp.exp(gc)[..., None]
    k_dec = kc * jnp.exp(gc[..., -1:] - gc)[..., None]
    g_last = jnp.exp(gc[..., -1])

    def step(s, xs):
        u_i, w_i, attn_i, qd_i, kd_i, gl_i = xs
        v_new = u_i - w_i @ s
        o = qd_i @ s + attn_i @ v_new
        s = s * gl_i[..., None, None] + jnp.swapaxes(kd_i, -1, -2) @ v_new
        return s, o

    s_fin, o = lax.scan(step, s0, (u, w, attn, q_dec, k_dec, g_last))
    o = jnp.moveaxis(o, (0, 3), (1, 2)).reshape(b, n, nh, dv)
    return o, s_fin


def deltanet_mixer(u_lat, u_ctx, w_in, conv_w, a_log, dt_bias, norm_g, w_out, need_ctx):
    cw = C_HEADS * C_HEAD_DIM
    f32 = jnp.float32

    def prep(h):
        b, n, _ = h.shape
        proj = h @ w_in
        qkv = jax.nn.silu(short_conv(proj[..., :3 * cw], conv_w)).astype(f32)
        q, k, v = [t.reshape(b, n, C_HEADS, C_HEAD_DIM) for t in jnp.split(qkv, 3, -1)]
        q = l2norm(q) * (C_HEAD_DIM ** -0.5)
        k = l2norm(k)
        z = proj[..., 3 * cw:4 * cw].astype(f32).reshape(b, n, C_HEADS, C_HEAD_DIM)
        ab = proj[..., 4 * cw:].astype(f32).reshape(b, n, 2, 2, C_HEADS)
        g = -jnp.exp(a_log.astype(f32)) * jax.nn.softplus(ab[:, :, 0] + dt_bias.astype(f32))
        beta = jax.nn.sigmoid(ab[:, :, 1])
        return q, k, v, g, beta, z

    def bidir(q, k, v, g, beta, s_f, s_b):
        flip = lambda t: jnp.flip(t, 1)
        o_f, s_f = gated_delta_chunked(q, k, v, g[:, :, 0], beta[:, :, 0], s_f)
        o_b, s_b = gated_delta_chunked(flip(q), flip(k), flip(v), flip(g[:, :, 1]), flip(beta[:, :, 1]), s_b)
        return o_f + flip(o_b), s_f, s_b

    def out(o, z, dtype):
        y = rms_norm(o, norm_g) * jax.nn.silu(z)
        return y.reshape(*y.shape[:2], cw).astype(dtype) @ w_out

    qc, kc, vc, gc, bc, zc = prep(u_ctx)
    s0 = jnp.zeros((u_ctx.shape[0], C_HEADS, C_HEAD_DIM, C_HEAD_DIM), f32)
    o_ctx, s_f, s_b = bidir(qc, kc, vc, gc, bc, s0, s0)
    ql, kl, vl, gl, bl, zl = prep(u_lat)
    o_lat, _, _ = bidir(ql, kl, vl, gl, bl, s_f, s_b)
    y_lat = out(o_lat, zl, u_lat.dtype)
    y_ctx = out(o_ctx, zc, u_ctx.dtype) if need_ctx else None
    return y_lat, y_ctx


def moe_ffn(t, w_router, router_bias, w_gate, w_up, w_down):
    n_tok, d = t.shape
    per = N_EXPERTS // N_GROUPS
    scores = jax.nn.sigmoid((t @ w_router).astype(jnp.float32))
    sel = scores + router_bias.astype(jnp.float32)
    grp_score = lax.top_k(sel.reshape(n_tok, N_GROUPS, per), 2)[0].sum(-1)
    _, gidx = lax.top_k(grp_score, TOPK_GROUPS)
    gmask = jnp.any(gidx[..., None] == jnp.arange(N_GROUPS), axis=1)
    emask = jnp.repeat(gmask, per, axis=1)
    _, eidx = lax.top_k(jnp.where(emask, sel, -jnp.inf), TOP_K)
    wts = jnp.take_along_axis(scores, eidx, 1)
    wts = wts / jnp.sum(wts, -1, keepdims=True)
    n_asg = n_tok * TOP_K
    e_flat = eidx.reshape(-1)
    tok_flat = jnp.repeat(jnp.arange(n_tok, dtype=jnp.int32), TOP_K)
    order = jnp.argsort(e_flat)
    e_s, tok_s, w_s = e_flat[order], tok_flat[order], wts.reshape(-1)[order]
    counts = jnp.zeros((N_EXPERTS,), jnp.int32).at[e_flat].add(1)
    padded = (counts + MOE_BLOCK - 1) // MOE_BLOCK * MOE_BLOCK
    start = jnp.cumsum(counts) - counts
    pend = jnp.cumsum(padded)
    pstart = pend - padded
    dest = pstart[e_s] + jnp.arange(n_asg, dtype=jnp.int32) - start[e_s]
    n_blocks = -(-(n_asg + N_EXPERTS * (MOE_BLOCK - 1)) // MOE_BLOCK)
    n_rows = n_blocks * MOE_BLOCK
    row_tok = jnp.full((n_rows,), n_tok, jnp.int32).at[dest].set(tok_s)
    row_w = jnp.zeros((n_rows,), jnp.float32).at[dest].set(w_s)
    block_e = jnp.minimum(jnp.searchsorted(pend, jnp.arange(n_blocks) * MOE_BLOCK, side="right"), N_EXPERTS - 1)
    t_pad = jnp.concatenate([t, jnp.zeros((1, d), t.dtype)], 0)
    xb = t_pad[row_tok].reshape(n_blocks, MOE_BLOCK, d)

    def expert_block(args):
        xblk, e = args
        hid = jax.nn.silu(xblk @ w_gate[e]) * (xblk @ w_up[e])
        return hid @ w_down[e]

    yb = lax.map(expert_block, (xb, block_e)).reshape(n_rows, d)
    y = jnp.zeros((n_tok + 1, d), jnp.float32).at[row_tok].add(yb.astype(jnp.float32) * row_w[:, None])
    return y[:n_tok].astype(t.dtype)


def setup_inputs(seed: int = 0) -> dict:
    key = jax.random.key(seed)
    keys = jax.random.split(key, 40)
    ctr = [0]
    f32 = jnp.float32

    def nxt():
        ctr[0] += 1
        return keys[ctr[0] - 1]

    def nrm(shape, scale=1.0):
        return jax.random.normal(nxt(), shape, f32) * scale

    d = D_MODEL
    n_a = len(range(0, DEPTH, N_MIXERS))
    n_b = len(range(1, DEPTH, N_MIXERS))
    n_c = len(range(2, DEPTH, N_MIXERS))
    a_cols = (A_HEADS + 2 * A_KV_HEADS) * A_HEAD_DIM
    a_w = A_HEADS * A_HEAD_DIM
    cw = C_HEADS * C_HEAD_DIM
    dt = jnp.exp(jax.random.uniform(nxt(), (n_c, 2, C_HEADS), f32, math.log(1e-3), math.log(1e-1)))
    return {
        "x": nrm((BATCH, SEQ, d)),
        "c": nrm((BATCH, d)),
        "ctx": nrm((BATCH, CTX_LEN, d)),
        "c_ctx": nrm((d,)),
        "w_ada": nrm((DEPTH, d, 6 * d), d ** -0.5),
        "b_ada": nrm((DEPTH, 6 * d), 0.02),
        "ln_g": 1.0 + nrm((DEPTH, 2, d), 0.02),
        "ln_b": nrm((DEPTH, 2, d), 0.02),
        "a_wqkv": nrm((n_a, d, a_cols), d ** -0.5),
        "a_qg": 1.0 + nrm((n_a, A_HEAD_DIM), 0.02),
        "a_kg": 1.0 + nrm((n_a, A_HEAD_DIM), 0.02),
        "a_wo": nrm((n_a, a_w, d), a_w ** -0.5 * DN_BETA),
        "b_win": nrm((n_b, d, 2 * B_WIDTH), d ** -0.5),
        "b_vg": 1.0 + nrm((n_b, B_WIDTH), 0.02),
        "b_vb": nrm((n_b, B_WIDTH), 0.02),
        "b_ws": nrm((n_b, B_GROUPS, B_CHUNK, B_CHUNK), B_CHUNK ** -0.5),
        "b_bs": 1.0 + nrm((n_b, B_GROUPS, B_CHUNK), 0.02),
        "b_wout": nrm((n_b, B_WIDTH, d), B_WIDTH ** -0.5 * DN_BETA),
        "c_win": nrm((n_c, d, 4 * cw + 4 * C_HEADS), d ** -0.5),
        "c_conv": nrm((n_c, C_CONV, 3 * cw), C_CONV ** -0.5),
        "c_alog": jnp.log(jax.random.uniform(nxt(), (n_c, 2, C_HEADS), f32, 1.0, 16.0)),
        "c_dtb": dt + jnp.log(-jnp.expm1(-dt)),
        "c_ng": 1.0 + nrm((n_c, C_HEAD_DIM), 0.02),
        "c_wout": nrm((n_c, cw, d), cw ** -0.5 * DN_BETA),
        "w_router": nrm((d, N_EXPERTS), d ** -0.5),
        "router_bias": nrm((N_EXPERTS,), 0.01),
        "e_gate": nrm((DEPTH, N_EXPERTS, d, D_EXPERT), d ** -0.5),
        "e_up": nrm((DEPTH, N_EXPERTS, d, D_EXPERT), d ** -0.5),
        "e_down": nrm((DEPTH, N_EXPERTS, D_EXPERT, d), D_EXPERT ** -0.5 * DN_BETA),
    }


def reference(x, c, ctx, c_ctx, w_ada, b_ada, ln_g, ln_b,
              a_wqkv, a_qg, a_kg, a_wo,
              b_win, b_vg, b_vb, b_ws, b_bs, b_wout,
              c_win, c_conv, c_alog, c_dtb, c_ng, c_wout,
              w_router, router_bias, e_gate, e_up, e_down):
    d = x.shape[-1]
    cos, sin = axial_rope(x.shape[1])
    s_lat = jax.nn.silu(c)
    s_ctx = jax.nn.silu(c_ctx)[None]
    h, hc = x, ctx
    for i in range(DEPTH):
        last = i == DEPTH - 1
        m, j = i % N_MIXERS, i // N_MIXERS
        sh1, sc1, g1, sh2, sc2, g2 = jnp.split(s_lat @ w_ada[i] + b_ada[i], 6, -1)
        csh1, csc1, cg1, csh2, csc2, cg2 = jnp.split(s_ctx @ w_ada[i] + b_ada[i], 6, -1)
        u = modulate(h, sh1, sc1)
        uc = modulate(hc, csh1, csc1)
        if m == 0:
            y, yc = attention_mixer(u, uc, a_wqkv[j], a_qg[j], a_kg[j], a_wo[j], cos, sin, not last)
        elif m == 1:
            y = chunk_mlp(u, b_win[j], b_vg[j], b_vb[j], b_ws[j], b_bs[j], b_wout[j])
            yc = None if last else chunk_mlp(uc, b_win[j], b_vg[j], b_vb[j], b_ws[j], b_bs[j], b_wout[j])
        else:
            y, yc = deltanet_mixer(u, uc, c_win[j], c_conv[j], c_alog[j], c_dtb[j], c_ng[j], c_wout[j], not last)
        h = layer_norm(DN_ALPHA * h + g1[:, None, :] * y, ln_g[i, 0], ln_b[i, 0])
        if not last:
            hc = layer_norm(DN_ALPHA * hc + cg1[:, None, :] * yc, ln_g[i, 0], ln_b[i, 0])
        u = modulate(h, sh2, sc2)
        if last:
            y = moe_ffn(u.reshape(-1, d), w_router, router_bias, e_gate[i], e_up[i], e_down[i]).reshape(h.shape)
            h = layer_norm(DN_ALPHA * h + g2[:, None, :] * y, ln_g[i, 1], ln_b[i, 1])
        else:
            uc = modulate(hc, csh2, csc2)
            n_lat_tok = u.shape[0] * u.shape[1]
            yt = moe_ffn(jnp.concatenate([u.reshape(-1, d), uc.reshape(-1, d)], 0),
                         w_router, router_bias, e_gate[i], e_up[i], e_down[i])
            y = yt[:n_lat_tok].reshape(h.shape)
            yc = yt[n_lat_tok:].reshape(hc.shape)
            h = layer_norm(DN_ALPHA * h + g2[:, None, :] * y, ln_g[i, 1], ln_b[i, 1])
            hc = layer_norm(DN_ALPHA * hc + cg2[:, None, :] * yc, ln_g[i, 1], ln_b[i, 1])
    return h
```

```cpp
#include <hip/hip_runtime.h>
#include <cstdio>
#include <cstdint>

#ifndef MK_ONE_LAUNCH
#define MK_ONE_LAUNCH 0
#endif

#define GAS __attribute__((address_space(1)))
#define LAS __attribute__((address_space(3)))
typedef unsigned short bf16_t;
typedef short bf16x8 __attribute__((ext_vector_type(8)));
typedef short s16x4 __attribute__((ext_vector_type(4)));
typedef float f32x2 __attribute__((ext_vector_type(2)));
typedef float f32x4 __attribute__((ext_vector_type(4)));
typedef float f32x8 __attribute__((ext_vector_type(8)));
typedef float f32x16 __attribute__((ext_vector_type(16)));
typedef unsigned u32x2 __attribute__((ext_vector_type(2)));
typedef unsigned u32x4 __attribute__((ext_vector_type(4)));
typedef int i32x2 __attribute__((ext_vector_type(2)));
typedef __bf16 bf16x2_t __attribute__((ext_vector_type(2)));

constexpr int D = 1024, NBATCH = 4, SEQ = 8192, CTXL = 256;
constexpr int TLAT = NBATCH * SEQ, TCTX = NBATCH * CTXL, TT = TLAT + TCTX;
constexpr int KVLEN = CTXL + SEQ;
constexpr int NE = 16, DE = 512, NLAYER = 4;
constexpr int CW_N = 4128, CW_NPAD = 4352;
constexpr float DN_ALPHA = 1.6817928305074292f;
constexpr float EPS = 1e-6f;
constexpr int XS_ROWS = 2 * TT + NE * 256;
constexpr int NWAVES = 8, NTHR = 512;

constexpr size_t MiB = 1u << 20;
constexpr size_t WS_CTL = 0, CTL_ZERO_BYTES = 1 * MiB;
constexpr size_t WS_MOD = 1 * MiB;
constexpr size_t WS_ROPE = 2 * MiB;
constexpr size_t WS_HCTX = 6 * MiB;
constexpr size_t WS_ASG = 10 * MiB;
constexpr size_t WS_ASGW = WS_ASG + 512 * 1024;
constexpr size_t WS_POS = WS_ASGW + 512 * 1024;
constexpr size_t WS_ROWMAP = WS_POS + 512 * 1024;
constexpr size_t WS_ROWW = WS_ROWMAP + 512 * 1024;
constexpr size_t WS_AB = 13 * MiB;
constexpr size_t WS_GC = 18 * MiB;
constexpr size_t WS_BETA = 21 * MiB;
constexpr size_t WS_WQKV = 26 * MiB;
constexpr size_t WS_WO = 32 * MiB;
constexpr size_t WS_BWIN = 36 * MiB;
constexpr size_t WS_BWOUT = 40 * MiB;
constexpr size_t WS_BWS = 42 * MiB;
constexpr size_t WS_CWIN = 43 * MiB;
constexpr size_t WS_CWOUT = 52 * MiB;
constexpr size_t WS_WE1 = 54 * MiB;
constexpr size_t WS_WE2 = 86 * MiB;
constexpr size_t WS_R0 = 102 * MiB, RSZ = 66 * MiB;
constexpr size_t WS_END = WS_R0 + 8 * RSZ;
constexpr size_t WS_XS = WS_R0, WS_HID = WS_R0 + 140 * MiB, WS_Y2 = WS_R0 + 4 * RSZ;
static_assert((size_t)XS_ROWS * 2048 <= 140 * MiB && (size_t)XS_ROWS * 1024 <= 70 * MiB && WS_HID + 70 * MiB <= WS_Y2, "moe overlay");
static_assert((size_t)TT * D * 2 == RSZ, "region size");

constexpr int CW_BAR = 4096;
constexpr int CW_CNT = 16384;

constexpr int LDS_BYTES = 155648;
constexpr int MISC_OFF = LDS_BYTES - 512;
constexpr int GTAB_OFF = 131072;

#define RLX_AGENT __ATOMIC_RELAXED, __HIP_MEMORY_SCOPE_AGENT
#define LDS_WAIT() asm volatile("s_waitcnt lgkmcnt(0)" ::: "memory")
#define VM_WAIT() asm volatile("s_waitcnt vmcnt(0)" ::: "memory")
__device__ __forceinline__ unsigned pk2(float lo, float hi) { f32x2 v = {lo, hi}; bf16x2_t b = __builtin_convertvector(v, bf16x2_t); return __builtin_bit_cast(unsigned, b); }
__device__ __forceinline__ float bflo(unsigned w) { return __uint_as_float(w << 16); }
__device__ __forceinline__ float bfhi(unsigned w) { return __uint_as_float(w & 0xffff0000u); }
__device__ __forceinline__ float bf1(bf16_t b) { return __uint_as_float((unsigned)b << 16); }
__device__ __forceinline__ float wave_sum(float v) {
#pragma unroll
    for (int o = 1; o < 64; o <<= 1) v += __shfl_xor(v, o);
    return v;
}
__device__ __forceinline__ float sum16(float v) {
#pragma unroll
    for (int o = 1; o < 16; o <<= 1) v += __shfl_xor(v, o);
    return v;
}
__device__ __forceinline__ float sigmoidf_(float x) { return 1.f / (1.f + __expf(-x)); }
__device__ __forceinline__ float siluf_(float x) { return x / (1.f + __expf(-x)); }
__device__ __forceinline__ int crow(int r, int hi) { return (r & 3) + 8 * (r >> 2) + 4 * hi; }
__device__ __forceinline__ bf16x8 mk8(u32x2 lo, u32x2 hi) { u32x4 w = {lo.x, lo.y, hi.x, hi.y}; return __builtin_bit_cast(bf16x8, w); }
__device__ __forceinline__ bf16x8 mk8w(unsigned a, unsigned b, unsigned c, unsigned d) { u32x4 w = {a, b, c, d}; return __builtin_bit_cast(bf16x8, w); }
#define MFMA32(a, b, c) __builtin_amdgcn_mfma_f32_32x32x16_bf16((a), (b), (c), 0, 0, 0)

#define XB_TMO      128
#define XB_XCNT(j)  (256  + 64 * (j))
#define XB_XSUB(j)  (1280 + 64 * (j))
#define XB_XGEN(j)  (2304 + 64 * (j))
#define XB_TOP      3328
#define XB_TOPGEN   3392
#define XCD_BAR_WORDS 3456
#define XB_SPIN_CAP (1u << 18)

__device__ __forceinline__ unsigned xb_ld(unsigned* p)              { return __hip_atomic_load(p, __ATOMIC_RELAXED, __HIP_MEMORY_SCOPE_AGENT); }
__device__ __forceinline__ unsigned xb_add(unsigned* p, unsigned v) { return __hip_atomic_fetch_add(p, v, __ATOMIC_RELAXED, __HIP_MEMORY_SCOPE_AGENT); }
__device__ __forceinline__ unsigned xb_xcc_id() { return (unsigned)__builtin_amdgcn_s_getreg((3 << 11) | 20) & 0xFu; }
#define XB_SPIN(cond, bar) do { unsigned _sp = 0; while (cond) { __builtin_amdgcn_s_sleep(1); \
    if ((++_sp & 255u) == 0u) { if (xb_ld(&(bar)[XB_TMO])) break; if (_sp > XB_SPIN_CAP) { atomicAdd(&(bar)[XB_TMO], 1u); break; } } } } while (0)

struct XcdBarrier {
    unsigned* bar; unsigned x;
    volatile LAS unsigned* st;
};
__device__ __forceinline__ XcdBarrier xcd_barrier_post(unsigned* bar, volatile LAS unsigned* st, int tid) {
    XcdBarrier b; b.bar = bar; b.x = xb_xcc_id(); b.st = st;
    if (tid == 0) (void)xb_add(&bar[XB_XCNT(b.x)], 1u);
    return b;
}
__device__ __forceinline__ void xcd_barrier_complete(unsigned* bar, unsigned x, unsigned& nloc, unsigned& nx) {
    const unsigned G = gridDim.x * gridDim.y * gridDim.z;
    unsigned sum, cnt, mine, sp = 0u;
    for (;;) {
        sum = 0u; cnt = 0u; mine = 0u;
#pragma unroll
        for (unsigned j = 0; j < 16; ++j) { const unsigned c = xb_ld(&bar[XB_XCNT(j)]); sum += c; cnt += (c > 0u) ? 1u : 0u; mine = (j == x) ? c : mine; }
        if (sum == G) break;
        __builtin_amdgcn_s_sleep(1);
        if ((++sp & 255u) == 0u) { if (xb_ld(&bar[XB_TMO])) break; if (sp > XB_SPIN_CAP) { atomicAdd(&bar[XB_TMO], 1u); break; } }
    }
    nloc = mine > 0u ? mine : 1u; nx = cnt > 0u ? cnt : 1u;
}
__device__ __forceinline__ void xcd_barrier(const XcdBarrier& b, int tid) {
    asm volatile("s_waitcnt vmcnt(0)" ::: "memory");
    __syncthreads();
    if (tid == 0) {
        unsigned* bar = b.bar;
        __builtin_amdgcn_s_waitcnt(0);
        unsigned nloc = b.st[0], nx = b.st[1];
        if (nloc == 0u) { xcd_barrier_complete(bar, b.x, nloc, nx); b.st[0] = nloc; b.st[1] = nx; }
        const unsigned old = xb_add(&bar[XB_XSUB(b.x)], 1u);
        const unsigned gen = old / nloc;
        if (old + 1u == (gen + 1u) * nloc) {
            __builtin_amdgcn_fence(__ATOMIC_RELEASE, "agent");
            asm volatile("s_waitcnt vmcnt(0)" ::: "memory");
            const unsigned og = xb_add(&bar[XB_TOP], 1u);
            const unsigned tg = og / nx;
            if (og + 1u == (tg + 1u) * nx) xb_add(&bar[XB_TOPGEN], 1u);
            else XB_SPIN(xb_ld(&bar[XB_TOPGEN]) == tg, bar);
            __builtin_amdgcn_fence(__ATOMIC_ACQUIRE, "agent");
            xb_add(&bar[XB_XGEN(b.x)], 1u);
            asm volatile("s_waitcnt vmcnt(0)" ::: "memory");
        } else {
            XB_SPIN(xb_ld(&bar[XB_XGEN(b.x)]) == gen, bar);
            __builtin_amdgcn_fence(__ATOMIC_ACQUIRE, "agent");
            asm volatile("s_waitcnt vmcnt(0)" ::: "memory");
        }
    }
    __syncthreads();
}

namespace pg8 {
constexpr int BM = 256, BK = 64, HALF = 128, HTB = HALF * BK * 2, STAGE_BYTES = 8 * HTB, NXCD = 8, WGM = 8;
__host__ __device__ __forceinline__ int lds_byte(int r, int c) { const int st = (r >> 4) * 2 + (c >> 5), rr = r & 15, cc = c & 31, ob = rr * 64 + cc * 2; return st * 1024 + (ob ^ (((ob >> 9) & 1) << 5)); }
__host__ __device__ __forceinline__ void stage_rc(int b, int& R, int& C) { const int st = b / 1024, sb = b % 1024, swz = sb ^ (((sb >> 9) & 1) << 5); R = (st >> 1) * 16 + swz / 64; C = (st & 1) * 32 + (swz % 64) / 2; }
__host__ __device__ __forceinline__ int perm32(int rho) { const int n = rho >> 4, i = rho & 15; return 8 * (i >> 2) + 4 * n + (i & 3); }

struct Unit { int pm, pn, e, rowend; };
struct Gemm { const bf16_t* A; const bf16_t* Bt; int M, N, K; size_t bstride; };

struct StaticOrder {
    int nM, nN, nwg, G, c;
    __device__ void init(int M, int N, int G_, int c_) { nM = M / BM; nN = N / BM; nwg = nM * nN; G = G_; c = c_; }
    __device__ bool next(int i, Unit& u) const {
        const long L = (long)i * G + c; if (L >= nwg) return false;
        int wgid = (int)L; { const int q = nwg / NXCD, r = nwg % NXCD, xcd = wgid % NXCD, off = wgid / NXCD; wgid = (xcd < r ? xcd * (q + 1) : r * (q + 1) + (xcd - r) * q) + off; }
        const int nig = WGM * nN, gid = wgid / nig, fm = gid * WGM, gsz = (nM - fm) < WGM ? (nM - fm) : WGM;
        u.pm = fm + ((wgid % nig) % gsz); u.pn = (wgid % nig) / gsz; u.e = 0; u.rowend = 0x7fffffff; return true;
    }
};
struct GroupedOrder {
    const LAS int* TS; const LAS int* CNT; int G, c;
    __device__ bool next(int i, Unit& u) const {
        const int L = i * G + c; const int total = TS[NE] * 4; if (L >= total) return false;
        const int rt = L >> 2; int e = 0;
#pragma unroll 1
        while (rt >= TS[e + 1]) ++e;
        u.pm = rt; u.pn = L & 3; u.e = e; u.rowend = TS[e] * 256 + CNT[e]; return true;
    }
};

template <class Epi, class Sched>
__device__ __forceinline__ void gemm_phase(LAS unsigned char* lds, const Gemm g, const Sched& S, const Epi& E, const int tid) {
    const int wid = __builtin_amdgcn_readfirstlane(tid >> 6), lane = tid & 63, wr = wid >> 2, wc = wid & 3, fr = lane & 15, fq = lane >> 4;
    const int K = g.K, nt = K / BK;
    unsigned voffA[2], voffB[2];
#pragma unroll
    for (int i = 0; i < 2; ++i) { int R, C; stage_rc(tid * 16 + i * 8192, R, C); const int Rb = Epi::PERM ? ((R & ~31) + perm32(R & 31)) : R;
        voffA[i] = (unsigned)(R * K + C) * 2u; voffB[i] = (unsigned)(Rb * K + C) * 2u; }
    const size_t kstep = (size_t)(BK * 2);
    const size_t hstep = (size_t)HALF * K * 2;
    const size_t tstep = 2 * hstep;
    const unsigned ldsw = (unsigned)wid * 1024u;
    const int aoff = lds_byte(wr * 64 + fr, fq * 8), boff = lds_byte(wc * 32 + fr, fq * 8);
#define PG8_SA(b, h) (((b) * 2 + (h)) * HTB)
#define PG8_SB(b, h) ((4 + (b) * 2 + (h)) * HTB)
#define PG8_STAGE(bufoff, gbase, voff) do { _Pragma("unroll") for (int _i = 0; _i < 2; ++_i) \
        __builtin_amdgcn_global_load_lds((const unsigned*)((const char*)(gbase) + (voff)[_i]), (LAS unsigned*)(lds + (bufoff) + ldsw + _i * 8192), 16, 0, 0); } while (0)
#define PG8_LDA(dst, b, h) do { _Pragma("unroll") for (int m = 0; m < 4; ++m) _Pragma("unroll") for (int k = 0; k < 2; ++k) dst[m][k] = *(const LAS bf16x8*)(lds + PG8_SA(b, h) + aoff + m * 2048 + k * 1024); } while (0)
#define PG8_LDB(dst, b, h) do { _Pragma("unroll") for (int n = 0; n < 2; ++n) _Pragma("unroll") for (int k = 0; k < 2; ++k) dst[n][k] = *(const LAS bf16x8*)(lds + PG8_SB(b, h) + boff + n * 2048 + k * 1024); } while (0)
#define PG8_MMA(ai, bj, At, Bt) do { __builtin_amdgcn_s_setprio(1); _Pragma("unroll") for (int m = 0; m < 4; ++m) _Pragma("unroll") for (int n = 0; n < 2; ++n) _Pragma("unroll") for (int k = 0; k < 2; ++k) \
        acc[ai][bj][m][n] = __builtin_amdgcn_mfma_f32_16x16x32_bf16(Bt[n][k], At[m][k], acc[ai][bj][m][n], 0, 0, 0); __builtin_amdgcn_s_setprio(0); } while (0)
#define PG8_WAIT_V(n) asm volatile("s_waitcnt vmcnt(" #n ")" ::: "memory")
#define PG8_WAIT_L(n) asm volatile("s_waitcnt lgkmcnt(" #n ")" ::: "memory")
#define PG8_BAR __builtin_amdgcn_s_barrier()
#define PG8_SCHED __builtin_amdgcn_sched_barrier(0)
    Unit cur, nxt; int ui = 0;
    if (!S.next(0, cur)) return;
    f32x4 acc[2][2][4][2];
#pragma unroll
    for (int a = 0; a < 2; ++a)
#pragma unroll
        for (int b = 0; b < 2; ++b)
#pragma unroll
            for (int m = 0; m < 4; ++m)
#pragma unroll
                for (int n = 0; n < 2; ++n) acc[a][b][m][n] = (f32x4){0.f, 0.f, 0.f, 0.f};
    bf16x8 At[4][2], B0[2][2], B1[2][2];
    const char* cA = (const char*)g.A + (size_t)cur.pm * tstep; const char* cB = (const char*)g.Bt + (size_t)cur.e * g.bstride + (size_t)cur.pn * tstep;
    PG8_STAGE(PG8_SB(0, 0), cB, voffB); PG8_STAGE(PG8_SB(0, 1), cB + hstep, voffB); PG8_STAGE(PG8_SA(0, 0), cA, voffA); PG8_STAGE(PG8_SA(0, 1), cA + hstep, voffA);
    if (wr == 1) PG8_BAR;
    PG8_WAIT_V(2); PG8_BAR;
    PG8_STAGE(PG8_SB(1, 0), cB + kstep, voffB); PG8_STAGE(PG8_SA(1, 0), cA + kstep, voffA); PG8_STAGE(PG8_SB(1, 1), cB + hstep + kstep, voffB);
    PG8_WAIT_V(6); PG8_BAR;
    for (;;) {
        const bool has_next = S.next(ui + 1, nxt);
        const char* nA = has_next ? (const char*)g.A + (size_t)nxt.pm * tstep : cA; const char* nB = has_next ? (const char*)g.Bt + (size_t)nxt.e * g.bstride + (size_t)nxt.pn * tstep : cB;
        for (int t = 0; t < nt; t += 2) {
            const bool last = (t == nt - 2);
            const char* a1 = cA + (size_t)(t + 1) * kstep;
            const char* a2 = last ? nA : cA + (size_t)(t + 2) * kstep; const char* b2 = last ? nB : cB + (size_t)(t + 2) * kstep;
            const char* a3 = a2 + kstep; const char* b3 = b2 + kstep;
            PG8_LDB(B0, 0, 0); PG8_LDB(B1, 0, 1); PG8_SCHED; PG8_LDA(At, 0, 0); PG8_STAGE(PG8_SA(1, 1), a1 + hstep, voffA);
            PG8_WAIT_V(8); PG8_WAIT_L(0); PG8_BAR; PG8_MMA(0, 0, At, B0); PG8_MMA(0, 1, At, B1); PG8_BAR; PG8_SCHED;
            PG8_LDA(At, 0, 1); PG8_STAGE(PG8_SB(0, 0), b2, voffB); PG8_STAGE(PG8_SB(0, 1), b2 + hstep, voffB); PG8_STAGE(PG8_SA(0, 0), a2, voffA);
            PG8_WAIT_V(8); PG8_WAIT_L(0); PG8_BAR; PG8_MMA(1, 0, At, B0); PG8_MMA(1, 1, At, B1); PG8_BAR; PG8_SCHED;
            PG8_LDB(B0, 1, 0); PG8_LDB(B1, 1, 1); PG8_SCHED; PG8_LDA(At, 1, 0); PG8_STAGE(PG8_SA(0, 1), a2 + hstep, voffA);
            PG8_WAIT_V(8); PG8_WAIT_L(0); PG8_BAR; PG8_MMA(0, 0, At, B0); PG8_MMA(0, 1, At, B1); PG8_BAR; PG8_SCHED;
            PG8_LDA(At, 1, 1); PG8_STAGE(PG8_SB(1, 0), b3, voffB); PG8_STAGE(PG8_SB(1, 1), b3 + hstep, voffB); PG8_STAGE(PG8_SA(1, 0), a3, voffA);
            PG8_WAIT_V(8); PG8_WAIT_L(0); PG8_BAR; PG8_MMA(1, 0, At, B0); PG8_MMA(1, 1, At, B1); PG8_BAR; PG8_SCHED;
        }
        if (wr == 0) PG8_BAR;
        E(acc, cur, wr, wc, fr, fq);
        if (!has_next) break;
#pragma unroll
        for (int a = 0; a < 2; ++a)
#pragma unroll
            for (int b = 0; b < 2; ++b)
#pragma unroll
                for (int m = 0; m < 4; ++m)
#pragma unroll
                    for (int n = 0; n < 2; ++n) acc[a][b][m][n] = (f32x4){0.f, 0.f, 0.f, 0.f};
        cur = nxt; cA = nA; cB = nB; ++ui;
        if (wr == 1) PG8_BAR;
    }
    PG8_WAIT_V(0);
    PG8_BAR;
#undef PG8_SA
#undef PG8_SB
#undef PG8_STAGE
#undef PG8_LDA
#undef PG8_LDB
#undef PG8_MMA
#undef PG8_WAIT_V
#undef PG8_WAIT_L
#undef PG8_BAR
#undef PG8_SCHED
}
}
using pg8::Unit;

typedef f32x4 AccT[2][2][4][2];

struct EpiResid {
    static constexpr bool PERM = false;
    float* hlat; float* hctx; const float* gate;
    __device__ __forceinline__ void operator()(const AccT& acc, const Unit& u, int wr, int wc, int fr, int fq) const {
        const int mi = u.pm < 128 ? (u.pm >> 5) : 4;
        float* hb = u.pm < 128 ? hlat + (size_t)u.pm * 256 * D : hctx + (size_t)(u.pm - 128) * 256 * D;
        const int col0 = u.pn * 256 + wc * 32 + 4 * fq;
        const float* g = gate + mi * 6144 + col0;
        f32x4 gv[2][2];
#pragma unroll
        for (int bj = 0; bj < 2; ++bj)
#pragma unroll
            for (int n = 0; n < 2; ++n) gv[bj][n] = *(const f32x4*)(g + bj * 128 + n * 16);
#pragma unroll
        for (int ai = 0; ai < 2; ++ai)
#pragma unroll
            for (int m = 0; m < 4; ++m) { float* rowp = hb + (size_t)(ai * 128 + wr * 64 + m * 16 + fr) * D + col0;
#pragma unroll
                for (int bj = 0; bj < 2; ++bj)
#pragma unroll
                    for (int n = 0; n < 2; ++n) { const f32x4 hv = *(const f32x4*)(rowp + bj * 128 + n * 16); *(f32x4*)(rowp + bj * 128 + n * 16) = hv * DN_ALPHA + gv[bj][n] * acc[ai][bj][m][n]; } }
    }
};
__device__ __forceinline__ u32x4 pack8(const f32x4 a, const f32x4 b) { u32x4 w; w.x = pk2(a[0], a[1]); w.y = pk2(a[2], a[3]); w.z = pk2(b[0], b[1]); w.w = pk2(b[2], b[3]); return w; }

struct EpiQKV {
    static constexpr bool PERM = true;
    bf16_t* Q; bf16_t* Kb; bf16_t* Vb;
    __device__ __forceinline__ void operator()(const AccT& acc, const Unit& u, int wr, int wc, int fr, int fq) const {
        const int cw = wc * 32 + 8 * fq;
        bf16_t* base; size_t ld; size_t r0;
        if (u.pn < 4) { base = Q + u.pn * 256; ld = D; r0 = (size_t)u.pm * 256; }
        else { base = (u.pn == 4) ? Kb : Vb; ld = 256; r0 = u.pm < 128 ? (size_t)(u.pm >> 5) * KVLEN + CTXL + (size_t)(u.pm & 31) * 256 : (size_t)(u.pm - 128) * KVLEN; }
#pragma unroll
        for (int ai = 0; ai < 2; ++ai)
#pragma unroll
            for (int m = 0; m < 4; ++m) { bf16_t* rowp = base + (r0 + ai * 128 + wr * 64 + m * 16 + fr) * ld + cw;
#pragma unroll
                for (int bj = 0; bj < 2; ++bj) *(u32x4*)(rowp + bj * 128) = pack8(acc[ai][bj][m][0], acc[ai][bj][m][1]); }
    }
};
__device__ __forceinline__ float gelu_tanh(float x) { const float t = 1.5957691216057308f * (x + 0.044715f * x * x * x); return x / (1.f + __expf(-t)); }
struct EpiGelu {
    static constexpr bool PERM = true;
    bf16_t* O;
    __device__ __forceinline__ void operator()(const AccT& acc, const Unit& u, int wr, int wc, int fr, int fq) const {
        const int col0 = u.pn * 256 + wc * 32 + 8 * fq;
#pragma unroll
        for (int ai = 0; ai < 2; ++ai)
#pragma unroll
            for (int m = 0; m < 4; ++m) { bf16_t* rowp = O + (size_t)(u.pm * 256 + ai * 128 + wr * 64 + m * 16 + fr) * 2048 + col0;
#pragma unroll
                for (int bj = 0; bj < 2; ++bj) { f32x4 a = acc[ai][bj][m][0], b = acc[ai][bj][m][1];
#pragma unroll
                    for (int i = 0; i < 4; ++i) { a[i] = gelu_tanh(a[i]); b[i] = gelu_tanh(b[i]); }
                    *(u32x4*)(rowp + bj * 128) = pack8(a, b); } }
    }
};
struct EpiDeltaIn {
    static constexpr bool PERM = true;
    bf16_t* R1; float* AB;
    __device__ __forceinline__ void operator()(const AccT& acc, const Unit& u, int wr, int wc, int fr, int fq) const {
        if (u.pn < 16) {
            bf16_t* base = R1 + (size_t)(u.pn >> 2) * (RSZ / 2) + (u.pn & 3) * 256 + wc * 32 + 8 * fq;
#pragma unroll
            for (int ai = 0; ai < 2; ++ai)
#pragma unroll
                for (int m = 0; m < 4; ++m) { bf16_t* rowp = base + (size_t)(u.pm * 256 + ai * 128 + wr * 64 + m * 16 + fr) * D;
#pragma unroll
                    for (int bj = 0; bj < 2; ++bj) *(u32x4*)(rowp + bj * 128) = pack8(acc[ai][bj][m][0], acc[ai][bj][m][1]); }
        } else if (wc == 0) {
#pragma unroll
            for (int ai = 0; ai < 2; ++ai)
#pragma unroll
                for (int m = 0; m < 4; ++m) { float* rowp = AB + (size_t)(u.pm * 256 + ai * 128 + wr * 64 + m * 16 + fr) * 32 + 8 * fq;
                    *(f32x4*)(rowp) = acc[ai][0][m][0]; *(f32x4*)(rowp + 4) = acc[ai][0][m][1]; }
        }
    }
};
struct EpiGateUp {
    static constexpr bool PERM = true;
    bf16_t* H;
    __device__ __forceinline__ void operator()(const AccT& acc, const Unit& u, int wr, int wc, int fr, int fq) const {
        const int col0 = u.pn * 128 + wc * 32 + 8 * fq;
#pragma unroll
        for (int ai = 0; ai < 2; ++ai)
#pragma unroll
            for (int m = 0; m < 4; ++m) { bf16_t* rowp = H + (size_t)(u.pm * 256 + ai * 128 + wr * 64 + m * 16 + fr) * DE + col0;
                f32x4 a, b;
#pragma unroll
                for (int i = 0; i < 4; ++i) { a[i] = siluf_(acc[ai][0][m][0][i]) * acc[ai][1][m][0][i]; b[i] = siluf_(acc[ai][0][m][1][i]) * acc[ai][1][m][1][i]; }
                *(u32x4*)(rowp) = pack8(a, b); }
    }
};
struct EpiDown {
    static constexpr bool PERM = true;
    bf16_t* Y2; const int* rowmap; const float* roww;
    __device__ __forceinline__ void operator()(const AccT& acc, const Unit& u, int wr, int wc, int fr, int fq) const {
        const int col0 = u.pn * 256 + wc * 32 + 8 * fq;
#pragma unroll
        for (int ai = 0; ai < 2; ++ai)
#pragma unroll
            for (int m = 0; m < 4; ++m) { const int r = u.pm * 256 + ai * 128 + wr * 64 + m * 16 + fr;
                if (r < u.rowend) { const int dst = rowmap[r]; const float w = roww[r]; bf16_t* rowp = Y2 + (size_t)dst * D + col0;
#pragma unroll
                    for (int bj = 0; bj < 2; ++bj) *(u32x4*)(rowp + bj * 128) = pack8(acc[ai][bj][m][0] * w, acc[ai][bj][m][1] * w); } }
    }
};

namespace att {
constexpr int DH = 128, NW = 8, QBLK = 32, KVBLK = 64;
constexpr float SCALE = 0.088388347648318440f;
constexpr float THR = 8.f;
constexpr int LDQ = D, LDK = 256, LDO = D;
constexpr size_t SHM_V = KVBLK * DH * 2, SHM_K = KVBLK * DH * 2, SHM_ATTN = 2 * SHM_V + 2 * SHM_K + NW * 64 * 4;
#define KSWZ(row, colB) ((row) * 256 + ((colB) ^ (((row) & 7) << 4)))
#define SBAR() __builtin_amdgcn_sched_barrier(0)
__device__ __forceinline__ unsigned cvtpk(float lo, float hi) { unsigned r; asm volatile("v_cvt_pk_bf16_f32 %0, %1, %2" : "=v"(r) : "v"(lo), "v"(hi)); return r; }
__device__ __forceinline__ void partialSM(f32x16& p0, f32x16& p1, float& m_reg, float& mn, float& alpha) {
  constexpr float C = SCALE * 1.4426950408889634f;
  float pmax = p0[0]; for (int r = 1; r < 16; ++r) pmax = fmaxf(pmax, p0[r]); for (int r = 0; r < 16; ++r) pmax = fmaxf(pmax, p1[r]);
  { auto rr = __builtin_amdgcn_permlane32_swap(__float_as_uint(pmax), __float_as_uint(pmax), false, false);
    pmax = fmaxf(__uint_as_float(rr[0]), __uint_as_float(rr[1])); }
  if (__builtin_expect(__all(pmax - m_reg <= THR / SCALE), 1)) { mn = m_reg; alpha = 1.f; }
  else { mn = fmaxf(m_reg, pmax); alpha = __builtin_amdgcn_exp2f((m_reg - mn) * C); m_reg = mn; }
  float mnC = -mn * C;
  for (int r = 0; r < 16; ++r) p0[r] = fmaf(p0[r], C, mnC); for (int r = 0; r < 16; ++r) p1[r] = fmaf(p1[r], C, mnC);
  for (int r = 0; r < 16; ++r) p0[r] = __builtin_amdgcn_exp2f(p0[r]);
}
__device__ __forceinline__ void finishSM(f32x16& p0, f32x16& p1, float alpha, float& l_reg, bf16x8& pa0, bf16x8& pa1, bf16x8& pa2, bf16x8& pa3) {
  for (int r = 0; r < 16; ++r) p1[r] = __builtin_amdgcn_exp2f(p1[r]);
  float ps = 0; for (int r = 0; r < 16; ++r) ps += p0[r]; for (int r = 0; r < 16; ++r) ps += p1[r];
  { auto rr = __builtin_amdgcn_permlane32_swap(__float_as_uint(ps), __float_as_uint(ps), false, false);
    ps = __uint_as_float(rr[0]) + __uint_as_float(rr[1]); }
  l_reg = l_reg * alpha + ps;
#define PK4(P, BASE, OUT) do { unsigned a0 = cvtpk(P[BASE + 0], P[BASE + 1]), a1 = cvtpk(P[BASE + 2], P[BASE + 3]);   \
    unsigned b0 = cvtpk(P[BASE + 4], P[BASE + 5]), b1 = cvtpk(P[BASE + 6], P[BASE + 7]);                              \
    auto r0 = __builtin_amdgcn_permlane32_swap(a0, b0, false, false); auto r1 = __builtin_amdgcn_permlane32_swap(a1, b1, false, false); \
    u32x4 w = {r0[0], r1[0], r0[1], r1[1]}; OUT = *reinterpret_cast<bf16x8*>(&w); } while (0)
  PK4(p0, 0, pa0); PK4(p0, 8, pa1); PK4(p1, 0, pa2); PK4(p1, 8, pa3);
#undef PK4
}
__device__ __forceinline__ void qkt(f32x16& p0, f32x16& p1, const bf16_t* Ks, const bf16x8* qr, int r32, int hi) {
  p0 = f32x16{}; p1 = f32x16{};
  for (int d0 = 0; d0 < 8; ++d0) { int cb = (d0 * 16 + hi * 8) * 2;
    bf16x8 b0 = *reinterpret_cast<const bf16x8*>((const char*)Ks + KSWZ(r32, cb));
    bf16x8 b1 = *reinterpret_cast<const bf16x8*>((const char*)Ks + KSWZ(32 + r32, cb));
    p0 = __builtin_amdgcn_mfma_f32_32x32x16_bf16(b0, qr[d0], p0, 0, 0, 0);
    p1 = __builtin_amdgcn_mfma_f32_32x32x16_bf16(b1, qr[d0], p1, 0, 0, 0); }
}
__device__ __forceinline__ int v_st(int k, int c) { const int kk = (k & ~0xC) | ((k & 4) << 1) | ((k & 8) >> 1); return ((kk >> 3) * 4 + (c >> 5)) * 512 + ((kk & 7) * 32 + (c & 31)) * 2; }
__device__ __forceinline__ int v_rd_base(int lane) { return ((lane & 3) << 3) | (((lane >> 2) & 3) << 6) | (((lane >> 4) & 1) << 5) | (((lane >> 5) & 1) << 8); }
constexpr int v_rd_off(int d0, int ks, int half) { return d0 * 512 + ks * 4096 + half * 2048; }
template <int OFF> __device__ __forceinline__ s16x4 tr_read(int vb) {
  s16x4 r; asm volatile("ds_read_b64_tr_b16 %0, %1 offset:%2" : "=&v"(r) : "v"(vb), "i"(OFF) : "memory"); return r;
}
template <int D0> __device__ __forceinline__ void pv_one(f32x16& od, int vb, bf16x8 pa0, bf16x8 pa1, bf16x8 pa2, bf16x8 pa3) {
  const s16x4 l0 = tr_read<v_rd_off(D0, 0, 0)>(vb), h0 = tr_read<v_rd_off(D0, 0, 1)>(vb), l1 = tr_read<v_rd_off(D0, 1, 0)>(vb), h1 = tr_read<v_rd_off(D0, 1, 1)>(vb);
  const s16x4 l2 = tr_read<v_rd_off(D0, 2, 0)>(vb), h2 = tr_read<v_rd_off(D0, 2, 1)>(vb), l3 = tr_read<v_rd_off(D0, 3, 0)>(vb), h3 = tr_read<v_rd_off(D0, 3, 1)>(vb);
  asm volatile("s_waitcnt lgkmcnt(0)" ::: "memory"); SBAR();
#define PK(L, H) (bf16x8){L[0], L[1], L[2], L[3], H[0], H[1], H[2], H[3]}
  od = __builtin_amdgcn_mfma_f32_32x32x16_bf16(pa0, PK(l0, h0), od, 0, 0, 0);
  od = __builtin_amdgcn_mfma_f32_32x32x16_bf16(pa1, PK(l1, h1), od, 0, 0, 0);
  od = __builtin_amdgcn_mfma_f32_32x32x16_bf16(pa2, PK(l2, h2), od, 0, 0, 0);
  od = __builtin_amdgcn_mfma_f32_32x32x16_bf16(pa3, PK(l3, h3), od, 0, 0, 0);
#undef PK
}
__device__ __forceinline__ void pv_d0(f32x16* o, int vb, bf16x8 pa0, bf16x8 pa1, bf16x8 pa2, bf16x8 pa3) {
  pv_one<0>(o[0], vb, pa0, pa1, pa2, pa3); pv_one<1>(o[1], vb, pa0, pa1, pa2, pa3); pv_one<2>(o[2], vb, pa0, pa1, pa2, pa3); pv_one<3>(o[3], vb, pa0, pa1, pa2, pa3);
}
__device__ __forceinline__ void attn_dense_body(const bf16_t* Qb, const bf16_t* __restrict__ Kh, const bf16_t* __restrict__ Vh, bf16_t* Ob, int seq, char* lds, const int tid) {
  constexpr int SDEPTH = 2;
  const int wid = tid >> 6, lane = tid & 63, r32 = lane & 31, hi = lane >> 5;
  bf16_t* V_lds = (bf16_t*)lds; bf16_t* K_lds = (bf16_t*)(lds + 2 * SHM_V);
  float* ws = (float*)(lds + 2 * SHM_V + 2 * SHM_K) + wid * 64; float* li_l = ws; float* al_l = ws + 32;
  float m_reg = -1e30f, l_reg = 0; f32x16 o[4] = {}; bf16x8 qr[8];
  const bf16_t* Qw = Qb + (long)(wid * QBLK + r32) * LDQ + hi * 8;
#pragma unroll
  for (int d0 = 0; d0 < 8; ++d0) qr[d0] = *reinterpret_cast<const bf16x8*>(Qw + d0 * 16);
  const int sr = tid >> 4, sc = (tid & 15) * 8, vst0 = v_st(sr, sc), vst1 = v_st(32 + sr, sc);
  const int vb0 = (int)(uintptr_t)V_lds + v_rd_base(lane);
  struct { bf16x8 vs0, vs1, ks0, ks1; } sr_[SDEPTH];
#define SLOAD(i, k0) do { sr_[i].vs0 = *reinterpret_cast<const bf16x8*>(&Vh[(long)((k0) + sr) * LDK + sc]); sr_[i].vs1 = *reinterpret_cast<const bf16x8*>(&Vh[(long)((k0) + 32 + sr) * LDK + sc]); \
    sr_[i].ks0 = *reinterpret_cast<const bf16x8*>(&Kh[(long)((k0) + sr) * LDK + sc]); sr_[i].ks1 = *reinterpret_cast<const bf16x8*>(&Kh[(long)((k0) + 32 + sr) * LDK + sc]); } while (0)
#define SWRITE(b, i) do { *(bf16x8*)((char*)V_lds + (b) * SHM_V + vst0) = sr_[i].vs0;          \
    *(bf16x8*)((char*)V_lds + (b) * SHM_V + vst1) = sr_[i].vs1; int kc = sc * 2;               \
    *(bf16x8*)((char*)K_lds + (b) * SHM_K + KSWZ(sr, kc)) = sr_[i].ks0;                       \
    *(bf16x8*)((char*)K_lds + (b) * SHM_K + KSWZ(32 + sr, kc)) = sr_[i].ks1; } while (0)
#define SWAIT() do { asm volatile("s_waitcnt vmcnt(4)" ::: "memory"); } while (0)
#define RESC(a) do { if (__any((a) < 1.f)) { if (hi == 0) al_l[r32] = (a); asm volatile("s_waitcnt lgkmcnt(0)" ::: "memory"); \
    for (int d = 0; d < 4; ++d) for (int r = 0; r < 16; ++r) o[d][r] *= al_l[crow(r, hi)]; } } while (0)
  f32x16 pA0, pA1, pB0, pB1; float mnA, mnB, alA, alB; bf16x8 pa0, pa1, pa2, pa3; const int NT = seq / KVBLK;
  constexpr int SE = 0, SO = SDEPTH - 1;
  SLOAD(SE, 0); asm volatile("s_waitcnt vmcnt(0)" ::: "memory"); SWRITE(0, SE); __syncthreads();
  qkt(pA0, pA1, K_lds, qr, r32, hi); partialSM(pA0, pA1, m_reg, mnA, alA);
  SLOAD(SO, KVBLK); if (2 < NT) SLOAD(SE, 2 * KVBLK);
  SWAIT(); SWRITE(1, SO); __syncthreads();
  for (int j = 1; j + 1 < NT; j += 2) {
    SBAR(); qkt(pB0, pB1, (bf16_t*)((char*)K_lds + SHM_K), qr, r32, hi);
    finishSM(pA0, pA1, alA, l_reg, pa0, pa1, pa2, pa3); SBAR();
    SLOAD(SO, (j + SDEPTH) * KVBLK); SBAR();
    pv_d0(o, vb0, pa0, pa1, pa2, pa3); partialSM(pB0, pB1, m_reg, mnB, alB);
    __syncthreads(); SWAIT(); SWRITE(0, SE);
    RESC(alB); __syncthreads();
    SBAR(); qkt(pA0, pA1, K_lds, qr, r32, hi);
    finishSM(pB0, pB1, alB, l_reg, pa0, pa1, pa2, pa3); SBAR();
    if (j + 3 < NT) SLOAD(SE, (j + 1 + SDEPTH) * KVBLK); SBAR();
    pv_d0(o, vb0 + (int)SHM_V, pa0, pa1, pa2, pa3); partialSM(pA0, pA1, m_reg, mnA, alA);
    __syncthreads(); SWAIT(); SWRITE(1, SO);
    RESC(alA); __syncthreads();
  }
  SBAR(); qkt(pB0, pB1, (bf16_t*)((char*)K_lds + SHM_K), qr, r32, hi);
  finishSM(pA0, pA1, alA, l_reg, pa0, pa1, pa2, pa3); SBAR();
  pv_d0(o, vb0, pa0, pa1, pa2, pa3); partialSM(pB0, pB1, m_reg, mnB, alB);
  __syncthreads(); RESC(alB);
  finishSM(pB0, pB1, alB, l_reg, pa0, pa1, pa2, pa3); SBAR();
  pv_d0(o, vb0 + (int)SHM_V, pa0, pa1, pa2, pa3);
  if (hi == 0) li_l[r32] = l_reg; asm volatile("s_waitcnt lgkmcnt(0)" ::: "memory");
  float rli[16];
#pragma unroll
  for (int r = 0; r < 16; ++r) rli[r] = __builtin_amdgcn_rcpf(li_l[crow(r, hi)]);
  bf16_t* Ow = Ob + (long)(wid * QBLK) * LDO;
#pragma unroll
  for (int r = 0; r < 16; ++r) { int orow = crow(r, hi);
#pragma unroll
    for (int d0 = 0; d0 < 4; ++d0) Ow[(long)orow * LDO + d0 * 32 + r32] = (bf16_t)(pk2(o[d0][r] * rli[r], 0.f) & 0xffffu); }
  asm volatile("s_waitcnt vmcnt(0) lgkmcnt(0)" ::: "memory"); __syncthreads();
#undef SLOAD
#undef SWRITE
#undef SWAIT
#undef RESC
}
}

struct Args {
    const float* in[29]; float* out; unsigned char* ws; int ph_lo, ph_hi;
};
enum { I_X = 0, I_C, I_CTX, I_CCTX, I_WADA, I_BADA, I_LNG, I_LNB, I_AWQKV, I_AQG, I_AKG, I_AWO, I_BWIN, I_BVG, I_BVB, I_BWS, I_BBS, I_BWOUT,
       I_CWIN, I_CCONV, I_CALOG, I_CDTB, I_CNG, I_CWOUT, I_WROUTER, I_RBIAS, I_EGATE, I_EUP, I_EDOWN };

struct Frame {
    LAS unsigned char* lds; char* ldsg;
    int tid, lane, wave, bid, G, gw, NGW;
    const Args* a;
    unsigned char* ws; float* out;
};
#define FRAME_REFRESH(F) do { int l_; asm volatile("v_mbcnt_lo_u32_b32 %0, -1, 0\n\tv_mbcnt_hi_u32_b32 %0, -1, %0" : "=v"(l_)); (F).lane = l_; (F).tid = (F).wave * 64 + l_; } while (0)
__device__ __forceinline__ float* hrow(const Frame& F, int t) { return t < TLAT ? F.out + (size_t)t * D : (float*)(F.ws + WS_HCTX) + (size_t)(t - TLAT) * D; }
__device__ __forceinline__ bf16_t* RG(const Frame& F, int i) { return (bf16_t*)(F.ws + WS_R0 + (size_t)i * RSZ); }
__device__ __forceinline__ const float* modrow(const Frame& F, int layer, int mi) { return (const float*)(F.ws + WS_MOD) + (size_t)(layer * 5 + mi) * 6144; }

__device__ __forceinline__ void transpose_item(const float* W, size_t sld, bf16_t* WT, size_t dld, int drow0, int k0, int n0, LAS float* scr, int lane) {
#pragma unroll 8
    for (int i = 0; i < 32; ++i) { const int kk = 2 * i + (lane >> 5); scr[kk * 33 + (lane & 31)] = W[(size_t)(k0 + kk) * sld + n0 + (lane & 31)]; }
    LDS_WAIT(); asm volatile("" ::: "memory");
    const int c = lane & 7;
#pragma unroll
    for (int j = 0; j < 4; ++j) { const int n = (lane >> 3) + 8 * j; const LAS float* s = scr + (8 * c) * 33 + n;
        u32x4 o; o.x = pk2(s[0 * 33], s[1 * 33]); o.y = pk2(s[2 * 33], s[3 * 33]); o.z = pk2(s[4 * 33], s[5 * 33]); o.w = pk2(s[6 * 33], s[7 * 33]);
        *(u32x4*)(WT + (size_t)(drow0 + n) * dld + k0 + 8 * c) = o; }
    LDS_WAIT(); asm volatile("" ::: "memory");
}
__device__ __forceinline__ bool dense_item(int& r, const float* W, int K, int N, bf16_t* WT, LAS float* scr, int lane) {
    const int nblk = N / 32, items = (K / 64) * nblk;
    if (r >= items) { r -= items; return false; }
    const int kb = r / nblk, nb = r % nblk;
    transpose_item(W, (size_t)N, WT, (size_t)K, 32 * nb, 64 * kb, 32 * nb, scr, lane);
    return true;
}
__device__ __forceinline__ void p0_prologue(Frame& F) {
    const Args& A = *F.a;
    LAS float* scr = (LAS float*)(F.lds + F.wave * 16384);
    constexpr int NITEMS = 2 * (16 * 48) + 2 * (16 * 32) + 16 * 64 + 16 * 32 + 16 * 129 + 16 * 32;
    for (int it = F.gw; it < NITEMS; it += F.NGW) {
        int r = it;
        if (dense_item(r, A.in[I_AWQKV], D, 1536, (bf16_t*)(F.ws + WS_WQKV), scr, F.lane)) continue;
        if (dense_item(r, A.in[I_AWQKV] + (size_t)D * 1536, D, 1536, (bf16_t*)(F.ws + WS_WQKV) + (size_t)1536 * D, scr, F.lane)) continue;
        if (dense_item(r, A.in[I_AWO], D, D, (bf16_t*)(F.ws + WS_WO), scr, F.lane)) continue;
        if (dense_item(r, A.in[I_AWO] + (size_t)D * D, D, D, (bf16_t*)(F.ws + WS_WO) + (size_t)D * D, scr, F.lane)) continue;
        if (dense_item(r, A.in[I_BWIN], D, 2048, (bf16_t*)(F.ws + WS_BWIN), scr, F.lane)) continue;
        if (dense_item(r, A.in[I_BWOUT], D, D, (bf16_t*)(F.ws + WS_BWOUT), scr, F.lane)) continue;
        if (dense_item(r, A.in[I_CWIN], D, CW_N, (bf16_t*)(F.ws + WS_CWIN), scr, F.lane)) continue;
        dense_item(r, A.in[I_CWOUT], D, D, (bf16_t*)(F.ws + WS_CWOUT), scr, F.lane);
    }
    const int gt = F.bid * NTHR + F.tid, NGT = F.G * NTHR;
    { u32x4* z = (u32x4*)((bf16_t*)(F.ws + WS_CWIN) + (size_t)CW_N * D); const int n16 = (CW_NPAD - CW_N) * D * 2 / 16;
      for (int i = gt; i < n16; i += NGT) z[i] = (u32x4){0u, 0u, 0u, 0u}; }
    { const float* s = A.in[I_BWS]; unsigned* d = (unsigned*)(F.ws + WS_BWS);
      for (int i = gt; i < 8 * 128 * 128 / 2; i += NGT) d[i] = pk2(s[2 * i], s[2 * i + 1]); }
    { f32x2* rt = (f32x2*)(F.ws + WS_ROPE);
      for (int i = gt; i < SEQ * 64; i += NGT) { const int n = i >> 6, p = i & 63; const int pp = p & 31;
        const float inv = 1.0f / powf(10000.0f, (float)(2 * pp) / 64.0f);
        const float pos = (p < 32) ? (float)(n >> 6) : (float)(n & 63);
        const float ang = pos * inv; float sn, cs; sincosf(ang, &sn, &cs); rt[i] = (f32x2){cs, sn}; } }
    __syncthreads();
    if (F.bid < 96) {
        LAS float* sc = (LAS float*)F.lds;
        LAS f32x4* red = (LAS f32x4*)(F.lds + 32768);
        for (int i = F.tid; i < 5 * D; i += NTHR) { const float v = (i < 4 * D) ? A.in[I_C][i] : A.in[I_CCTX][i - 4 * D]; sc[i] = siluf_(v); }
        __syncthreads();
        for (int item = F.bid; item < 96; item += F.G) {
            const int l = item / 24, cb = item % 24, col0 = cb * 256 + 4 * F.lane;
            const float* wp = A.in[I_WADA] + ((size_t)l * D + F.wave * 128) * 6144 + col0;
            f32x4 acc[5];
#pragma unroll
            for (int mi = 0; mi < 5; ++mi) acc[mi] = (f32x4){0.f, 0.f, 0.f, 0.f};
#pragma unroll 8
            for (int k = 0; k < 128; ++k) { const f32x4 w = *(const f32x4*)(wp + (size_t)k * 6144);
#pragma unroll
                for (int mi = 0; mi < 5; ++mi) acc[mi] += w * sc[mi * D + F.wave * 128 + k]; }
#pragma unroll
            for (int mi = 0; mi < 5; ++mi) red[(F.wave * 5 + mi) * 64 + F.lane] = acc[mi];
            __syncthreads();
            for (int o = F.tid; o < 5 * 256; o += NTHR) { const int mi = o >> 8, c = o & 255; float s = A.in[I_BADA][l * 6144 + cb * 256 + c];
                const LAS float* rf = (const LAS float*)red;
#pragma unroll
                for (int w = 0; w < 8; ++w) s += rf[((w * 5 + mi) * 64 + (c >> 2)) * 4 + (c & 3)];
                ((float*)(F.ws + WS_MOD))[(size_t)(l * 5 + mi) * 6144 + cb * 256 + c] = s; }
            __syncthreads();
        }
    }
}
__device__ __forceinline__ void p1_init(Frame& F) {
    const Args& A = *F.a; bf16_t* U = RG(F, 0);
    for (int t = F.gw; t < TT; t += F.NGW) {
        const float* src = t < TLAT ? A.in[I_X] + (size_t)t * D : A.in[I_CTX] + (size_t)(t - TLAT) * D;
        float* hp = hrow(F, t); const int mi = t < TLAT ? (t >> 13) : 4; const float* mp = modrow(F, 0, mi);
#pragma unroll
        for (int j = 0; j < 4; ++j) { const int col = 256 * j + 4 * F.lane; const f32x4 v = *(const f32x4*)(src + col);
            *(f32x4*)(hp + col) = v;
            const f32x4 sh = *(const f32x4*)(mp + col), sc = *(const f32x4*)(mp + 1024 + col); const f32x4 u = v * (sc + 1.0f) + sh;
            *(u32x2*)(U + (size_t)t * D + col) = (u32x2){pk2(u[0], u[1]), pk2(u[2], u[3])}; }
    }
}

__device__ __forceinline__ void moe_route(Frame& F, int layer, int nrows) {
    const Args& A = *F.a;
    { LAS float* scr = (LAS float*)(F.lds + F.wave * 16384);
      const float* eg = A.in[I_EGATE] + (size_t)layer * NE * D * DE; const float* eu = A.in[I_EUP] + (size_t)layer * NE * D * DE; const float* ed = A.in[I_EDOWN] + (size_t)layer * NE * DE * D;
      bf16_t* W1 = (bf16_t*)(F.ws + WS_WE1); bf16_t* W2 = (bf16_t*)(F.ws + WS_WE2);
      for (int it = F.gw; it < NE * 768; it += F.NGW) { const int e = it / 768, r = it % 768;
        if (r < 512) { const int up = r >> 8, q = r & 255, kb = q >> 4, nb = q & 15, n0 = 32 * nb;
            transpose_item((up ? eu : eg) + (size_t)e * D * DE, DE, W1 + (size_t)e * D * D, D, (n0 >> 7) * 256 + (n0 & 127) + up * 128, 64 * kb, n0, scr, F.lane); }
        else { const int q = r - 512, kb = q >> 5, nb = q & 31;
            transpose_item(ed + (size_t)e * DE * D, D, W2 + (size_t)e * D * DE, DE, 32 * nb, 64 * kb, 32 * nb, scr, F.lane); } }
    }
    __syncthreads();
    LAS float* WR = (LAS float*)F.lds;
    LAS int* CNT = (LAS int*)(F.lds + 65536); LAS int* BASE = CNT + 16; LAS int* EID = CNT + 64; LAS int* RK = EID + 2 * 272; LAS float* WT = (LAS float*)(RK + 2 * 272);
    for (int idx = F.tid; idx < D * NE; idx += NTHR) { const int k = idx >> 4, e = idx & 15, j = k >> 8, ln = (k >> 2) & 63, i = k & 3, q = e >> 2;
        WR[((((j * 4 + i) * 4 + q) * 64 + ln) << 2) + (e & 3)] = A.in[I_WROUTER][idx]; }
    if (F.tid < 16) CNT[F.tid] = 0;
    __syncthreads();
    const int per = (nrows + F.G - 1) / F.G, r0 = F.bid * per, r1 = (r0 + per < nrows) ? r0 + per : nrows;
    const float* lg = A.in[I_LNG] + (size_t)(layer * 2 + 0) * D; const float* lb = A.in[I_LNB] + (size_t)(layer * 2 + 0) * D;
    float rb[16];
#pragma unroll
    for (int e = 0; e < 16; ++e) rb[e] = A.in[I_RBIAS][e];
    for (int t = r0 + F.wave; t < r1; t += NWAVES) {
        FRAME_REFRESH(F);
        float* hp = hrow(F, t); const int mi = t < TLAT ? (t >> 13) : 4; const float* mp = modrow(F, layer, mi);
        f32x4 v[4]; float s = 0.f;
#pragma unroll
        for (int j = 0; j < 4; ++j) { v[j] = *(const f32x4*)(hp + 256 * j + 4 * F.lane); s += (v[j][0] + v[j][1]) + (v[j][2] + v[j][3]); }
        const float mean = wave_sum(s) * (1.f / D); float s2 = 0.f;
#pragma unroll
        for (int j = 0; j < 4; ++j) { v[j] = v[j] - mean; s2 += (v[j][0] * v[j][0] + v[j][1] * v[j][1]) + (v[j][2] * v[j][2] + v[j][3] * v[j][3]); }
        const float rstd = 1.f / sqrtf(wave_sum(s2) * (1.f / D) + EPS);
        float acc[16];
#pragma unroll
        for (int e = 0; e < 16; ++e) acc[e] = 0.f;
#pragma unroll
        for (int j = 0; j < 4; ++j) { const int col = 256 * j + 4 * F.lane;
            const f32x4 hn = v[j] * rstd * *(const f32x4*)(lg + col) + *(const f32x4*)(lb + col);
            *(f32x4*)(hp + col) = hn;
            const f32x4 u2 = hn * (*(const f32x4*)(mp + 4096 + col) + 1.0f) + *(const f32x4*)(mp + 3072 + col);
#pragma unroll
            for (int i = 0; i < 4; ++i)
#pragma unroll
                for (int q = 0; q < 4; ++q) { const f32x4 w = *(const LAS f32x4*)(WR + ((((j * 4 + i) * 4 + q) * 64 + F.lane) << 2));
                    acc[4 * q + 0] += u2[i] * w[0]; acc[4 * q + 1] += u2[i] * w[1]; acc[4 * q + 2] += u2[i] * w[2]; acc[4 * q + 3] += u2[i] * w[3]; } }
        float sc[16], sel[16];
#pragma unroll
        for (int e = 0; e < 16; ++e) { acc[e] = wave_sum(acc[e]); sc[e] = 1.f / (1.f + expf(-acc[e])); sel[e] = sc[e] + rb[e]; }
        float gs[4];
#pragma unroll
        for (int g = 0; g < 4; ++g) { const float a = sel[4 * g], b = sel[4 * g + 1], c = sel[4 * g + 2], d = sel[4 * g + 3];
            const float hi1 = fmaxf(a, b), lo1 = fminf(a, b), hi2 = fmaxf(c, d), lo2 = fminf(c, d);
            const float m1 = fmaxf(hi1, hi2), m2 = fmaxf(fminf(hi1, hi2), fmaxf(lo1, lo2)); gs[g] = m1 + m2; }
        int bg = 0; float bgs = gs[0];
#pragma unroll
        for (int g = 1; g < 4; ++g) if (gs[g] > bgs) { bgs = gs[g]; bg = g; }
        float s4[4], c4[4];
#pragma unroll
        for (int i = 0; i < 4; ++i) { s4[i] = bg == 0 ? sel[i] : bg == 1 ? sel[4 + i] : bg == 2 ? sel[8 + i] : sel[12 + i]; c4[i] = bg == 0 ? sc[i] : bg == 1 ? sc[4 + i] : bg == 2 ? sc[8 + i] : sc[12 + i]; }
        int i1 = 0; float b1 = s4[0], w1 = c4[0];
#pragma unroll
        for (int i = 1; i < 4; ++i) if (s4[i] > b1) { b1 = s4[i]; i1 = i; w1 = c4[i]; }
        int i2 = -1; float b2 = -3.0e38f, w2 = 0.f;
#pragma unroll
        for (int i = 0; i < 4; ++i) if (i != i1 && s4[i] > b2) { b2 = s4[i]; i2 = i; w2 = c4[i]; }
        const int e1 = bg * 4 + i1, e2 = bg * 4 + i2; const float wn = 1.f / (w1 + w2);
        if (F.lane == 0) { const int rl = t - r0;
            const int k1 = __hip_atomic_fetch_add(CNT + e1, 1, __ATOMIC_RELAXED, __HIP_MEMORY_SCOPE_WORKGROUP);
            const int k2 = __hip_atomic_fetch_add(CNT + e2, 1, __ATOMIC_RELAXED, __HIP_MEMORY_SCOPE_WORKGROUP);
            EID[2 * rl] = e1; EID[2 * rl + 1] = e2; RK[2 * rl] = k1; RK[2 * rl + 1] = k2; WT[2 * rl] = w1 * wn; WT[2 * rl + 1] = w2 * wn; }
    }
    FRAME_REFRESH(F);
    __syncthreads();
    if (F.tid < 16) BASE[F.tid] = (int)__hip_atomic_fetch_add((unsigned*)(F.ws + WS_CTL) + CW_CNT + layer * 16 + F.tid, (unsigned)CNT[F.tid], RLX_AGENT);
    __syncthreads();
    for (int rl = F.tid; rl < r1 - r0; rl += NTHR) { const int t = r0 + rl; const int e1 = EID[2 * rl], e2 = EID[2 * rl + 1];
        ((i32x2*)(F.ws + WS_ASG))[t] = (i32x2){e1, e2}; ((f32x2*)(F.ws + WS_ASGW))[t] = (f32x2){WT[2 * rl], WT[2 * rl + 1]};
        ((i32x2*)(F.ws + WS_POS))[t] = (i32x2){BASE[e1] + RK[2 * rl], BASE[e2] + RK[2 * rl + 1]}; }
}
__device__ __forceinline__ void moe_tables(Frame& F, int layer) {
    LAS int* TS = (LAS int*)(F.lds + GTAB_OFF); LAS int* CN = TS + 32;
    if (F.tid == 0) { const unsigned* gc = (const unsigned*)(F.ws + WS_CTL) + CW_CNT + layer * 16; int acc = 0;
        for (int e = 0; e < NE; ++e) { const int c = (int)gc[e]; TS[e] = acc; CN[e] = c; acc += (c + 255) >> 8; } TS[NE] = acc; }
    __syncthreads();
}
__device__ __forceinline__ void moe_scatter(Frame& F, int layer, int nrows) {
    moe_tables(F, layer);
    const LAS int* TS = (const LAS int*)(F.lds + GTAB_OFF);
    bf16_t* XS = (bf16_t*)(F.ws + WS_XS); int* rowmap = (int*)(F.ws + WS_ROWMAP); float* roww = (float*)(F.ws + WS_ROWW);
    for (int t = F.gw; t < nrows; t += F.NGW) {
        const float* hp = hrow(F, t); const int mi = t < TLAT ? (t >> 13) : 4; const float* mp = modrow(F, layer, mi);
        const i32x2 ee = ((const i32x2*)(F.ws + WS_ASG))[t]; const i32x2 pp = ((const i32x2*)(F.ws + WS_POS))[t]; const f32x2 ww = ((const f32x2*)(F.ws + WS_ASGW))[t];
        const int d0 = TS[ee.x] * 256 + pp.x, d1 = TS[ee.y] * 256 + pp.y;
#pragma unroll
        for (int j = 0; j < 4; ++j) { const int col = 256 * j + 4 * F.lane; const f32x4 hn = *(const f32x4*)(hp + col);
            const f32x4 u = hn * (*(const f32x4*)(mp + 4096 + col) + 1.0f) + *(const f32x4*)(mp + 3072 + col);
            const u32x2 w = {pk2(u[0], u[1]), pk2(u[2], u[3])};
            *(u32x2*)(XS + (size_t)d0 * D + col) = w; *(u32x2*)(XS + (size_t)d1 * D + col) = w; }
        if (F.lane == 0) { rowmap[d0] = 2 * t; rowmap[d1] = 2 * t + 1; roww[d0] = ww.x; roww[d1] = ww.y; }
    }
}
__device__ __forceinline__ void moe_ln2(Frame& F, int layer, int nrows, bool last) {
    const Args& A = *F.a; const bf16_t* Y2 = (const bf16_t*)(F.ws + WS_Y2); bf16_t* U = RG(F, 0);
    const float* lg = A.in[I_LNG] + (size_t)(layer * 2 + 1) * D; const float* lb = A.in[I_LNB] + (size_t)(layer * 2 + 1) * D;
    for (int t = F.gw; t < nrows; t += F.NGW) {
        float* hp = hrow(F, t); const int mi = t < TLAT ? (t >> 13) : 4; const float* mp = modrow(F, layer, mi);
        f32x4 v[4]; float s = 0.f;
#pragma unroll
        for (int j = 0; j < 4; ++j) { const int col = 256 * j + 4 * F.lane; const f32x4 hv = *(const f32x4*)(hp + col);
            const u32x2 ya = *(const u32x2*)(Y2 + (size_t)(2 * t) * D + col), yb = *(const u32x2*)(Y2 + (size_t)(2 * t + 1) * D + col);
            const f32x4 y = {bflo(ya.x) + bflo(yb.x), bfhi(ya.x) + bfhi(yb.x), bflo(ya.y) + bflo(yb.y), bfhi(ya.y) + bfhi(yb.y)};
            v[j] = hv * DN_ALPHA + *(const f32x4*)(mp + 5120 + col) * y; s += (v[j][0] + v[j][1]) + (v[j][2] + v[j][3]); }
        const float mean = wave_sum(s) * (1.f / D); float s2 = 0.f;
#pragma unroll
        for (int j = 0; j < 4; ++j) { v[j] = v[j] - mean; s2 += (v[j][0] * v[j][0] + v[j][1] * v[j][1]) + (v[j][2] * v[j][2] + v[j][3] * v[j][3]); }
        const float rstd = 1.f / sqrtf(wave_sum(s2) * (1.f / D) + EPS);
        const float* mn = modrow(F, last ? layer : layer + 1, mi);
#pragma unroll
        for (int j = 0; j < 4; ++j) { const int col = 256 * j + 4 * F.lane;
            const f32x4 hn = v[j] * rstd * *(const f32x4*)(lg + col) + *(const f32x4*)(lb + col);
            *(f32x4*)(hp + col) = hn;
            if (!last) { const f32x4 u = hn * (*(const f32x4*)(mn + 1024 + col) + 1.0f) + *(const f32x4*)(mn + col);
                *(u32x2*)(U + (size_t)t * D + col) = (u32x2){pk2(u[0], u[1]), pk2(u[2], u[3])}; } }
    }
}

__device__ __forceinline__ void qk_norm_rope(Frame& F, int j, const pg8::StaticOrder& S) {
    const Args& A = *F.a; const float* qg = A.in[I_AQG] + j * 128; const float* kg = A.in[I_AKG] + j * 128;
    bf16_t* Q = RG(F, 1); bf16_t* Kb = RG(F, 2); const f32x2* rope = (const f32x2*)(F.ws + WS_ROPE);
    const int sub = F.lane >> 4, l16 = F.lane & 15;
    Unit u;
    for (int i = 0; S.next(i, u); ++i) {
        if (u.pn >= 5) continue;
        const float* gn = u.pn < 4 ? qg : kg;
        float gv[8];
#pragma unroll
        for (int e = 0; e < 8; ++e) gv[e] = gn[l16 * 8 + e];
        bf16_t* base; size_t ld; size_t r0;
        if (u.pn < 4) { base = Q + u.pn * 256; ld = D; r0 = (size_t)u.pm * 256; }
        else { base = Kb; ld = 256; r0 = u.pm < 128 ? (size_t)(u.pm >> 5) * KVLEN + CTXL + (size_t)(u.pm & 31) * 256 : (size_t)(u.pm - 128) * KVLEN; }
        const bool lat = u.pm < 128;
        for (int it = 0; it < 16; ++it) {
            const int pi = it * 32 + F.wave * 4 + sub, row = pi >> 1, hh = pi & 1;
            bf16_t* p = base + (r0 + row) * ld + hh * 128 + l16 * 8;
            const u32x4 w = *(const u32x4*)p;
            float x[8] = {bflo(w.x), bfhi(w.x), bflo(w.y), bfhi(w.y), bflo(w.z), bfhi(w.z), bflo(w.w), bfhi(w.w)};
            float ss = 0.f;
#pragma unroll
            for (int e = 0; e < 8; ++e) ss += x[e] * x[e];
            ss = sum16(ss);
            const float rs = 1.f / sqrtf(ss * (1.f / 128.f) + EPS);
#pragma unroll
            for (int e = 0; e < 8; ++e) x[e] = x[e] * rs * gv[e];
            if (lat) { const int n = (u.pm & 31) * 256 + row;
#pragma unroll
                for (int e = 0; e < 4; ++e) { const f32x2 cs = rope[(size_t)n * 64 + l16 * 4 + e]; const float a = x[2 * e], b = x[2 * e + 1];
                    x[2 * e] = a * cs.x - b * cs.y; x[2 * e + 1] = a * cs.y + b * cs.x; } }
            *(u32x4*)p = (u32x4){pk2(x[0], x[1]), pk2(x[2], x[3]), pk2(x[4], x[5]), pk2(x[6], x[7])};
        }
    }
}
__device__ __forceinline__ void attn_phase(Frame& F, bool need_ctx) {
    const bf16_t* Q = RG(F, 1); const bf16_t* Kb = RG(F, 2); const bf16_t* Vb = (const bf16_t*)((const char*)RG(F, 2) + 17 * MiB);
    const int nunits = 1024 + (need_ctx ? 32 : 0);
    for (int L = F.bid; L < nunits; L += F.G) {
        int b, h, t0, seq;
        if (L < 1024) { const int qb = L & 31; h = (L >> 5) & 7; b = L >> 8; t0 = b * SEQ + qb * 256; seq = KVLEN; }
        else { const int i = L - 1024; b = i >> 3; h = i & 7; t0 = TLAT + b * CTXL; seq = CTXL; }
        const bf16_t* Qp = Q + (size_t)t0 * D + h * 128;
        const size_t kvo = (size_t)b * KVLEN * 256 + (h >> 2) * 128;
        att::attn_dense_body(Qp, Kb + kvo, Vb + kvo, (bf16_t*)Qp, seq, F.ldsg, F.tid);
    }
}

__device__ __forceinline__ void gmlp_spatial(Frame& F) {
    const Args& A = *F.a; const bf16_t* ZB = RG(F, 1); bf16_t* P = RG(F, 0); const bf16_t* WS_ = (const bf16_t*)(F.ws + WS_BWS);
    LAS float* ST = (LAS float*)F.lds;
    LAS bf16_t* VT = (LAS bf16_t*)(F.lds + 2048);
    constexpr int VP = 130;
    const int r = F.lane & 31, hh = F.lane >> 5, wr = F.wave >> 1, wc = F.wave & 1;
    for (int un = F.bid; un < 528; un += F.G) {
        const int ck = un >> 1, hf = un & 1, t0 = ck * 128;
        { const int row = F.tid >> 2, q = F.tid & 3; const bf16_t* vp = ZB + (size_t)(t0 + row) * 2048 + 1024 + q * 256; float s = 0.f, s2 = 0.f;
#pragma unroll 4
          for (int i = 0; i < 32; ++i) { const u32x4 w = *(const u32x4*)(vp + i * 8); const float x[8] = {bflo(w.x), bfhi(w.x), bflo(w.y), bfhi(w.y), bflo(w.z), bfhi(w.z), bflo(w.w), bfhi(w.w)};
#pragma unroll
              for (int e = 0; e < 8; ++e) { s += x[e]; s2 += x[e] * x[e]; } }
          s += __shfl_xor(s, 1); s += __shfl_xor(s, 2); s2 += __shfl_xor(s2, 1); s2 += __shfl_xor(s2, 2);
          const float mean = s * (1.f / 1024.f), var = fmaxf(s2 * (1.f / 1024.f) - mean * mean, 0.f);
          if (q == 0) { ST[2 * row] = mean; ST[2 * row + 1] = 1.f / sqrtf(var + EPS); } }
        __syncthreads();
        for (int gi = 0; gi < 4; ++gi) { const int g = hf * 4 + gi;
            { const int row = F.tid >> 2, q = F.tid & 3; const float mean = ST[2 * row], rstd = ST[2 * row + 1];
              const bf16_t* vp = ZB + (size_t)(t0 + row) * 2048 + 1024 + g * 128 + q * 32;
#pragma unroll
              for (int i = 0; i < 4; ++i) { const u32x4 w = *(const u32x4*)(vp + i * 8); const float x[8] = {bflo(w.x), bfhi(w.x), bflo(w.y), bfhi(w.y), bflo(w.z), bfhi(w.z), bflo(w.w), bfhi(w.w)};
                  const int c0 = g * 128 + q * 32 + i * 8;
#pragma unroll
                  for (int e = 0; e < 8; e += 2) { const float y0 = (x[e] - mean) * rstd * A.in[I_BVG][c0 + e] + A.in[I_BVB][c0 + e], y1 = (x[e + 1] - mean) * rstd * A.in[I_BVG][c0 + e + 1] + A.in[I_BVB][c0 + e + 1];
                      *(LAS unsigned*)(VT + row * VP + q * 32 + i * 8 + e) = pk2(y0, y1); } } }
            __syncthreads();
            f32x16 acc[2] = {};
            const bf16_t* wp = WS_ + ((size_t)g * 128 + wr * 32 + r) * 128 + hh * 8;
#pragma unroll
            for (int ks = 0; ks < 8; ++ks) { const bf16x8 af = *(const bf16x8*)(wp + ks * 16);
#pragma unroll
                for (int cb = 0; cb < 2; ++cb) { const LAS bf16_t* bp = VT + (ks * 16 + hh * 8) * VP + wc * 64 + cb * 32 + r;
                    bf16x8 bfr;
#pragma unroll
                    for (int e = 0; e < 8; ++e) bfr[e] = (short)bp[e * VP];
                    acc[cb] = MFMA32(af, bfr, acc[cb]); } }
#pragma unroll
            for (int cb = 0; cb < 2; ++cb)
#pragma unroll
                for (int reg = 0; reg < 16; ++reg) { const int tl = wr * 32 + crow(reg, hh), c = g * 128 + wc * 64 + cb * 32 + r;
                    const float mixed = acc[cb][reg] + A.in[I_BBS][g * 128 + tl];
                    const float uu = bf1(ZB[(size_t)(t0 + tl) * 2048 + c]);
                    P[(size_t)(t0 + tl) * D + c] = (bf16_t)(pk2(uu * mixed, 0.f) & 0xffffu); }
            __syncthreads();
        }
    }
}

__device__ __forceinline__ void delta_prep(Frame& F) {
    const Args& A = *F.a; const float* cw = A.in[I_CCONV];
    for (int wu = F.gw; wu < 528 * 6; wu += F.NGW) {
        const int ck = wu / 6, slab = wu % 6, buf = slab >> 1, ch = (slab & 1) * 512 + 8 * F.lane, t0 = ck * 64;
        const bf16_t* src = RG(F, 1 + buf) + ch; bf16_t* dst = RG(F, 5 + buf) + ch;
        float w0[8], w1[8], w2[8];
#pragma unroll
        for (int e = 0; e < 8; ++e) { const int cg = buf * 1024 + ch + e; w0[e] = cw[cg]; w1[e] = cw[3072 + cg]; w2[e] = cw[6144 + cg]; }
        const int seqlen = t0 < TLAT ? SEQ : CTXL, n0 = t0 < TLAT ? (t0 & (SEQ - 1)) : ((t0 - TLAT) & (CTXL - 1));
        u32x4 prev = {0u, 0u, 0u, 0u}, cur, nxt;
        if (n0 > 0) prev = *(const u32x4*)(src + (size_t)(t0 - 1) * D);
        cur = *(const u32x4*)(src + (size_t)t0 * D);
        for (int rr = 0; rr < 64; ++rr) {
            const int t = t0 + rr;
            nxt = (u32x4){0u, 0u, 0u, 0u};
            if (n0 + rr + 1 < seqlen) nxt = *(const u32x4*)(src + (size_t)(t + 1) * D);
            const float xp[8] = {bflo(prev.x), bfhi(prev.x), bflo(prev.y), bfhi(prev.y), bflo(prev.z), bfhi(prev.z), bflo(prev.w), bfhi(prev.w)};
            const float xc[8] = {bflo(cur.x), bfhi(cur.x), bflo(cur.y), bfhi(cur.y), bflo(cur.z), bfhi(cur.z), bflo(cur.w), bfhi(cur.w)};
            const float xn[8] = {bflo(nxt.x), bfhi(nxt.x), bflo(nxt.y), bfhi(nxt.y), bflo(nxt.z), bfhi(nxt.z), bflo(nxt.w), bfhi(nxt.w)};
            float y[8]; float ss = 0.f;
#pragma unroll
            for (int e = 0; e < 8; ++e) { y[e] = siluf_(w0[e] * xp[e] + w1[e] * xc[e] + w2[e] * xn[e]); ss += y[e] * y[e]; }
            if (buf < 2) { ss = sum16(ss); const float rs = (1.f / sqrtf(ss + EPS)) * (buf == 0 ? 0.08838834764831845f : 1.f);
#pragma unroll
                for (int e = 0; e < 8; ++e) y[e] *= rs; }
            *(u32x4*)(dst + (size_t)t * D) = (u32x4){pk2(y[0], y[1]), pk2(y[2], y[3]), pk2(y[4], y[5]), pk2(y[6], y[7])};
            prev = cur; cur = nxt;
        }
    }
}
__device__ __forceinline__ void delta_local(Frame& F) {
    const Args& A = *F.a; const float* AB = (const float*)(F.ws + WS_AB); float* GC = (float*)(F.ws + WS_GC); float* BETA = (float*)(F.ws + WS_BETA);
    const bf16_t* QN = RG(F, 5); const bf16_t* KN = RG(F, 6); bf16_t* TB = RG(F, 1); bf16_t* ATT = RG(F, 2);
    LAS float* Aw = (LAS float*)(F.lds + F.wave * 16384);
    for (int wu = F.gw; wu < 528 * 16; wu += F.NGW) {
        int lane = F.lane; asm volatile("" : "+v"(lane));
        const int r = lane & 31, hh = lane >> 5;
        const int dir = wu & 1, h = (wu >> 1) & 7, ck = wu >> 4, t0 = ck * 64;
        const int tok = dir ? t0 + 63 - lane : t0 + lane;
        const float a = AB[(size_t)tok * 32 + dir * 8 + h], bb = AB[(size_t)tok * 32 + 16 + dir * 8 + h];
        const float x = a + A.in[I_CDTB][dir * 8 + h];
        const float sp = fmaxf(x, 0.f) + log1pf(expf(-fabsf(x)));
        const float g = -expf(A.in[I_CALOG][dir * 8 + h]) * sp;
        const float beta = 1.f / (1.f + expf(-bb));
        float gc = g;
#pragma unroll
        for (int o = 1; o < 64; o <<= 1) { const float tv = __shfl_up(gc, o); if (lane >= o) gc += tv; }
        GC[(size_t)(dir * 8 + h) * TT + tok] = gc; BETA[(size_t)(dir * 8 + h) * TT + tok] = beta;
        const int tk0 = dir ? t0 + 63 - r : t0 + r, tk1 = dir ? t0 + 31 - r : t0 + 32 + r;
        const bf16_t* kp0 = KN + (size_t)tk0 * D + h * 128 + hh * 8; const bf16_t* kp1 = KN + (size_t)tk1 * D + h * 128 + hh * 8;
        const bf16_t* qp0 = QN + (size_t)tk0 * D + h * 128 + hh * 8; const bf16_t* qp1 = QN + (size_t)tk1 * D + h * 128 + hh * 8;
        bf16x8 kf0[8], kf1[8];
#pragma unroll
        for (int ks = 0; ks < 8; ++ks) { kf0[ks] = *(const bf16x8*)(kp0 + ks * 16); kf1[ks] = *(const bf16x8*)(kp1 + ks * 16); }
        const float gcj0 = __shfl(gc, r), gcj1 = __shfl(gc, 32 + r);
        bf16_t* attp = ATT + (size_t)wu * 4096;
        {   f32x16 s00 = {}, s10 = {}, s11 = {};
#pragma unroll
            for (int ks = 0; ks < 8; ++ks) { s00 = MFMA32(kf0[ks], kf0[ks], s00); s10 = MFMA32(kf1[ks], kf0[ks], s10); s11 = MFMA32(kf1[ks], kf1[ks], s11); }
#pragma unroll
            for (int reg = 0; reg < 16; ++reg) { const int il = crow(reg, hh);
                const float gci0 = __shfl(gc, il), gci1 = __shfl(gc, 32 + il), bt0 = __shfl(beta, il), bt1 = __shfl(beta, 32 + il);
                const float d00 = (il > r) ? expf(gci0 - gcj0) : 0.f, d10 = expf(gci1 - gcj0), d11 = (il > r) ? expf(gci1 - gcj1) : 0.f;
                Aw[il * 64 + r] = bt0 * s00[reg] * d00;
                Aw[il * 64 + 32 + r] = 0.f;
                Aw[(32 + il) * 64 + r] = bt1 * s10[reg] * d10;
                Aw[(32 + il) * 64 + 32 + r] = bt1 * s11[reg] * d11; }
        }
        asm volatile("" ::: "memory"); __builtin_amdgcn_sched_barrier(0);
        {   f32x16 q00 = {}, q10 = {}, q11 = {};
#pragma unroll
            for (int ks = 0; ks < 8; ++ks) { const bf16x8 q0 = *(const bf16x8*)(qp0 + ks * 16), q1 = *(const bf16x8*)(qp1 + ks * 16);
                q00 = MFMA32(q0, kf0[ks], q00); q10 = MFMA32(q1, kf0[ks], q10); q11 = MFMA32(q1, kf1[ks], q11); }
#pragma unroll
            for (int reg = 0; reg < 16; ++reg) { const int il = crow(reg, hh);
                const float gci0 = __shfl(gc, il), gci1 = __shfl(gc, 32 + il);
                const float d00 = (il >= r) ? expf(gci0 - gcj0) : 0.f, d10 = expf(gci1 - gcj0), d11 = (il >= r) ? expf(gci1 - gcj1) : 0.f;
                attp[il * 64 + r] = (bf16_t)(pk2(q00[reg] * d00, 0.f) & 0xffffu);
                attp[il * 64 + 32 + r] = 0;
                attp[(32 + il) * 64 + r] = (bf16_t)(pk2(q10[reg] * d10, 0.f) & 0xffffu);
                attp[(32 + il) * 64 + 32 + r] = (bf16_t)(pk2(q11[reg] * d11, 0.f) & 0xffffu); }
        }
        asm volatile("" ::: "memory"); __builtin_amdgcn_sched_barrier(0);
        LDS_WAIT(); asm volatile("" ::: "memory");
        float Tc[64]; bf16_t* tp = TB + (size_t)wu * 4096 + lane;
#pragma unroll
        for (int i = 0; i < 64; ++i) { float acc = (i == lane) ? 1.f : 0.f;
#pragma unroll
            for (int j4 = 0; j4 < (i + 3) / 4; ++j4) { const f32x4 av = *(const LAS f32x4*)(Aw + i * 64 + 4 * j4);
#pragma unroll
                for (int e = 0; e < 4; ++e) if (4 * j4 + e < i) acc -= av[e] * Tc[4 * j4 + e]; }
            Tc[i] = acc; tp[i * 64] = (bf16_t)(pk2(acc, 0.f) & 0xffffu);
            if ((i & 3) == 3) { asm volatile("" ::: "memory"); __builtin_amdgcn_sched_barrier(0); } }
        LDS_WAIT(); asm volatile("" ::: "memory");
    }
}
constexpr int SC_QT = 0, SC_KT = 16896, SC_KTT = 33792, SC_TT = 51200, SC_AT = 59904, SC_VT = 68608, SC_TAB = 76800, SC_XP = 77824, SC_OP = 110592;
static_assert(SC_OP + 32768 <= MISC_OFF, "scan LDS");
__device__ __forceinline__ bf16x8 lds_frag(const LAS unsigned char* p) { return mk8(*(const LAS u32x2*)p, *(const LAS u32x2*)(p + 16)); }
__device__ __forceinline__ bf16x8 pack_acc(const f32x16& v, int s) { return mk8w(pk2(v[8 * s], v[8 * s + 1]), pk2(v[8 * s + 2], v[8 * s + 3]), pk2(v[8 * s + 4], v[8 * s + 5]), pk2(v[8 * s + 6], v[8 * s + 7])); }
__device__ __forceinline__ void delta_scan(Frame& F) {
    const bf16_t* QN = RG(F, 5); const bf16_t* KN = RG(F, 6); const bf16_t* VN = RG(F, 7); const bf16_t* TB = RG(F, 1); const bf16_t* ATT = RG(F, 2);
    const float* GC = (const float*)(F.ws + WS_GC); const float* BETA = (const float*)(F.ws + WS_BETA);
    LAS unsigned char* L = F.lds; const int w = F.wave;
    LAS float* TAB = (LAS float*)(L + SC_TAB); LAS float* XP = (LAS float*)(L + SC_XP); LAS float* OP = (LAS float*)(L + SC_OP); LAS float* VT = (LAS float*)(L + SC_VT);
    for (int item = F.bid; item < 256; item += F.G) {
        const int ch = item >> 2, dvs = item & 3, b = ch >> 4, h = (ch >> 1) & 7, dir = ch & 1;
        bf16_t* OB = RG(F, dir ? 3 : 0);
        f32x16 S = {};
        u32x4 sq[2], sk[2], st, sa, sv; float sgc = 0.f, sbt = 0.f;
#define SCAN_CK(step) ((step) < 4 ? 512 + b * 4 + (dir ? 3 - (step) : (step)) : b * 128 + (dir ? 131 - (step) : (step) - 4))
#define SCAN_LOAD(step) do { const int ck_ = SCAN_CK(step); const int t0_ = ck_ * 64; const size_t un_ = ((size_t)ck_ * 8 + h) * 2 + dir; \
        _Pragma("unroll") for (int e_ = 0; e_ < 2; ++e_) { const int id_ = tid + 512 * e_, row_ = id_ >> 4, c16_ = id_ & 15; const int tk_ = dir ? t0_ + 63 - row_ : t0_ + row_; \
            sq[e_] = *(const u32x4*)(QN + (size_t)tk_ * D + h * 128 + c16_ * 8); sk[e_] = *(const u32x4*)(KN + (size_t)tk_ * D + h * 128 + c16_ * 8); } \
        st = *(const u32x4*)(TB + un_ * 4096 + tid * 8); sa = *(const u32x4*)(ATT + un_ * 4096 + tid * 8); \
        if (tid < 256) { const int row_ = tid >> 2, c_ = tid & 3; const int tk_ = dir ? t0_ + 63 - row_ : t0_ + row_; sv = *(const u32x4*)(VN + (size_t)tk_ * D + h * 128 + dvs * 32 + c_ * 8); } \
        if (tid < 64) { const int tk_ = dir ? t0_ + 63 - tid : t0_ + tid; sgc = GC[(size_t)(dir * 8 + h) * TT + tk_]; sbt = BETA[(size_t)(dir * 8 + h) * TT + tk_]; } } while (0)
#define SCAN_STORE() do { \
        _Pragma("unroll") for (int e_ = 0; e_ < 2; ++e_) { const int id_ = tid + 512 * e_, row_ = id_ >> 4, c16_ = id_ & 15; \
            *(LAS u32x2*)(L + SC_QT + row_ * 264 + c16_ * 16) = (u32x2){sq[e_].x, sq[e_].y}; *(LAS u32x2*)(L + SC_QT + row_ * 264 + c16_ * 16 + 8) = (u32x2){sq[e_].z, sq[e_].w}; \
            *(LAS u32x2*)(L + SC_KT + row_ * 264 + c16_ * 16) = (u32x2){sk[e_].x, sk[e_].y}; *(LAS u32x2*)(L + SC_KT + row_ * 264 + c16_ * 16 + 8) = (u32x2){sk[e_].z, sk[e_].w}; \
            LAS bf16_t* kt_ = (LAS bf16_t*)(L + SC_KTT) + (c16_ * 8) * 68 + row_; \
            kt_[0 * 68] = (bf16_t)(sk[e_].x & 0xffffu); kt_[1 * 68] = (bf16_t)(sk[e_].x >> 16); kt_[2 * 68] = (bf16_t)(sk[e_].y & 0xffffu); kt_[3 * 68] = (bf16_t)(sk[e_].y >> 16); \
            kt_[4 * 68] = (bf16_t)(sk[e_].z & 0xffffu); kt_[5 * 68] = (bf16_t)(sk[e_].z >> 16); kt_[6 * 68] = (bf16_t)(sk[e_].w & 0xffffu); kt_[7 * 68] = (bf16_t)(sk[e_].w >> 16); } \
        { const int row_ = tid >> 3, c16_ = tid & 7; \
          *(LAS u32x2*)(L + SC_TT + row_ * 136 + c16_ * 16) = (u32x2){st.x, st.y}; *(LAS u32x2*)(L + SC_TT + row_ * 136 + c16_ * 16 + 8) = (u32x2){st.z, st.w}; \
          *(LAS u32x2*)(L + SC_AT + row_ * 136 + c16_ * 16) = (u32x2){sa.x, sa.y}; *(LAS u32x2*)(L + SC_AT + row_ * 136 + c16_ * 16 + 8) = (u32x2){sa.z, sa.w}; } \
        if (tid < 256) { const int row_ = tid >> 2, c_ = tid & 3; LAS f32x4* vp_ = (LAS f32x4*)(VT + row_ * 32 + c_ * 8); \
            vp_[0] = (f32x4){bflo(sv.x), bfhi(sv.x), bflo(sv.y), bfhi(sv.y)}; vp_[1] = (f32x4){bflo(sv.z), bfhi(sv.z), bflo(sv.w), bfhi(sv.w)}; } \
        if (tid < 64) { const float gl_ = __shfl(sgc, 63); TAB[tid] = expf(sgc); TAB[64 + tid] = expf(gl_ - sgc); TAB[128 + tid] = sbt; if (tid == 0) TAB[192] = expf(gl_); } } while (0)
        int tid = F.tid; asm volatile("" : "+v"(tid));
        SCAN_LOAD(0); VM_WAIT(); SCAN_STORE(); __syncthreads();
#pragma unroll 1
        for (int step = 0; step < 132; ++step) {
            tid = F.tid; asm volatile("" : "+v"(tid));
            const int lane = tid & 63, r = lane & 31, hh = lane >> 5;
            const int ck = SCAN_CK(step), t0 = ck * 64;
            if (step + 1 < 132) SCAN_LOAD(step + 1);
            if (w < 4) {
                const bf16x8 Sb0 = pack_acc(S, 0), Sb1 = pack_acc(S, 1);
#pragma unroll
                for (int bi = 0; bi < 2; ++bi) { const int off = (32 * bi + r) * 264 + (32 * w + 4 * hh) * 2;
                    { f32x16 X = {}; const bf16x8 k0 = lds_frag(L + SC_KT + off), k1 = lds_frag(L + SC_KT + off + 32);
                      X = MFMA32(k0, Sb0, X); X = MFMA32(k1, Sb1, X);
#pragma unroll
                      for (int reg = 0; reg < 16; ++reg) XP[((w * 2 + bi) * 16 + reg) * 64 + lane] = X[reg]; }
                    { f32x16 X = {}; const bf16x8 q0 = lds_frag(L + SC_QT + off), q1 = lds_frag(L + SC_QT + off + 32);
                      X = MFMA32(q0, Sb0, X); X = MFMA32(q1, Sb1, X);
#pragma unroll
                      for (int reg = 0; reg < 16; ++reg) OP[((w * 2 + bi) * 16 + reg) * 64 + lane] = X[reg]; }
                    asm volatile("" ::: "memory"); }
            }
            __syncthreads();
            if (w < 4) {
                bf16x8 Rp[2][2];
#pragma unroll
                for (int bi = 0; bi < 2; ++bi)
#pragma unroll
                    for (int sh = 0; sh < 2; ++sh) { float R[8];
#pragma unroll
                        for (int e = 0; e < 8; ++e) { const int reg = 8 * sh + e; const int i = 32 * bi + crow(reg, hh);
                            const float X = (XP[((0 * 2 + bi) * 16 + reg) * 64 + lane] + XP[((1 * 2 + bi) * 16 + reg) * 64 + lane]) + (XP[((2 * 2 + bi) * 16 + reg) * 64 + lane] + XP[((3 * 2 + bi) * 16 + reg) * 64 + lane]);
                            R[e] = TAB[128 + i] * (VT[i * 32 + r] - TAB[i] * X); }
                        Rp[bi][sh] = mk8w(pk2(R[0], R[1]), pk2(R[2], R[3]), pk2(R[4], R[5]), pk2(R[6], R[7]));
                        asm volatile("" ::: "memory"); __builtin_amdgcn_sched_barrier(0); }
                f32x16 Vn0 = {}, Vn1 = {};
                { const int o0 = r * 136 + (4 * hh) * 2, o1 = (32 + r) * 136 + (4 * hh) * 2;
                  Vn0 = MFMA32(lds_frag(L + SC_TT + o0), Rp[0][0], Vn0); Vn0 = MFMA32(lds_frag(L + SC_TT + o0 + 32), Rp[0][1], Vn0);
                  Vn1 = MFMA32(lds_frag(L + SC_TT + o1), Rp[0][0], Vn1); Vn1 = MFMA32(lds_frag(L + SC_TT + o1 + 32), Rp[0][1], Vn1);
                  Vn1 = MFMA32(lds_frag(L + SC_TT + o1 + 64), Rp[1][0], Vn1); Vn1 = MFMA32(lds_frag(L + SC_TT + o1 + 96), Rp[1][1], Vn1); }
                asm volatile("" ::: "memory");
                bf16x8 Vsp[2][2];
                { f32x16 Vs;
#pragma unroll
                  for (int reg = 0; reg < 16; ++reg) Vs[reg] = Vn0[reg] * TAB[64 + crow(reg, hh)];
                  Vsp[0][0] = pack_acc(Vs, 0); Vsp[0][1] = pack_acc(Vs, 1);
#pragma unroll
                  for (int reg = 0; reg < 16; ++reg) Vs[reg] = Vn1[reg] * TAB[64 + 32 + crow(reg, hh)];
                  Vsp[1][0] = pack_acc(Vs, 0); Vsp[1][1] = pack_acc(Vs, 1); }
                const float gl = TAB[192];
#pragma unroll
                for (int reg = 0; reg < 16; ++reg) S[reg] *= gl;
                { const int o = (32 * w + r) * 136 + (4 * hh) * 2;
                  S = MFMA32(lds_frag(L + SC_KTT + o), Vsp[0][0], S); S = MFMA32(lds_frag(L + SC_KTT + o + 32), Vsp[0][1], S);
                  S = MFMA32(lds_frag(L + SC_KTT + o + 64), Vsp[1][0], S); S = MFMA32(lds_frag(L + SC_KTT + o + 96), Vsp[1][1], S); }
                asm volatile("" ::: "memory");
                if (w < 2) { f32x16 O = {};
                    const int o = (32 * w + r) * 136 + (4 * hh) * 2;
                    O = MFMA32(lds_frag(L + SC_AT + o), pack_acc(Vn0, 0), O); O = MFMA32(lds_frag(L + SC_AT + o + 32), pack_acc(Vn0, 1), O);
                    if (w == 1) { O = MFMA32(lds_frag(L + SC_AT + o + 64), pack_acc(Vn1, 0), O); O = MFMA32(lds_frag(L + SC_AT + o + 96), pack_acc(Vn1, 1), O); }
#pragma unroll
                    for (int sh = 0; sh < 2; ++sh) {
#pragma unroll
                        for (int e = 0; e < 8; ++e) { const int reg = 8 * sh + e; const int i = 32 * w + crow(reg, hh);
                            const float o1 = (OP[((0 * 2 + w) * 16 + reg) * 64 + lane] + OP[((1 * 2 + w) * 16 + reg) * 64 + lane]) + (OP[((2 * 2 + w) * 16 + reg) * 64 + lane] + OP[((3 * 2 + w) * 16 + reg) * 64 + lane]);
                            const float ov = O[reg] + TAB[i] * o1; const int tk = dir ? t0 + 63 - i : t0 + i;
                            OB[(size_t)tk * D + h * 128 + dvs * 32 + r] = (bf16_t)(pk2(ov, 0.f) & 0xffffu); }
                        asm volatile("" ::: "memory"); __builtin_amdgcn_sched_barrier(0); } }
            }
            __syncthreads();
            if (step + 1 < 132) { VM_WAIT(); SCAN_STORE(); }
            __syncthreads();
        }
#undef SCAN_CK
#undef SCAN_LOAD
#undef SCAN_STORE
    }
}
__device__ __forceinline__ void delta_out(Frame& F) {
    const Args& A = *F.a; const bf16_t* OF = RG(F, 0); const bf16_t* OBk = RG(F, 3); const bf16_t* Z = RG(F, 4); bf16_t* Y = RG(F, 5);
    for (int t = F.gw; t < TT; t += F.NGW) {
#pragma unroll
        for (int j = 0; j < 2; ++j) { const int col = j * 512 + 8 * F.lane; const size_t off = (size_t)t * D + col;
            const u32x4 a = *(const u32x4*)(OF + off), bq = *(const u32x4*)(OBk + off), z = *(const u32x4*)(Z + off);
            float o[8] = {bflo(a.x) + bflo(bq.x), bfhi(a.x) + bfhi(bq.x), bflo(a.y) + bflo(bq.y), bfhi(a.y) + bfhi(bq.y), bflo(a.z) + bflo(bq.z), bfhi(a.z) + bfhi(bq.z), bflo(a.w) + bflo(bq.w), bfhi(a.w) + bfhi(bq.w)};
            const float zz[8] = {bflo(z.x), bfhi(z.x), bflo(z.y), bfhi(z.y), bflo(z.z), bfhi(z.z), bflo(z.w), bfhi(z.w)};
            float ss = 0.f;
#pragma unroll
            for (int e = 0; e < 8; ++e) ss += o[e] * o[e];
            ss = sum16(ss); const float rs = 1.f / sqrtf(ss * (1.f / 128.f) + EPS);
#pragma unroll
            for (int e = 0; e < 8; ++e) o[e] = o[e] * rs * A.in[I_CNG][(col & 127) + e] * siluf_(zz[e]);
            *(u32x4*)(Y + off) = (u32x4){pk2(o[0], o[1]), pk2(o[2], o[3]), pk2(o[4], o[5]), pk2(o[6], o[7])}; }
    }
}

__global__ void __launch_bounds__(NTHR, 2) hybrid_fwd(Args args) {
    extern __shared__ __attribute__((aligned(16))) unsigned char lds[];
    Frame F;
    F.lds = (LAS unsigned char*)lds; F.ldsg = (char*)lds;
    F.wave = __builtin_amdgcn_readfirstlane((int)threadIdx.x >> 6);
#define REFRESH() FRAME_REFRESH(F)
    REFRESH();
    F.bid = blockIdx.x; F.G = gridDim.x; F.gw = F.bid * NWAVES + F.wave; F.NGW = F.G * NWAVES;
    F.a = &args; F.ws = args.ws; F.out = args.out;
    volatile LAS unsigned* MISC = (volatile LAS unsigned*)(F.lds + MISC_OFF);
    if (F.tid < 4) MISC[F.tid] = 0u;
    __syncthreads();
    const int lo = args.ph_lo, hi = args.ph_hi;
    XcdBarrier bar; bar.bar = (unsigned*)(args.ws + WS_CTL) + CW_BAR; bar.x = 0; bar.st = MISC;
    if (hi - lo > 1) bar = xcd_barrier_post((unsigned*)(args.ws + WS_CTL) + CW_BAR, MISC, F.tid);
    int ph = 0;
#ifndef PHMASK
#define PHMASK 0xFFFFFFFFu
#endif
#define PHASE_BEGIN(cls) if (((PHMASK >> (cls)) & 1u) && ph >= lo && ph < hi) { REFRESH();
#define PHASE_END   if (ph + 1 < hi) { REFRESH(); xcd_barrier(bar, F.tid); } } ++ph;
    const Args& A = args;
    float* hctx = (float*)(F.ws + WS_HCTX);

    PHASE_BEGIN(0) p0_prologue(F); PHASE_END
    PHASE_BEGIN(1) p1_init(F); PHASE_END

#define GEMM_DENSE(EPI, Aptr, Bptr, M_, N_, K_) do { pg8::Gemm g_{(Aptr), (Bptr), (M_), (N_), (K_), 0}; pg8::StaticOrder S_; S_.init((M_), (N_), F.G, F.bid); \
        pg8::gemm_phase(F.lds, g_, S_, EPI, F.tid); } while (0)
#define MOE_LAYER(layer, last) do { const int nrows_ = (last) ? TLAT : TT; \
        PHASE_BEGIN(5) moe_route(F, (layer), nrows_); PHASE_END \
        PHASE_BEGIN(6) moe_scatter(F, (layer), nrows_); PHASE_END \
        PHASE_BEGIN(7) { moe_tables(F, (layer)); pg8::Gemm g_{(const bf16_t*)(F.ws + WS_XS), (const bf16_t*)(F.ws + WS_WE1), XS_ROWS, 1024, D, (size_t)D * D * 2}; \
            pg8::GroupedOrder S_{(const LAS int*)(F.lds + GTAB_OFF), (const LAS int*)(F.lds + GTAB_OFF) + 32, F.G, F.bid}; EpiGateUp E_{(bf16_t*)(F.ws + WS_HID)}; pg8::gemm_phase(F.lds, g_, S_, E_, F.tid); } PHASE_END \
        PHASE_BEGIN(8) { moe_tables(F, (layer)); pg8::Gemm g_{(const bf16_t*)(F.ws + WS_HID), (const bf16_t*)(F.ws + WS_WE2), XS_ROWS, 1024, DE, (size_t)D * DE * 2}; \
            pg8::GroupedOrder S_{(const LAS int*)(F.lds + GTAB_OFF), (const LAS int*)(F.lds + GTAB_OFF) + 32, F.G, F.bid}; EpiDown E_{(bf16_t*)(F.ws + WS_Y2), (const int*)(F.ws + WS_ROWMAP), (const float*)(F.ws + WS_ROWW)}; pg8::gemm_phase(F.lds, g_, S_, E_, F.tid); } PHASE_END \
        PHASE_BEGIN(9) moe_ln2(F, (layer), nrows_, (last)); PHASE_END } while (0)
#define ATTN_LAYER(layer, j, last) do { \
        PHASE_BEGIN(2) { pg8::Gemm g_{RG(F, 0), (const bf16_t*)(F.ws + WS_WQKV) + (size_t)(j) * 1536 * D, TT, 1536, D, 0}; pg8::StaticOrder S_; S_.init(TT, 1536, F.G, F.bid); \
            EpiQKV E_{RG(F, 1), RG(F, 2), (bf16_t*)((char*)RG(F, 2) + 17 * MiB)}; pg8::gemm_phase(F.lds, g_, S_, E_, F.tid); VM_WAIT(); __syncthreads(); qk_norm_rope(F, (j), S_); } PHASE_END \
        PHASE_BEGIN(3) attn_phase(F, !(last)); PHASE_END \
        PHASE_BEGIN(4) { EpiResid E_{F.out, hctx, modrow(F, (layer), 0) + 2048}; GEMM_DENSE(E_, RG(F, 1), (const bf16_t*)(F.ws + WS_WO) + (size_t)(j) * D * D, (last) ? TLAT : TT, D, D); } PHASE_END } while (0)

    ATTN_LAYER(0, 0, false);
    MOE_LAYER(0, false);
    PHASE_BEGIN(10) { EpiGelu E_{RG(F, 1)}; GEMM_DENSE(E_, RG(F, 0), (const bf16_t*)(F.ws + WS_BWIN), TT, 2048, D); } PHASE_END
    PHASE_BEGIN(11) gmlp_spatial(F); PHASE_END
    PHASE_BEGIN(4) { EpiResid E_{F.out, hctx, modrow(F, 1, 0) + 2048}; GEMM_DENSE(E_, RG(F, 0), (const bf16_t*)(F.ws + WS_BWOUT), TT, D, D); } PHASE_END
    MOE_LAYER(1, false);
    PHASE_BEGIN(12) { EpiDeltaIn E_{RG(F, 1), (float*)(F.ws + WS_AB)}; GEMM_DENSE(E_, RG(F, 0), (const bf16_t*)(F.ws + WS_CWIN), TT, CW_NPAD, D); } PHASE_END
    PHASE_BEGIN(13) delta_prep(F); PHASE_END
    PHASE_BEGIN(14) delta_local(F); PHASE_END
    PHASE_BEGIN(15) delta_scan(F); PHASE_END
    PHASE_BEGIN(16) delta_out(F); PHASE_END
    PHASE_BEGIN(4) { EpiResid E_{F.out, hctx, modrow(F, 2, 0) + 2048}; GEMM_DENSE(E_, RG(F, 5), (const bf16_t*)(F.ws + WS_CWOUT), TT, D, D); } PHASE_END
    MOE_LAYER(2, false);
    ATTN_LAYER(3, 1, true);
    MOE_LAYER(3, true);
    (void)A;
}
constexpr int NPHASES = 2 + (3 + 5) + (3 + 5) + (6 + 5) + (3 + 5);

extern "C" void kernel_launch(void* const* d_in, const int* in_sizes, int n_in, void* d_out, int out_size, void* d_ws, size_t ws_size, hipStream_t stream) {
    static int grid = 0;
    if (grid == 0) {
        if (n_in != 29 || out_size != TLAT * D || ws_size < WS_END) { fprintf(stderr, "kernel_launch: unexpected shapes: n_in %d out %d ws %zu (need %zu)\n", n_in, out_size, ws_size, (size_t)WS_END); grid = -1; return; }
        int dev = 0, cus = 0, per_cu = 0;
        if (hipGetDevice(&dev) != hipSuccess || hipDeviceGetAttribute(&cus, hipDeviceAttributeMultiprocessorCount, dev) != hipSuccess) { grid = -1; return; }
        if (hipFuncSetAttribute((const void*)hybrid_fwd, hipFuncAttributeMaxDynamicSharedMemorySize, LDS_BYTES) != hipSuccess) { fprintf(stderr, "kernel_launch: hipFuncSetAttribute failed\n"); grid = -1; return; }
        if (hipOccupancyMaxActiveBlocksPerMultiprocessor(&per_cu, (const void*)hybrid_fwd, NTHR, LDS_BYTES) != hipSuccess || per_cu < 1) fprintf(stderr, "kernel_launch: occupancy query says %d\n", per_cu);
        (void)hipGetLastError();
        grid = cus < 256 ? cus : 256;
    }
    if (grid < 0) return;
    (void)hipMemsetAsync((char*)d_ws + WS_CTL, 0, CTL_ZERO_BYTES, stream);
    Args a{};
    for (int i = 0; i < 29; ++i) a.in[i] = (const float*)d_in[i];
    a.out = (float*)d_out; a.ws = (unsigned char*)d_ws;
#if MK_ONE_LAUNCH
    a.ph_lo = 0; a.ph_hi = NPHASES;
    hipLaunchKernelGGL(hybrid_fwd, dim3(grid), dim3(NTHR), LDS_BYTES, stream, a);
#else
    for (int p = 0; p < NPHASES; ++p) { a.ph_lo = p; a.ph_hi = p + 1; hipLaunchKernelGGL(hybrid_fwd, dim3(grid), dim3(NTHR), LDS_BYTES, stream, a); }
#endif
    const hipError_t le = hipPeekAtLastError();
    if (le != hipSuccess) fprintf(stderr, "kernel_launch: launch failed: %s\n", hipGetErrorName(le));
}
```

```cpp
#include <hip/hip_runtime.h>
#include <cstdio>
#include <cstdint>

#ifndef MK_ONE_LAUNCH
#define MK_ONE_LAUNCH 1
#endif

#define GAS __attribute__((address_space(1)))
#define LAS __attribute__((address_space(3)))
typedef unsigned short bf16_t;
typedef short bf16x8 __attribute__((ext_vector_type(8)));
typedef short s16x4 __attribute__((ext_vector_type(4)));
typedef float f32x2 __attribute__((ext_vector_type(2)));
typedef float f32x4 __attribute__((ext_vector_type(4)));
typedef float f32x8 __attribute__((ext_vector_type(8)));
typedef float f32x16 __attribute__((ext_vector_type(16)));
typedef unsigned u32x2 __attribute__((ext_vector_type(2)));
typedef unsigned u32x4 __attribute__((ext_vector_type(4)));
typedef int i32x2 __attribute__((ext_vector_type(2)));
typedef __bf16 bf16x2_t __attribute__((ext_vector_type(2)));

constexpr int D = 1024, NBATCH = 4, SEQ = 8192, CTXL = 256;
constexpr int TLAT = NBATCH * SEQ, TCTX = NBATCH * CTXL, TT = TLAT + TCTX;
constexpr int KVLEN = CTXL + SEQ;
constexpr int NE = 16, DE = 512, NLAYER = 4;
constexpr int CW_N = 4128, CW_NPAD = 4352;
constexpr float DN_ALPHA = 1.6817928305074292f;
constexpr float EPS = 1e-6f;
constexpr int XS_ROWS = 2 * TT + NE * 256;
constexpr int NWAVES = 8, NTHR = 512;

constexpr size_t MiB = 1u << 20;
constexpr size_t WS_CTL = 0, CTL_ZERO_BYTES = 1 * MiB;
constexpr size_t WS_MOD = 1 * MiB;
constexpr size_t WS_ROPE = 2 * MiB;
constexpr size_t WS_HCTX = 6 * MiB;
constexpr size_t WS_ASG = 10 * MiB;
constexpr size_t WS_ASGW = WS_ASG + 512 * 1024;
constexpr size_t WS_POS = WS_ASGW + 512 * 1024;
constexpr size_t WS_ROWMAP = WS_POS + 512 * 1024;
constexpr size_t WS_ROWW = WS_ROWMAP + 512 * 1024;
constexpr size_t WS_AB = 13 * MiB;
constexpr size_t WS_GC = 18 * MiB;
constexpr size_t WS_BETA = 21 * MiB;
constexpr size_t WS_WQKV = 26 * MiB;
constexpr size_t WS_WO = 32 * MiB;
constexpr size_t WS_BWIN = 36 * MiB;
constexpr size_t WS_BWOUT = 40 * MiB;
constexpr size_t WS_BWS = 42 * MiB;
constexpr size_t WS_CWIN = 43 * MiB;
constexpr size_t WS_CWOUT = 52 * MiB;
constexpr size_t WS_WE1 = 54 * MiB;
constexpr size_t WS_WE2 = 86 * MiB;
constexpr size_t WS_R0 = 102 * MiB, RSZ = 66 * MiB;
constexpr size_t WS_END = WS_R0 + 8 * RSZ;
constexpr size_t WS_XS = WS_R0, WS_HID = WS_R0 + 140 * MiB, WS_Y2 = WS_R0 + 4 * RSZ;
static_assert((size_t)XS_ROWS * 2048 <= 140 * MiB && (size_t)XS_ROWS * 1024 <= 70 * MiB && WS_HID + 70 * MiB <= WS_Y2, "moe overlay");
static_assert((size_t)TT * D * 2 == RSZ, "region size");

constexpr int CW_BAR = 4096;
constexpr int CW_CNT = 16384;

constexpr int LDS_BYTES = 155648;
constexpr int MISC_OFF = LDS_BYTES - 512;
constexpr int GTAB_OFF = 131072;

#define RLX_AGENT __ATOMIC_RELAXED, __HIP_MEMORY_SCOPE_AGENT
#define LDS_WAIT() asm volatile("s_waitcnt lgkmcnt(0)" ::: "memory")
#define VM_WAIT() asm volatile("s_waitcnt vmcnt(0)" ::: "memory")
__device__ __forceinline__ unsigned pk2(float lo, float hi) { f32x2 v = {lo, hi}; bf16x2_t b = __builtin_convertvector(v, bf16x2_t); return __builtin_bit_cast(unsigned, b); }
__device__ __forceinline__ float bflo(unsigned w) { return __uint_as_float(w << 16); }
__device__ __forceinline__ float bfhi(unsigned w) { return __uint_as_float(w & 0xffff0000u); }
__device__ __forceinline__ float bf1(bf16_t b) { return __uint_as_float((unsigned)b << 16); }
__device__ __forceinline__ float wave_sum(float v) {
#pragma unroll
    for (int o = 1; o < 64; o <<= 1) v += __shfl_xor(v, o);
    return v;
}
__device__ __forceinline__ float sum16(float v) {
#pragma unroll
    for (int o = 1; o < 16; o <<= 1) v += __shfl_xor(v, o);
    return v;
}
__device__ __forceinline__ float sigmoidf_(float x) { return 1.f / (1.f + __expf(-x)); }
__device__ __forceinline__ float siluf_(float x) { return x / (1.f + __expf(-x)); }
__device__ __forceinline__ int crow(int r, int hi) { return (r & 3) + 8 * (r >> 2) + 4 * hi; }
__device__ __forceinline__ bf16x8 mk8(u32x2 lo, u32x2 hi) { u32x4 w = {lo.x, lo.y, hi.x, hi.y}; return __builtin_bit_cast(bf16x8, w); }
__device__ __forceinline__ bf16x8 mk8w(unsigned a, unsigned b, unsigned c, unsigned d) { u32x4 w = {a, b, c, d}; return __builtin_bit_cast(bf16x8, w); }
#define MFMA32(a, b, c) __builtin_amdgcn_mfma_f32_32x32x16_bf16((a), (b), (c), 0, 0, 0)

#define XB_TMO      128
#define XB_XCNT(j)  (256  + 64 * (j))
#define XB_XSUB(j)  (1280 + 64 * (j))
#define XB_XGEN(j)  (2304 + 64 * (j))
#define XB_TOP      3328
#define XB_TOPGEN   3392
#define XCD_BAR_WORDS 3456
#define XB_SPIN_CAP (1u << 18)

__device__ __forceinline__ unsigned xb_ld(unsigned* p)              { return __hip_atomic_load(p, __ATOMIC_RELAXED, __HIP_MEMORY_SCOPE_AGENT); }
__device__ __forceinline__ unsigned xb_add(unsigned* p, unsigned v) { return __hip_atomic_fetch_add(p, v, __ATOMIC_RELAXED, __HIP_MEMORY_SCOPE_AGENT); }
__device__ __forceinline__ unsigned xb_xcc_id() { return (unsigned)__builtin_amdgcn_s_getreg((3 << 11) | 20) & 0xFu; }
#define XB_SPIN(cond, bar) do { unsigned _sp = 0; while (cond) { __builtin_amdgcn_s_sleep(1); \
    if ((++_sp & 255u) == 0u) { if (xb_ld(&(bar)[XB_TMO])) break; if (_sp > XB_SPIN_CAP) { atomicAdd(&(bar)[XB_TMO], 1u); break; } } } } while (0)

struct XcdBarrier {
    unsigned* bar; unsigned x;
    volatile LAS unsigned* st;
};
__device__ __forceinline__ XcdBarrier xcd_barrier_post(unsigned* bar, volatile LAS unsigned* st, int tid) {
    XcdBarrier b; b.bar = bar; b.x = xb_xcc_id(); b.st = st;
    if (tid == 0) (void)xb_add(&bar[XB_XCNT(b.x)], 1u);
    return b;
}
__device__ __forceinline__ void xcd_barrier_complete(unsigned* bar, unsigned x, unsigned& nloc, unsigned& nx) {
    const unsigned G = gridDim.x * gridDim.y * gridDim.z;
    unsigned sum, cnt, mine, sp = 0u;
    for (;;) {
        sum = 0u; cnt = 0u; mine = 0u;
#pragma unroll
        for (unsigned j = 0; j < 16; ++j) { const unsigned c = xb_ld(&bar[XB_XCNT(j)]); sum += c; cnt += (c > 0u) ? 1u : 0u; mine = (j == x) ? c : mine; }
        if (sum == G) break;
        __builtin_amdgcn_s_sleep(1);
        if ((++sp & 255u) == 0u) { if (xb_ld(&bar[XB_TMO])) break; if (sp > XB_SPIN_CAP) { atomicAdd(&bar[XB_TMO], 1u); break; } }
    }
    nloc = mine > 0u ? mine : 1u; nx = cnt > 0u ? cnt : 1u;
}
__device__ __forceinline__ void xcd_barrier(const XcdBarrier& b, int tid) {
    asm volatile("s_waitcnt vmcnt(0)" ::: "memory");
    __syncthreads();
    if (tid == 0) {
        unsigned* bar = b.bar;
        __builtin_amdgcn_s_waitcnt(0);
        unsigned nloc = b.st[0], nx = b.st[1];
        if (nloc == 0u) { xcd_barrier_complete(bar, b.x, nloc, nx); b.st[0] = nloc; b.st[1] = nx; }
        const unsigned old = xb_add(&bar[XB_XSUB(b.x)], 1u);
        const unsigned gen = old / nloc;
        if (old + 1u == (gen + 1u) * nloc) {
            __builtin_amdgcn_fence(__ATOMIC_RELEASE, "agent");
            asm volatile("s_waitcnt vmcnt(0)" ::: "memory");
            const unsigned og = xb_add(&bar[XB_TOP], 1u);
            const unsigned tg = og / nx;
            if (og + 1u == (tg + 1u) * nx) xb_add(&bar[XB_TOPGEN], 1u);
            else XB_SPIN(xb_ld(&bar[XB_TOPGEN]) == tg, bar);
            __builtin_amdgcn_fence(__ATOMIC_ACQUIRE, "agent");
            xb_add(&bar[XB_XGEN(b.x)], 1u);
            asm volatile("s_waitcnt vmcnt(0)" ::: "memory");
        } else {
            XB_SPIN(xb_ld(&bar[XB_XGEN(b.x)]) == gen, bar);
            __builtin_amdgcn_fence(__ATOMIC_ACQUIRE, "agent");
            asm volatile("s_waitcnt vmcnt(0)" ::: "memory");
        }
    }
    __syncthreads();
}

namespace pg8 {
constexpr int BM = 256, BK = 64, HALF = 128, HTB = HALF * BK * 2, STAGE_BYTES = 8 * HTB, NXCD = 8, WGM = 8;
__host__ __device__ __forceinline__ int lds_byte(int r, int c) { const int st = (r >> 4) * 2 + (c >> 5), rr = r & 15, cc = c & 31, ob = rr * 64 + cc * 2; return st * 1024 + (ob ^ (((ob >> 9) & 1) << 5)); }
__host__ __device__ __forceinline__ void stage_rc(int b, int& R, int& C) { const int st = b / 1024, sb = b % 1024, swz = sb ^ (((sb >> 9) & 1) << 5); R = (st >> 1) * 16 + swz / 64; C = (st & 1) * 32 + (swz % 64) / 2; }
__host__ __device__ __forceinline__ int perm32(int rho) { const int n = rho >> 4, i = rho & 15; return 8 * (i >> 2) + 4 * n + (i & 3); }

struct Unit { int pm, pn, e, rowend; };
struct Gemm { const bf16_t* A; const bf16_t* Bt; int M, N, K; size_t bstride; };

struct StaticOrder {
    int nM, nN, nwg, G, c;
    __device__ void init(int M, int N, int G_, int c_) { nM = M / BM; nN = N / BM; nwg = nM * nN; G = G_; c = c_; }
    __device__ bool next(int i, Unit& u) const {
        const long L = (long)i * G + c; if (L >= nwg) return false;
        int wgid = (int)L; { const int q = nwg / NXCD, r = nwg % NXCD, xcd = wgid % NXCD, off = wgid / NXCD; wgid = (xcd < r ? xcd * (q + 1) : r * (q + 1) + (xcd - r) * q) + off; }
        const int nig = WGM * nN, gid = wgid / nig, fm = gid * WGM, gsz = (nM - fm) < WGM ? (nM - fm) : WGM;
        u.pm = fm + ((wgid % nig) % gsz); u.pn = (wgid % nig) / gsz; u.e = 0; u.rowend = 0x7fffffff; return true;
    }
};
struct GroupedOrder {
    const LAS int* TS; const LAS int* CNT; int G, c;
    __device__ bool next(int i, Unit& u) const {
        const int L = i * G + c; const int total = TS[NE] * 4; if (L >= total) return false;
        const int rt = L >> 2; int e = 0;
#pragma unroll 1
        while (rt >= TS[e + 1]) ++e;
        u.pm = rt; u.pn = L & 3; u.e = e; u.rowend = TS[e] * 256 + CNT[e]; return true;
    }
};

template <class Epi, class Sched>
__device__ __forceinline__ void gemm_phase(LAS unsigned char* lds, const Gemm g, const Sched& S, const Epi& E, const int tid) {
    const int wid = __builtin_amdgcn_readfirstlane(tid >> 6), lane = tid & 63, wr = wid >> 2, wc = wid & 3, fr = lane & 15, fq = lane >> 4;
    const int K = g.K, nt = K / BK;
    unsigned voffA[2], voffB[2];
#pragma unroll
    for (int i = 0; i < 2; ++i) { int R, C; stage_rc(tid * 16 + i * 8192, R, C); const int Rb = Epi::PERM ? ((R & ~31) + perm32(R & 31)) : R;
        voffA[i] = (unsigned)(R * K + C) * 2u; voffB[i] = (unsigned)(Rb * K + C) * 2u; }
    const size_t kstep = (size_t)(BK * 2);
    const size_t hstep = (size_t)HALF * K * 2;
    const size_t tstep = 2 * hstep;
    const unsigned ldsw = (unsigned)wid * 1024u;
    const int aoff = lds_byte(wr * 64 + fr, fq * 8), boff = lds_byte(wc * 32 + fr, fq * 8);
#define PG8_SA(b, h) (((b) * 2 + (h)) * HTB)
#define PG8_SB(b, h) ((4 + (b) * 2 + (h)) * HTB)
#define PG8_STAGE(bufoff, gbase, voff) do { _Pragma("unroll") for (int _i = 0; _i < 2; ++_i) \
        __builtin_amdgcn_global_load_lds((const unsigned*)((const char*)(gbase) + (voff)[_i]), (LAS unsigned*)(lds + (bufoff) + ldsw + _i * 8192), 16, 0, 0); } while (0)
#define PG8_LDA(dst, b, h) do { _Pragma("unroll") for (int m = 0; m < 4; ++m) _Pragma("unroll") for (int k = 0; k < 2; ++k) dst[m][k] = *(const LAS bf16x8*)(lds + PG8_SA(b, h) + aoff + m * 2048 + k * 1024); } while (0)
#define PG8_LDB(dst, b, h) do { _Pragma("unroll") for (int n = 0; n < 2; ++n) _Pragma("unroll") for (int k = 0; k < 2; ++k) dst[n][k] = *(const LAS bf16x8*)(lds + PG8_SB(b, h) + boff + n * 2048 + k * 1024); } while (0)
#define PG8_MMA(ai, bj, At, Bt) do { __builtin_amdgcn_s_setprio(1); _Pragma("unroll") for (int m = 0; m < 4; ++m) _Pragma("unroll") for (int n = 0; n < 2; ++n) _Pragma("unroll") for (int k = 0; k < 2; ++k) \
        acc[ai][bj][m][n] = __builtin_amdgcn_mfma_f32_16x16x32_bf16(Bt[n][k], At[m][k], acc[ai][bj][m][n], 0, 0, 0); __builtin_amdgcn_s_setprio(0); } while (0)
#define PG8_WAIT_V(n) asm volatile("s_waitcnt vmcnt(" #n ")" ::: "memory")
#define PG8_WAIT_L(n) asm volatile("s_waitcnt lgkmcnt(" #n ")" ::: "memory")
#define PG8_BAR __builtin_amdgcn_s_barrier()
#define PG8_SCHED __builtin_amdgcn_sched_barrier(0)
    Unit cur, nxt; int ui = 0;
    if (!S.next(0, cur)) return;
    f32x4 acc[2][2][4][2];
#pragma unroll
    for (int a = 0; a < 2; ++a)
#pragma unroll
        for (int b = 0; b < 2; ++b)
#pragma unroll
            for (int m = 0; m < 4; ++m)
#pragma unroll
                for (int n = 0; n < 2; ++n) acc[a][b][m][n] = (f32x4){0.f, 0.f, 0.f, 0.f};
    bf16x8 At[4][2], B0[2][2], B1[2][2];
    const char* cA = (const char*)g.A + (size_t)cur.pm * tstep; const char* cB = (const char*)g.Bt + (size_t)cur.e * g.bstride + (size_t)cur.pn * tstep;
    PG8_STAGE(PG8_SB(0, 0), cB, voffB); PG8_STAGE(PG8_SB(0, 1), cB + hstep, voffB); PG8_STAGE(PG8_SA(0, 0), cA, voffA); PG8_STAGE(PG8_SA(0, 1), cA + hstep, voffA);
    if (wr == 1) PG8_BAR;
    PG8_WAIT_V(2); PG8_BAR;
    PG8_STAGE(PG8_SB(1, 0), cB + kstep, voffB); PG8_STAGE(PG8_SA(1, 0), cA + kstep, voffA); PG8_STAGE(PG8_SB(1, 1), cB + hstep + kstep, voffB);
    PG8_WAIT_V(6); PG8_BAR;
    for (;;) {
        const bool has_next = S.next(ui + 1, nxt);
        const char* nA = has_next ? (const char*)g.A + (size_t)nxt.pm * tstep : cA; const char* nB = has_next ? (const char*)g.Bt + (size_t)nxt.e * g.bstride + (size_t)nxt.pn * tstep : cB;
        for (int t = 0; t < nt; t += 2) {
            const bool last = (t == nt - 2);
            const char* a1 = cA + (size_t)(t + 1) * kstep;
            const char* a2 = last ? nA : cA + (size_t)(t + 2) * kstep; const char* b2 = last ? nB : cB + (size_t)(t + 2) * kstep;
            const char* a3 = a2 + kstep; const char* b3 = b2 + kstep;
            PG8_LDB(B0, 0, 0); PG8_LDB(B1, 0, 1); PG8_SCHED; PG8_LDA(At, 0, 0); PG8_STAGE(PG8_SA(1, 1), a1 + hstep, voffA);
            PG8_WAIT_V(8); PG8_WAIT_L(0); PG8_BAR; PG8_MMA(0, 0, At, B0); PG8_MMA(0, 1, At, B1); PG8_BAR; PG8_SCHED;
            PG8_LDA(At, 0, 1); PG8_STAGE(PG8_SB(0, 0), b2, voffB); PG8_STAGE(PG8_SB(0, 1), b2 + hstep, voffB); PG8_STAGE(PG8_SA(0, 0), a2, voffA);
            PG8_WAIT_V(8); PG8_WAIT_L(0); PG8_BAR; PG8_MMA(1, 0, At, B0); PG8_MMA(1, 1, At, B1); PG8_BAR; PG8_SCHED;
            PG8_LDB(B0, 1, 0); PG8_LDB(B1, 1, 1); PG8_SCHED; PG8_LDA(At, 1, 0); PG8_STAGE(PG8_SA(0, 1), a2 + hstep, voffA);
            PG8_WAIT_V(8); PG8_WAIT_L(0); PG8_BAR; PG8_MMA(0, 0, At, B0); PG8_MMA(0, 1, At, B1); PG8_BAR; PG8_SCHED;
            PG8_LDA(At, 1, 1); PG8_STAGE(PG8_SB(1, 0), b3, voffB); PG8_STAGE(PG8_SB(1, 1), b3 + hstep, voffB); PG8_STAGE(PG8_SA(1, 0), a3, voffA);
            PG8_WAIT_V(8); PG8_WAIT_L(0); PG8_BAR; PG8_MMA(1, 0, At, B0); PG8_MMA(1, 1, At, B1); PG8_BAR; PG8_SCHED;
        }
        if (wr == 0) PG8_BAR;
        E(acc, cur, wr, wc, fr, fq);
        if (!has_next) break;
#pragma unroll
        for (int a = 0; a < 2; ++a)
#pragma unroll
            for (int b = 0; b < 2; ++b)
#pragma unroll
                for (int m = 0; m < 4; ++m)
#pragma unroll
                    for (int n = 0; n < 2; ++n) acc[a][b][m][n] = (f32x4){0.f, 0.f, 0.f, 0.f};
        cur = nxt; cA = nA; cB = nB; ++ui;
        if (wr == 1) PG8_BAR;
    }
    PG8_WAIT_V(0);
    PG8_BAR;
#undef PG8_SA
#undef PG8_SB
#undef PG8_STAGE
#undef PG8_LDA
#undef PG8_LDB
#undef PG8_MMA
#undef PG8_WAIT_V
#undef PG8_WAIT_L
#undef PG8_BAR
#undef PG8_SCHED
}
}
using pg8::Unit;

typedef f32x4 AccT[2][2][4][2];

struct EpiResid {
    static constexpr bool PERM = false;
    float* hlat; float* hctx; const float* gate;
    __device__ __forceinline__ void operator()(const AccT& acc, const Unit& u, int wr, int wc, int fr, int fq) const {
        const int mi = u.pm < 128 ? (u.pm >> 5) : 4;
        float* hb = u.pm < 128 ? hlat + (size_t)u.pm * 256 * D : hctx + (size_t)(u.pm - 128) * 256 * D;
        const int col0 = u.pn * 256 + wc * 32 + 4 * fq;
        const float* g = gate + mi * 6144 + col0;
        f32x4 gv[2][2];
#pragma unroll
        for (int bj = 0; bj < 2; ++bj)
#pragma unroll
            for (int n = 0; n < 2; ++n) gv[bj][n] = *(const f32x4*)(g + bj * 128 + n * 16);
#pragma unroll
        for (int ai = 0; ai < 2; ++ai)
#pragma unroll
            for (int m = 0; m < 4; ++m) { float* rowp = hb + (size_t)(ai * 128 + wr * 64 + m * 16 + fr) * D + col0;
#pragma unroll
                for (int bj = 0; bj < 2; ++bj)
#pragma unroll
                    for (int n = 0; n < 2; ++n) { const f32x4 hv = *(const f32x4*)(rowp + bj * 128 + n * 16); *(f32x4*)(rowp + bj * 128 + n * 16) = hv * DN_ALPHA + gv[bj][n] * acc[ai][bj][m][n]; } }
    }
};
__device__ __forceinline__ u32x4 pack8(const f32x4 a, const f32x4 b) { u32x4 w; w.x = pk2(a[0], a[1]); w.y = pk2(a[2], a[3]); w.z = pk2(b[0], b[1]); w.w = pk2(b[2], b[3]); return w; }

struct EpiQKV {
    static constexpr bool PERM = true;
    bf16_t* Q; bf16_t* Kb; bf16_t* Vb;
    __device__ __forceinline__ void operator()(const AccT& acc, const Unit& u, int wr, int wc, int fr, int fq) const {
        const int cw = wc * 32 + 8 * fq;
        bf16_t* base; size_t ld; size_t r0;
        if (u.pn < 4) { base = Q + u.pn * 256; ld = D; r0 = (size_t)u.pm * 256; }
        else { base = (u.pn == 4) ? Kb : Vb; ld = 256; r0 = u.pm < 128 ? (size_t)(u.pm >> 5) * KVLEN + CTXL + (size_t)(u.pm & 31) * 256 : (size_t)(u.pm - 128) * KVLEN; }
#pragma unroll
        for (int ai = 0; ai < 2; ++ai)
#pragma unroll
            for (int m = 0; m < 4; ++m) { bf16_t* rowp = base + (r0 + ai * 128 + wr * 64 + m * 16 + fr) * ld + cw;
#pragma unroll
                for (int bj = 0; bj < 2; ++bj) *(u32x4*)(rowp + bj * 128) = pack8(acc[ai][bj][m][0], acc[ai][bj][m][1]); }
    }
};
__device__ __forceinline__ float gelu_tanh(float x) { const float t = 1.5957691216057308f * (x + 0.044715f * x * x * x); return x / (1.f + __expf(-t)); }
struct EpiGelu {
    static constexpr bool PERM = true;
    bf16_t* O;
    __device__ __forceinline__ void operator()(const AccT& acc, const Unit& u, int wr, int wc, int fr, int fq) const {
        const int col0 = u.pn * 256 + wc * 32 + 8 * fq;
#pragma unroll
        for (int ai = 0; ai < 2; ++ai)
#pragma unroll
            for (int m = 0; m < 4; ++m) { bf16_t* rowp = O + (size_t)(u.pm * 256 + ai * 128 + wr * 64 + m * 16 + fr) * 2048 + col0;
#pragma unroll
                for (int bj = 0; bj < 2; ++bj) { f32x4 a = acc[ai][bj][m][0], b = acc[ai][bj][m][1];
#pragma unroll
                    for (int i = 0; i < 4; ++i) { a[i] = gelu_tanh(a[i]); b[i] = gelu_tanh(b[i]); }
                    *(u32x4*)(rowp + bj * 128) = pack8(a, b); } }
    }
};
struct EpiDeltaIn {
    static constexpr bool PERM = true;
    bf16_t* R1; float* AB;
    __device__ __forceinline__ void operator()(const AccT& acc, const Unit& u, int wr, int wc, int fr, int fq) const {
        if (u.pn < 16) {
            bf16_t* base = R1 + (size_t)(u.pn >> 2) * (RSZ / 2) + (u.pn & 3) * 256 + wc * 32 + 8 * fq;
#pragma unroll
            for (int ai = 0; ai < 2; ++ai)
#pragma unroll
                for (int m = 0; m < 4; ++m) { bf16_t* rowp = base + (size_t)(u.pm * 256 + ai * 128 + wr * 64 + m * 16 + fr) * D;
#pragma unroll
                    for (int bj = 0; bj < 2; ++bj) *(u32x4*)(rowp + bj * 128) = pack8(acc[ai][bj][m][0], acc[ai][bj][m][1]); }
        } else if (wc == 0) {
#pragma unroll
            for (int ai = 0; ai < 2; ++ai)
#pragma unroll
                for (int m = 0; m < 4; ++m) { float* rowp = AB + (size_t)(u.pm * 256 + ai * 128 + wr * 64 + m * 16 + fr) * 32 + 8 * fq;
                    *(f32x4*)(rowp) = acc[ai][0][m][0]; *(f32x4*)(rowp + 4) = acc[ai][0][m][1]; }
        }
    }
};
struct EpiGateUp {
    static constexpr bool PERM = true;
    bf16_t* H;
    __device__ __forceinline__ void operator()(const AccT& acc, const Unit& u, int wr, int wc, int fr, int fq) const {
        const int col0 = u.pn * 128 + wc * 32 + 8 * fq;
#pragma unroll
        for (int ai = 0; ai < 2; ++ai)
#pragma unroll
            for (int m = 0; m < 4; ++m) { bf16_t* rowp = H + (size_t)(u.pm * 256 + ai * 128 + wr * 64 + m * 16 + fr) * DE + col0;
                f32x4 a, b;
#pragma unroll
                for (int i = 0; i < 4; ++i) { a[i] = siluf_(acc[ai][0][m][0][i]) * acc[ai][1][m][0][i]; b[i] = siluf_(acc[ai][0][m][1][i]) * acc[ai][1][m][1][i]; }
                *(u32x4*)(rowp) = pack8(a, b); }
    }
};
struct EpiDown {
    static constexpr bool PERM = true;
    bf16_t* Y2; const int* rowmap; const float* roww;
    __device__ __forceinline__ void operator()(const AccT& acc, const Unit& u, int wr, int wc, int fr, int fq) const {
        const int col0 = u.pn * 256 + wc * 32 + 8 * fq;
#pragma unroll
        for (int ai = 0; ai < 2; ++ai)
#pragma unroll
            for (int m = 0; m < 4; ++m) { const int r = u.pm * 256 + ai * 128 + wr * 64 + m * 16 + fr;
                if (r < u.rowend) { const int dst = rowmap[r]; const float w = roww[r]; bf16_t* rowp = Y2 + (size_t)dst * D + col0;
#pragma unroll
                    for (int bj = 0; bj < 2; ++bj) *(u32x4*)(rowp + bj * 128) = pack8(acc[ai][bj][m][0] * w, acc[ai][bj][m][1] * w); } }
    }
};

namespace att {
constexpr int DH = 128, NW = 8, QBLK = 32, KVBLK = 64;
constexpr float SCALE = 0.088388347648318440f;
constexpr float THR = 8.f;
constexpr int LDQ = D, LDK = 256, LDO = D;
constexpr size_t SHM_V = KVBLK * DH * 2, SHM_K = KVBLK * DH * 2, SHM_ATTN = 2 * SHM_V + 2 * SHM_K + NW * 64 * 4;
#define KSWZ(row, colB) ((row) * 256 + ((colB) ^ (((row) & 7) << 4)))
#define SBAR() __builtin_amdgcn_sched_barrier(0)
__device__ __forceinline__ unsigned cvtpk(float lo, float hi) { unsigned r; asm volatile("v_cvt_pk_bf16_f32 %0, %1, %2" : "=v"(r) : "v"(lo), "v"(hi)); return r; }
__device__ __forceinline__ void partialSM(f32x16& p0, f32x16& p1, float& m_reg, float& mn, float& alpha) {
  constexpr float C = SCALE * 1.4426950408889634f;
  float pmax = p0[0]; for (int r = 1; r < 16; ++r) pmax = fmaxf(pmax, p0[r]); for (int r = 0; r < 16; ++r) pmax = fmaxf(pmax, p1[r]);
  { auto rr = __builtin_amdgcn_permlane32_swap(__float_as_uint(pmax), __float_as_uint(pmax), false, false);
    pmax = fmaxf(__uint_as_float(rr[0]), __uint_as_float(rr[1])); }
  if (__builtin_expect(__all(pmax - m_reg <= THR / SCALE), 1)) { mn = m_reg; alpha = 1.f; }
  else { mn = fmaxf(m_reg, pmax); alpha = __builtin_amdgcn_exp2f((m_reg - mn) * C); m_reg = mn; }
  float mnC = -mn * C;
  for (int r = 0; r < 16; ++r) p0[r] = fmaf(p0[r], C, mnC); for (int r = 0; r < 16; ++r) p1[r] = fmaf(p1[r], C, mnC);
  for (int r = 0; r < 16; ++r) p0[r] = __builtin_amdgcn_exp2f(p0[r]);
}
__device__ __forceinline__ void finishSM(f32x16& p0, f32x16& p1, float alpha, float& l_reg, bf16x8& pa0, bf16x8& pa1, bf16x8& pa2, bf16x8& pa3) {
  for (int r = 0; r < 16; ++r) p1[r] = __builtin_amdgcn_exp2f(p1[r]);
  float ps = 0; for (int r = 0; r < 16; ++r) ps += p0[r]; for (int r = 0; r < 16; ++r) ps += p1[r];
  { auto rr = __builtin_amdgcn_permlane32_swap(__float_as_uint(ps), __float_as_uint(ps), false, false);
    ps = __uint_as_float(rr[0]) + __uint_as_float(rr[1]); }
  l_reg = l_reg * alpha + ps;
#define PK4(P, BASE, OUT) do { unsigned a0 = cvtpk(P[BASE + 0], P[BASE + 1]), a1 = cvtpk(P[BASE + 2], P[BASE + 3]);   \
    unsigned b0 = cvtpk(P[BASE + 4], P[BASE + 5]), b1 = cvtpk(P[BASE + 6], P[BASE + 7]);                              \
    auto r0 = __builtin_amdgcn_permlane32_swap(a0, b0, false, false); auto r1 = __builtin_amdgcn_permlane32_swap(a1, b1, false, false); \
    u32x4 w = {r0[0], r1[0], r0[1], r1[1]}; OUT = *reinterpret_cast<bf16x8*>(&w); } while (0)
  PK4(p0, 0, pa0); PK4(p0, 8, pa1); PK4(p1, 0, pa2); PK4(p1, 8, pa3);
#undef PK4
}
__device__ __forceinline__ void qkt(f32x16& p0, f32x16& p1, const bf16_t* Ks, const bf16x8* qr, int r32, int hi) {
  p0 = f32x16{}; p1 = f32x16{};
  for (int d0 = 0; d0 < 8; ++d0) { int cb = (d0 * 16 + hi * 8) * 2;
    bf16x8 b0 = *reinterpret_cast<const bf16x8*>((const char*)Ks + KSWZ(r32, cb));
    bf16x8 b1 = *reinterpret_cast<const bf16x8*>((const char*)Ks + KSWZ(32 + r32, cb));
    p0 = __builtin_amdgcn_mfma_f32_32x32x16_bf16(b0, qr[d0], p0, 0, 0, 0);
    p1 = __builtin_amdgcn_mfma_f32_32x32x16_bf16(b1, qr[d0], p1, 0, 0, 0); }
}
__device__ __forceinline__ int v_st(int k, int c) { const int kk = (k & ~0xC) | ((k & 4) << 1) | ((k & 8) >> 1); return ((kk >> 3) * 4 + (c >> 5)) * 512 + ((kk & 7) * 32 + (c & 31)) * 2; }
__device__ __forceinline__ int v_rd_base(int lane) { return ((lane & 3) << 3) | (((lane >> 2) & 3) << 6) | (((lane >> 4) & 1) << 5) | (((lane >> 5) & 1) << 8); }
constexpr int v_rd_off(int d0, int ks, int half) { return d0 * 512 + ks * 4096 + half * 2048; }
template <int OFF> __device__ __forceinline__ s16x4 tr_read(int vb) {
  s16x4 r; asm volatile("ds_read_b64_tr_b16 %0, %1 offset:%2" : "=&v"(r) : "v"(vb), "i"(OFF) : "memory"); return r;
}
template <int D0> __device__ __forceinline__ void pv_one(f32x16& od, int vb, bf16x8 pa0, bf16x8 pa1, bf16x8 pa2, bf16x8 pa3) {
  const s16x4 l0 = tr_read<v_rd_off(D0, 0, 0)>(vb), h0 = tr_read<v_rd_off(D0, 0, 1)>(vb), l1 = tr_read<v_rd_off(D0, 1, 0)>(vb), h1 = tr_read<v_rd_off(D0, 1, 1)>(vb);
  const s16x4 l2 = tr_read<v_rd_off(D0, 2, 0)>(vb), h2 = tr_read<v_rd_off(D0, 2, 1)>(vb), l3 = tr_read<v_rd_off(D0, 3, 0)>(vb), h3 = tr_read<v_rd_off(D0, 3, 1)>(vb);
  asm volatile("s_waitcnt lgkmcnt(0)" ::: "memory"); SBAR();
#define PK(L, H) (bf16x8){L[0], L[1], L[2], L[3], H[0], H[1], H[2], H[3]}
  od = __builtin_amdgcn_mfma_f32_32x32x16_bf16(pa0, PK(l0, h0), od, 0, 0, 0);
  od = __builtin_amdgcn_mfma_f32_32x32x16_bf16(pa1, PK(l1, h1), od, 0, 0, 0);
  od = __builtin_amdgcn_mfma_f32_32x32x16_bf16(pa2, PK(l2, h2), od, 0, 0, 0);
  od = __builtin_amdgcn_mfma_f32_32x32x16_bf16(pa3, PK(l3, h3), od, 0, 0, 0);
#undef PK
}
__device__ __forceinline__ void pv_d0(f32x16* o, int vb, bf16x8 pa0, bf16x8 pa1, bf16x8 pa2, bf16x8 pa3) {
  pv_one<0>(o[0], vb, pa0, pa1, pa2, pa3); pv_one<1>(o[1], vb, pa0, pa1, pa2, pa3); pv_one<2>(o[2], vb, pa0, pa1, pa2, pa3); pv_one<3>(o[3], vb, pa0, pa1, pa2, pa3);
}
__device__ __forceinline__ void attn_dense_body(const bf16_t* Qb, const bf16_t* __restrict__ Kh, const bf16_t* __restrict__ Vh, bf16_t* Ob, int seq, char* lds, const int tid) {
  constexpr int SDEPTH = 2;
  const int wid = tid >> 6, lane = tid & 63, r32 = lane & 31, hi = lane >> 5;
  bf16_t* V_lds = (bf16_t*)lds; bf16_t* K_lds = (bf16_t*)(lds + 2 * SHM_V);
  float* ws = (float*)(lds + 2 * SHM_V + 2 * SHM_K) + wid * 64; float* li_l = ws; float* al_l = ws + 32;
  float m_reg = -1e30f, l_reg = 0; f32x16 o[4] = {}; bf16x8 qr[8];
  const bf16_t* Qw = Qb + (long)(wid * QBLK + r32) * LDQ + hi * 8;
#pragma unroll
  for (int d0 = 0; d0 < 8; ++d0) qr[d0] = *reinterpret_cast<const bf16x8*>(Qw + d0 * 16);
  const int sr = tid >> 4, sc = (tid & 15) * 8, vst0 = v_st(sr, sc), vst1 = v_st(32 + sr, sc);
  const int vb0 = (int)(uintptr_t)V_lds + v_rd_base(lane);
  struct { bf16x8 vs0, vs1, ks0, ks1; } sr_[SDEPTH];
#define SLOAD(i, k0) do { sr_[i].vs0 = *reinterpret_cast<const bf16x8*>(&Vh[(long)((k0) + sr) * LDK + sc]); sr_[i].vs1 = *reinterpret_cast<const bf16x8*>(&Vh[(long)((k0) + 32 + sr) * LDK + sc]); \
    sr_[i].ks0 = *reinterpret_cast<const bf16x8*>(&Kh[(long)((k0) + sr) * LDK + sc]); sr_[i].ks1 = *reinterpret_cast<const bf16x8*>(&Kh[(long)((k0) + 32 + sr) * LDK + sc]); } while (0)
#define SWRITE(b, i) do { *(bf16x8*)((char*)V_lds + (b) * SHM_V + vst0) = sr_[i].vs0;          \
    *(bf16x8*)((char*)V_lds + (b) * SHM_V + vst1) = sr_[i].vs1; int kc = sc * 2;               \
    *(bf16x8*)((char*)K_lds + (b) * SHM_K + KSWZ(sr, kc)) = sr_[i].ks0;                       \
    *(bf16x8*)((char*)K_lds + (b) * SHM_K + KSWZ(32 + sr, kc)) = sr_[i].ks1; } while (0)
#define SWAIT() do { asm volatile("s_waitcnt vmcnt(4)" ::: "memory"); } while (0)
#define RESC(a) do { if (__any((a) < 1.f)) { if (hi == 0) al_l[r32] = (a); asm volatile("s_waitcnt lgkmcnt(0)" ::: "memory"); \
    for (int d = 0; d < 4; ++d) for (int r = 0; r < 16; ++r) o[d][r] *= al_l[crow(r, hi)]; } } while (0)
  f32x16 pA0, pA1, pB0, pB1; float mnA, mnB, alA, alB; bf16x8 pa0, pa1, pa2, pa3; const int NT = seq / KVBLK;
  constexpr int SE = 0, SO = SDEPTH - 1;
  SLOAD(SE, 0); asm volatile("s_waitcnt vmcnt(0)" ::: "memory"); SWRITE(0, SE); __syncthreads();
  qkt(pA0, pA1, K_lds, qr, r32, hi); partialSM(pA0, pA1, m_reg, mnA, alA);
  SLOAD(SO, KVBLK); if (2 < NT) SLOAD(SE, 2 * KVBLK);
  SWAIT(); SWRITE(1, SO); __syncthreads();
  for (int j = 1; j + 1 < NT; j += 2) {
    SBAR(); qkt(pB0, pB1, (bf16_t*)((char*)K_lds + SHM_K), qr, r32, hi);
    finishSM(pA0, pA1, alA, l_reg, pa0, pa1, pa2, pa3); SBAR();
    SLOAD(SO, (j + SDEPTH) * KVBLK); SBAR();
    pv_d0(o, vb0, pa0, pa1, pa2, pa3); partialSM(pB0, pB1, m_reg, mnB, alB);
    __syncthreads(); SWAIT(); SWRITE(0, SE);
    RESC(alB); __syncthreads();
    SBAR(); qkt(pA0, pA1, K_lds, qr, r32, hi);
    finishSM(pB0, pB1, alB, l_reg, pa0, pa1, pa2, pa3); SBAR();
    if (j + 3 < NT) SLOAD(SE, (j + 1 + SDEPTH) * KVBLK); SBAR();
    pv_d0(o, vb0 + (int)SHM_V, pa0, pa1, pa2, pa3); partialSM(pA0, pA1, m_reg, mnA, alA);
    __syncthreads(); SWAIT(); SWRITE(1, SO);
    RESC(alA); __syncthreads();
  }
  SBAR(); qkt(pB0, pB1, (bf16_t*)((char*)K_lds + SHM_K), qr, r32, hi);
  finishSM(pA0, pA1, alA, l_reg, pa0, pa1, pa2, pa3); SBAR();
  pv_d0(o, vb0, pa0, pa1, pa2, pa3); partialSM(pB0, pB1, m_reg, mnB, alB);
  __syncthreads(); RESC(alB);
  finishSM(pB0, pB1, alB, l_reg, pa0, pa1, pa2, pa3); SBAR();
  pv_d0(o, vb0 + (int)SHM_V, pa0, pa1, pa2, pa3);
  if (hi == 0) li_l[r32] = l_reg; asm volatile("s_waitcnt lgkmcnt(0)" ::: "memory");
  float rli[16];
#pragma unroll
  for (int r = 0; r < 16; ++r) rli[r] = __builtin_amdgcn_rcpf(li_l[crow(r, hi)]);
  bf16_t* Ow = Ob + (long)(wid * QBLK) * LDO;
#pragma unroll
  for (int r = 0; r < 16; ++r) { int orow = crow(r, hi);
#pragma unroll
    for (int d0 = 0; d0 < 4; ++d0) Ow[(long)orow * LDO + d0 * 32 + r32] = (bf16_t)(pk2(o[d0][r] * rli[r], 0.f) & 0xffffu); }
  asm volatile("s_waitcnt vmcnt(0) lgkmcnt(0)" ::: "memory"); __syncthreads();
#undef SLOAD
#undef SWRITE
#undef SWAIT
#undef RESC
}
}

struct Args {
    const float* in[29]; float* out; unsigned char* ws; int ph_lo, ph_hi;
};
enum { I_X = 0, I_C, I_CTX, I_CCTX, I_WADA, I_BADA, I_LNG, I_LNB, I_AWQKV, I_AQG, I_AKG, I_AWO, I_BWIN, I_BVG, I_BVB, I_BWS, I_BBS, I_BWOUT,
       I_CWIN, I_CCONV, I_CALOG, I_CDTB, I_CNG, I_CWOUT, I_WROUTER, I_RBIAS, I_EGATE, I_EUP, I_EDOWN };

struct Frame {
    LAS unsigned char* lds; char* ldsg;
    int tid, lane, wave, bid, G, gw, NGW;
    const Args* a;
    unsigned char* ws; float* out;
};
#define FRAME_REFRESH(F) do { int l_; asm volatile("v_mbcnt_lo_u32_b32 %0, -1, 0\n\tv_mbcnt_hi_u32_b32 %0, -1, %0" : "=v"(l_)); (F).lane = l_; (F).tid = (F).wave * 64 + l_; } while (0)
__device__ __forceinline__ float* hrow(const Frame& F, int t) { return t < TLAT ? F.out + (size_t)t * D : (float*)(F.ws + WS_HCTX) + (size_t)(t - TLAT) * D; }
__device__ __forceinline__ bf16_t* RG(const Frame& F, int i) { return (bf16_t*)(F.ws + WS_R0 + (size_t)i * RSZ); }
__device__ __forceinline__ const float* modrow(const Frame& F, int layer, int mi) { return (const float*)(F.ws + WS_MOD) + (size_t)(layer * 5 + mi) * 6144; }

__device__ __forceinline__ void transpose_item(const float* W, size_t sld, bf16_t* WT, size_t dld, int drow0, int k0, int n0, LAS float* scr, int lane) {
#pragma unroll 8
    for (int i = 0; i < 32; ++i) { const int kk = 2 * i + (lane >> 5); scr[kk * 33 + (lane & 31)] = W[(size_t)(k0 + kk) * sld + n0 + (lane & 31)]; }
    LDS_WAIT(); asm volatile("" ::: "memory");
    const int c = lane & 7;
#pragma unroll
    for (int j = 0; j < 4; ++j) { const int n = (lane >> 3) + 8 * j; const LAS float* s = scr + (8 * c) * 33 + n;
        u32x4 o; o.x = pk2(s[0 * 33], s[1 * 33]); o.y = pk2(s[2 * 33], s[3 * 33]); o.z = pk2(s[4 * 33], s[5 * 33]); o.w = pk2(s[6 * 33], s[7 * 33]);
        *(u32x4*)(WT + (size_t)(drow0 + n) * dld + k0 + 8 * c) = o; }
    LDS_WAIT(); asm volatile("" ::: "memory");
}
__device__ __forceinline__ bool dense_item(int& r, const float* W, int K, int N, bf16_t* WT, LAS float* scr, int lane) {
    const int nblk = N / 32, items = (K / 64) * nblk;
    if (r >= items) { r -= items; return false; }
    const int kb = r / nblk, nb = r % nblk;
    transpose_item(W, (size_t)N, WT, (size_t)K, 32 * nb, 64 * kb, 32 * nb, scr, lane);
    return true;
}
__device__ __forceinline__ void p0_prologue(Frame& F) {
    const Args& A = *F.a;
    LAS float* scr = (LAS float*)(F.lds + F.wave * 16384);
    constexpr int NITEMS = 2 * (16 * 48) + 2 * (16 * 32) + 16 * 64 + 16 * 32 + 16 * 129 + 16 * 32;
    for (int it = F.gw; it < NITEMS; it += F.NGW) {
        int r = it;
        if (dense_item(r, A.in[I_AWQKV], D, 1536, (bf16_t*)(F.ws + WS_WQKV), scr, F.lane)) continue;
        if (dense_item(r, A.in[I_AWQKV] + (size_t)D * 1536, D, 1536, (bf16_t*)(F.ws + WS_WQKV) + (size_t)1536 * D, scr, F.lane)) continue;
        if (dense_item(r, A.in[I_AWO], D, D, (bf16_t*)(F.ws + WS_WO), scr, F.lane)) continue;
        if (dense_item(r, A.in[I_AWO] + (size_t)D * D, D, D, (bf16_t*)(F.ws + WS_WO) + (size_t)D * D, scr, F.lane)) continue;
        if (dense_item(r, A.in[I_BWIN], D, 2048, (bf16_t*)(F.ws + WS_BWIN), scr, F.lane)) continue;
        if (dense_item(r, A.in[I_BWOUT], D, D, (bf16_t*)(F.ws + WS_BWOUT), scr, F.lane)) continue;
        if (dense_item(r, A.in[I_CWIN], D, CW_N, (bf16_t*)(F.ws + WS_CWIN), scr, F.lane)) continue;
        dense_item(r, A.in[I_CWOUT], D, D, (bf16_t*)(F.ws + WS_CWOUT), scr, F.lane);
    }
    const int gt = F.bid * NTHR + F.tid, NGT = F.G * NTHR;
    { u32x4* z = (u32x4*)((bf16_t*)(F.ws + WS_CWIN) + (size_t)CW_N * D); const int n16 = (CW_NPAD - CW_N) * D * 2 / 16;
      for (int i = gt; i < n16; i += NGT) z[i] = (u32x4){0u, 0u, 0u, 0u}; }
    { const float* s = A.in[I_BWS]; unsigned* d = (unsigned*)(F.ws + WS_BWS);
      for (int i = gt; i < 8 * 128 * 128 / 2; i += NGT) d[i] = pk2(s[2 * i], s[2 * i + 1]); }
    { f32x2* rt = (f32x2*)(F.ws + WS_ROPE);
      for (int i = gt; i < SEQ * 64; i += NGT) { const int n = i >> 6, p = i & 63; const int pp = p & 31;
        const float inv = 1.0f / powf(10000.0f, (float)(2 * pp) / 64.0f);
        const float pos = (p < 32) ? (float)(n >> 6) : (float)(n & 63);
        const float ang = pos * inv; float sn, cs; sincosf(ang, &sn, &cs); rt[i] = (f32x2){cs, sn}; } }
    __syncthreads();
    if (F.bid < 96) {
        LAS float* sc = (LAS float*)F.lds;
        LAS f32x4* red = (LAS f32x4*)(F.lds + 32768);
        for (int i = F.tid; i < 5 * D; i += NTHR) { const float v = (i < 4 * D) ? A.in[I_C][i] : A.in[I_CCTX][i - 4 * D]; sc[i] = siluf_(v); }
        __syncthreads();
        for (int item = F.bid; item < 96; item += F.G) {
            const int l = item / 24, cb = item % 24, col0 = cb * 256 + 4 * F.lane;
            const float* wp = A.in[I_WADA] + ((size_t)l * D + F.wave * 128) * 6144 + col0;
            f32x4 acc[5];
#pragma unroll
            for (int mi = 0; mi < 5; ++mi) acc[mi] = (f32x4){0.f, 0.f, 0.f, 0.f};
#pragma unroll 8
            for (int k = 0; k < 128; ++k) { const f32x4 w = *(const f32x4*)(wp + (size_t)k * 6144);
#pragma unroll
                for (int mi = 0; mi < 5; ++mi) acc[mi] += w * sc[mi * D + F.wave * 128 + k]; }
#pragma unroll
            for (int mi = 0; mi < 5; ++mi) red[(F.wave * 5 + mi) * 64 + F.lane] = acc[mi];
            __syncthreads();
            for (int o = F.tid; o < 5 * 256; o += NTHR) { const int mi = o >> 8, c = o & 255; float s = A.in[I_BADA][l * 6144 + cb * 256 + c];
                const LAS float* rf = (const LAS float*)red;
#pragma unroll
                for (int w = 0; w < 8; ++w) s += rf[((w * 5 + mi) * 64 + (c >> 2)) * 4 + (c & 3)];
                ((float*)(F.ws + WS_MOD))[(size_t)(l * 5 + mi) * 6144 + cb * 256 + c] = s; }
            __syncthreads();
        }
    }
}
__device__ __forceinline__ void p1_init(Frame& F) {
    const Args& A = *F.a; bf16_t* U = RG(F, 0);
    for (int t = F.gw; t < TT; t += F.NGW) {
        const float* src = t < TLAT ? A.in[I_X] + (size_t)t * D : A.in[I_CTX] + (size_t)(t - TLAT) * D;
        float* hp = hrow(F, t); const int mi = t < TLAT ? (t >> 13) : 4; const float* mp = modrow(F, 0, mi);
#pragma unroll
        for (int j = 0; j < 4; ++j) { const int col = 256 * j + 4 * F.lane; const f32x4 v = *(const f32x4*)(src + col);
            *(f32x4*)(hp + col) = v;
            const f32x4 sh = *(const f32x4*)(mp + col), sc = *(const f32x4*)(mp + 1024 + col); const f32x4 u = v * (sc + 1.0f) + sh;
            *(u32x2*)(U + (size_t)t * D + col) = (u32x2){pk2(u[0], u[1]), pk2(u[2], u[3])}; }
    }
}

__device__ __forceinline__ void moe_route(Frame& F, int layer, int nrows) {
    const Args& A = *F.a;
    { LAS float* scr = (LAS float*)(F.lds + F.wave * 16384);
      const float* eg = A.in[I_EGATE] + (size_t)layer * NE * D * DE; const float* eu = A.in[I_EUP] + (size_t)layer * NE * D * DE; const float* ed = A.in[I_EDOWN] + (size_t)layer * NE * DE * D;
      bf16_t* W1 = (bf16_t*)(F.ws + WS_WE1); bf16_t* W2 = (bf16_t*)(F.ws + WS_WE2);
      for (int it = F.gw; it < NE * 768; it += F.NGW) { const int e = it / 768, r = it % 768;
        if (r < 512) { const int up = r >> 8, q = r & 255, kb = q >> 4, nb = q & 15, n0 = 32 * nb;
            transpose_item((up ? eu : eg) + (size_t)e * D * DE, DE, W1 + (size_t)e * D * D, D, (n0 >> 7) * 256 + (n0 & 127) + up * 128, 64 * kb, n0, scr, F.lane); }
        else { const int q = r - 512, kb = q >> 5, nb = q & 31;
            transpose_item(ed + (size_t)e * DE * D, D, W2 + (size_t)e * D * DE, DE, 32 * nb, 64 * kb, 32 * nb, scr, F.lane); } }
    }
    __syncthreads();
    LAS float* WR = (LAS float*)F.lds;
    LAS int* CNT = (LAS int*)(F.lds + 65536); LAS int* BASE = CNT + 16; LAS int* EID = CNT + 64; LAS int* RK = EID + 2 * 272; LAS float* WT = (LAS float*)(RK + 2 * 272);
    for (int idx = F.tid; idx < D * NE; idx += NTHR) { const int k = idx >> 4, e = idx & 15, j = k >> 8, ln = (k >> 2) & 63, i = k & 3, q = e >> 2;
        WR[((((j * 4 + i) * 4 + q) * 64 + ln) << 2) + (e & 3)] = A.in[I_WROUTER][idx]; }
    if (F.tid < 16) CNT[F.tid] = 0;
    __syncthreads();
    const int per = (nrows + F.G - 1) / F.G, r0 = F.bid * per, r1 = (r0 + per < nrows) ? r0 + per : nrows;
    const float* lg = A.in[I_LNG] + (size_t)(layer * 2 + 0) * D; const float* lb = A.in[I_LNB] + (size_t)(layer * 2 + 0) * D;
    float rb[16];
#pragma unroll
    for (int e = 0; e < 16; ++e) rb[e] = A.in[I_RBIAS][e];
    for (int t = r0 + F.wave; t < r1; t += NWAVES) {
        FRAME_REFRESH(F);
        float* hp = hrow(F, t); const int mi = t < TLAT ? (t >> 13) : 4; const float* mp = modrow(F, layer, mi);
        f32x4 v[4]; float s = 0.f;
#pragma unroll
        for (int j = 0; j < 4; ++j) { v[j] = *(const f32x4*)(hp + 256 * j + 4 * F.lane); s += (v[j][0] + v[j][1]) + (v[j][2] + v[j][3]); }
        const float mean = wave_sum(s) * (1.f / D); float s2 = 0.f;
#pragma unroll
        for (int j = 0; j < 4; ++j) { v[j] = v[j] - mean; s2 += (v[j][0] * v[j][0] + v[j][1] * v[j][1]) + (v[j][2] * v[j][2] + v[j][3] * v[j][3]); }
        const float rstd = 1.f / sqrtf(wave_sum(s2) * (1.f / D) + EPS);
        float acc[16];
#pragma unroll
        for (int e = 0; e < 16; ++e) acc[e] = 0.f;
#pragma unroll
        for (int j = 0; j < 4; ++j) { const int col = 256 * j + 4 * F.lane;
            const f32x4 hn = v[j] * rstd * *(const f32x4*)(lg + col) + *(const f32x4*)(lb + col);
            *(f32x4*)(hp + col) = hn;
            const f32x4 u2 = hn * (*(const f32x4*)(mp + 4096 + col) + 1.0f) + *(const f32x4*)(mp + 3072 + col);
#pragma unroll
            for (int i = 0; i < 4; ++i)
#pragma unroll
                for (int q = 0; q < 4; ++q) { const f32x4 w = *(const LAS f32x4*)(WR + ((((j * 4 + i) * 4 + q) * 64 + F.lane) << 2));
                    acc[4 * q + 0] += u2[i] * w[0]; acc[4 * q + 1] += u2[i] * w[1]; acc[4 * q + 2] += u2[i] * w[2]; acc[4 * q + 3] += u2[i] * w[3]; } }
        float sc[16], sel[16];
#pragma unroll
        for (int e = 0; e < 16; ++e) { acc[e] = wave_sum(acc[e]); sc[e] = 1.f / (1.f + expf(-acc[e])); sel[e] = sc[e] + rb[e]; }
        float gs[4];
#pragma unroll
        for (int g = 0; g < 4; ++g) { const float a = sel[4 * g], b = sel[4 * g + 1], c = sel[4 * g + 2], d = sel[4 * g + 3];
            const float hi1 = fmaxf(a, b), lo1 = fminf(a, b), hi2 = fmaxf(c, d), lo2 = fminf(c, d);
            const float m1 = fmaxf(hi1, hi2), m2 = fmaxf(fminf(hi1, hi2), fmaxf(lo1, lo2)); gs[g] = m1 + m2; }
        int bg = 0; float bgs = gs[0];
#pragma unroll
        for (int g = 1; g < 4; ++g) if (gs[g] > bgs) { bgs = gs[g]; bg = g; }
        float s4[4], c4[4];
#pragma unroll
        for (int i = 0; i < 4; ++i) { s4[i] = bg == 0 ? sel[i] : bg == 1 ? sel[4 + i] : bg == 2 ? sel[8 + i] : sel[12 + i]; c4[i] = bg == 0 ? sc[i] : bg == 1 ? sc[4 + i] : bg == 2 ? sc[8 + i] : sc[12 + i]; }
        int i1 = 0; float b1 = s4[0], w1 = c4[0];
#pragma unroll
        for (int i = 1; i < 4; ++i) if (s4[i] > b1) { b1 = s4[i]; i1 = i; w1 = c4[i]; }
        int i2 = -1; float b2 = -3.0e38f, w2 = 0.f;
#pragma unroll
        for (int i = 0; i < 4; ++i) if (i != i1 && s4[i] > b2) { b2 = s4[i]; i2 = i; w2 = c4[i]; }
        const int e1 = bg * 4 + i1, e2 = bg * 4 + i2; const float wn = 1.f / (w1 + w2);
        if (F.lane == 0) { const int rl = t - r0;
            const int k1 = __hip_atomic_fetch_add(CNT + e1, 1, __ATOMIC_RELAXED, __HIP_MEMORY_SCOPE_WORKGROUP);
            const int k2 = __hip_atomic_fetch_add(CNT + e2, 1, __ATOMIC_RELAXED, __HIP_MEMORY_SCOPE_WORKGROUP);
            EID[2 * rl] = e1; EID[2 * rl + 1] = e2; RK[2 * rl] = k1; RK[2 * rl + 1] = k2; WT[2 * rl] = w1 * wn; WT[2 * rl + 1] = w2 * wn; }
    }
    FRAME_REFRESH(F);
    __syncthreads();
    if (F.tid < 16) BASE[F.tid] = (int)__hip_atomic_fetch_add((unsigned*)(F.ws + WS_CTL) + CW_CNT + layer * 16 + F.tid, (unsigned)CNT[F.tid], RLX_AGENT);
    __syncthreads();
    for (int rl = F.tid; rl < r1 - r0; rl += NTHR) { const int t = r0 + rl; const int e1 = EID[2 * rl], e2 = EID[2 * rl + 1];
        ((i32x2*)(F.ws + WS_ASG))[t] = (i32x2){e1, e2}; ((f32x2*)(F.ws + WS_ASGW))[t] = (f32x2){WT[2 * rl], WT[2 * rl + 1]};
        ((i32x2*)(F.ws + WS_POS))[t] = (i32x2){BASE[e1] + RK[2 * rl], BASE[e2] + RK[2 * rl + 1]}; }
}
__device__ __forceinline__ void moe_tables(Frame& F, int layer) {
    LAS int* TS = (LAS int*)(F.lds + GTAB_OFF); LAS int* CN = TS + 32;
    if (F.tid == 0) { const unsigned* gc = (const unsigned*)(F.ws + WS_CTL) + CW_CNT + layer * 16; int acc = 0;
        for (int e = 0; e < NE; ++e) { const int c = (int)gc[e]; TS[e] = acc; CN[e] = c; acc += (c + 255) >> 8; } TS[NE] = acc; }
    __syncthreads();
}
__device__ __forceinline__ void moe_scatter(Frame& F, int layer, int nrows) {
    moe_tables(F, layer);
    const LAS int* TS = (const LAS int*)(F.lds + GTAB_OFF);
    bf16_t* XS = (bf16_t*)(F.ws + WS_XS); int* rowmap = (int*)(F.ws + WS_ROWMAP); float* roww = (float*)(F.ws + WS_ROWW);
    for (int t = F.gw; t < nrows; t += F.NGW) {
        const float* hp = hrow(F, t); const int mi = t < TLAT ? (t >> 13) : 4; const float* mp = modrow(F, layer, mi);
        const i32x2 ee = ((const i32x2*)(F.ws + WS_ASG))[t]; const i32x2 pp = ((const i32x2*)(F.ws + WS_POS))[t]; const f32x2 ww = ((const f32x2*)(F.ws + WS_ASGW))[t];
        const int d0 = TS[ee.x] * 256 + pp.x, d1 = TS[ee.y] * 256 + pp.y;
#pragma unroll
        for (int j = 0; j < 4; ++j) { const int col = 256 * j + 4 * F.lane; const f32x4 hn = *(const f32x4*)(hp + col);
            const f32x4 u = hn * (*(const f32x4*)(mp + 4096 + col) + 1.0f) + *(const f32x4*)(mp + 3072 + col);
            const u32x2 w = {pk2(u[0], u[1]), pk2(u[2], u[3])};
            *(u32x2*)(XS + (size_t)d0 * D + col) = w; *(u32x2*)(XS + (size_t)d1 * D + col) = w; }
        if (F.lane == 0) { rowmap[d0] = 2 * t; rowmap[d1] = 2 * t + 1; roww[d0] = ww.x; roww[d1] = ww.y; }
    }
}
__device__ __forceinline__ void moe_ln2(Frame& F, int layer, int nrows, bool last) {
    const Args& A = *F.a; const bf16_t* Y2 = (const bf16_t*)(F.ws + WS_Y2); bf16_t* U = RG(F, 0);
    const float* lg = A.in[I_LNG] + (size_t)(layer * 2 + 1) * D; const float* lb = A.in[I_LNB] + (size_t)(layer * 2 + 1) * D;
    for (int t = F.gw; t < nrows; t += F.NGW) {
        float* hp = hrow(F, t); const int mi = t < TLAT ? (t >> 13) : 4; const float* mp = modrow(F, layer, mi);
        f32x4 v[4]; float s = 0.f;
#pragma unroll
        for (int j = 0; j < 4; ++j) { const int col = 256 * j + 4 * F.lane; const f32x4 hv = *(const f32x4*)(hp + col);
            const u32x2 ya = *(const u32x2*)(Y2 + (size_t)(2 * t) * D + col), yb = *(const u32x2*)(Y2 + (size_t)(2 * t + 1) * D + col);
            const f32x4 y = {bflo(ya.x) + bflo(yb.x), bfhi(ya.x) + bfhi(yb.x), bflo(ya.y) + bflo(yb.y), bfhi(ya.y) + bfhi(yb.y)};
            v[j] = hv * DN_ALPHA + *(const f32x4*)(mp + 5120 + col) * y; s += (v[j][0] + v[j][1]) + (v[j][2] + v[j][3]); }
        const float mean = wave_sum(s) * (1.f / D); float s2 = 0.f;
#pragma unroll
        for (int j = 0; j < 4; ++j) { v[j] = v[j] - mean; s2 += (v[j][0] * v[j][0] + v[j][1] * v[j][1]) + (v[j][2] * v[j][2] + v[j][3] * v[j][3]); }
        const float rstd = 1.f / sqrtf(wave_sum(s2) * (1.f / D) + EPS);
        const float* mn = modrow(F, last ? layer : layer + 1, mi);
#pragma unroll
        for (int j = 0; j < 4; ++j) { const int col = 256 * j + 4 * F.lane;
            const f32x4 hn = v[j] * rstd * *(const f32x4*)(lg + col) + *(const f32x4*)(lb + col);
            *(f32x4*)(hp + col) = hn;
            if (!last) { const f32x4 u = hn * (*(const f32x4*)(mn + 1024 + col) + 1.0f) + *(const f32x4*)(mn + col);
                *(u32x2*)(U + (size_t)t * D + col) = (u32x2){pk2(u[0], u[1]), pk2(u[2], u[3])}; } }
    }
}

__device__ __forceinline__ void qk_norm_rope(Frame& F, int j, const pg8::StaticOrder& S) {
    const Args& A = *F.a; const float* qg = A.in[I_AQG] + j * 128; const float* kg = A.in[I_AKG] + j * 128;
    bf16_t* Q = RG(F, 1); bf16_t* Kb = RG(F, 2); const f32x2* rope = (const f32x2*)(F.ws + WS_ROPE);
    const int sub = F.lane >> 4, l16 = F.lane & 15;
    Unit u;
    for (int i = 0; S.next(i, u); ++i) {
        if (u.pn >= 5) continue;
        const float* gn = u.pn < 4 ? qg : kg;
        float gv[8];
#pragma unroll
        for (int e = 0; e < 8; ++e) gv[e] = gn[l16 * 8 + e];
        bf16_t* base; size_t ld; size_t r0;
        if (u.pn < 4) { base = Q + u.pn * 256; ld = D; r0 = (size_t)u.pm * 256; }
        else { base = Kb; ld = 256; r0 = u.pm < 128 ? (size_t)(u.pm >> 5) * KVLEN + CTXL + (size_t)(u.pm & 31) * 256 : (size_t)(u.pm - 128) * KVLEN; }
        const bool lat = u.pm < 128;
        for (int it = 0; it < 16; ++it) {
            const int pi = it * 32 + F.wave * 4 + sub, row = pi >> 1, hh = pi & 1;
            bf16_t* p = base + (r0 + row) * ld + hh * 128 + l16 * 8;
            const u32x4 w = *(const u32x4*)p;
            float x[8] = {bflo(w.x), bfhi(w.x), bflo(w.y), bfhi(w.y), bflo(w.z), bfhi(w.z), bflo(w.w), bfhi(w.w)};
            float ss = 0.f;
#pragma unroll
            for (int e = 0; e < 8; ++e) ss += x[e] * x[e];
            ss = sum16(ss);
            const float rs = 1.f / sqrtf(ss * (1.f / 128.f) + EPS);
#pragma unroll
            for (int e = 0; e < 8; ++e) x[e] = x[e] * rs * gv[e];
            if (lat) { const int n = (u.pm & 31) * 256 + row;
#pragma unroll
                for (int e = 0; e < 4; ++e) { const f32x2 cs = rope[(size_t)n * 64 + l16 * 4 + e]; const float a = x[2 * e], b = x[2 * e + 1];
                    x[2 * e] = a * cs.x - b * cs.y; x[2 * e + 1] = a * cs.y + b * cs.x; } }
            *(u32x4*)p = (u32x4){pk2(x[0], x[1]), pk2(x[2], x[3]), pk2(x[4], x[5]), pk2(x[6], x[7])};
        }
    }
}
__device__ __forceinline__ void attn_phase(Frame& F, bool need_ctx) {
    const bf16_t* Q = RG(F, 1); const bf16_t* Kb = RG(F, 2); const bf16_t* Vb = (const bf16_t*)((const char*)RG(F, 2) + 17 * MiB);
    const int nunits = 1024 + (need_ctx ? 32 : 0);
    for (int L = F.bid; L < nunits; L += F.G) {
        int b, h, t0, seq;
        if (L < 1024) { const int qb = L & 31; h = (L >> 5) & 7; b = L >> 8; t0 = b * SEQ + qb * 256; seq = KVLEN; }
        else { const int i = L - 1024; b = i >> 3; h = i & 7; t0 = TLAT + b * CTXL; seq = CTXL; }
        const bf16_t* Qp = Q + (size_t)t0 * D + h * 128;
        const size_t kvo = (size_t)b * KVLEN * 256 + (h >> 2) * 128;
        att::attn_dense_body(Qp, Kb + kvo, Vb + kvo, (bf16_t*)Qp, seq, F.ldsg, F.tid);
    }
}

__device__ __forceinline__ void gmlp_spatial(Frame& F) {
    const Args& A = *F.a; const bf16_t* ZB = RG(F, 1); bf16_t* P = RG(F, 0); const bf16_t* WS_ = (const bf16_t*)(F.ws + WS_BWS);
    LAS float* ST = (LAS float*)F.lds;
    LAS bf16_t* VT = (LAS bf16_t*)(F.lds + 2048);
    constexpr int VP = 130;
    const int r = F.lane & 31, hh = F.lane >> 5, wr = F.wave >> 1, wc = F.wave & 1;
    for (int un = F.bid; un < 528; un += F.G) {
        const int ck = un >> 1, hf = un & 1, t0 = ck * 128;
        { const int row = F.tid >> 2, q = F.tid & 3; const bf16_t* vp = ZB + (size_t)(t0 + row) * 2048 + 1024 + q * 256; float s = 0.f, s2 = 0.f;
#pragma unroll 4
          for (int i = 0; i < 32; ++i) { const u32x4 w = *(const u32x4*)(vp + i * 8); const float x[8] = {bflo(w.x), bfhi(w.x), bflo(w.y), bfhi(w.y), bflo(w.z), bfhi(w.z), bflo(w.w), bfhi(w.w)};
#pragma unroll
              for (int e = 0; e < 8; ++e) { s += x[e]; s2 += x[e] * x[e]; } }
          s += __shfl_xor(s, 1); s += __shfl_xor(s, 2); s2 += __shfl_xor(s2, 1); s2 += __shfl_xor(s2, 2);
          const float mean = s * (1.f / 1024.f), var = fmaxf(s2 * (1.f / 1024.f) - mean * mean, 0.f);
          if (q == 0) { ST[2 * row] = mean; ST[2 * row + 1] = 1.f / sqrtf(var + EPS); } }
        __syncthreads();
        for (int gi = 0; gi < 4; ++gi) { const int g = hf * 4 + gi;
            { const int row = F.tid >> 2, q = F.tid & 3; const float mean = ST[2 * row], rstd = ST[2 * row + 1];
              const bf16_t* vp = ZB + (size_t)(t0 + row) * 2048 + 1024 + g * 128 + q * 32;
#pragma unroll
              for (int i = 0; i < 4; ++i) { const u32x4 w = *(const u32x4*)(vp + i * 8); const float x[8] = {bflo(w.x), bfhi(w.x), bflo(w.y), bfhi(w.y), bflo(w.z), bfhi(w.z), bflo(w.w), bfhi(w.w)};
                  const int c0 = g * 128 + q * 32 + i * 8;
#pragma unroll
                  for (int e = 0; e < 8; e += 2) { const float y0 = (x[e] - mean) * rstd * A.in[I_BVG][c0 + e] + A.in[I_BVB][c0 + e], y1 = (x[e + 1] - mean) * rstd * A.in[I_BVG][c0 + e + 1] + A.in[I_BVB][c0 + e + 1];
                      *(LAS unsigned*)(VT + row * VP + q * 32 + i * 8 + e) = pk2(y0, y1); } } }
            __syncthreads();
            f32x16 acc[2] = {};
            const bf16_t* wp = WS_ + ((size_t)g * 128 + wr * 32 + r) * 128 + hh * 8;
#pragma unroll
            for (int ks = 0; ks < 8; ++ks) { const bf16x8 af = *(const bf16x8*)(wp + ks * 16);
#pragma unroll
                for (int cb = 0; cb < 2; ++cb) { const LAS bf16_t* bp = VT + (ks * 16 + hh * 8) * VP + wc * 64 + cb * 32 + r;
                    bf16x8 bfr;
#pragma unroll
                    for (int e = 0; e < 8; ++e) bfr[e] = (short)bp[e * VP];
                    acc[cb] = MFMA32(af, bfr, acc[cb]); } }
#pragma unroll
            for (int cb = 0; cb < 2; ++cb)
#pragma unroll
                for (int reg = 0; reg < 16; ++reg) { const int tl = wr * 32 + crow(reg, hh), c = g * 128 + wc * 64 + cb * 32 + r;
                    const float mixed = acc[cb][reg] + A.in[I_BBS][g * 128 + tl];
                    const float uu = bf1(ZB[(size_t)(t0 + tl) * 2048 + c]);
                    P[(size_t)(t0 + tl) * D + c] = (bf16_t)(pk2(uu * mixed, 0.f) & 0xffffu); }
            __syncthreads();
        }
    }
}

__device__ __forceinline__ void delta_prep(Frame& F) {
    const Args& A = *F.a; const float* cw = A.in[I_CCONV];
    for (int wu = F.gw; wu < 528 * 6; wu += F.NGW) {
        const int ck = wu / 6, slab = wu % 6, buf = slab >> 1, ch = (slab & 1) * 512 + 8 * F.lane, t0 = ck * 64;
        const bf16_t* src = RG(F, 1 + buf) + ch; bf16_t* dst = RG(F, 5 + buf) + ch;
        float w0[8], w1[8], w2[8];
#pragma unroll
        for (int e = 0; e < 8; ++e) { const int cg = buf * 1024 + ch + e; w0[e] = cw[cg]; w1[e] = cw[3072 + cg]; w2[e] = cw[6144 + cg]; }
        const int seqlen = t0 < TLAT ? SEQ : CTXL, n0 = t0 < TLAT ? (t0 & (SEQ - 1)) : ((t0 - TLAT) & (CTXL - 1));
        u32x4 prev = {0u, 0u, 0u, 0u}, cur, nxt;
        if (n0 > 0) prev = *(const u32x4*)(src + (size_t)(t0 - 1) * D);
        cur = *(const u32x4*)(src + (size_t)t0 * D);
        for (int rr = 0; rr < 64; ++rr) {
            const int t = t0 + rr;
            nxt = (u32x4){0u, 0u, 0u, 0u};
            if (n0 + rr + 1 < seqlen) nxt = *(const u32x4*)(src + (size_t)(t + 1) * D);
            const float xp[8] = {bflo(prev.x), bfhi(prev.x), bflo(prev.y), bfhi(prev.y), bflo(prev.z), bfhi(prev.z), bflo(prev.w), bfhi(prev.w)};
            const float xc[8] = {bflo(cur.x), bfhi(cur.x), bflo(cur.y), bfhi(cur.y), bflo(cur.z), bfhi(cur.z), bflo(cur.w), bfhi(cur.w)};
            const float xn[8] = {bflo(nxt.x), bfhi(nxt.x), bflo(nxt.y), bfhi(nxt.y), bflo(nxt.z), bfhi(nxt.z), bflo(nxt.w), bfhi(nxt.w)};
            float y[8]; float ss = 0.f;
#pragma unroll
            for (int e = 0; e < 8; ++e) { y[e] = siluf_(w0[e] * xp[e] + w1[e] * xc[e] + w2[e] * xn[e]); ss += y[e] * y[e]; }
            if (buf < 2) { ss = sum16(ss); const float rs = (1.f / sqrtf(ss + EPS)) * (buf == 0 ? 0.08838834764831845f : 1.f);
#pragma unroll
                for (int e = 0; e < 8; ++e) y[e] *= rs; }
            *(u32x4*)(dst + (size_t)t * D) = (u32x4){pk2(y[0], y[1]), pk2(y[2], y[3]), pk2(y[4], y[5]), pk2(y[6], y[7])};
            prev = cur; cur = nxt;
        }
    }
}
__device__ __forceinline__ void delta_local(Frame& F) {
    const Args& A = *F.a; const float* AB = (const float*)(F.ws + WS_AB); float* GC = (float*)(F.ws + WS_GC); float* BETA = (float*)(F.ws + WS_BETA);
    const bf16_t* QN = RG(F, 5); const bf16_t* KN = RG(F, 6); bf16_t* TB = RG(F, 1); bf16_t* ATT = RG(F, 2);
    LAS float* Aw = (LAS float*)(F.lds + F.wave * 16384);
    for (int wu = F.gw; wu < 528 * 16; wu += F.NGW) {
        int lane = F.lane; asm volatile("" : "+v"(lane));
        const int r = lane & 31, hh = lane >> 5;
        const int dir = wu & 1, h = (wu >> 1) & 7, ck = wu >> 4, t0 = ck * 64;
        const int tok = dir ? t0 + 63 - lane : t0 + lane;
        const float a = AB[(size_t)tok * 32 + dir * 8 + h], bb = AB[(size_t)tok * 32 + 16 + dir * 8 + h];
        const float x = a + A.in[I_CDTB][dir * 8 + h];
        const float sp = fmaxf(x, 0.f) + log1pf(expf(-fabsf(x)));
        const float g = -expf(A.in[I_CALOG][dir * 8 + h]) * sp;
        const float beta = 1.f / (1.f + expf(-bb));
        float gc = g;
#pragma unroll
        for (int o = 1; o < 64; o <<= 1) { const float tv = __shfl_up(gc, o); if (lane >= o) gc += tv; }
        GC[(size_t)(dir * 8 + h) * TT + tok] = gc; BETA[(size_t)(dir * 8 + h) * TT + tok] = beta;
        const int tk0 = dir ? t0 + 63 - r : t0 + r, tk1 = dir ? t0 + 31 - r : t0 + 32 + r;
        const bf16_t* kp0 = KN + (size_t)tk0 * D + h * 128 + hh * 8; const bf16_t* kp1 = KN + (size_t)tk1 * D + h * 128 + hh * 8;
        const bf16_t* qp0 = QN + (size_t)tk0 * D + h * 128 + hh * 8; const bf16_t* qp1 = QN + (size_t)tk1 * D + h * 128 + hh * 8;
        bf16x8 kf0[8], kf1[8];
#pragma unroll
        for (int ks = 0; ks < 8; ++ks) { kf0[ks] = *(const bf16x8*)(kp0 + ks * 16); kf1[ks] = *(const bf16x8*)(kp1 + ks * 16); }
        const float gcj0 = __shfl(gc, r), gcj1 = __shfl(gc, 32 + r);
        bf16_t* attp = ATT + (size_t)wu * 4096;
        {   f32x16 s00 = {}, s10 = {}, s11 = {};
#pragma unroll
            for (int ks = 0; ks < 8; ++ks) { s00 = MFMA32(kf0[ks], kf0[ks], s00); s10 = MFMA32(kf1[ks], kf0[ks], s10); s11 = MFMA32(kf1[ks], kf1[ks], s11); }
#pragma unroll
            for (int reg = 0; reg < 16; ++reg) { const int il = crow(reg, hh);
                const float gci0 = __shfl(gc, il), gci1 = __shfl(gc, 32 + il), bt0 = __shfl(beta, il), bt1 = __shfl(beta, 32 + il);
                const float d00 = (il > r) ? expf(gci0 - gcj0) : 0.f, d10 = expf(gci1 - gcj0), d11 = (il > r) ? expf(gci1 - gcj1) : 0.f;
                Aw[il * 64 + r] = bt0 * s00[reg] * d00;
                Aw[il * 64 + 32 + r] = 0.f;
                Aw[(32 + il) * 64 + r] = bt1 * s10[reg] * d10;
                Aw[(32 + il) * 64 + 32 + r] = bt1 * s11[reg] * d11; }
        }
        asm volatile("" ::: "memory"); __builtin_amdgcn_sched_barrier(0);
        {   f32x16 q00 = {}, q10 = {}, q11 = {};
#pragma unroll
            for (int ks = 0; ks < 8; ++ks) { const bf16x8 q0 = *(const bf16x8*)(qp0 + ks * 16), q1 = *(const bf16x8*)(qp1 + ks * 16);
                q00 = MFMA32(q0, kf0[ks], q00); q10 = MFMA32(q1, kf0[ks], q10); q11 = MFMA32(q1, kf1[ks], q11); }
#pragma unroll
            for (int reg = 0; reg < 16; ++reg) { const int il = crow(reg, hh);
                const float gci0 = __shfl(gc, il), gci1 = __shfl(gc, 32 + il);
                const float d00 = (il >= r) ? expf(gci0 - gcj0) : 0.f, d10 = expf(gci1 - gcj0), d11 = (il >= r) ? expf(gci1 - gcj1) : 0.f;
                attp[il * 64 + r] = (bf16_t)(pk2(q00[reg] * d00, 0.f) & 0xffffu);
                attp[il * 64 + 32 + r] = 0;
                attp[(32 + il) * 64 + r] = (bf16_t)(pk2(q10[reg] * d10, 0.f) & 0xffffu);
                attp[(32 + il) * 64 + 32 + r] = (bf16_t)(pk2(q11[reg] * d11, 0.f) & 0xffffu); }
        }
        asm volatile("" ::: "memory"); __builtin_amdgcn_sched_barrier(0);
        LDS_WAIT(); asm volatile("" ::: "memory");
        float Tc[64]; bf16_t* tp = TB + (size_t)wu * 4096 + lane;
#pragma unroll
        for (int i = 0; i < 64; ++i) { float acc = (i == lane) ? 1.f : 0.f;
#pragma unroll
            for (int j4 = 0; j4 < (i + 3) / 4; ++j4) { const f32x4 av = *(const LAS f32x4*)(Aw + i * 64 + 4 * j4);
#pragma unroll
                for (int e = 0; e < 4; ++e) if (4 * j4 + e < i) acc -= av[e] * Tc[4 * j4 + e]; }
            Tc[i] = acc; tp[i * 64] = (bf16_t)(pk2(acc, 0.f) & 0xffffu);
            if ((i & 3) == 3) { asm volatile("" ::: "memory"); __builtin_amdgcn_sched_barrier(0); } }
        LDS_WAIT(); asm volatile("" ::: "memory");
    }
}
constexpr int SC_QT = 0, SC_KT = 16896, SC_KTT = 33792, SC_TT = 51200, SC_AT = 59904, SC_VT = 68608, SC_TAB = 76800, SC_XP = 77824, SC_OP = 110592;
static_assert(SC_OP + 32768 <= MISC_OFF, "scan LDS");
__device__ __forceinline__ bf16x8 lds_frag(const LAS unsigned char* p) { return mk8(*(const LAS u32x2*)p, *(const LAS u32x2*)(p + 16)); }
__device__ __forceinline__ bf16x8 pack_acc(const f32x16& v, int s) { return mk8w(pk2(v[8 * s], v[8 * s + 1]), pk2(v[8 * s + 2], v[8 * s + 3]), pk2(v[8 * s + 4], v[8 * s + 5]), pk2(v[8 * s + 6], v[8 * s + 7])); }
__device__ __forceinline__ void delta_scan(Frame& F) {
    const bf16_t* QN = RG(F, 5); const bf16_t* KN = RG(F, 6); const bf16_t* VN = RG(F, 7); const bf16_t* TB = RG(F, 1); const bf16_t* ATT = RG(F, 2);
    const float* GC = (const float*)(F.ws + WS_GC); const float* BETA = (const float*)(F.ws + WS_BETA);
    LAS unsigned char* L = F.lds; const int w = F.wave;
    LAS float* TAB = (LAS float*)(L + SC_TAB); LAS float* XP = (LAS float*)(L + SC_XP); LAS float* OP = (LAS float*)(L + SC_OP); LAS float* VT = (LAS float*)(L + SC_VT);
    for (int item = F.bid; item < 256; item += F.G) {
        const int ch = item >> 2, dvs = item & 3, b = ch >> 4, h = (ch >> 1) & 7, dir = ch & 1;
        bf16_t* OB = RG(F, dir ? 3 : 0);
        f32x16 S = {};
        u32x4 sq[2], sk[2], st, sa, sv; float sgc = 0.f, sbt = 0.f;
#define SCAN_CK(step) ((step) < 4 ? 512 + b * 4 + (dir ? 3 - (step) : (step)) : b * 128 + (dir ? 131 - (step) : (step) - 4))
#define SCAN_LOAD(step) do { const int ck_ = SCAN_CK(step); const int t0_ = ck_ * 64; const size_t un_ = ((size_t)ck_ * 8 + h) * 2 + dir; \
        _Pragma("unroll") for (int e_ = 0; e_ < 2; ++e_) { const int id_ = tid + 512 * e_, row_ = id_ >> 4, c16_ = id_ & 15; const int tk_ = dir ? t0_ + 63 - row_ : t0_ + row_; \
            sq[e_] = *(const u32x4*)(QN + (size_t)tk_ * D + h * 128 + c16_ * 8); sk[e_] = *(const u32x4*)(KN + (size_t)tk_ * D + h * 128 + c16_ * 8); } \
        st = *(const u32x4*)(TB + un_ * 4096 + tid * 8); sa = *(const u32x4*)(ATT + un_ * 4096 + tid * 8); \
        if (tid < 256) { const int row_ = tid >> 2, c_ = tid & 3; const int tk_ = dir ? t0_ + 63 - row_ : t0_ + row_; sv = *(const u32x4*)(VN + (size_t)tk_ * D + h * 128 + dvs * 32 + c_ * 8); } \
        if (tid < 64) { const int tk_ = dir ? t0_ + 63 - tid : t0_ + tid; sgc = GC[(size_t)(dir * 8 + h) * TT + tk_]; sbt = BETA[(size_t)(dir * 8 + h) * TT + tk_]; } } while (0)
#define SCAN_STORE() do { \
        _Pragma("unroll") for (int e_ = 0; e_ < 2; ++e_) { const int id_ = tid + 512 * e_, row_ = id_ >> 4, c16_ = id_ & 15; \
            *(LAS u32x2*)(L + SC_QT + row_ * 264 + c16_ * 16) = (u32x2){sq[e_].x, sq[e_].y}; *(LAS u32x2*)(L + SC_QT + row_ * 264 + c16_ * 16 + 8) = (u32x2){sq[e_].z, sq[e_].w}; \
            *(LAS u32x2*)(L + SC_KT + row_ * 264 + c16_ * 16) = (u32x2){sk[e_].x, sk[e_].y}; *(LAS u32x2*)(L + SC_KT + row_ * 264 + c16_ * 16 + 8) = (u32x2){sk[e_].z, sk[e_].w}; \
            LAS bf16_t* kt_ = (LAS bf16_t*)(L + SC_KTT) + (c16_ * 8) * 68 + row_; \
            kt_[0 * 68] = (bf16_t)(sk[e_].x & 0xffffu); kt_[1 * 68] = (bf16_t)(sk[e_].x >> 16); kt_[2 * 68] = (bf16_t)(sk[e_].y & 0xffffu); kt_[3 * 68] = (bf16_t)(sk[e_].y >> 16); \
            kt_[4 * 68] = (bf16_t)(sk[e_].z & 0xffffu); kt_[5 * 68] = (bf16_t)(sk[e_].z >> 16); kt_[6 * 68] = (bf16_t)(sk[e_].w & 0xffffu); kt_[7 * 68] = (bf16_t)(sk[e_].w >> 16); } \
        { const int row_ = tid >> 3, c16_ = tid & 7; \
          *(LAS u32x2*)(L + SC_TT + row_ * 136 + c16_ * 16) = (u32x2){st.x, st.y}; *(LAS u32x2*)(L + SC_TT + row_ * 136 + c16_ * 16 + 8) = (u32x2){st.z, st.w}; \
          *(LAS u32x2*)(L + SC_AT + row_ * 136 + c16_ * 16) = (u32x2){sa.x, sa.y}; *(LAS u32x2*)(L + SC_AT + row_ * 136 + c16_ * 16 + 8) = (u32x2){sa.z, sa.w}; } \
        if (tid < 256) { const int row_ = tid >> 2, c_ = tid & 3; LAS f32x4* vp_ = (LAS f32x4*)(VT + row_ * 32 + c_ * 8); \
            vp_[0] = (f32x4){bflo(sv.x), bfhi(sv.x), bflo(sv.y), bfhi(sv.y)}; vp_[1] = (f32x4){bflo(sv.z), bfhi(sv.z), bflo(sv.w), bfhi(sv.w)}; } \
        if (tid < 64) { const float gl_ = __shfl(sgc, 63); TAB[tid] = expf(sgc); TAB[64 + tid] = expf(gl_ - sgc); TAB[128 + tid] = sbt; if (tid == 0) TAB[192] = expf(gl_); } } while (0)
        int tid = F.tid; asm volatile("" : "+v"(tid));
        SCAN_LOAD(0); VM_WAIT(); SCAN_STORE(); __syncthreads();
#pragma unroll 1
        for (int step = 0; step < 132; ++step) {
            tid = F.tid; asm volatile("" : "+v"(tid));
            const int lane = tid & 63, r = lane & 31, hh = lane >> 5;
            const int ck = SCAN_CK(step), t0 = ck * 64;
            if (step + 1 < 132) SCAN_LOAD(step + 1);
            if (w < 4) {
                const bf16x8 Sb0 = pack_acc(S, 0), Sb1 = pack_acc(S, 1);
#pragma unroll
                for (int bi = 0; bi < 2; ++bi) { const int off = (32 * bi + r) * 264 + (32 * w + 4 * hh) * 2;
                    { f32x16 X = {}; const bf16x8 k0 = lds_frag(L + SC_KT + off), k1 = lds_frag(L + SC_KT + off + 32);
                      X = MFMA32(k0, Sb0, X); X = MFMA32(k1, Sb1, X);
#pragma unroll
                      for (int reg = 0; reg < 16; ++reg) XP[((w * 2 + bi) * 16 + reg) * 64 + lane] = X[reg]; }
                    { f32x16 X = {}; const bf16x8 q0 = lds_frag(L + SC_QT + off), q1 = lds_frag(L + SC_QT + off + 32);
                      X = MFMA32(q0, Sb0, X); X = MFMA32(q1, Sb1, X);
#pragma unroll
                      for (int reg = 0; reg < 16; ++reg) OP[((w * 2 + bi) * 16 + reg) * 64 + lane] = X[reg]; }
                    asm volatile("" ::: "memory"); }
            }
            __syncthreads();
            if (w < 4) {
                bf16x8 Rp[2][2];
#pragma unroll
                for (int bi = 0; bi < 2; ++bi)
#pragma unroll
                    for (int sh = 0; sh < 2; ++sh) { float R[8];
#pragma unroll
                        for (int e = 0; e < 8; ++e) { const int reg = 8 * sh + e; const int i = 32 * bi + crow(reg, hh);
                            const float X = (XP[((0 * 2 + bi) * 16 + reg) * 64 + lane] + XP[((1 * 2 + bi) * 16 + reg) * 64 + lane]) + (XP[((2 * 2 + bi) * 16 + reg) * 64 + lane] + XP[((3 * 2 + bi) * 16 + reg) * 64 + lane]);
                            R[e] = TAB[128 + i] * (VT[i * 32 + r] - TAB[i] * X); }
                        Rp[bi][sh] = mk8w(pk2(R[0], R[1]), pk2(R[2], R[3]), pk2(R[4], R[5]), pk2(R[6], R[7]));
                        asm volatile("" ::: "memory"); __builtin_amdgcn_sched_barrier(0); }
                f32x16 Vn0 = {}, Vn1 = {};
                { const int o0 = r * 136 + (4 * hh) * 2, o1 = (32 + r) * 136 + (4 * hh) * 2;
                  Vn0 = MFMA32(lds_frag(L + SC_TT + o0), Rp[0][0], Vn0); Vn0 = MFMA32(lds_frag(L + SC_TT + o0 + 32), Rp[0][1], Vn0);
                  Vn1 = MFMA32(lds_frag(L + SC_TT + o1), Rp[0][0], Vn1); Vn1 = MFMA32(lds_frag(L + SC_TT + o1 + 32), Rp[0][1], Vn1);
                  Vn1 = MFMA32(lds_frag(L + SC_TT + o1 + 64), Rp[1][0], Vn1); Vn1 = MFMA32(lds_frag(L + SC_TT + o1 + 96), Rp[1][1], Vn1); }
                asm volatile("" ::: "memory");
                bf16x8 Vsp[2][2];
                { f32x16 Vs;
#pragma unroll
                  for (int reg = 0; reg < 16; ++reg) Vs[reg] = Vn0[reg] * TAB[64 + crow(reg, hh)];
                  Vsp[0][0] = pack_acc(Vs, 0); Vsp[0][1] = pack_acc(Vs, 1);
#pragma unroll
                  for (int reg = 0; reg < 16; ++reg) Vs[reg] = Vn1[reg] * TAB[64 + 32 + crow(reg, hh)];
                  Vsp[1][0] = pack_acc(Vs, 0); Vsp[1][1] = pack_acc(Vs, 1); }
                const float gl = TAB[192];
#pragma unroll
                for (int reg = 0; reg < 16; ++reg) S[reg] *= gl;
                { const int o = (32 * w + r) * 136 + (4 * hh) * 2;
                  S = MFMA32(lds_frag(L + SC_KTT + o), Vsp[0][0], S); S = MFMA32(lds_frag(L + SC_KTT + o + 32), Vsp[0][1], S);
                  S = MFMA32(lds_frag(L + SC_KTT + o + 64), Vsp[1][0], S); S = MFMA32(lds_frag(L + SC_KTT + o + 96), Vsp[1][1], S); }
                asm volatile("" ::: "memory");
                if (w < 2) { f32x16 O = {};
                    const int o = (32 * w + r) * 136 + (4 * hh) * 2;
                    O = MFMA32(lds_frag(L + SC_AT + o), pack_acc(Vn0, 0), O); O = MFMA32(lds_frag(L + SC_AT + o + 32), pack_acc(Vn0, 1), O);
                    if (w == 1) { O = MFMA32(lds_frag(L + SC_AT + o + 64), pack_acc(Vn1, 0), O); O = MFMA32(lds_frag(L + SC_AT + o + 96), pack_acc(Vn1, 1), O); }
#pragma unroll
                    for (int sh = 0; sh < 2; ++sh) {
#pragma unroll
                        for (int e = 0; e < 8; ++e) { const int reg = 8 * sh + e; const int i = 32 * w + crow(reg, hh);
                            const float o1 = (OP[((0 * 2 + w) * 16 + reg) * 64 + lane] + OP[((1 * 2 + w) * 16 + reg) * 64 + lane]) + (OP[((2 * 2 + w) * 16 + reg) * 64 + lane] + OP[((3 * 2 + w) * 16 + reg) * 64 + lane]);
                            const float ov = O[reg] + TAB[i] * o1; const int tk = dir ? t0 + 63 - i : t0 + i;
                            OB[(size_t)tk * D + h * 128 + dvs * 32 + r] = (bf16_t)(pk2(ov, 0.f) & 0xffffu); }
                        asm volatile("" ::: "memory"); __builtin_amdgcn_sched_barrier(0); } }
            }
            __syncthreads();
            if (step + 1 < 132) { VM_WAIT(); SCAN_STORE(); }
            __syncthreads();
        }
#undef SCAN_CK
#undef SCAN_LOAD
#undef SCAN_STORE
    }
}
__device__ __forceinline__ void delta_out(Frame& F) {
    const Args& A = *F.a; const bf16_t* OF = RG(F, 0); const bf16_t* OBk = RG(F, 3); const bf16_t* Z = RG(F, 4); bf16_t* Y = RG(F, 5);
    for (int t = F.gw; t < TT; t += F.NGW) {
#pragma unroll
        for (int j = 0; j < 2; ++j) { const int col = j * 512 + 8 * F.lane; const size_t off = (size_t)t * D + col;
            const u32x4 a = *(const u32x4*)(OF + off), bq = *(const u32x4*)(OBk + off), z = *(const u32x4*)(Z + off);
            float o[8] = {bflo(a.x) + bflo(bq.x), bfhi(a.x) + bfhi(bq.x), bflo(a.y) + bflo(bq.y), bfhi(a.y) + bfhi(bq.y), bflo(a.z) + bflo(bq.z), bfhi(a.z) + bfhi(bq.z), bflo(a.w) + bflo(bq.w), bfhi(a.w) + bfhi(bq.w)};
            const float zz[8] = {bflo(z.x), bfhi(z.x), bflo(z.y), bfhi(z.y), bflo(z.z), bfhi(z.z), bflo(z.w), bfhi(z.w)};
            float ss = 0.f;
#pragma unroll
            for (int e = 0; e < 8; ++e) ss += o[e] * o[e];
            ss = sum16(ss); const float rs = 1.f / sqrtf(ss * (1.f / 128.f) + EPS);
#pragma unroll
            for (int e = 0; e < 8; ++e) o[e] = o[e] * rs * A.in[I_CNG][(col & 127) + e] * siluf_(zz[e]);
            *(u32x4*)(Y + off) = (u32x4){pk2(o[0], o[1]), pk2(o[2], o[3]), pk2(o[4], o[5]), pk2(o[6], o[7])}; }
    }
}

__global__ void __launch_bounds__(NTHR, 2) hybrid_fwd(Args args) {
    extern __shared__ __attribute__((aligned(16))) unsigned char lds[];
    Frame F;
    F.lds = (LAS unsigned char*)lds; F.ldsg = (char*)lds;
    F.wave = __builtin_amdgcn_readfirstlane((int)threadIdx.x >> 6);
#define REFRESH() FRAME_REFRESH(F)
    REFRESH();
    F.bid = blockIdx.x; F.G = gridDim.x; F.gw = F.bid * NWAVES + F.wave; F.NGW = F.G * NWAVES;
    F.a = &args; F.ws = args.ws; F.out = args.out;
    volatile LAS unsigned* MISC = (volatile LAS unsigned*)(F.lds + MISC_OFF);
    if (F.tid < 4) MISC[F.tid] = 0u;
    __syncthreads();
    const int lo = args.ph_lo, hi = args.ph_hi;
    XcdBarrier bar; bar.bar = (unsigned*)(args.ws + WS_CTL) + CW_BAR; bar.x = 0; bar.st = MISC;
    if (hi - lo > 1) bar = xcd_barrier_post((unsigned*)(args.ws + WS_CTL) + CW_BAR, MISC, F.tid);
    int ph = 0;
#ifndef PHMASK
#define PHMASK 0xFFFFFFFFu
#endif
#define PHASE_BEGIN(cls) if (((PHMASK >> (cls)) & 1u) && ph >= lo && ph < hi) { REFRESH();
#define PHASE_END   if (ph + 1 < hi) { REFRESH(); xcd_barrier(bar, F.tid); } } ++ph;
    const Args& A = args;
    float* hctx = (float*)(F.ws + WS_HCTX);

    PHASE_BEGIN(0) p0_prologue(F); PHASE_END
    PHASE_BEGIN(1) p1_init(F); PHASE_END

#define GEMM_DENSE(EPI, Aptr, Bptr, M_, N_, K_) do { pg8::Gemm g_{(Aptr), (Bptr), (M_), (N_), (K_), 0}; pg8::StaticOrder S_; S_.init((M_), (N_), F.G, F.bid); \
        pg8::gemm_phase(F.lds, g_, S_, EPI, F.tid); } while (0)
#define MOE_LAYER(layer, last) do { const int nrows_ = (last) ? TLAT : TT; \
        PHASE_BEGIN(5) moe_route(F, (layer), nrows_); PHASE_END \
        PHASE_BEGIN(6) moe_scatter(F, (layer), nrows_); PHASE_END \
        PHASE_BEGIN(7) { moe_tables(F, (layer)); pg8::Gemm g_{(const bf16_t*)(F.ws + WS_XS), (const bf16_t*)(F.ws + WS_WE1), XS_ROWS, 1024, D, (size_t)D * D * 2}; \
            pg8::GroupedOrder S_{(const LAS int*)(F.lds + GTAB_OFF), (const LAS int*)(F.lds + GTAB_OFF) + 32, F.G, F.bid}; EpiGateUp E_{(bf16_t*)(F.ws + WS_HID)}; pg8::gemm_phase(F.lds, g_, S_, E_, F.tid); } PHASE_END \
        PHASE_BEGIN(8) { moe_tables(F, (layer)); pg8::Gemm g_{(const bf16_t*)(F.ws + WS_HID), (const bf16_t*)(F.ws + WS_WE2), XS_ROWS, 1024, DE, (size_t)D * DE * 2}; \
            pg8::GroupedOrder S_{(const LAS int*)(F.lds + GTAB_OFF), (const LAS int*)(F.lds + GTAB_OFF) + 32, F.G, F.bid}; EpiDown E_{(bf16_t*)(F.ws + WS_Y2), (const int*)(F.ws + WS_ROWMAP), (const float*)(F.ws + WS_ROWW)}; pg8::gemm_phase(F.lds, g_, S_, E_, F.tid); } PHASE_END \
        PHASE_BEGIN(9) moe_ln2(F, (layer), nrows_, (last)); PHASE_END } while (0)
#define ATTN_LAYER(layer, j, last) do { \
        PHASE_BEGIN(2) { pg8::Gemm g_{RG(F, 0), (const bf16_t*)(F.ws + WS_WQKV) + (size_t)(j) * 1536 * D, TT, 1536, D, 0}; pg8::StaticOrder S_; S_.init(TT, 1536, F.G, F.bid); \
            EpiQKV E_{RG(F, 1), RG(F, 2), (bf16_t*)((char*)RG(F, 2) + 17 * MiB)}; pg8::gemm_phase(F.lds, g_, S_, E_, F.tid); VM_WAIT(); __syncthreads(); qk_norm_rope(F, (j), S_); } PHASE_END \
        PHASE_BEGIN(3) attn_phase(F, !(last)); PHASE_END \
        PHASE_BEGIN(4) { EpiResid E_{F.out, hctx, modrow(F, (layer), 0) + 2048}; GEMM_DENSE(E_, RG(F, 1), (const bf16_t*)(F.ws + WS_WO) + (size_t)(j) * D * D, (last) ? TLAT : TT, D, D); } PHASE_END } while (0)

    ATTN_LAYER(0, 0, false);
    MOE_LAYER(0, false);
    PHASE_BEGIN(10) { EpiGelu E_{RG(F, 1)}; GEMM_DENSE(E_, RG(F, 0), (const bf16_t*)(F.ws + WS_BWIN), TT, 2048, D); } PHASE_END
    PHASE_BEGIN(11) gmlp_spatial(F); PHASE_END
    PHASE_BEGIN(4) { EpiResid E_{F.out, hctx, modrow(F, 1, 0) + 2048}; GEMM_DENSE(E_, RG(F, 0), (const bf16_t*)(F.ws + WS_BWOUT), TT, D, D); } PHASE_END
    MOE_LAYER(1, false);
    PHASE_BEGIN(12) { EpiDeltaIn E_{RG(F, 1), (float*)(F.ws + WS_AB)}; GEMM_DENSE(E_, RG(F, 0), (const bf16_t*)(F.ws + WS_CWIN), TT, CW_NPAD, D); } PHASE_END
    PHASE_BEGIN(13) delta_prep(F); PHASE_END
    PHASE_BEGIN(14) delta_local(F); PHASE_END
    PHASE_BEGIN(15) delta_scan(F); PHASE_END
    PHASE_BEGIN(16) delta_out(F); PHASE_END
    PHASE_BEGIN(4) { EpiResid E_{F.out, hctx, modrow(F, 2, 0) + 2048}; GEMM_DENSE(E_, RG(F, 5), (const bf16_t*)(F.ws + WS_CWOUT), TT, D, D); } PHASE_END
    MOE_LAYER(2, false);
    ATTN_LAYER(3, 1, true);
    MOE_LAYER(3, true);
    (void)A;
}
constexpr int NPHASES = 2 + (3 + 5) + (3 + 5) + (6 + 5) + (3 + 5);

extern "C" void kernel_launch(void* const* d_in, const int* in_sizes, int n_in, void* d_out, int out_size, void* d_ws, size_t ws_size, hipStream_t stream) {
    static int grid = 0;
    if (grid == 0) {
        if (n_in != 29 || out_size != TLAT * D || ws_size < WS_END) { fprintf(stderr, "kernel_launch: unexpected shapes: n_in %d out %d ws %zu (need %zu)\n", n_in, out_size, ws_size, (size_t)WS_END); grid = -1; return; }
        int dev = 0, cus = 0, per_cu = 0;
        if (hipGetDevice(&dev) != hipSuccess || hipDeviceGetAttribute(&cus, hipDeviceAttributeMultiprocessorCount, dev) != hipSuccess) { grid = -1; return; }
        if (hipFuncSetAttribute((const void*)hybrid_fwd, hipFuncAttributeMaxDynamicSharedMemorySize, LDS_BYTES) != hipSuccess) { fprintf(stderr, "kernel_launch: hipFuncSetAttribute failed\n"); grid = -1; return; }
        if (hipOccupancyMaxActiveBlocksPerMultiprocessor(&per_cu, (const void*)hybrid_fwd, NTHR, LDS_BYTES) != hipSuccess || per_cu < 1) fprintf(stderr, "kernel_launch: occupancy query says %d\n", per_cu);
        (void)hipGetLastError();
        grid = cus < 256 ? cus : 256;
    }
    if (grid < 0) return;
    (void)hipMemsetAsync((char*)d_ws + WS_CTL, 0, CTL_ZERO_BYTES, stream);
    Args a{};
    for (int i = 0; i < 29; ++i) a.in[i] = (const float*)d_in[i];
    a.out = (float*)d_out; a.ws = (unsigned char*)d_ws;
#if MK_ONE_LAUNCH
    a.ph_lo = 0; a.ph_hi = NPHASES;
    hipLaunchKernelGGL(hybrid_fwd, dim3(grid), dim3(NTHR), LDS_BYTES, stream, a);
#else
    for (int p = 0; p < NPHASES; ++p) { a.ph_lo = p; a.ph_hi = p + 1; hipLaunchKernelGGL(hybrid_fwd, dim3(grid), dim3(NTHR), LDS_BYTES, stream, a); }
#endif
    const hipError_t le = hipPeekAtLastError();
    if (le != hipSuccess) fprintf(stderr, "kernel_launch: launch failed: %s\n", hipGetErrorName(le));
}
```

```cpp
#include <hip/hip_runtime.h>
#include <cstdio>
#include <cstdint>

#ifndef MK_ONE_LAUNCH
#define MK_ONE_LAUNCH 1
#endif

#define GAS __attribute__((address_space(1)))
#define LAS __attribute__((address_space(3)))
typedef unsigned short bf16_t;
typedef short bf16x8 __attribute__((ext_vector_type(8)));
typedef short s16x4 __attribute__((ext_vector_type(4)));
typedef float f32x2 __attribute__((ext_vector_type(2)));
typedef float f32x4 __attribute__((ext_vector_type(4)));
typedef float f32x8 __attribute__((ext_vector_type(8)));
typedef float f32x16 __attribute__((ext_vector_type(16)));
typedef unsigned u32x2 __attribute__((ext_vector_type(2)));
typedef unsigned u32x4 __attribute__((ext_vector_type(4)));
typedef int i32x2 __attribute__((ext_vector_type(2)));
typedef __bf16 bf16x2_t __attribute__((ext_vector_type(2)));

constexpr int D = 1024, NBATCH = 4, SEQ = 8192, CTXL = 256;
constexpr int TLAT = NBATCH * SEQ, TCTX = NBATCH * CTXL, TT = TLAT + TCTX;
constexpr int KVLEN = CTXL + SEQ;
constexpr int NE = 16, DE = 512, NLAYER = 4;
constexpr int CW_N = 4128, CW_NPAD = 4352;
constexpr float DN_ALPHA = 1.6817928305074292f;
constexpr float EPS = 1e-6f;
constexpr int XS_ROWS = 2 * TT + NE * 256;
constexpr int NWAVES = 8, NTHR = 512;

constexpr size_t MiB = 1u << 20;
constexpr size_t WS_CTL = 0, CTL_ZERO_BYTES = 1 * MiB;
constexpr size_t WS_MOD = 1 * MiB;
constexpr size_t WS_ROPE = 2 * MiB;
constexpr size_t WS_HCTX = 6 * MiB;
constexpr size_t WS_ASG = 10 * MiB;
constexpr size_t WS_ASGW = WS_ASG + 512 * 1024;
constexpr size_t WS_POS = WS_ASGW + 512 * 1024;
constexpr size_t WS_ROWMAP = WS_POS + 512 * 1024;
constexpr size_t WS_ROWW = WS_ROWMAP + 512 * 1024;
constexpr size_t WS_WLIST = 10 * MiB;
constexpr size_t WS_LIST = 23 * MiB + 512 * 1024;
constexpr size_t WS_AB = 13 * MiB;
constexpr size_t WS_GC = 18 * MiB;
constexpr size_t WS_BETA = 21 * MiB;
constexpr size_t WS_WQKV = 26 * MiB;
constexpr size_t WS_WO = 32 * MiB;
constexpr size_t WS_BWIN = 36 * MiB;
constexpr size_t WS_BWOUT = 40 * MiB;
constexpr size_t WS_BWS = 42 * MiB;
constexpr size_t WS_CWIN = 43 * MiB;
constexpr size_t WS_CWOUT = 52 * MiB;
constexpr size_t WS_WE1 = 54 * MiB;
constexpr size_t WS_WE2 = 86 * MiB;
constexpr size_t WS_R0 = 102 * MiB, RSZ = 66 * MiB;
constexpr size_t WS_END = WS_R0 + 8 * RSZ;
constexpr size_t WS_XS = WS_R0, WS_HID = WS_R0 + 140 * MiB, WS_Y2 = WS_R0 + 4 * RSZ;
static_assert((size_t)XS_ROWS * 2048 <= 140 * MiB && (size_t)XS_ROWS * 1024 <= 70 * MiB && WS_HID + 70 * MiB <= WS_Y2, "moe overlay");
static_assert((size_t)TT * D * 2 == RSZ, "region size");

constexpr int CW_BAR = 4096;
constexpr int CW_CNT = 16384;

constexpr int LDS_BYTES = 155648;
constexpr int MISC_OFF = LDS_BYTES - 512;
constexpr int GTAB_OFF = 131072;   constexpr int GTOK_OFF = GTAB_OFF + 1024, GTOK_MAXU = 16;
static_assert(GTOK_OFF + GTOK_MAXU * 1024 <= MISC_OFF, "token table");
constexpr int XX_DUMMY = 0;

#define RLX_AGENT __ATOMIC_RELAXED, __HIP_MEMORY_SCOPE_AGENT
#define LDS_WAIT() asm volatile("s_waitcnt lgkmcnt(0)" ::: "memory")
#define VM_WAIT() asm volatile("s_waitcnt vmcnt(0)" ::: "memory")
__device__ __forceinline__ unsigned pk2(float lo, float hi) { f32x2 v = {lo, hi}; bf16x2_t b = __builtin_convertvector(v, bf16x2_t); return __builtin_bit_cast(unsigned, b); }
__device__ __forceinline__ float bflo(unsigned w) { return __uint_as_float(w << 16); }
__device__ __forceinline__ float bfhi(unsigned w) { return __uint_as_float(w & 0xffff0000u); }
__device__ __forceinline__ float bf1(bf16_t b) { return __uint_as_float((unsigned)b << 16); }
__device__ __forceinline__ float wave_sum(float v) {
#pragma unroll
    for (int o = 1; o < 64; o <<= 1) v += __shfl_xor(v, o);
    return v;
}
__device__ __forceinline__ float sum16(float v) {
#pragma unroll
    for (int o = 1; o < 16; o <<= 1) v += __shfl_xor(v, o);
    return v;
}
__device__ __forceinline__ float sigmoidf_(float x) { return 1.f / (1.f + __expf(-x)); }
__device__ __forceinline__ float siluf_(float x) { return x / (1.f + __expf(-x)); }
__device__ __forceinline__ int crow(int r, int hi) { return (r & 3) + 8 * (r >> 2) + 4 * hi; }
__device__ __forceinline__ bf16x8 mk8(u32x2 lo, u32x2 hi) { u32x4 w = {lo.x, lo.y, hi.x, hi.y}; return __builtin_bit_cast(bf16x8, w); }
__device__ __forceinline__ bf16x8 mk8w(unsigned a, unsigned b, unsigned c, unsigned d) { u32x4 w = {a, b, c, d}; return __builtin_bit_cast(bf16x8, w); }
#define MFMA32(a, b, c) __builtin_amdgcn_mfma_f32_32x32x16_bf16((a), (b), (c), 0, 0, 0)

#define XB_TMO      128
#define XB_XCNT(j)  (256  + 64 * (j))
#define XB_XSUB(j)  (1280 + 64 * (j))
#define XB_XGEN(j)  (2304 + 64 * (j))
#define XB_TOP      3328
#define XB_TOPGEN   3392
#define XCD_BAR_WORDS 3456
#define XB_SPIN_CAP (1u << 18)

__device__ __forceinline__ unsigned xb_ld(unsigned* p)              { return __hip_atomic_load(p, __ATOMIC_RELAXED, __HIP_MEMORY_SCOPE_AGENT); }
__device__ __forceinline__ unsigned xb_add(unsigned* p, unsigned v) { return __hip_atomic_fetch_add(p, v, __ATOMIC_RELAXED, __HIP_MEMORY_SCOPE_AGENT); }
__device__ __forceinline__ unsigned xb_xcc_id() { return (unsigned)__builtin_amdgcn_s_getreg((3 << 11) | 20) & 0xFu; }
#define XB_SPIN(cond, bar) do { unsigned _sp = 0; while (cond) { __builtin_amdgcn_s_sleep(1); \
    if ((++_sp & 255u) == 0u) { if (xb_ld(&(bar)[XB_TMO])) break; if (_sp > XB_SPIN_CAP) { atomicAdd(&(bar)[XB_TMO], 1u); break; } } } } while (0)

struct XcdBarrier {
    unsigned* bar; unsigned x;
    volatile LAS unsigned* st;
};
__device__ __forceinline__ XcdBarrier xcd_barrier_post(unsigned* bar, volatile LAS unsigned* st, int tid) {
    XcdBarrier b; b.bar = bar; b.x = xb_xcc_id(); b.st = st;
    if (tid == 0) (void)xb_add(&bar[XB_XCNT(b.x)], 1u);
    return b;
}
__device__ __forceinline__ void xcd_barrier_complete(unsigned* bar, unsigned x, unsigned& nloc, unsigned& nx) {
    const unsigned G = gridDim.x * gridDim.y * gridDim.z;
    unsigned sum, cnt, mine, sp = 0u;
    for (;;) {
        sum = 0u; cnt = 0u; mine = 0u;
#pragma unroll
        for (unsigned j = 0; j < 16; ++j) { const unsigned c = xb_ld(&bar[XB_XCNT(j)]); sum += c; cnt += (c > 0u) ? 1u : 0u; mine = (j == x) ? c : mine; }
        if (sum == G) break;
        __builtin_amdgcn_s_sleep(1);
        if ((++sp & 255u) == 0u) { if (xb_ld(&bar[XB_TMO])) break; if (sp > XB_SPIN_CAP) { atomicAdd(&bar[XB_TMO], 1u); break; } }
    }
    nloc = mine > 0u ? mine : 1u; nx = cnt > 0u ? cnt : 1u;
}
__device__ __forceinline__ void xcd_barrier(const XcdBarrier& b, int tid) {
    asm volatile("s_waitcnt vmcnt(0)" ::: "memory");
    __syncthreads();
    if (tid == 0) {
        unsigned* bar = b.bar;
        __builtin_amdgcn_s_waitcnt(0);
        unsigned nloc = b.st[0], nx = b.st[1];
        if (nloc == 0u) { xcd_barrier_complete(bar, b.x, nloc, nx); b.st[0] = nloc; b.st[1] = nx; }
        const unsigned old = xb_add(&bar[XB_XSUB(b.x)], 1u);
        const unsigned gen = old / nloc;
        if (old + 1u == (gen + 1u) * nloc) {
            __builtin_amdgcn_fence(__ATOMIC_RELEASE, "agent");
            asm volatile("s_waitcnt vmcnt(0)" ::: "memory");
            const unsigned og = xb_add(&bar[XB_TOP], 1u);
            const unsigned tg = og / nx;
            if (og + 1u == (tg + 1u) * nx) xb_add(&bar[XB_TOPGEN], 1u);
            else XB_SPIN(xb_ld(&bar[XB_TOPGEN]) == tg, bar);
            __builtin_amdgcn_fence(__ATOMIC_ACQUIRE, "agent");
            xb_add(&bar[XB_XGEN(b.x)], 1u);
            asm volatile("s_waitcnt vmcnt(0)" ::: "memory");
        } else {
            XB_SPIN(xb_ld(&bar[XB_XGEN(b.x)]) == gen, bar);
            __builtin_amdgcn_fence(__ATOMIC_ACQUIRE, "agent");
            asm volatile("s_waitcnt vmcnt(0)" ::: "memory");
        }
    }
    __syncthreads();
}

namespace pg8 {
constexpr int BM = 256, BK = 64, HALF = 128, HTB = HALF * BK * 2, STAGE_BYTES = 8 * HTB, NXCD = 8, WGM = 8;
__host__ __device__ __forceinline__ int lds_byte(int r, int c) { const int st = (r >> 4) * 2 + (c >> 5), rr = r & 15, cc = c & 31, ob = rr * 64 + cc * 2; return st * 1024 + (ob ^ (((ob >> 9) & 1) << 5)); }
__host__ __device__ __forceinline__ void stage_rc(int b, int& R, int& C) { const int st = b / 1024, sb = b % 1024, swz = sb ^ (((sb >> 9) & 1) << 5); R = (st >> 1) * 16 + swz / 64; C = (st & 1) * 32 + (swz % 64) / 2; }
__host__ __device__ __forceinline__ int perm32(int rho) { const int n = rho >> 4, i = rho & 15; return 8 * (i >> 2) + 4 * n + (i & 3); }

struct Unit { int pm, pn, e, nvalid, lbase; };
struct Gemm { const bf16_t* A; const bf16_t* Bt; int M, N, K; size_t bstride; };

struct StaticOrder {
    int nM, nN, nwg, G, c;
    __device__ void init(int M, int N, int G_, int c_) { nM = M / BM; nN = N / BM; nwg = nM * nN; G = G_; c = c_; }
    __device__ bool next(int i, Unit& u) const {
        const long L = (long)i * G + c; if (L >= nwg) return false;
        int wgid = (int)L; { const int q = nwg / NXCD, r = nwg % NXCD, xcd = wgid % NXCD, off = wgid / NXCD; wgid = (xcd < r ? xcd * (q + 1) : r * (q + 1) + (xcd - r) * q) + off; }
        const int nig = WGM * nN, gid = wgid / nig, fm = gid * WGM, gsz = (nM - fm) < WGM ? (nM - fm) : WGM;
        u.pm = fm + ((wgid % nig) % gsz); u.pn = (wgid % nig) / gsz; u.e = 0; u.nvalid = 256; u.lbase = 0; return true;
    }
};
struct GroupedOrder {
    const LAS int* TS; const LAS int* CNT; int G, c;
    __device__ bool next(int i, Unit& u) const {
        const int L = i * G + c; const int total = TS[NE] * 4; if (L >= total) return false;
        const int rt = L >> 2; int e = 0;
#pragma unroll 1
        while (rt >= TS[e + 1]) ++e;
        u.pm = rt; u.pn = L & 3; u.e = e; const int tin = rt - TS[e]; u.nvalid = CNT[e] - tin * 256; u.lbase = e * TT + tin * 256; return true;
    }
};

template <class Epi, class Sched>
__device__ __forceinline__ void gemm_phase(LAS unsigned char* lds, const Gemm g, const Sched& S, const Epi& E, const int tid) {
    const int wid = __builtin_amdgcn_readfirstlane(tid >> 6), lane = tid & 63, wr = wid >> 2, wc = wid & 3, fr = lane & 15, fq = lane >> 4;
    const int K = g.K, nt = K / BK;
    unsigned voffA[2], voffB[2];
#pragma unroll
    for (int i = 0; i < 2; ++i) { int R, C; stage_rc(tid * 16 + i * 8192, R, C); const int Rb = Epi::PERM ? ((R & ~31) + perm32(R & 31)) : R;
        voffA[i] = (unsigned)(R * K + C) * 2u; voffB[i] = (unsigned)(Rb * K + C) * 2u; }
    const size_t kstep = (size_t)(BK * 2);
    const size_t hstep = (size_t)HALF * K * 2;
    const size_t tstep = 2 * hstep;
    const unsigned ldsw = (unsigned)wid * 1024u;
    const int aoff = lds_byte(wr * 64 + fr, fq * 8), boff = lds_byte(wc * 32 + fr, fq * 8);
#define PG8_SA(b, h) (((b) * 2 + (h)) * HTB)
#define PG8_SB(b, h) ((4 + (b) * 2 + (h)) * HTB)
#define PG8_STAGE(bufoff, gbase, voff) do { _Pragma("unroll") for (int _i = 0; _i < 2; ++_i) \
        __builtin_amdgcn_global_load_lds((const unsigned*)((const char*)(gbase) + (voff)[_i]), (LAS unsigned*)(lds + (bufoff) + ldsw + _i * 8192), 16, 0, 0); } while (0)
#define PG8_LDA(dst, b, h) do { _Pragma("unroll") for (int m = 0; m < 4; ++m) _Pragma("unroll") for (int k = 0; k < 2; ++k) dst[m][k] = *(const LAS bf16x8*)(lds + PG8_SA(b, h) + aoff + m * 2048 + k * 1024); } while (0)
#define PG8_LDB(dst, b, h) do { _Pragma("unroll") for (int n = 0; n < 2; ++n) _Pragma("unroll") for (int k = 0; k < 2; ++k) dst[n][k] = *(const LAS bf16x8*)(lds + PG8_SB(b, h) + boff + n * 2048 + k * 1024); } while (0)
#define PG8_MMA(ai, bj, At, Bt) do { __builtin_amdgcn_s_setprio(1); _Pragma("unroll") for (int m = 0; m < 4; ++m) _Pragma("unroll") for (int n = 0; n < 2; ++n) _Pragma("unroll") for (int k = 0; k < 2; ++k) \
        acc[ai][bj][m][n] = __builtin_amdgcn_mfma_f32_16x16x32_bf16(Bt[n][k], At[m][k], acc[ai][bj][m][n], 0, 0, 0); __builtin_amdgcn_s_setprio(0); } while (0)
#define PG8_WAIT_V(n) asm volatile("s_waitcnt vmcnt(" #n ")" ::: "memory")
#define PG8_WAIT_L(n) asm volatile("s_waitcnt lgkmcnt(" #n ")" ::: "memory")
#define PG8_BAR __builtin_amdgcn_s_barrier()
#define PG8_SCHED __builtin_amdgcn_sched_barrier(0)
    Unit cur, nxt; int ui = 0;
    if (!S.next(0, cur)) return;
    f32x4 acc[2][2][4][2];
#pragma unroll
    for (int a = 0; a < 2; ++a)
#pragma unroll
        for (int b = 0; b < 2; ++b)
#pragma unroll
            for (int m = 0; m < 4; ++m)
#pragma unroll
                for (int n = 0; n < 2; ++n) acc[a][b][m][n] = (f32x4){0.f, 0.f, 0.f, 0.f};
    bf16x8 At[4][2], B0[2][2], B1[2][2];
    const char* cA = (const char*)g.A + (size_t)cur.pm * tstep; const char* cB = (const char*)g.Bt + (size_t)cur.e * g.bstride + (size_t)cur.pn * tstep;
    PG8_STAGE(PG8_SB(0, 0), cB, voffB); PG8_STAGE(PG8_SB(0, 1), cB + hstep, voffB); PG8_STAGE(PG8_SA(0, 0), cA, voffA); PG8_STAGE(PG8_SA(0, 1), cA + hstep, voffA);
    if (wr == 1) PG8_BAR;
    PG8_WAIT_V(2); PG8_BAR;
    PG8_STAGE(PG8_SB(1, 0), cB + kstep, voffB); PG8_STAGE(PG8_SA(1, 0), cA + kstep, voffA); PG8_STAGE(PG8_SB(1, 1), cB + hstep + kstep, voffB);
    PG8_WAIT_V(6); PG8_BAR;
    for (;;) {
        const bool has_next = S.next(ui + 1, nxt);
        const char* nA = has_next ? (const char*)g.A + (size_t)nxt.pm * tstep : cA; const char* nB = has_next ? (const char*)g.Bt + (size_t)nxt.e * g.bstride + (size_t)nxt.pn * tstep : cB;
        for (int t = 0; t < nt; t += 2) {
            const bool last = (t == nt - 2);
            const char* a1 = cA + (size_t)(t + 1) * kstep;
            const char* a2 = last ? nA : cA + (size_t)(t + 2) * kstep; const char* b2 = last ? nB : cB + (size_t)(t + 2) * kstep;
            const char* a3 = a2 + kstep; const char* b3 = b2 + kstep;
            PG8_LDB(B0, 0, 0); PG8_LDB(B1, 0, 1); PG8_SCHED; PG8_LDA(At, 0, 0); PG8_STAGE(PG8_SA(1, 1), a1 + hstep, voffA);
            PG8_WAIT_V(8); PG8_WAIT_L(0); PG8_BAR; PG8_MMA(0, 0, At, B0); PG8_MMA(0, 1, At, B1); PG8_BAR; PG8_SCHED;
            PG8_LDA(At, 0, 1); PG8_STAGE(PG8_SB(0, 0), b2, voffB); PG8_STAGE(PG8_SB(0, 1), b2 + hstep, voffB); PG8_STAGE(PG8_SA(0, 0), a2, voffA);
            PG8_WAIT_V(8); PG8_WAIT_L(0); PG8_BAR; PG8_MMA(1, 0, At, B0); PG8_MMA(1, 1, At, B1); PG8_BAR; PG8_SCHED;
            PG8_LDB(B0, 1, 0); PG8_LDB(B1, 1, 1); PG8_SCHED; PG8_LDA(At, 1, 0); PG8_STAGE(PG8_SA(0, 1), a2 + hstep, voffA);
            PG8_WAIT_V(8); PG8_WAIT_L(0); PG8_BAR; PG8_MMA(0, 0, At, B0); PG8_MMA(0, 1, At, B1); PG8_BAR; PG8_SCHED;
            PG8_LDA(At, 1, 1); PG8_STAGE(PG8_SB(1, 0), b3, voffB); PG8_STAGE(PG8_SB(1, 1), b3 + hstep, voffB); PG8_STAGE(PG8_SA(1, 0), a3, voffA);
            PG8_WAIT_V(8); PG8_WAIT_L(0); PG8_BAR; PG8_MMA(1, 0, At, B0); PG8_MMA(1, 1, At, B1); PG8_BAR; PG8_SCHED;
        }
        if (wr == 0) PG8_BAR;
        E(acc, cur, wr, wc, fr, fq);
        if (!has_next) break;
#pragma unroll
        for (int a = 0; a < 2; ++a)
#pragma unroll
            for (int b = 0; b < 2; ++b)
#pragma unroll
                for (int m = 0; m < 4; ++m)
#pragma unroll
                    for (int n = 0; n < 2; ++n) acc[a][b][m][n] = (f32x4){0.f, 0.f, 0.f, 0.f};
        cur = nxt; cA = nA; cB = nB; ++ui;
        if (wr == 1) PG8_BAR;
    }
    PG8_WAIT_V(0);
    PG8_BAR;
#undef PG8_SA
#undef PG8_SB
#undef PG8_STAGE
#undef PG8_LDA
#undef PG8_LDB
#undef PG8_MMA
#undef PG8_WAIT_V
#undef PG8_WAIT_L
#undef PG8_BAR
#undef PG8_SCHED
}
template <class Epi, class Sched>
__device__ __forceinline__ void gemm_phase_gather(LAS unsigned char* lds, const Gemm g, const Sched& S, const Epi& E, const int tid, const LAS int* toks) {
    const int wid = __builtin_amdgcn_readfirstlane(tid >> 6), lane = tid & 63, wr = wid >> 2, wc = wid & 3, fr = lane & 15, fq = lane >> 4;
    const int K = g.K, nt = K / BK;
    unsigned voffB[2]; int RA[2]; unsigned CA[2];
#pragma unroll
    for (int i = 0; i < 2; ++i) { int R, C; stage_rc(tid * 16 + i * 8192, R, C); const int Rb = Epi::PERM ? ((R & ~31) + perm32(R & 31)) : R;
        RA[i] = R; CA[i] = (unsigned)C * 2u; voffB[i] = (unsigned)(Rb * K + C) * 2u; }
    unsigned roC[2][2], roN[2][2];
#define PG8_TOKS(ro, ui_) do { _Pragma("unroll") for (int hf_ = 0; hf_ < 2; ++hf_) _Pragma("unroll") for (int i_ = 0; i_ < 2; ++i_) \
        ro[hf_][i_] = (unsigned)toks[(ui_) * 256 + hf_ * 128 + RA[i_]] * (unsigned)(K * 2) + CA[i_]; } while (0)
#define PG8_STAGE_AG(bufoff, ktb, ro) do { _Pragma("unroll") for (int _i = 0; _i < 2; ++_i) \
        __builtin_amdgcn_global_load_lds((const unsigned*)((const char*)g.A + (ktb) + (ro)[_i]), (LAS unsigned*)(lds + (bufoff) + ldsw + _i * 8192), 16, 0, 0); } while (0)
    const size_t kstep = (size_t)(BK * 2);
    const size_t hstep = (size_t)HALF * K * 2;
    const size_t tstep = 2 * hstep;
    const unsigned ldsw = (unsigned)wid * 1024u;
    const int aoff = lds_byte(wr * 64 + fr, fq * 8), boff = lds_byte(wc * 32 + fr, fq * 8);
#define PG8_SA(b, h) (((b) * 2 + (h)) * HTB)
#define PG8_SB(b, h) ((4 + (b) * 2 + (h)) * HTB)
#define PG8_STAGE(bufoff, gbase, voff) do { _Pragma("unroll") for (int _i = 0; _i < 2; ++_i) \
        __builtin_amdgcn_global_load_lds((const unsigned*)((const char*)(gbase) + (voff)[_i]), (LAS unsigned*)(lds + (bufoff) + ldsw + _i * 8192), 16, 0, 0); } while (0)
#define PG8_LDA(dst, b, h) do { _Pragma("unroll") for (int m = 0; m < 4; ++m) _Pragma("unroll") for (int k = 0; k < 2; ++k) dst[m][k] = *(const LAS bf16x8*)(lds + PG8_SA(b, h) + aoff + m * 2048 + k * 1024); } while (0)
#define PG8_LDB(dst, b, h) do { _Pragma("unroll") for (int n = 0; n < 2; ++n) _Pragma("unroll") for (int k = 0; k < 2; ++k) dst[n][k] = *(const LAS bf16x8*)(lds + PG8_SB(b, h) + boff + n * 2048 + k * 1024); } while (0)
#define PG8_MMA(ai, bj, At, Bt) do { __builtin_amdgcn_s_setprio(1); _Pragma("unroll") for (int m = 0; m < 4; ++m) _Pragma("unroll") for (int n = 0; n < 2; ++n) _Pragma("unroll") for (int k = 0; k < 2; ++k) \
        acc[ai][bj][m][n] = __builtin_amdgcn_mfma_f32_16x16x32_bf16(Bt[n][k], At[m][k], acc[ai][bj][m][n], 0, 0, 0); __builtin_amdgcn_s_setprio(0); } while (0)
#define PG8_WAIT_V(n) asm volatile("s_waitcnt vmcnt(" #n ")" ::: "memory")
#define PG8_WAIT_L(n) asm volatile("s_waitcnt lgkmcnt(" #n ")" ::: "memory")
#define PG8_BAR __builtin_amdgcn_s_barrier()
#define PG8_SCHED __builtin_amdgcn_sched_barrier(0)
    Unit cur, nxt; int ui = 0;
    if (!S.next(0, cur)) return;
    f32x4 acc[2][2][4][2];
#pragma unroll
    for (int a = 0; a < 2; ++a)
#pragma unroll
        for (int b = 0; b < 2; ++b)
#pragma unroll
            for (int m = 0; m < 4; ++m)
#pragma unroll
                for (int n = 0; n < 2; ++n) acc[a][b][m][n] = (f32x4){0.f, 0.f, 0.f, 0.f};
    bf16x8 At[4][2], B0[2][2], B1[2][2];
    const char* cB = (const char*)g.Bt + (size_t)cur.e * g.bstride + (size_t)cur.pn * tstep;
    PG8_TOKS(roC, 0);
    PG8_STAGE(PG8_SB(0, 0), cB, voffB); PG8_STAGE(PG8_SB(0, 1), cB + hstep, voffB); PG8_STAGE_AG(PG8_SA(0, 0), 0, roC[0]); PG8_STAGE_AG(PG8_SA(0, 1), 0, roC[1]);
    if (wr == 1) PG8_BAR;
    PG8_WAIT_V(2); PG8_BAR;
    PG8_STAGE(PG8_SB(1, 0), cB + kstep, voffB); PG8_STAGE_AG(PG8_SA(1, 0), kstep, roC[0]); PG8_STAGE(PG8_SB(1, 1), cB + hstep + kstep, voffB);
    PG8_WAIT_V(6); PG8_BAR;
    for (;;) {
        const bool has_next = S.next(ui + 1, nxt);
        const char* nB = has_next ? (const char*)g.Bt + (size_t)nxt.e * g.bstride + (size_t)nxt.pn * tstep : cB;
        if (has_next) { PG8_TOKS(roN, ui + 1); } else {
#pragma unroll
            for (int hf_ = 0; hf_ < 2; ++hf_)
#pragma unroll
                for (int i_ = 0; i_ < 2; ++i_) roN[hf_][i_] = roC[hf_][i_]; }
        for (int t = 0; t < nt; t += 2) {
            const bool last = (t == nt - 2);
            const size_t k1 = (size_t)(t + 1) * kstep, k2 = last ? (size_t)0 : (size_t)(t + 2) * kstep, k3 = k2 + kstep;
            const char* b2 = last ? nB : cB + (size_t)(t + 2) * kstep; const char* b3 = b2 + kstep;
            unsigned r20[2], r21[2];
#pragma unroll
            for (int i_ = 0; i_ < 2; ++i_) { r20[i_] = last ? roN[0][i_] : roC[0][i_]; r21[i_] = last ? roN[1][i_] : roC[1][i_]; }
            PG8_LDB(B0, 0, 0); PG8_LDB(B1, 0, 1); PG8_SCHED; PG8_LDA(At, 0, 0); PG8_STAGE_AG(PG8_SA(1, 1), k1, roC[1]);
            PG8_WAIT_V(8); PG8_WAIT_L(0); PG8_BAR; PG8_MMA(0, 0, At, B0); PG8_MMA(0, 1, At, B1); PG8_BAR; PG8_SCHED;
            PG8_LDA(At, 0, 1); PG8_STAGE(PG8_SB(0, 0), b2, voffB); PG8_STAGE(PG8_SB(0, 1), b2 + hstep, voffB); PG8_STAGE_AG(PG8_SA(0, 0), k2, r20);
            PG8_WAIT_V(8); PG8_WAIT_L(0); PG8_BAR; PG8_MMA(1, 0, At, B0); PG8_MMA(1, 1, At, B1); PG8_BAR; PG8_SCHED;
            PG8_LDB(B0, 1, 0); PG8_LDB(B1, 1, 1); PG8_SCHED; PG8_LDA(At, 1, 0); PG8_STAGE_AG(PG8_SA(0, 1), k2, r21);
            PG8_WAIT_V(8); PG8_WAIT_L(0); PG8_BAR; PG8_MMA(0, 0, At, B0); PG8_MMA(0, 1, At, B1); PG8_BAR; PG8_SCHED;
            PG8_LDA(At, 1, 1); PG8_STAGE(PG8_SB(1, 0), b3, voffB); PG8_STAGE(PG8_SB(1, 1), b3 + hstep, voffB); PG8_STAGE_AG(PG8_SA(1, 0), k3, r20);
            PG8_WAIT_V(8); PG8_WAIT_L(0); PG8_BAR; PG8_MMA(1, 0, At, B0); PG8_MMA(1, 1, At, B1); PG8_BAR; PG8_SCHED;
        }
        if (wr == 0) PG8_BAR;
        E(acc, cur, wr, wc, fr, fq);
        if (!has_next) break;
#pragma unroll
        for (int a = 0; a < 2; ++a)
#pragma unroll
            for (int b = 0; b < 2; ++b)
#pragma unroll
                for (int m = 0; m < 4; ++m)
#pragma unroll
                    for (int n = 0; n < 2; ++n) acc[a][b][m][n] = (f32x4){0.f, 0.f, 0.f, 0.f};
        cur = nxt; cB = nB; ++ui;
#pragma unroll
        for (int hf_ = 0; hf_ < 2; ++hf_)
#pragma unroll
            for (int i_ = 0; i_ < 2; ++i_) roC[hf_][i_] = roN[hf_][i_];
        if (wr == 1) PG8_BAR;
    }
    PG8_WAIT_V(0);
    PG8_BAR;
#undef PG8_TOKS
#undef PG8_STAGE_AG
#undef PG8_SA
#undef PG8_SB
#undef PG8_STAGE
#undef PG8_LDA
#undef PG8_LDB
#undef PG8_MMA
#undef PG8_WAIT_V
#undef PG8_WAIT_L
#undef PG8_BAR
#undef PG8_SCHED
}
}
using pg8::Unit;

typedef f32x4 AccT[2][2][4][2];

__device__ __forceinline__ u32x4 pack8(const f32x4 a, const f32x4 b) { u32x4 w; w.x = pk2(a[0], a[1]); w.y = pk2(a[2], a[3]); w.z = pk2(b[0], b[1]); w.w = pk2(b[2], b[3]); return w; }
struct EpiResid {
    static constexpr bool PERM = true;
    bf16_t* hlat; bf16_t* hctx; const float* gate;
    __device__ __forceinline__ void operator()(const AccT& acc, const Unit& u, int wr, int wc, int fr, int fq) const {
        const int mi = u.pm < 128 ? (u.pm >> 5) : 4;
        bf16_t* hb = u.pm < 128 ? hlat + (size_t)u.pm * 256 * D : hctx + (size_t)(u.pm - 128) * 256 * D;
        const int col0 = u.pn * 256 + wc * 32 + 8 * fq;
        const float* g = gate + mi * 6144 + col0;
        f32x4 gv[2][2];
#pragma unroll
        for (int bj = 0; bj < 2; ++bj)
#pragma unroll
            for (int n = 0; n < 2; ++n) gv[bj][n] = *(const f32x4*)(g + bj * 128 + n * 4);
#pragma unroll
        for (int ai = 0; ai < 2; ++ai)
#pragma unroll
            for (int m = 0; m < 4; ++m) { bf16_t* rowp = hb + (size_t)(ai * 128 + wr * 64 + m * 16 + fr) * D + col0;
#pragma unroll
                for (int bj = 0; bj < 2; ++bj) { const u32x4 hw = *(const u32x4*)(rowp + bj * 128);
                    const f32x4 h0 = {bflo(hw.x), bfhi(hw.x), bflo(hw.y), bfhi(hw.y)}, h1 = {bflo(hw.z), bfhi(hw.z), bflo(hw.w), bfhi(hw.w)};
                    *(u32x4*)(rowp + bj * 128) = pack8(h0 * DN_ALPHA + gv[bj][0] * acc[ai][bj][m][0], h1 * DN_ALPHA + gv[bj][1] * acc[ai][bj][m][1]); } }
    }
};

struct EpiQKV {
    static constexpr bool PERM = true;
    bf16_t* Q; bf16_t* Kb; bf16_t* Vb;
    __device__ __forceinline__ void operator()(const AccT& acc, const Unit& u, int wr, int wc, int fr, int fq) const {
        const int cw = wc * 32 + 8 * fq;
        bf16_t* base; size_t ld; size_t r0;
        if (u.pn < 4) { base = Q + u.pn * 256; ld = D; r0 = (size_t)u.pm * 256; }
        else { base = (u.pn == 4) ? Kb : Vb; ld = 256; r0 = u.pm < 128 ? (size_t)(u.pm >> 5) * KVLEN + CTXL + (size_t)(u.pm & 31) * 256 : (size_t)(u.pm - 128) * KVLEN; }
#pragma unroll
        for (int ai = 0; ai < 2; ++ai)
#pragma unroll
            for (int m = 0; m < 4; ++m) { bf16_t* rowp = base + (r0 + ai * 128 + wr * 64 + m * 16 + fr) * ld + cw;
#pragma unroll
                for (int bj = 0; bj < 2; ++bj) *(u32x4*)(rowp + bj * 128) = pack8(acc[ai][bj][m][0], acc[ai][bj][m][1]); }
    }
};
__device__ __forceinline__ float gelu_tanh(float x) { const float t = 1.5957691216057308f * (x + 0.044715f * x * x * x); return x / (1.f + __expf(-t)); }
struct EpiGelu {
    static constexpr bool PERM = true;
    bf16_t* O;
    __device__ __forceinline__ void operator()(const AccT& acc, const Unit& u, int wr, int wc, int fr, int fq) const {
        const int col0 = u.pn * 256 + wc * 32 + 8 * fq;
#pragma unroll
        for (int ai = 0; ai < 2; ++ai)
#pragma unroll
            for (int m = 0; m < 4; ++m) { bf16_t* rowp = O + (size_t)(u.pm * 256 + ai * 128 + wr * 64 + m * 16 + fr) * 2048 + col0;
#pragma unroll
                for (int bj = 0; bj < 2; ++bj) { f32x4 a = acc[ai][bj][m][0], b = acc[ai][bj][m][1];
#pragma unroll
                    for (int i = 0; i < 4; ++i) { a[i] = gelu_tanh(a[i]); b[i] = gelu_tanh(b[i]); }
                    *(u32x4*)(rowp + bj * 128) = pack8(a, b); } }
    }
};
struct EpiDeltaIn {
    static constexpr bool PERM = true;
    bf16_t* R1; float* AB;
    __device__ __forceinline__ void operator()(const AccT& acc, const Unit& u, int wr, int wc, int fr, int fq) const {
        if (u.pn < 16) {
            bf16_t* base = R1 + (size_t)(u.pn >> 2) * (RSZ / 2) + (u.pn & 3) * 256 + wc * 32 + 8 * fq;
#pragma unroll
            for (int ai = 0; ai < 2; ++ai)
#pragma unroll
                for (int m = 0; m < 4; ++m) { bf16_t* rowp = base + (size_t)(u.pm * 256 + ai * 128 + wr * 64 + m * 16 + fr) * D;
#pragma unroll
                    for (int bj = 0; bj < 2; ++bj) *(u32x4*)(rowp + bj * 128) = pack8(acc[ai][bj][m][0], acc[ai][bj][m][1]); }
        } else if (wc == 0) {
#pragma unroll
            for (int ai = 0; ai < 2; ++ai)
#pragma unroll
                for (int m = 0; m < 4; ++m) { float* rowp = AB + (size_t)(u.pm * 256 + ai * 128 + wr * 64 + m * 16 + fr) * 32 + 8 * fq;
                    *(f32x4*)(rowp) = acc[ai][0][m][0]; *(f32x4*)(rowp + 4) = acc[ai][0][m][1]; }
        }
    }
};
struct EpiGateUp {
    static constexpr bool PERM = true;
    bf16_t* H;
    __device__ __forceinline__ void operator()(const AccT& acc, const Unit& u, int wr, int wc, int fr, int fq) const {
        const int col0 = u.pn * 128 + wc * 32 + 8 * fq;
#pragma unroll
        for (int ai = 0; ai < 2; ++ai)
#pragma unroll
            for (int m = 0; m < 4; ++m) { bf16_t* rowp = H + (size_t)(u.pm * 256 + ai * 128 + wr * 64 + m * 16 + fr) * DE + col0;
                f32x4 a, b;
#pragma unroll
                for (int i = 0; i < 4; ++i) { a[i] = siluf_(acc[ai][0][m][0][i]) * acc[ai][1][m][0][i]; b[i] = siluf_(acc[ai][0][m][1][i]) * acc[ai][1][m][1][i]; }
                *(u32x4*)(rowp) = pack8(a, b); }
    }
};
struct EpiDown {
    static constexpr bool PERM = true;
    bf16_t* Y2; const int* list; const float* wlist;
    __device__ __forceinline__ void operator()(const AccT& acc, const Unit& u, int wr, int wc, int fr, int fq) const {
        const int col0 = u.pn * 256 + wc * 32 + 8 * fq;
#pragma unroll
        for (int ai = 0; ai < 2; ++ai)
#pragma unroll
            for (int m = 0; m < 4; ++m) { const int r = ai * 128 + wr * 64 + m * 16 + fr;
                if (r < u.nvalid) { const int dst = list[u.lbase + r]; const float w = wlist[u.lbase + r]; bf16_t* rowp = Y2 + (size_t)dst * D + col0;
#pragma unroll
                    for (int bj = 0; bj < 2; ++bj) *(u32x4*)(rowp + bj * 128) = pack8(acc[ai][bj][m][0] * w, acc[ai][bj][m][1] * w); } }
    }
};

namespace att {
constexpr int DH = 128, NW = 8, QBLK = 32, KVBLK = 64;
constexpr float SCALE = 0.088388347648318440f;
constexpr float THR = 8.f;
constexpr int LDQ = D, LDK = 256, LDO = D;
constexpr size_t SHM_V = KVBLK * DH * 2, SHM_K = KVBLK * DH * 2, SHM_ATTN = 2 * SHM_V + 2 * SHM_K + NW * 64 * 4;
#define KSWZ(row, colB) ((row) * 256 + ((colB) ^ (((row) & 7) << 4)))
#define SBAR() __builtin_amdgcn_sched_barrier(0)
__device__ __forceinline__ unsigned cvtpk(float lo, float hi) { unsigned r; asm volatile("v_cvt_pk_bf16_f32 %0, %1, %2" : "=v"(r) : "v"(lo), "v"(hi)); return r; }
__device__ __forceinline__ void partialSM(f32x16& p0, f32x16& p1, float& m_reg, float& mn, float& alpha) {
  constexpr float C = SCALE * 1.4426950408889634f;
  float pmax = p0[0]; for (int r = 1; r < 16; ++r) pmax = fmaxf(pmax, p0[r]); for (int r = 0; r < 16; ++r) pmax = fmaxf(pmax, p1[r]);
  { auto rr = __builtin_amdgcn_permlane32_swap(__float_as_uint(pmax), __float_as_uint(pmax), false, false);
    pmax = fmaxf(__uint_as_float(rr[0]), __uint_as_float(rr[1])); }
  if (__builtin_expect(__all(pmax - m_reg <= THR / SCALE), 1)) { mn = m_reg; alpha = 1.f; }
  else { mn = fmaxf(m_reg, pmax); alpha = __builtin_amdgcn_exp2f((m_reg - mn) * C); m_reg = mn; }
  float mnC = -mn * C;
  for (int r = 0; r < 16; ++r) p0[r] = fmaf(p0[r], C, mnC); for (int r = 0; r < 16; ++r) p1[r] = fmaf(p1[r], C, mnC);
  for (int r = 0; r < 16; ++r) p0[r] = __builtin_amdgcn_exp2f(p0[r]);
}
__device__ __forceinline__ void finishSM(f32x16& p0, f32x16& p1, float alpha, float& l_reg, bf16x8& pa0, bf16x8& pa1, bf16x8& pa2, bf16x8& pa3) {
  for (int r = 0; r < 16; ++r) p1[r] = __builtin_amdgcn_exp2f(p1[r]);
  float ps = 0; for (int r = 0; r < 16; ++r) ps += p0[r]; for (int r = 0; r < 16; ++r) ps += p1[r];
  { auto rr = __builtin_amdgcn_permlane32_swap(__float_as_uint(ps), __float_as_uint(ps), false, false);
    ps = __uint_as_float(rr[0]) + __uint_as_float(rr[1]); }
  l_reg = l_reg * alpha + ps;
#define PK4(P, BASE, OUT) do { unsigned a0 = cvtpk(P[BASE + 0], P[BASE + 1]), a1 = cvtpk(P[BASE + 2], P[BASE + 3]);   \
    unsigned b0 = cvtpk(P[BASE + 4], P[BASE + 5]), b1 = cvtpk(P[BASE + 6], P[BASE + 7]);                              \
    auto r0 = __builtin_amdgcn_permlane32_swap(a0, b0, false, false); auto r1 = __builtin_amdgcn_permlane32_swap(a1, b1, false, false); \
    u32x4 w = {r0[0], r1[0], r0[1], r1[1]}; OUT = *reinterpret_cast<bf16x8*>(&w); } while (0)
  PK4(p0, 0, pa0); PK4(p0, 8, pa1); PK4(p1, 0, pa2); PK4(p1, 8, pa3);
#undef PK4
}
__device__ __forceinline__ void qkt(f32x16& p0, f32x16& p1, const bf16_t* Ks, const bf16x8* qr, int r32, int hi) {
  p0 = f32x16{}; p1 = f32x16{};
  for (int d0 = 0; d0 < 8; ++d0) { int cb = (d0 * 16 + hi * 8) * 2;
    bf16x8 b0 = *reinterpret_cast<const bf16x8*>((const char*)Ks + KSWZ(r32, cb));
    bf16x8 b1 = *reinterpret_cast<const bf16x8*>((const char*)Ks + KSWZ(32 + r32, cb));
    p0 = __builtin_amdgcn_mfma_f32_32x32x16_bf16(b0, qr[d0], p0, 0, 0, 0);
    p1 = __builtin_amdgcn_mfma_f32_32x32x16_bf16(b1, qr[d0], p1, 0, 0, 0); }
}
__device__ __forceinline__ int v_st(int k, int c) { const int kk = (k & ~0xC) | ((k & 4) << 1) | ((k & 8) >> 1); return ((kk >> 3) * 4 + (c >> 5)) * 512 + ((kk & 7) * 32 + (c & 31)) * 2; }
__device__ __forceinline__ int v_rd_base(int lane) { return ((lane & 3) << 3) | (((lane >> 2) & 3) << 6) | (((lane >> 4) & 1) << 5) | (((lane >> 5) & 1) << 8); }
constexpr int v_rd_off(int d0, int ks, int half) { return d0 * 512 + ks * 4096 + half * 2048; }
template <int OFF> __device__ __forceinline__ s16x4 tr_read(int vb) {
  s16x4 r; asm volatile("ds_read_b64_tr_b16 %0, %1 offset:%2" : "=&v"(r) : "v"(vb), "i"(OFF) : "memory"); return r;
}
template <int D0> __device__ __forceinline__ void pv_one(f32x16& od, int vb, bf16x8 pa0, bf16x8 pa1, bf16x8 pa2, bf16x8 pa3) {
  const s16x4 l0 = tr_read<v_rd_off(D0, 0, 0)>(vb), h0 = tr_read<v_rd_off(D0, 0, 1)>(vb), l1 = tr_read<v_rd_off(D0, 1, 0)>(vb), h1 = tr_read<v_rd_off(D0, 1, 1)>(vb);
  const s16x4 l2 = tr_read<v_rd_off(D0, 2, 0)>(vb), h2 = tr_read<v_rd_off(D0, 2, 1)>(vb), l3 = tr_read<v_rd_off(D0, 3, 0)>(vb), h3 = tr_read<v_rd_off(D0, 3, 1)>(vb);
  asm volatile("s_waitcnt lgkmcnt(0)" ::: "memory"); SBAR();
#define PK(L, H) (bf16x8){L[0], L[1], L[2], L[3], H[0], H[1], H[2], H[3]}
  od = __builtin_amdgcn_mfma_f32_32x32x16_bf16(pa0, PK(l0, h0), od, 0, 0, 0);
  od = __builtin_amdgcn_mfma_f32_32x32x16_bf16(pa1, PK(l1, h1), od, 0, 0, 0);
  od = __builtin_amdgcn_mfma_f32_32x32x16_bf16(pa2, PK(l2, h2), od, 0, 0, 0);
  od = __builtin_amdgcn_mfma_f32_32x32x16_bf16(pa3, PK(l3, h3), od, 0, 0, 0);
#undef PK
}
__device__ __forceinline__ void pv_d0(f32x16* o, int vb, bf16x8 pa0, bf16x8 pa1, bf16x8 pa2, bf16x8 pa3) {
  pv_one<0>(o[0], vb, pa0, pa1, pa2, pa3); pv_one<1>(o[1], vb, pa0, pa1, pa2, pa3); pv_one<2>(o[2], vb, pa0, pa1, pa2, pa3); pv_one<3>(o[3], vb, pa0, pa1, pa2, pa3);
}
__device__ __forceinline__ void attn_dense_body(const bf16_t* Qb, const bf16_t* __restrict__ Kh, const bf16_t* __restrict__ Vh, bf16_t* Ob, int seq, char* lds, const int tid) {
  constexpr int SDEPTH = 2;
  const int wid = tid >> 6, lane = tid & 63, r32 = lane & 31, hi = lane >> 5;
  bf16_t* V_lds = (bf16_t*)lds; bf16_t* K_lds = (bf16_t*)(lds + 2 * SHM_V);
  float* ws = (float*)(lds + 2 * SHM_V + 2 * SHM_K) + wid * 64; float* li_l = ws; float* al_l = ws + 32;
  float m_reg = -1e30f, l_reg = 0; f32x16 o[4] = {}; bf16x8 qr[8];
  const bf16_t* Qw = Qb + (long)(wid * QBLK + r32) * LDQ + hi * 8;
#pragma unroll
  for (int d0 = 0; d0 < 8; ++d0) qr[d0] = *reinterpret_cast<const bf16x8*>(Qw + d0 * 16);
  const int sr = tid >> 4, sc = (tid & 15) * 8, vst0 = v_st(sr, sc), vst1 = v_st(32 + sr, sc);
  const int vb0 = (int)(uintptr_t)V_lds + v_rd_base(lane);
  struct { bf16x8 vs0, vs1, ks0, ks1; } sr_[SDEPTH];
#define SLOAD(i, k0) do { sr_[i].vs0 = *reinterpret_cast<const bf16x8*>(&Vh[(long)((k0) + sr) * LDK + sc]); sr_[i].vs1 = *reinterpret_cast<const bf16x8*>(&Vh[(long)((k0) + 32 + sr) * LDK + sc]); \
    sr_[i].ks0 = *reinterpret_cast<const bf16x8*>(&Kh[(long)((k0) + sr) * LDK + sc]); sr_[i].ks1 = *reinterpret_cast<const bf16x8*>(&Kh[(long)((k0) + 32 + sr) * LDK + sc]); } while (0)
#define SWRITE(b, i) do { *(bf16x8*)((char*)V_lds + (b) * SHM_V + vst0) = sr_[i].vs0;          \
    *(bf16x8*)((char*)V_lds + (b) * SHM_V + vst1) = sr_[i].vs1; int kc = sc * 2;               \
    *(bf16x8*)((char*)K_lds + (b) * SHM_K + KSWZ(sr, kc)) = sr_[i].ks0;                       \
    *(bf16x8*)((char*)K_lds + (b) * SHM_K + KSWZ(32 + sr, kc)) = sr_[i].ks1; } while (0)
#define SWAIT() do { asm volatile("s_waitcnt vmcnt(4)" ::: "memory"); } while (0)
#define RESC(a) do { if (__any((a) < 1.f)) { if (hi == 0) al_l[r32] = (a); asm volatile("s_waitcnt lgkmcnt(0)" ::: "memory"); \
    for (int d = 0; d < 4; ++d) for (int r = 0; r < 16; ++r) o[d][r] *= al_l[crow(r, hi)]; } } while (0)
  f32x16 pA0, pA1, pB0, pB1; float mnA, mnB, alA, alB; bf16x8 pa0, pa1, pa2, pa3; const int NT = seq / KVBLK;
  constexpr int SE = 0, SO = SDEPTH - 1;
  SLOAD(SE, 0); asm volatile("s_waitcnt vmcnt(0)" ::: "memory"); SWRITE(0, SE); __syncthreads();
  qkt(pA0, pA1, K_lds, qr, r32, hi); partialSM(pA0, pA1, m_reg, mnA, alA);
  SLOAD(SO, KVBLK); if (2 < NT) SLOAD(SE, 2 * KVBLK);
  SWAIT(); SWRITE(1, SO); __syncthreads();
  for (int j = 1; j + 1 < NT; j += 2) {
    SBAR(); qkt(pB0, pB1, (bf16_t*)((char*)K_lds + SHM_K), qr, r32, hi);
    finishSM(pA0, pA1, alA, l_reg, pa0, pa1, pa2, pa3); SBAR();
    SLOAD(SO, (j + SDEPTH) * KVBLK); SBAR();
    pv_d0(o, vb0, pa0, pa1, pa2, pa3); partialSM(pB0, pB1, m_reg, mnB, alB);
    __syncthreads(); SWAIT(); SWRITE(0, SE);
    RESC(alB); __syncthreads();
    SBAR(); qkt(pA0, pA1, K_lds, qr, r32, hi);
    finishSM(pB0, pB1, alB, l_reg, pa0, pa1, pa2, pa3); SBAR();
    if (j + 3 < NT) SLOAD(SE, (j + 1 + SDEPTH) * KVBLK); SBAR();
    pv_d0(o, vb0 + (int)SHM_V, pa0, pa1, pa2, pa3); partialSM(pA0, pA1, m_reg, mnA, alA);
    __syncthreads(); SWAIT(); SWRITE(1, SO);
    RESC(alA); __syncthreads();
  }
  SBAR(); qkt(pB0, pB1, (bf16_t*)((char*)K_lds + SHM_K), qr, r32, hi);
  finishSM(pA0, pA1, alA, l_reg, pa0, pa1, pa2, pa3); SBAR();
  pv_d0(o, vb0, pa0, pa1, pa2, pa3); partialSM(pB0, pB1, m_reg, mnB, alB);
  __syncthreads(); RESC(alB);
  finishSM(pB0, pB1, alB, l_reg, pa0, pa1, pa2, pa3); SBAR();
  pv_d0(o, vb0 + (int)SHM_V, pa0, pa1, pa2, pa3);
  if (hi == 0) li_l[r32] = l_reg; asm volatile("s_waitcnt lgkmcnt(0)" ::: "memory");
  float rli[16];
#pragma unroll
  for (int r = 0; r < 16; ++r) rli[r] = __builtin_amdgcn_rcpf(li_l[crow(r, hi)]);
  bf16_t* Ow = Ob + (long)(wid * QBLK) * LDO;
#pragma unroll
  for (int r = 0; r < 16; ++r) { int orow = crow(r, hi);
#pragma unroll
    for (int d0 = 0; d0 < 4; ++d0) Ow[(long)orow * LDO + d0 * 32 + r32] = (bf16_t)(pk2(o[d0][r] * rli[r], 0.f) & 0xffffu); }
  asm volatile("s_waitcnt vmcnt(0) lgkmcnt(0)" ::: "memory"); __syncthreads();
#undef SLOAD
#undef SWRITE
#undef SWAIT
#undef RESC
}
}

struct Args {
    const float* in[29]; float* out; unsigned char* ws; int ph_lo, ph_hi;
};
enum { I_X = 0, I_C, I_CTX, I_CCTX, I_WADA, I_BADA, I_LNG, I_LNB, I_AWQKV, I_AQG, I_AKG, I_AWO, I_BWIN, I_BVG, I_BVB, I_BWS, I_BBS, I_BWOUT,
       I_CWIN, I_CCONV, I_CALOG, I_CDTB, I_CNG, I_CWOUT, I_WROUTER, I_RBIAS, I_EGATE, I_EUP, I_EDOWN };

struct Frame {
    LAS unsigned char* lds; char* ldsg;
    int tid, lane, wave, bid, G, gw, NGW;
    const Args* a;
    unsigned char* ws; float* out;
};
#define FRAME_REFRESH(F) do { int l_; asm volatile("v_mbcnt_lo_u32_b32 %0, -1, 0\n\tv_mbcnt_hi_u32_b32 %0, -1, %0" : "=v"(l_)); (F).lane = l_; (F).tid = (F).wave * 64 + l_; } while (0)
__device__ __forceinline__ bf16_t* hlat_base(const Frame& F) { return (bf16_t*)((char*)F.out + 64 * MiB); }
__device__ __forceinline__ bf16_t* hrow(const Frame& F, int t) { return t < TLAT ? hlat_base(F) + (size_t)t * D : (bf16_t*)(F.ws + WS_HCTX) + (size_t)(t - TLAT) * D; }
__device__ __forceinline__ bf16_t* RG(const Frame& F, int i) { return (bf16_t*)(F.ws + WS_R0 + (size_t)i * RSZ); }
__device__ __forceinline__ const float* modrow(const Frame& F, int layer, int mi) { return (const float*)(F.ws + WS_MOD) + (size_t)(layer * 5 + mi) * 6144; }

__device__ __forceinline__ void transpose_item(const float* W, size_t sld, bf16_t* WT, size_t dld, int drow0, int k0, int n0, LAS float* scr, int lane) {
#pragma unroll 8
    for (int i = 0; i < 32; ++i) { const int kk = 2 * i + (lane >> 5); scr[kk * 33 + (lane & 31)] = W[(size_t)(k0 + kk) * sld + n0 + (lane & 31)]; }
    LDS_WAIT(); asm volatile("" ::: "memory");
    const int c = lane & 7;
#pragma unroll
    for (int j = 0; j < 4; ++j) { const int n = (lane >> 3) + 8 * j; const LAS float* s = scr + (8 * c) * 33 + n;
        u32x4 o; o.x = pk2(s[0 * 33], s[1 * 33]); o.y = pk2(s[2 * 33], s[3 * 33]); o.z = pk2(s[4 * 33], s[5 * 33]); o.w = pk2(s[6 * 33], s[7 * 33]);
        *(u32x4*)(WT + (size_t)(drow0 + n) * dld + k0 + 8 * c) = o; }
    LDS_WAIT(); asm volatile("" ::: "memory");
}
__device__ __forceinline__ bool dense_item(int& r, const float* W, int K, int N, bf16_t* WT, LAS float* scr, int lane) {
    const int nblk = N / 32, items = (K / 64) * nblk;
    if (r >= items) { r -= items; return false; }
    const int kb = r / nblk, nb = r % nblk;
    transpose_item(W, (size_t)N, WT, (size_t)K, 32 * nb, 64 * kb, 32 * nb, scr, lane);
    return true;
}
__device__ __forceinline__ void p0_prologue(Frame& F) {
    const Args& A = *F.a;
    LAS float* scr = (LAS float*)(F.lds + F.wave * 16384);
    constexpr int NITEMS = 2 * (16 * 48) + 2 * (16 * 32) + 16 * 64 + 16 * 32 + 16 * 129 + 16 * 32;
    for (int it = F.gw; it < NITEMS; it += F.NGW) {
        int r = it;
        if (dense_item(r, A.in[I_AWQKV], D, 1536, (bf16_t*)(F.ws + WS_WQKV), scr, F.lane)) continue;
        if (dense_item(r, A.in[I_AWQKV] + (size_t)D * 1536, D, 1536, (bf16_t*)(F.ws + WS_WQKV) + (size_t)1536 * D, scr, F.lane)) continue;
        if (dense_item(r, A.in[I_AWO], D, D, (bf16_t*)(F.ws + WS_WO), scr, F.lane)) continue;
        if (dense_item(r, A.in[I_AWO] + (size_t)D * D, D, D, (bf16_t*)(F.ws + WS_WO) + (size_t)D * D, scr, F.lane)) continue;
        if (dense_item(r, A.in[I_BWIN], D, 2048, (bf16_t*)(F.ws + WS_BWIN), scr, F.lane)) continue;
        if (dense_item(r, A.in[I_BWOUT], D, D, (bf16_t*)(F.ws + WS_BWOUT), scr, F.lane)) continue;
        if (dense_item(r, A.in[I_CWIN], D, CW_N, (bf16_t*)(F.ws + WS_CWIN), scr, F.lane)) continue;
        dense_item(r, A.in[I_CWOUT], D, D, (bf16_t*)(F.ws + WS_CWOUT), scr, F.lane);
    }
    const int gt = F.bid * NTHR + F.tid, NGT = F.G * NTHR;
    { u32x4* z = (u32x4*)((bf16_t*)(F.ws + WS_CWIN) + (size_t)CW_N * D); const int n16 = (CW_NPAD - CW_N) * D * 2 / 16;
      for (int i = gt; i < n16; i += NGT) z[i] = (u32x4){0u, 0u, 0u, 0u}; }
    { const float* s = A.in[I_BWS]; unsigned* d = (unsigned*)(F.ws + WS_BWS);
      for (int i = gt; i < 8 * 128 * 128 / 2; i += NGT) d[i] = pk2(s[2 * i], s[2 * i + 1]); }
    { f32x2* rt = (f32x2*)(F.ws + WS_ROPE);
      for (int i = gt; i < SEQ * 64; i += NGT) { const int n = i >> 6, p = i & 63; const int pp = p & 31;
        const float inv = 1.0f / powf(10000.0f, (float)(2 * pp) / 64.0f);
        const float pos = (p < 32) ? (float)(n >> 6) : (float)(n & 63);
        const float ang = pos * inv; float sn, cs; sincosf(ang, &sn, &cs); rt[i] = (f32x2){cs, sn}; } }
    __syncthreads();
    if (F.bid < 96) {
        LAS float* sc = (LAS float*)F.lds;
        LAS f32x4* red = (LAS f32x4*)(F.lds + 32768);
        for (int i = F.tid; i < 5 * D; i += NTHR) { const float v = (i < 4 * D) ? A.in[I_C][i] : A.in[I_CCTX][i - 4 * D]; sc[i] = siluf_(v); }
        __syncthreads();
        for (int item = F.bid; item < 96; item += F.G) {
            const int l = item / 24, cb = item % 24, col0 = cb * 256 + 4 * F.lane;
            const float* wp = A.in[I_WADA] + ((size_t)l * D + F.wave * 128) * 6144 + col0;
            f32x4 acc[5];
#pragma unroll
            for (int mi = 0; mi < 5; ++mi) acc[mi] = (f32x4){0.f, 0.f, 0.f, 0.f};
#pragma unroll 8
            for (int k = 0; k < 128; ++k) { const f32x4 w = *(const f32x4*)(wp + (size_t)k * 6144);
#pragma unroll
                for (int mi = 0; mi < 5; ++mi) acc[mi] += w * sc[mi * D + F.wave * 128 + k]; }
#pragma unroll
            for (int mi = 0; mi < 5; ++mi) red[(F.wave * 5 + mi) * 64 + F.lane] = acc[mi];
            __syncthreads();
            for (int o = F.tid; o < 5 * 256; o += NTHR) { const int mi = o >> 8, c = o & 255; float s = A.in[I_BADA][l * 6144 + cb * 256 + c];
                const LAS float* rf = (const LAS float*)red;
#pragma unroll
                for (int w = 0; w < 8; ++w) s += rf[((w * 5 + mi) * 64 + (c >> 2)) * 4 + (c & 3)];
                ((float*)(F.ws + WS_MOD))[(size_t)(l * 5 + mi) * 6144 + cb * 256 + c] = s; }
            __syncthreads();
        }
    }
}
__device__ __forceinline__ void p1_init(Frame& F) {
    const Args& A = *F.a; bf16_t* U = RG(F, 0);
    for (int t = F.gw; t < TT; t += F.NGW) {
        const float* src = t < TLAT ? A.in[I_X] + (size_t)t * D : A.in[I_CTX] + (size_t)(t - TLAT) * D;
        bf16_t* hp = hrow(F, t); const int mi = t < TLAT ? (t >> 13) : 4; const float* mp = modrow(F, 0, mi);
#pragma unroll
        for (int j = 0; j < 4; ++j) { const int col = 256 * j + 4 * F.lane; const f32x4 v = *(const f32x4*)(src + col);
            *(u32x2*)(hp + col) = (u32x2){pk2(v[0], v[1]), pk2(v[2], v[3])};
            const f32x4 sh = *(const f32x4*)(mp + col), sc = *(const f32x4*)(mp + 1024 + col); const f32x4 u = v * (sc + 1.0f) + sh;
            *(u32x2*)(U + (size_t)t * D + col) = (u32x2){pk2(u[0], u[1]), pk2(u[2], u[3])}; }
    }
}

__device__ __forceinline__ void moe_route(Frame& F, int layer, int nrows, bool last) {
    const Args& A = *F.a;
    { LAS float* scr = (LAS float*)(F.lds + F.wave * 16384);
      const float* eg = A.in[I_EGATE] + (size_t)layer * NE * D * DE; const float* eu = A.in[I_EUP] + (size_t)layer * NE * D * DE; const float* ed = A.in[I_EDOWN] + (size_t)layer * NE * DE * D;
      bf16_t* W1 = (bf16_t*)(F.ws + WS_WE1); bf16_t* W2 = (bf16_t*)(F.ws + WS_WE2);
      for (int it = F.gw; it < NE * 768; it += F.NGW) { const int e = it / 768, r = it % 768;
        if (r < 512) { const int up = r >> 8, q = r & 255, kb = q >> 4, nb = q & 15, n0 = 32 * nb;
            transpose_item((up ? eu : eg) + (size_t)e * D * DE, DE, W1 + (size_t)e * D * D, D, (n0 >> 7) * 256 + (n0 & 127) + up * 128, 64 * kb, n0, scr, F.lane); }
        else { const int q = r - 512, kb = q >> 5, nb = q & 31;
            transpose_item(ed + (size_t)e * DE * D, D, W2 + (size_t)e * D * DE, DE, 32 * nb, 64 * kb, 32 * nb, scr, F.lane); } }
    }
    __syncthreads();
    LAS float* WR = (LAS float*)F.lds;
    LAS int* CNT = (LAS int*)(F.lds + 65536); LAS int* BASE = CNT + 16; LAS int* EID = CNT + 64; LAS int* RK = EID + 2 * 272; LAS float* WT = (LAS float*)(RK + 2 * 272);
    for (int idx = F.tid; idx < D * NE; idx += NTHR) { const int k = idx >> 4, e = idx & 15, j = k >> 8, ln = (k >> 2) & 63, i = k & 3, q = e >> 2;
        WR[((((j * 4 + i) * 4 + q) * 64 + ln) << 2) + (e & 3)] = A.in[I_WROUTER][idx]; }
    if (F.tid < 16) CNT[F.tid] = 0;
    __syncthreads();
    const int per = (nrows + F.G - 1) / F.G, r0 = F.bid * per, r1 = (r0 + per < nrows) ? r0 + per : nrows;
    const float* lg = A.in[I_LNG] + (size_t)(layer * 2 + 0) * D; const float* lb = A.in[I_LNB] + (size_t)(layer * 2 + 0) * D;
    bf16_t* U2 = RG(F, 0); int* LIST = (int*)(F.ws + WS_LIST); float* WLIST = (float*)(F.ws + WS_WLIST);
    float rb[16];
#pragma unroll
    for (int e = 0; e < 16; ++e) rb[e] = A.in[I_RBIAS][e];
    for (int t = r0 + F.wave; t < r1; t += NWAVES) {
        FRAME_REFRESH(F);
        const bf16_t* zp = hrow(F, t); bf16_t* hp = last ? RG(F, 6) + (size_t)t * D : hrow(F, t); const int mi = t < TLAT ? (t >> 13) : 4; const float* mp = modrow(F, layer, mi);
        f32x4 v[4]; float s = 0.f;
#pragma unroll
        for (int j = 0; j < 4; ++j) { const u32x2 zw = *(const u32x2*)(zp + 256 * j + 4 * F.lane); v[j] = (f32x4){bflo(zw.x), bfhi(zw.x), bflo(zw.y), bfhi(zw.y)}; s += (v[j][0] + v[j][1]) + (v[j][2] + v[j][3]); }
        const float mean = wave_sum(s) * (1.f / D); float s2 = 0.f;
#pragma unroll
        for (int j = 0; j < 4; ++j) { v[j] = v[j] - mean; s2 += (v[j][0] * v[j][0] + v[j][1] * v[j][1]) + (v[j][2] * v[j][2] + v[j][3] * v[j][3]); }
        const float rstd = 1.f / sqrtf(wave_sum(s2) * (1.f / D) + EPS);
        float acc[16];
#pragma unroll
        for (int e = 0; e < 16; ++e) acc[e] = 0.f;
#pragma unroll
        for (int j = 0; j < 4; ++j) { const int col = 256 * j + 4 * F.lane;
            const f32x4 hn = v[j] * rstd * *(const f32x4*)(lg + col) + *(const f32x4*)(lb + col);
            *(u32x2*)(hp + col) = (u32x2){pk2(hn[0], hn[1]), pk2(hn[2], hn[3])};
            const f32x4 u2 = hn * (*(const f32x4*)(mp + 4096 + col) + 1.0f) + *(const f32x4*)(mp + 3072 + col);
            *(u32x2*)(U2 + (size_t)t * D + col) = (u32x2){pk2(u2[0], u2[1]), pk2(u2[2], u2[3])};
#pragma unroll
            for (int i = 0; i < 4; ++i)
#pragma unroll
                for (int q = 0; q < 4; ++q) { const f32x4 w = *(const LAS f32x4*)(WR + ((((j * 4 + i) * 4 + q) * 64 + F.lane) << 2));
                    acc[4 * q + 0] += u2[i] * w[0]; acc[4 * q + 1] += u2[i] * w[1]; acc[4 * q + 2] += u2[i] * w[2]; acc[4 * q + 3] += u2[i] * w[3]; } }
        float sc[16], sel[16];
#pragma unroll
        for (int e = 0; e < 16; ++e) { acc[e] = wave_sum(acc[e]); sc[e] = 1.f / (1.f + expf(-acc[e])); sel[e] = sc[e] + rb[e]; }
        float gs[4];
#pragma unroll
        for (int g = 0; g < 4; ++g) { const float a = sel[4 * g], b = sel[4 * g + 1], c = sel[4 * g + 2], d = sel[4 * g + 3];
            const float hi1 = fmaxf(a, b), lo1 = fminf(a, b), hi2 = fmaxf(c, d), lo2 = fminf(c, d);
            const float m1 = fmaxf(hi1, hi2), m2 = fmaxf(fminf(hi1, hi2), fmaxf(lo1, lo2)); gs[g] = m1 + m2; }
        int bg = 0; float bgs = gs[0];
#pragma unroll
        for (int g = 1; g < 4; ++g) if (gs[g] > bgs) { bgs = gs[g]; bg = g; }
        float s4[4], c4[4];
#pragma unroll
        for (int i = 0; i < 4; ++i) { s4[i] = bg == 0 ? sel[i] : bg == 1 ? sel[4 + i] : bg == 2 ? sel[8 + i] : sel[12 + i]; c4[i] = bg == 0 ? sc[i] : bg == 1 ? sc[4 + i] : bg == 2 ? sc[8 + i] : sc[12 + i]; }
        int i1 = 0; float b1 = s4[0], w1 = c4[0];
#pragma unroll
        for (int i = 1; i < 4; ++i) if (s4[i] > b1) { b1 = s4[i]; i1 = i; w1 = c4[i]; }
        int i2 = -1; float b2 = -3.0e38f, w2 = 0.f;
#pragma unroll
        for (int i = 0; i < 4; ++i) if (i != i1 && s4[i] > b2) { b2 = s4[i]; i2 = i; w2 = c4[i]; }
        const int e1 = bg * 4 + i1, e2 = bg * 4 + i2; const float wn = 1.f / (w1 + w2);
        if (F.lane == 0) { const int rl = t - r0;
            const int k1 = __hip_atomic_fetch_add(CNT + e1, 1, __ATOMIC_RELAXED, __HIP_MEMORY_SCOPE_WORKGROUP);
            const int k2 = __hip_atomic_fetch_add(CNT + e2, 1, __ATOMIC_RELAXED, __HIP_MEMORY_SCOPE_WORKGROUP);
            EID[2 * rl] = e1; EID[2 * rl + 1] = e2; RK[2 * rl] = k1; RK[2 * rl + 1] = k2; WT[2 * rl] = w1 * wn; WT[2 * rl + 1] = w2 * wn; }
    }
    FRAME_REFRESH(F);
    __syncthreads();
    if (F.tid < 16) BASE[F.tid] = (int)__hip_atomic_fetch_add((unsigned*)(F.ws + WS_CTL) + CW_CNT + layer * 16 + F.tid, (unsigned)CNT[F.tid], RLX_AGENT);
    __syncthreads();
    for (int rl = F.tid; rl < r1 - r0; rl += NTHR) { const int t = r0 + rl; const int e1 = EID[2 * rl], e2 = EID[2 * rl + 1];
        const int p1 = e1 * TT + BASE[e1] + RK[2 * rl], p2 = e2 * TT + BASE[e2] + RK[2 * rl + 1];
        LIST[p1] = 2 * t; WLIST[p1] = WT[2 * rl]; LIST[p2] = 2 * t + 1; WLIST[p2] = WT[2 * rl + 1]; }
}
__device__ __forceinline__ void moe_tables(Frame& F, int layer) {
    LAS int* TS = (LAS int*)(F.lds + GTAB_OFF); LAS int* CN = TS + 32;
    if (F.tid == 0) { const unsigned* gc = (const unsigned*)(F.ws + WS_CTL) + CW_CNT + layer * 16; int acc = 0;
        for (int e = 0; e < NE; ++e) { const int c = (int)gc[e]; TS[e] = acc; CN[e] = c; acc += (c + 255) >> 8; } TS[NE] = acc; }
    __syncthreads();
}
__device__ __forceinline__ void moe_toktable(Frame& F, const pg8::GroupedOrder& S) {
    const int* LIST = (const int*)(F.ws + WS_LIST); LAS int* TOK = (LAS int*)(F.lds + GTOK_OFF);
    Unit u;
    for (int i = 0; i < GTOK_MAXU && S.next(i, u); ++i)
        if (F.tid < 256) TOK[i * 256 + F.tid] = (F.tid < u.nvalid) ? (LIST[u.lbase + F.tid] >> 1) : 0;
    __syncthreads();
}
__device__ __forceinline__ void moe_scatter(Frame& F, int layer, int nrows, bool last) {
    moe_tables(F, layer);
    const LAS int* TS = (const LAS int*)(F.lds + GTAB_OFF);
    bf16_t* XS = (bf16_t*)(F.ws + WS_XS); int* rowmap = (int*)(F.ws + WS_ROWMAP); float* roww = (float*)(F.ws + WS_ROWW);
    for (int t = F.gw; t < nrows; t += F.NGW) {
        const bf16_t* hp = last ? RG(F, 6) + (size_t)t * D : hrow(F, t); const int mi = t < TLAT ? (t >> 13) : 4; const float* mp = modrow(F, layer, mi);
        const i32x2 ee = ((const i32x2*)(F.ws + WS_ASG))[t]; const i32x2 pp = ((const i32x2*)(F.ws + WS_POS))[t]; const f32x2 ww = ((const f32x2*)(F.ws + WS_ASGW))[t];
        const int d0 = TS[ee.x] * 256 + pp.x, d1 = TS[ee.y] * 256 + pp.y;
#pragma unroll
        for (int j = 0; j < 4; ++j) { const int col = 256 * j + 4 * F.lane; const u32x2 hw = *(const u32x2*)(hp + col); const f32x4 hn = {bflo(hw.x), bfhi(hw.x), bflo(hw.y), bfhi(hw.y)};
            const f32x4 u = hn * (*(const f32x4*)(mp + 4096 + col) + 1.0f) + *(const f32x4*)(mp + 3072 + col);
            const u32x2 w = {pk2(u[0], u[1]), pk2(u[2], u[3])};
            *(u32x2*)(XS + (size_t)d0 * D + col) = w; *(u32x2*)(XS + (size_t)d1 * D + col) = w; }
        if (F.lane == 0) { rowmap[d0] = 2 * t; rowmap[d1] = 2 * t + 1; roww[d0] = ww.x; roww[d1] = ww.y; }
    }
}
__device__ __forceinline__ void moe_ln2(Frame& F, int layer, int nrows, bool last) {
    const Args& A = *F.a; const bf16_t* Y2 = (const bf16_t*)(F.ws + WS_Y2); bf16_t* U = RG(F, 0);
    const float* lg = A.in[I_LNG] + (size_t)(layer * 2 + 1) * D; const float* lb = A.in[I_LNB] + (size_t)(layer * 2 + 1) * D;
    for (int t = F.gw; t < nrows; t += F.NGW) {
        const bf16_t* hin = last ? RG(F, 6) + (size_t)t * D : hrow(F, t); bf16_t* hp = hrow(F, t); const int mi = t < TLAT ? (t >> 13) : 4; const float* mp = modrow(F, layer, mi);
        f32x4 v[4]; float s = 0.f;
#pragma unroll
        for (int j = 0; j < 4; ++j) { const int col = 256 * j + 4 * F.lane; const u32x2 hw = *(const u32x2*)(hin + col); const f32x4 hv = {bflo(hw.x), bfhi(hw.x), bflo(hw.y), bfhi(hw.y)};
            const u32x2 ya = *(const u32x2*)(Y2 + (size_t)(2 * t) * D + col), yb = *(const u32x2*)(Y2 + (size_t)(2 * t + 1) * D + col);
            const f32x4 y = {bflo(ya.x) + bflo(yb.x), bfhi(ya.x) + bfhi(yb.x), bflo(ya.y) + bflo(yb.y), bfhi(ya.y) + bfhi(yb.y)};
            v[j] = hv * DN_ALPHA + *(const f32x4*)(mp + 5120 + col) * y; s += (v[j][0] + v[j][1]) + (v[j][2] + v[j][3]); }
        const float mean = wave_sum(s) * (1.f / D); float s2 = 0.f;
#pragma unroll
        for (int j = 0; j < 4; ++j) { v[j] = v[j] - mean; s2 += (v[j][0] * v[j][0] + v[j][1] * v[j][1]) + (v[j][2] * v[j][2] + v[j][3] * v[j][3]); }
        const float rstd = 1.f / sqrtf(wave_sum(s2) * (1.f / D) + EPS);
        const float* mn = modrow(F, last ? layer : layer + 1, mi);
#pragma unroll
        for (int j = 0; j < 4; ++j) { const int col = 256 * j + 4 * F.lane;
            const f32x4 hn = v[j] * rstd * *(const f32x4*)(lg + col) + *(const f32x4*)(lb + col);
            if (last) *(f32x4*)(F.out + (size_t)t * D + col) = hn; else *(u32x2*)(hp + col) = (u32x2){pk2(hn[0], hn[1]), pk2(hn[2], hn[3])};
            if (!last) { const f32x4 u = hn * (*(const f32x4*)(mn + 1024 + col) + 1.0f) + *(const f32x4*)(mn + col);
                *(u32x2*)(U + (size_t)t * D + col) = (u32x2){pk2(u[0], u[1]), pk2(u[2], u[3])}; } }
    }
}

__device__ __forceinline__ void qk_norm_rope(Frame& F, int j, const pg8::StaticOrder& S) {
    const Args& A = *F.a; const float* qg = A.in[I_AQG] + j * 128; const float* kg = A.in[I_AKG] + j * 128;
    bf16_t* Q = RG(F, 1); bf16_t* Kb = RG(F, 2); const f32x2* rope = (const f32x2*)(F.ws + WS_ROPE);
    const int sub = F.lane >> 4, l16 = F.lane & 15;
    Unit u;
    for (int i = 0; S.next(i, u); ++i) {
        if (u.pn >= 5) continue;
        const float* gn = u.pn < 4 ? qg : kg;
        float gv[8];
#pragma unroll
        for (int e = 0; e < 8; ++e) gv[e] = gn[l16 * 8 + e];
        bf16_t* base; size_t ld; size_t r0;
        if (u.pn < 4) { base = Q + u.pn * 256; ld = D; r0 = (size_t)u.pm * 256; }
        else { base = Kb; ld = 256; r0 = u.pm < 128 ? (size_t)(u.pm >> 5) * KVLEN + CTXL + (size_t)(u.pm & 31) * 256 : (size_t)(u.pm - 128) * KVLEN; }
        const bool lat = u.pm < 128;
        for (int it = 0; it < 16; ++it) {
            const int pi = it * 32 + F.wave * 4 + sub, row = pi >> 1, hh = pi & 1;
            bf16_t* p = base + (r0 + row) * ld + hh * 128 + l16 * 8;
            const u32x4 w = *(const u32x4*)p;
            float x[8] = {bflo(w.x), bfhi(w.x), bflo(w.y), bfhi(w.y), bflo(w.z), bfhi(w.z), bflo(w.w), bfhi(w.w)};
            float ss = 0.f;
#pragma unroll
            for (int e = 0; e < 8; ++e) ss += x[e] * x[e];
            ss = sum16(ss);
            const float rs = 1.f / sqrtf(ss * (1.f / 128.f) + EPS);
#pragma unroll
            for (int e = 0; e < 8; ++e) x[e] = x[e] * rs * gv[e];
            if (lat) { const int n = (u.pm & 31) * 256 + row;
#pragma unroll
                for (int e = 0; e < 4; ++e) { const f32x2 cs = rope[(size_t)n * 64 + l16 * 4 + e]; const float a = x[2 * e], b = x[2 * e + 1];
                    x[2 * e] = a * cs.x - b * cs.y; x[2 * e + 1] = a * cs.y + b * cs.x; } }
            *(u32x4*)p = (u32x4){pk2(x[0], x[1]), pk2(x[2], x[3]), pk2(x[4], x[5]), pk2(x[6], x[7])};
        }
    }
}
__device__ __forceinline__ void attn_phase(Frame& F, bool need_ctx, bf16_t* Oout) {
    const bf16_t* Q = RG(F, 1); const bf16_t* Kb = RG(F, 2); const bf16_t* Vb = (const bf16_t*)((const char*)RG(F, 2) + 17 * MiB);
    const int nunits = 1024 + (need_ctx ? 32 : 0);
    for (int L = F.bid; L < nunits; L += F.G) {
        int b, h, t0, seq;
        if (L < 1024) { const int qb = L & 31; h = (L >> 5) & 7; b = L >> 8; t0 = b * SEQ + qb * 256; seq = KVLEN; }
        else { const int i = L - 1024; b = i >> 3; h = i & 7; t0 = TLAT + b * CTXL; seq = CTXL; }
        const bf16_t* Qp = Q + (size_t)t0 * D + h * 128;
        const size_t kvo = (size_t)b * KVLEN * 256 + (h >> 2) * 128;
        att::attn_dense_body(Qp, Kb + kvo, Vb + kvo, Oout + (size_t)t0 * D + h * 128, seq, F.ldsg, F.tid);
    }
}

__device__ __forceinline__ void gmlp_spatial(Frame& F) {
    const Args& A = *F.a; const bf16_t* ZB = RG(F, 1); bf16_t* P = RG(F, 0); const bf16_t* WS_ = (const bf16_t*)(F.ws + WS_BWS);
    LAS float* ST = (LAS float*)F.lds;
    LAS bf16_t* VT = (LAS bf16_t*)(F.lds + 2048);
    constexpr int VP = 130;
    const int r = F.lane & 31, hh = F.lane >> 5, wr = F.wave >> 1, wc = F.wave & 1;
    for (int un = F.bid; un < 528; un += F.G) {
        const int ck = un >> 1, hf = un & 1, t0 = ck * 128;
        { const int row = F.tid >> 2, q = F.tid & 3; const bf16_t* vp = ZB + (size_t)(t0 + row) * 2048 + 1024 + q * 256; float s = 0.f, s2 = 0.f;
#pragma unroll 4
          for (int i = 0; i < 32; ++i) { const u32x4 w = *(const u32x4*)(vp + i * 8); const float x[8] = {bflo(w.x), bfhi(w.x), bflo(w.y), bfhi(w.y), bflo(w.z), bfhi(w.z), bflo(w.w), bfhi(w.w)};
#pragma unroll
              for (int e = 0; e < 8; ++e) { s += x[e]; s2 += x[e] * x[e]; } }
          s += __shfl_xor(s, 1); s += __shfl_xor(s, 2); s2 += __shfl_xor(s2, 1); s2 += __shfl_xor(s2, 2);
          const float mean = s * (1.f / 1024.f), var = fmaxf(s2 * (1.f / 1024.f) - mean * mean, 0.f);
          if (q == 0) { ST[2 * row] = mean; ST[2 * row + 1] = 1.f / sqrtf(var + EPS); } }
        __syncthreads();
        for (int gi = 0; gi < 4; ++gi) { const int g = hf * 4 + gi;
            { const int row = F.tid >> 2, q = F.tid & 3; const float mean = ST[2 * row], rstd = ST[2 * row + 1];
              const bf16_t* vp = ZB + (size_t)(t0 + row) * 2048 + 1024 + g * 128 + q * 32;
#pragma unroll
              for (int i = 0; i < 4; ++i) { const u32x4 w = *(const u32x4*)(vp + i * 8); const float x[8] = {bflo(w.x), bfhi(w.x), bflo(w.y), bfhi(w.y), bflo(w.z), bfhi(w.z), bflo(w.w), bfhi(w.w)};
                  const int c0 = g * 128 + q * 32 + i * 8;
#pragma unroll
                  for (int e = 0; e < 8; e += 2) { const float y0 = (x[e] - mean) * rstd * A.in[I_BVG][c0 + e] + A.in[I_BVB][c0 + e], y1 = (x[e + 1] - mean) * rstd * A.in[I_BVG][c0 + e + 1] + A.in[I_BVB][c0 + e + 1];
                      *(LAS unsigned*)(VT + row * VP + q * 32 + i * 8 + e) = pk2(y0, y1); } } }
            __syncthreads();
            f32x16 acc[2] = {};
            const bf16_t* wp = WS_ + ((size_t)g * 128 + wr * 32 + r) * 128 + hh * 8;
#pragma unroll
            for (int ks = 0; ks < 8; ++ks) { const bf16x8 af = *(const bf16x8*)(wp + ks * 16);
#pragma unroll
                for (int cb = 0; cb < 2; ++cb) { const LAS bf16_t* bp = VT + (ks * 16 + hh * 8) * VP + wc * 64 + cb * 32 + r;
                    bf16x8 bfr;
#pragma unroll
                    for (int e = 0; e < 8; ++e) bfr[e] = (short)bp[e * VP];
                    acc[cb] = MFMA32(af, bfr, acc[cb]); } }
#pragma unroll
            for (int cb = 0; cb < 2; ++cb)
#pragma unroll
                for (int reg = 0; reg < 16; ++reg) { const int tl = wr * 32 + crow(reg, hh), c = g * 128 + wc * 64 + cb * 32 + r;
                    const float mixed = acc[cb][reg] + A.in[I_BBS][g * 128 + tl];
                    const float uu = bf1(ZB[(size_t)(t0 + tl) * 2048 + c]);
                    P[(size_t)(t0 + tl) * D + c] = (bf16_t)(pk2(uu * mixed, 0.f) & 0xffffu); }
            __syncthreads();
        }
    }
}

__device__ __forceinline__ void delta_prep(Frame& F) {
    const Args& A = *F.a; const float* cw = A.in[I_CCONV];
    for (int wu = F.gw; wu < 528 * 6; wu += F.NGW) {
        const int ck = wu / 6, slab = wu % 6, buf = slab >> 1, ch = (slab & 1) * 512 + 8 * F.lane, t0 = ck * 64;
        const bf16_t* src = RG(F, 1 + buf) + ch; bf16_t* dst = RG(F, 5 + buf) + ch;
        float w0[8], w1[8], w2[8];
#pragma unroll
        for (int e = 0; e < 8; ++e) { const int cg = buf * 1024 + ch + e; w0[e] = cw[cg]; w1[e] = cw[3072 + cg]; w2[e] = cw[6144 + cg]; }
        const int seqlen = t0 < TLAT ? SEQ : CTXL, n0 = t0 < TLAT ? (t0 & (SEQ - 1)) : ((t0 - TLAT) & (CTXL - 1));
        u32x4 prev = {0u, 0u, 0u, 0u}, cur, nxt;
        if (n0 > 0) prev = *(const u32x4*)(src + (size_t)(t0 - 1) * D);
        cur = *(const u32x4*)(src + (size_t)t0 * D);
        for (int rr = 0; rr < 64; ++rr) {
            const int t = t0 + rr;
            nxt = (u32x4){0u, 0u, 0u, 0u};
            if (n0 + rr + 1 < seqlen) nxt = *(const u32x4*)(src + (size_t)(t + 1) * D);
            const float xp[8] = {bflo(prev.x), bfhi(prev.x), bflo(prev.y), bfhi(prev.y), bflo(prev.z), bfhi(prev.z), bflo(prev.w), bfhi(prev.w)};
            const float xc[8] = {bflo(cur.x), bfhi(cur.x), bflo(cur.y), bfhi(cur.y), bflo(cur.z), bfhi(cur.z), bflo(cur.w), bfhi(cur.w)};
            const float xn[8] = {bflo(nxt.x), bfhi(nxt.x), bflo(nxt.y), bfhi(nxt.y), bflo(nxt.z), bfhi(nxt.z), bflo(nxt.w), bfhi(nxt.w)};
            float y[8]; float ss = 0.f;
#pragma unroll
            for (int e = 0; e < 8; ++e) { y[e] = siluf_(w0[e] * xp[e] + w1[e] * xc[e] + w2[e] * xn[e]); ss += y[e] * y[e]; }
            if (buf < 2) { ss = sum16(ss); const float rs = (1.f / sqrtf(ss + EPS)) * (buf == 0 ? 0.08838834764831845f : 1.f);
#pragma unroll
                for (int e = 0; e < 8; ++e) y[e] *= rs; }
            *(u32x4*)(dst + (size_t)t * D) = (u32x4){pk2(y[0], y[1]), pk2(y[2], y[3]), pk2(y[4], y[5]), pk2(y[6], y[7])};
            prev = cur; cur = nxt;
        }
    }
}
__device__ __forceinline__ void delta_local(Frame& F) {
    const Args& A = *F.a; const float* AB = (const float*)(F.ws + WS_AB); float* GC = (float*)(F.ws + WS_GC); float* BETA = (float*)(F.ws + WS_BETA);
    const bf16_t* QN = RG(F, 5); const bf16_t* KN = RG(F, 6); bf16_t* TB = RG(F, 1); bf16_t* ATT = RG(F, 2);
    LAS float* Aw = (LAS float*)(F.lds + F.wave * 16384);
    for (int wu = F.gw; wu < 528 * 16; wu += F.NGW) {
        int lane = F.lane; asm volatile("" : "+v"(lane));
        const int r = lane & 31, hh = lane >> 5;
        const int dir = wu & 1, h = (wu >> 1) & 7, ck = wu >> 4, t0 = ck * 64;
        const int tok = dir ? t0 + 63 - lane : t0 + lane;
        const float a = AB[(size_t)tok * 32 + dir * 8 + h], bb = AB[(size_t)tok * 32 + 16 + dir * 8 + h];
        const float x = a + A.in[I_CDTB][dir * 8 + h];
        const float sp = fmaxf(x, 0.f) + log1pf(expf(-fabsf(x)));
        const float g = -expf(A.in[I_CALOG][dir * 8 + h]) * sp;
        const float beta = 1.f / (1.f + expf(-bb));
        float gc = g;
#pragma unroll
        for (int o = 1; o < 64; o <<= 1) { const float tv = __shfl_up(gc, o); if (lane >= o) gc += tv; }
        GC[(size_t)(dir * 8 + h) * TT + tok] = gc; BETA[(size_t)(dir * 8 + h) * TT + tok] = beta;
        const int tk0 = dir ? t0 + 63 - r : t0 + r, tk1 = dir ? t0 + 31 - r : t0 + 32 + r;
        const bf16_t* kp0 = KN + (size_t)tk0 * D + h * 128 + hh * 8; const bf16_t* kp1 = KN + (size_t)tk1 * D + h * 128 + hh * 8;
        const bf16_t* qp0 = QN + (size_t)tk0 * D + h * 128 + hh * 8; const bf16_t* qp1 = QN + (size_t)tk1 * D + h * 128 + hh * 8;
        bf16x8 kf0[8], kf1[8];
#pragma unroll
        for (int ks = 0; ks < 8; ++ks) { kf0[ks] = *(const bf16x8*)(kp0 + ks * 16); kf1[ks] = *(const bf16x8*)(kp1 + ks * 16); }
        const float gcj0 = __shfl(gc, r), gcj1 = __shfl(gc, 32 + r);
        bf16_t* attp = ATT + (size_t)wu * 4096;
        {   f32x16 s00 = {}, s10 = {}, s11 = {};
#pragma unroll
            for (int ks = 0; ks < 8; ++ks) { s00 = MFMA32(kf0[ks], kf0[ks], s00); s10 = MFMA32(kf1[ks], kf0[ks], s10); s11 = MFMA32(kf1[ks], kf1[ks], s11); }
#pragma unroll
            for (int reg = 0; reg < 16; ++reg) { const int il = crow(reg, hh);
                const float gci0 = __shfl(gc, il), gci1 = __shfl(gc, 32 + il), bt0 = __shfl(beta, il), bt1 = __shfl(beta, 32 + il);
                const float d00 = (il > r) ? expf(gci0 - gcj0) : 0.f, d10 = expf(gci1 - gcj0), d11 = (il > r) ? expf(gci1 - gcj1) : 0.f;
                Aw[il * 64 + r] = bt0 * s00[reg] * d00;
                Aw[il * 64 + 32 + r] = 0.f;
                Aw[(32 + il) * 64 + r] = bt1 * s10[reg] * d10;
                Aw[(32 + il) * 64 + 32 + r] = bt1 * s11[reg] * d11; }
        }
        asm volatile("" ::: "memory"); __builtin_amdgcn_sched_barrier(0);
        {   f32x16 q00 = {}, q10 = {}, q11 = {};
#pragma unroll
            for (int ks = 0; ks < 8; ++ks) { const bf16x8 q0 = *(const bf16x8*)(qp0 + ks * 16), q1 = *(const bf16x8*)(qp1 + ks * 16);
                q00 = MFMA32(q0, kf0[ks], q00); q10 = MFMA32(q1, kf0[ks], q10); q11 = MFMA32(q1, kf1[ks], q11); }
#pragma unroll
            for (int reg = 0; reg < 16; ++reg) { const int il = crow(reg, hh);
                const float gci0 = __shfl(gc, il), gci1 = __shfl(gc, 32 + il);
                const float d00 = (il >= r) ? expf(gci0 - gcj0) : 0.f, d10 = expf(gci1 - gcj0), d11 = (il >= r) ? expf(gci1 - gcj1) : 0.f;
                attp[il * 64 + r] = (bf16_t)(pk2(q00[reg] * d00, 0.f) & 0xffffu);
                attp[il * 64 + 32 + r] = 0;
                attp[(32 + il) * 64 + r] = (bf16_t)(pk2(q10[reg] * d10, 0.f) & 0xffffu);
                attp[(32 + il) * 64 + 32 + r] = (bf16_t)(pk2(q11[reg] * d11, 0.f) & 0xffffu); }
        }
        asm volatile("" ::: "memory"); __builtin_amdgcn_sched_barrier(0);
        LDS_WAIT(); asm volatile("" ::: "memory");
        float Tc[64]; bf16_t* tp = TB + (size_t)wu * 4096 + lane;
#pragma unroll
        for (int i = 0; i < 64; ++i) { float acc = (i == lane) ? 1.f : 0.f;
#pragma unroll
            for (int j4 = 0; j4 < (i + 3) / 4; ++j4) { const f32x4 av = *(const LAS f32x4*)(Aw + i * 64 + 4 * j4);
#pragma unroll
                for (int e = 0; e < 4; ++e) if (4 * j4 + e < i) acc -= av[e] * Tc[4 * j4 + e]; }
            Tc[i] = acc; tp[i * 64] = (bf16_t)(pk2(acc, 0.f) & 0xffffu);
            if ((i & 3) == 3) { asm volatile("" ::: "memory"); __builtin_amdgcn_sched_barrier(0); } }
        LDS_WAIT(); asm volatile("" ::: "memory");
    }
}
constexpr int SC_QT = 0, SC_KT = 16896, SC_KTT = 33792, SC_TT = 51200, SC_AT = 59904, SC_VT = 68608, SC_TAB = 76800, SC_XP = 77824, SC_OP = 110592;
static_assert(SC_OP + 32768 <= MISC_OFF, "scan LDS");
__device__ __forceinline__ bf16x8 lds_frag(const LAS unsigned char* p) { return mk8(*(const LAS u32x2*)p, *(const LAS u32x2*)(p + 16)); }
__device__ __forceinline__ bf16x8 pack_acc(const f32x16& v, int s) { return mk8w(pk2(v[8 * s], v[8 * s + 1]), pk2(v[8 * s + 2], v[8 * s + 3]), pk2(v[8 * s + 4], v[8 * s + 5]), pk2(v[8 * s + 6], v[8 * s + 7])); }
__device__ __forceinline__ void delta_scan(Frame& F) {
    const bf16_t* QN = RG(F, 5); const bf16_t* KN = RG(F, 6); const bf16_t* VN = RG(F, 7); const bf16_t* TB = RG(F, 1); const bf16_t* ATT = RG(F, 2);
    const float* GC = (const float*)(F.ws + WS_GC); const float* BETA = (const float*)(F.ws + WS_BETA);
    LAS unsigned char* L = F.lds; const int w = F.wave;
    LAS float* TAB = (LAS float*)(L + SC_TAB); LAS float* XP = (LAS float*)(L + SC_XP); LAS float* OP = (LAS float*)(L + SC_OP); LAS float* VT = (LAS float*)(L + SC_VT);
    for (int item = F.bid; item < 256; item += F.G) {
        const int ch = item >> 2, dvs = item & 3, b = ch >> 4, h = (ch >> 1) & 7, dir = ch & 1;
        bf16_t* OB = RG(F, dir ? 3 : 0);
        f32x16 S = {};
        u32x4 sq[2], sk[2], st, sa, sv; float sgc = 0.f, sbt = 0.f;
#define SCAN_CK(step) ((step) < 4 ? 512 + b * 4 + (dir ? 3 - (step) : (step)) : b * 128 + (dir ? 131 - (step) : (step) - 4))
#define SCAN_LOAD(step) do { const int ck_ = SCAN_CK(step); const int t0_ = ck_ * 64; const size_t un_ = ((size_t)ck_ * 8 + h) * 2 + dir; \
        _Pragma("unroll") for (int e_ = 0; e_ < 2; ++e_) { const int id_ = tid + 512 * e_, row_ = id_ >> 4, c16_ = id_ & 15; const int tk_ = dir ? t0_ + 63 - row_ : t0_ + row_; \
            sq[e_] = *(const u32x4*)(QN + (size_t)tk_ * D + h * 128 + c16_ * 8); sk[e_] = *(const u32x4*)(KN + (size_t)tk_ * D + h * 128 + c16_ * 8); } \
        st = *(const u32x4*)(TB + un_ * 4096 + tid * 8); sa = *(const u32x4*)(ATT + un_ * 4096 + tid * 8); \
        if (tid < 256) { const int row_ = tid >> 2, c_ = tid & 3; const int tk_ = dir ? t0_ + 63 - row_ : t0_ + row_; sv = *(const u32x4*)(VN + (size_t)tk_ * D + h * 128 + dvs * 32 + c_ * 8); } \
        if (tid < 64) { const int tk_ = dir ? t0_ + 63 - tid : t0_ + tid; sgc = GC[(size_t)(dir * 8 + h) * TT + tk_]; sbt = BETA[(size_t)(dir * 8 + h) * TT + tk_]; } } while (0)
#define SCAN_STORE() do { \
        _Pragma("unroll") for (int e_ = 0; e_ < 2; ++e_) { const int id_ = tid + 512 * e_, row_ = id_ >> 4, c16_ = id_ & 15; \
            *(LAS u32x2*)(L + SC_QT + row_ * 264 + c16_ * 16) = (u32x2){sq[e_].x, sq[e_].y}; *(LAS u32x2*)(L + SC_QT + row_ * 264 + c16_ * 16 + 8) = (u32x2){sq[e_].z, sq[e_].w}; \
            *(LAS u32x2*)(L + SC_KT + row_ * 264 + c16_ * 16) = (u32x2){sk[e_].x, sk[e_].y}; *(LAS u32x2*)(L + SC_KT + row_ * 264 + c16_ * 16 + 8) = (u32x2){sk[e_].z, sk[e_].w}; \
            LAS bf16_t* kt_ = (LAS bf16_t*)(L + SC_KTT) + (c16_ * 8) * 68 + row_; \
            kt_[0 * 68] = (bf16_t)(sk[e_].x & 0xffffu); kt_[1 * 68] = (bf16_t)(sk[e_].x >> 16); kt_[2 * 68] = (bf16_t)(sk[e_].y & 0xffffu); kt_[3 * 68] = (bf16_t)(sk[e_].y >> 16); \
            kt_[4 * 68] = (bf16_t)(sk[e_].z & 0xffffu); kt_[5 * 68] = (bf16_t)(sk[e_].z >> 16); kt_[6 * 68] = (bf16_t)(sk[e_].w & 0xffffu); kt_[7 * 68] = (bf16_t)(sk[e_].w >> 16); } \
        { const int row_ = tid >> 3, c16_ = tid & 7; \
          *(LAS u32x2*)(L + SC_TT + row_ * 136 + c16_ * 16) = (u32x2){st.x, st.y}; *(LAS u32x2*)(L + SC_TT + row_ * 136 + c16_ * 16 + 8) = (u32x2){st.z, st.w}; \
          *(LAS u32x2*)(L + SC_AT + row_ * 136 + c16_ * 16) = (u32x2){sa.x, sa.y}; *(LAS u32x2*)(L + SC_AT + row_ * 136 + c16_ * 16 + 8) = (u32x2){sa.z, sa.w}; } \
        if (tid < 256) { const int row_ = tid >> 2, c_ = tid & 3; LAS f32x4* vp_ = (LAS f32x4*)(VT + row_ * 32 + c_ * 8); \
            vp_[0] = (f32x4){bflo(sv.x), bfhi(sv.x), bflo(sv.y), bfhi(sv.y)}; vp_[1] = (f32x4){bflo(sv.z), bfhi(sv.z), bflo(sv.w), bfhi(sv.w)}; } \
        if (tid < 64) { const float gl_ = __shfl(sgc, 63); TAB[tid] = expf(sgc); TAB[64 + tid] = expf(gl_ - sgc); TAB[128 + tid] = sbt; if (tid == 0) TAB[192] = expf(gl_); } } while (0)
        int tid = F.tid; asm volatile("" : "+v"(tid));
        SCAN_LOAD(0); VM_WAIT(); SCAN_STORE(); __syncthreads();
#pragma unroll 1
        for (int step = 0; step < 132; ++step) {
            tid = F.tid; asm volatile("" : "+v"(tid));
            const int lane = tid & 63, r = lane & 31, hh = lane >> 5;
            const int ck = SCAN_CK(step), t0 = ck * 64;
            if (step + 1 < 132) SCAN_LOAD(step + 1);
            if (w < 4) {
                const bf16x8 Sb0 = pack_acc(S, 0), Sb1 = pack_acc(S, 1);
#pragma unroll
                for (int bi = 0; bi < 2; ++bi) { const int off = (32 * bi + r) * 264 + (32 * w + 4 * hh) * 2;
                    { f32x16 X = {}; const bf16x8 k0 = lds_frag(L + SC_KT + off), k1 = lds_frag(L + SC_KT + off + 32);
                      X = MFMA32(k0, Sb0, X); X = MFMA32(k1, Sb1, X);
#pragma unroll
                      for (int reg = 0; reg < 16; ++reg) XP[((w * 2 + bi) * 16 + reg) * 64 + lane] = X[reg]; }
                    { f32x16 X = {}; const bf16x8 q0 = lds_frag(L + SC_QT + off), q1 = lds_frag(L + SC_QT + off + 32);
                      X = MFMA32(q0, Sb0, X); X = MFMA32(q1, Sb1, X);
#pragma unroll
                      for (int reg = 0; reg < 16; ++reg) OP[((w * 2 + bi) * 16 + reg) * 64 + lane] = X[reg]; }
                    asm volatile("" ::: "memory"); }
            }
            __syncthreads();
            if (w < 4) {
                bf16x8 Rp[2][2];
#pragma unroll
                for (int bi = 0; bi < 2; ++bi)
#pragma unroll
                    for (int sh = 0; sh < 2; ++sh) { float R[8];
#pragma unroll
                        for (int e = 0; e < 8; ++e) { const int reg = 8 * sh + e; const int i = 32 * bi + crow(reg, hh);
                            const float X = (XP[((0 * 2 + bi) * 16 + reg) * 64 + lane] + XP[((1 * 2 + bi) * 16 + reg) * 64 + lane]) + (XP[((2 * 2 + bi) * 16 + reg) * 64 + lane] + XP[((3 * 2 + bi) * 16 + reg) * 64 + lane]);
                            R[e] = TAB[128 + i] * (VT[i * 32 + r] - TAB[i] * X); }
                        Rp[bi][sh] = mk8w(pk2(R[0], R[1]), pk2(R[2], R[3]), pk2(R[4], R[5]), pk2(R[6], R[7]));
                        asm volatile("" ::: "memory"); __builtin_amdgcn_sched_barrier(0); }
                f32x16 Vn0 = {}, Vn1 = {};
                { const int o0 = r * 136 + (4 * hh) * 2, o1 = (32 + r) * 136 + (4 * hh) * 2;
                  Vn0 = MFMA32(lds_frag(L + SC_TT + o0), Rp[0][0], Vn0); Vn0 = MFMA32(lds_frag(L + SC_TT + o0 + 32), Rp[0][1], Vn0);
                  Vn1 = MFMA32(lds_frag(L + SC_TT + o1), Rp[0][0], Vn1); Vn1 = MFMA32(lds_frag(L + SC_TT + o1 + 32), Rp[0][1], Vn1);
                  Vn1 = MFMA32(lds_frag(L + SC_TT + o1 + 64), Rp[1][0], Vn1); Vn1 = MFMA32(lds_frag(L + SC_TT + o1 + 96), Rp[1][1], Vn1); }
                asm volatile("" ::: "memory");
                bf16x8 Vsp[2][2];
                { f32x16 Vs;
#pragma unroll
                  for (int reg = 0; reg < 16; ++reg) Vs[reg] = Vn0[reg] * TAB[64 + crow(reg, hh)];
                  Vsp[0][0] = pack_acc(Vs, 0); Vsp[0][1] = pack_acc(Vs, 1);
#pragma unroll
                  for (int reg = 0; reg < 16; ++reg) Vs[reg] = Vn1[reg] * TAB[64 + 32 + crow(reg, hh)];
                  Vsp[1][0] = pack_acc(Vs, 0); Vsp[1][1] = pack_acc(Vs, 1); }
                const float gl = TAB[192];
#pragma unroll
                for (int reg = 0; reg < 16; ++reg) S[reg] *= gl;
                { const int o = (32 * w + r) * 136 + (4 * hh) * 2;
                  S = MFMA32(lds_frag(L + SC_KTT + o), Vsp[0][0], S); S = MFMA32(lds_frag(L + SC_KTT + o + 32), Vsp[0][1], S);
                  S = MFMA32(lds_frag(L + SC_KTT + o + 64), Vsp[1][0], S); S = MFMA32(lds_frag(L + SC_KTT + o + 96), Vsp[1][1], S); }
                asm volatile("" ::: "memory");
                if (w < 2) { f32x16 O = {};
                    const int o = (32 * w + r) * 136 + (4 * hh) * 2;
                    O = MFMA32(lds_frag(L + SC_AT + o), pack_acc(Vn0, 0), O); O = MFMA32(lds_frag(L + SC_AT + o + 32), pack_acc(Vn0, 1), O);
                    if (w == 1) { O = MFMA32(lds_frag(L + SC_AT + o + 64), pack_acc(Vn1, 0), O); O = MFMA32(lds_frag(L + SC_AT + o + 96), pack_acc(Vn1, 1), O); }
#pragma unroll
                    for (int sh = 0; sh < 2; ++sh) {
#pragma unroll
                        for (int e = 0; e < 8; ++e) { const int reg = 8 * sh + e; const int i = 32 * w + crow(reg, hh);
                            const float o1 = (OP[((0 * 2 + w) * 16 + reg) * 64 + lane] + OP[((1 * 2 + w) * 16 + reg) * 64 + lane]) + (OP[((2 * 2 + w) * 16 + reg) * 64 + lane] + OP[((3 * 2 + w) * 16 + reg) * 64 + lane]);
                            const float ov = O[reg] + TAB[i] * o1; const int tk = dir ? t0 + 63 - i : t0 + i;
                            OB[(size_t)tk * D + h * 128 + dvs * 32 + r] = (bf16_t)(pk2(ov, 0.f) & 0xffffu); }
                        asm volatile("" ::: "memory"); __builtin_amdgcn_sched_barrier(0); } }
            }
            __syncthreads();
            if (step + 1 < 132) { VM_WAIT(); SCAN_STORE(); }
            __syncthreads();
        }
#undef SCAN_CK
#undef SCAN_LOAD
#undef SCAN_STORE
    }
}
constexpr int S2_QT = 0, S2_KT = 16384, S2_VT = 32768, S2_TT = 49152, S2_AT = 57344, S2_TAB = 65536, S2_BUF = 66560;
static_assert(2 * S2_BUF <= MISC_OFF, "scan2 LDS");
__device__ __forceinline__ unsigned off_b(unsigned row, unsigned ch) { return 256u * row + 16u * (ch ^ (((row & 3) << 2) | ((row >> 2) & 3))); }
__device__ __forceinline__ bf16x8 pka(const f32x16& P, const int BASE) {
    const unsigned a0 = pk2(P[BASE + 0], P[BASE + 1]), a1 = pk2(P[BASE + 2], P[BASE + 3]), b0 = pk2(P[BASE + 4], P[BASE + 5]), b1 = pk2(P[BASE + 6], P[BASE + 7]);
    auto r0 = __builtin_amdgcn_permlane32_swap(a0, b0, false, false); auto r1 = __builtin_amdgcn_permlane32_swap(a1, b1, false, false);
    return mk8w(r0[0], r1[0], r0[1], r1[1]);
}
__device__ __forceinline__ s16x4 trr(unsigned addr) { s16x4 r; asm volatile("ds_read_b64_tr_b16 %0, %1" : "=&v"(r) : "v"(addr) : "memory"); return r; }
#define GLDS16(gp, lp) __builtin_amdgcn_global_load_lds((const unsigned*)(gp), (LAS unsigned*)(lp), 16, 0, 0)
__device__ __forceinline__ void delta_scan2(Frame& F) {
    const bf16_t* QN = RG(F, 5); const bf16_t* KN = RG(F, 6); const bf16_t* VN = RG(F, 7); const bf16_t* TB = RG(F, 1); const bf16_t* ATT = RG(F, 2);
    const float* GC = (const float*)(F.ws + WS_GC); const float* BETA = (const float*)(F.ws + WS_BETA);
    LAS unsigned char* L = F.lds; const int w = F.wave;
    const unsigned lbase = (unsigned)(uintptr_t)F.ldsg;
    for (int ch = F.bid; ch < 64; ch += F.G) {
        const int b = ch >> 4, h = (ch >> 1) & 7, dir = ch & 1;
        bf16_t* OB = RG(F, dir ? 3 : 0);
        const float* gcp = GC + (size_t)(dir * 8 + h) * TT; const float* btp = BETA + (size_t)(dir * 8 + h) * TT;
#define S2_CK(step) ((step) < 4 ? 512 + b * 4 + (dir ? 3 - (step) : (step)) : b * 128 + (dir ? 131 - (step) : (step) - 4))
#define S2_FILL(step, buf) do { const int lane_ = F.lane, lw_ = w - 4; const int ck_ = S2_CK(step), t0_ = ck_ * 64; const size_t un_ = ((size_t)ck_ * 8 + h) * 2 + dir; \
        LAS unsigned char* Bf_ = L + (buf) * S2_BUF; \
        _Pragma("unroll") for (int e_ = 0; e_ < 4; ++e_) { const int pc_ = 4 * lw_ + e_; const unsigned row_ = 4 * pc_ + (lane_ >> 4), ch_ = (lane_ & 15) ^ (((row_ & 3) << 2) | ((row_ >> 2) & 3)); \
            const size_t go_ = (size_t)(dir ? t0_ + 63 - (int)row_ : t0_ + (int)row_) * D + h * 128 + ch_ * 8; \
            GLDS16(QN + go_, Bf_ + S2_QT + pc_ * 1024); GLDS16(KN + go_, Bf_ + S2_KT + pc_ * 1024); GLDS16(VN + go_, Bf_ + S2_VT + pc_ * 1024); } \
        _Pragma("unroll") for (int e_ = 0; e_ < 2; ++e_) { const int pc_ = 2 * lw_ + e_; const unsigned R_ = 4 * pc_ + (lane_ >> 4), c_ = (lane_ & 15) ^ (((R_ & 3) << 2) | ((R_ >> 2) & 3)); \
            const size_t go_ = un_ * 4096 + (size_t)(32 * (c_ >> 3) + R_) * 64 + (c_ & 7) * 8; \
            GLDS16(TB + go_, Bf_ + S2_TT + pc_ * 1024); GLDS16(ATT + go_, Bf_ + S2_AT + pc_ * 1024); } \
        if (lw_ == 0) { const int tk_ = dir ? t0_ + 63 - lane_ : t0_ + lane_; const float g_ = gcp[tk_], b_ = btp[tk_], l_ = gcp[dir ? t0_ : t0_ + 63]; \
            LAS float* tb_ = (LAS float*)(Bf_ + S2_TAB); tb_[lane_] = expf(g_); tb_[64 + lane_] = expf(l_ - g_); tb_[128 + lane_] = b_; if (lane_ == 0) tb_[192] = expf(l_); } } while (0)
        f32x16 S[4];
#pragma unroll
        for (int kb = 0; kb < 4; ++kb) S[kb] = (f32x16){};
        FRAME_REFRESH(F);
        if (w >= 4) { S2_FILL(0, 0); }
        asm volatile("s_waitcnt vmcnt(0) lgkmcnt(0)" ::: "memory"); __builtin_amdgcn_s_barrier(); asm volatile("" ::: "memory");
#pragma unroll 1
        for (int s2 = 0; s2 < 132; s2 += 2) {
#pragma unroll
            for (int par = 0; par < 2; ++par) {
                const int step = s2 + par;
                FRAME_REFRESH(F);
                if (w >= 4) { if (step + 1 < 132) { S2_FILL(step + 1, par ^ 1); } asm volatile("s_waitcnt vmcnt(0) lgkmcnt(0)" ::: "memory"); }
                else {
                    const int lane = F.lane, r = lane & 31, hh = lane >> 5;
                    LAS unsigned char* Bf = L + par * S2_BUF; const unsigned ab = lbase + par * S2_BUF;
                    const LAS float* tab = (const LAS float*)(Bf + S2_TAB);
                    const int ck = S2_CK(step), t0 = ck * 64;
                    bf16x8 Sb[4][2];
#pragma unroll
                    for (int kb = 0; kb < 4; ++kb) { Sb[kb][0] = pka(S[kb], 0); Sb[kb][1] = pka(S[kb], 8); }
                    f32x16 X[2] = {}, O1[2] = {};
#pragma unroll
                    for (int ks = 0; ks < 8; ++ks)
#pragma unroll
                        for (int bi = 0; bi < 2; ++bi) { const unsigned o = off_b(32 * bi + r, 2 * ks + hh);
                            const bf16x8 kf = *(const LAS bf16x8*)(Bf + S2_KT + o), qf = *(const LAS bf16x8*)(Bf + S2_QT + o);
                            X[bi] = MFMA32(kf, Sb[ks >> 1][ks & 1], X[bi]); O1[bi] = MFMA32(qf, Sb[ks >> 1][ks & 1], O1[bi]); }
                    bf16x8 Rp[2][2];
                    { const int ql = (lane & 15) >> 2, p = lane & 3, rh = (lane >> 4) & 1;
                      s16x4 vv[2][4];
#pragma unroll
                      for (int bi = 0; bi < 2; ++bi)
#pragma unroll
                          for (int q4 = 0; q4 < 4; ++q4) vv[bi][q4] = trr(ab + S2_VT + off_b(32 * bi + 8 * q4 + 4 * hh + ql, 4 * w + 2 * rh + (p >> 1)) + 8 * (p & 1));
                      asm volatile("s_waitcnt lgkmcnt(0)" ::: "memory"); __builtin_amdgcn_sched_barrier(0);
#pragma unroll
                      for (int bi = 0; bi < 2; ++bi) { f32x16 R;
#pragma unroll
                          for (int q4 = 0; q4 < 4; ++q4) { const f32x4 eg = *(const LAS f32x4*)(tab + 32 * bi + 8 * q4 + 4 * hh), bt = *(const LAS f32x4*)(tab + 128 + 32 * bi + 8 * q4 + 4 * hh);
#pragma unroll
                              for (int e = 0; e < 4; ++e) R[4 * q4 + e] = bt[e] * (bf1((bf16_t)vv[bi][q4][e]) - eg[e] * X[bi][4 * q4 + e]); }
                          Rp[bi][0] = pka(R, 0); Rp[bi][1] = pka(R, 8); } }
                    f32x16 Vn[2] = {};
#pragma unroll
                    for (int ks = 0; ks < 4; ++ks) {
                        if (ks < 2) Vn[0] = MFMA32(*(const LAS bf16x8*)(Bf + S2_TT + off_b(r, 2 * ks + hh)), Rp[ks >> 1][ks & 1], Vn[0]);
                        Vn[1] = MFMA32(*(const LAS bf16x8*)(Bf + S2_TT + off_b(r, 8 + 2 * ks + hh)), Rp[ks >> 1][ks & 1], Vn[1]); }
                    { bf16x8 Vp[2][2];
#pragma unroll
                      for (int bi = 0; bi < 2; ++bi) { Vp[bi][0] = pka(Vn[bi], 0); Vp[bi][1] = pka(Vn[bi], 8); }
                      f32x16 O2[2] = {};
#pragma unroll
                      for (int ks = 0; ks < 4; ++ks) {
                          if (ks < 2) O2[0] = MFMA32(*(const LAS bf16x8*)(Bf + S2_AT + off_b(r, 2 * ks + hh)), Vp[ks >> 1][ks & 1], O2[0]);
                          O2[1] = MFMA32(*(const LAS bf16x8*)(Bf + S2_AT + off_b(r, 8 + 2 * ks + hh)), Vp[ks >> 1][ks & 1], O2[1]); }
#pragma unroll
                      for (int bi = 0; bi < 2; ++bi)
#pragma unroll
                          for (int q4 = 0; q4 < 4; ++q4) { const f32x4 eg = *(const LAS f32x4*)(tab + 32 * bi + 8 * q4 + 4 * hh);
#pragma unroll
                              for (int e = 0; e < 4; ++e) { const int i = 32 * bi + 8 * q4 + 4 * hh + e; const int tk = dir ? t0 + 63 - i : t0 + i;
                                  OB[(size_t)tk * D + h * 128 + 32 * w + r] = (bf16_t)(pk2(O2[bi][4 * q4 + e] + eg[e] * O1[bi][4 * q4 + e], 0.f) & 0xffffu); } } }
                    { bf16x8 Vs[2][2];
#pragma unroll
                      for (int bi = 0; bi < 2; ++bi) { f32x16 T2;
#pragma unroll
                          for (int q4 = 0; q4 < 4; ++q4) { const f32x4 ed = *(const LAS f32x4*)(tab + 64 + 32 * bi + 8 * q4 + 4 * hh);
#pragma unroll
                              for (int e = 0; e < 4; ++e) T2[4 * q4 + e] = Vn[bi][4 * q4 + e] * ed[e]; }
                          Vs[bi][0] = pka(T2, 0); Vs[bi][1] = pka(T2, 8); }
                      const float gl = tab[192];
                      const unsigned blk = (lane >> 4) & 1, q = (lane & 15) >> 2, p = lane & 3;
#pragma unroll
                      for (int kb = 0; kb < 4; ++kb) {
                          s16x4 kt[4][2];
#pragma unroll
                          for (int ks = 0; ks < 4; ++ks)
#pragma unroll
                              for (int t = 0; t < 2; ++t) kt[ks][t] = trr(ab + S2_KT + off_b(16 * ks + 8 * hh + 4 * t + q, 4 * kb + 2 * blk + (p >> 1)) + 8 * (p & 1));
                          asm volatile("s_waitcnt lgkmcnt(0)" ::: "memory"); __builtin_amdgcn_sched_barrier(0);
#pragma unroll
                          for (int reg = 0; reg < 16; ++reg) S[kb][reg] *= gl;
#pragma unroll
                          for (int ks = 0; ks < 4; ++ks) { const bf16x8 kf = (bf16x8){kt[ks][0][0], kt[ks][0][1], kt[ks][0][2], kt[ks][0][3], kt[ks][1][0], kt[ks][1][1], kt[ks][1][2], kt[ks][1][3]};
                              S[kb] = MFMA32(kf, Vs[ks >> 1][ks & 1], S[kb]); } } }
                    asm volatile("s_waitcnt lgkmcnt(0)" ::: "memory");
                }
                __builtin_amdgcn_s_barrier(); asm volatile("" ::: "memory");
            }
        }
        asm volatile("s_waitcnt vmcnt(0)" ::: "memory");
#undef S2_CK
#undef S2_FILL
    }
}
__device__ __forceinline__ void delta_out(Frame& F) {
    const Args& A = *F.a; const bf16_t* OF = RG(F, 0); const bf16_t* OBk = RG(F, 3); const bf16_t* Z = RG(F, 4); bf16_t* Y = RG(F, 5);
    for (int t = F.gw; t < TT; t += F.NGW) {
#pragma unroll
        for (int j = 0; j < 2; ++j) { const int col = j * 512 + 8 * F.lane; const size_t off = (size_t)t * D + col;
            const u32x4 a = *(const u32x4*)(OF + off), bq = *(const u32x4*)(OBk + off), z = *(const u32x4*)(Z + off);
            float o[8] = {bflo(a.x) + bflo(bq.x), bfhi(a.x) + bfhi(bq.x), bflo(a.y) + bflo(bq.y), bfhi(a.y) + bfhi(bq.y), bflo(a.z) + bflo(bq.z), bfhi(a.z) + bfhi(bq.z), bflo(a.w) + bflo(bq.w), bfhi(a.w) + bfhi(bq.w)};
            const float zz[8] = {bflo(z.x), bfhi(z.x), bflo(z.y), bfhi(z.y), bflo(z.z), bfhi(z.z), bflo(z.w), bfhi(z.w)};
            float ss = 0.f;
#pragma unroll
            for (int e = 0; e < 8; ++e) ss += o[e] * o[e];
            ss = sum16(ss); const float rs = 1.f / sqrtf(ss * (1.f / 128.f) + EPS);
#pragma unroll
            for (int e = 0; e < 8; ++e) o[e] = o[e] * rs * A.in[I_CNG][(col & 127) + e] * siluf_(zz[e]);
            *(u32x4*)(Y + off) = (u32x4){pk2(o[0], o[1]), pk2(o[2], o[3]), pk2(o[4], o[5]), pk2(o[6], o[7])}; }
    }
}

__global__ void __launch_bounds__(NTHR, 2) hybrid_fwd(Args args) {
    extern __shared__ __attribute__((aligned(16))) unsigned char lds[];
    Frame F;
    F.lds = (LAS unsigned char*)lds; F.ldsg = (char*)lds;
    F.wave = __builtin_amdgcn_readfirstlane((int)threadIdx.x >> 6);
#define REFRESH() FRAME_REFRESH(F)
    REFRESH();
    F.bid = blockIdx.x; F.G = gridDim.x; F.gw = F.bid * NWAVES + F.wave; F.NGW = F.G * NWAVES;
    F.a = &args; F.ws = args.ws; F.out = args.out;
    volatile LAS unsigned* MISC = (volatile LAS unsigned*)(F.lds + MISC_OFF);
    if (F.tid < 4) MISC[F.tid] = 0u;
    __syncthreads();
    const int lo = args.ph_lo, hi = args.ph_hi;
    XcdBarrier bar; bar.bar = (unsigned*)(args.ws + WS_CTL) + CW_BAR; bar.x = 0; bar.st = MISC;
    if (hi - lo > 1) bar = xcd_barrier_post((unsigned*)(args.ws + WS_CTL) + CW_BAR, MISC, F.tid);
    int ph = 0;
#ifndef PHMASK
#define PHMASK 0xFFFFFFFFu
#endif
#ifndef REPMASK
#define REPMASK 0u
#endif
#define PHASE_BEGIN(cls) if (((PHMASK >> (cls)) & 1u) && ph >= lo && ph < hi) { for (int rep_ = 0; rep_ < 1 + (int)((REPMASK >> (cls)) & 1u); ++rep_) { REFRESH();
#define PHASE_END   } if (ph + 1 < hi) { REFRESH(); xcd_barrier(bar, F.tid); } } ++ph;
    const Args& A = args;
    bf16_t* hctx = (bf16_t*)(F.ws + WS_HCTX); bf16_t* hlat = hlat_base(F);

    PHASE_BEGIN(0) p0_prologue(F); PHASE_END
    PHASE_BEGIN(1) p1_init(F); PHASE_END

#define GEMM_DENSE(EPI, Aptr, Bptr, M_, N_, K_) do { pg8::Gemm g_{(Aptr), (Bptr), (M_), (N_), (K_), 0}; pg8::StaticOrder S_; S_.init((M_), (N_), F.G, F.bid); \
        pg8::gemm_phase(F.lds, g_, S_, EPI, F.tid); } while (0)
#define MOE_LAYER(layer, last) do { const int nrows_ = (last) ? TLAT : TT; \
        PHASE_BEGIN(5) moe_route(F, (layer), nrows_, (last)); PHASE_END \
        PHASE_BEGIN(7) if (!(rep_ && (last))) { moe_tables(F, (layer)); pg8::Gemm g_{RG(F, 0), (const bf16_t*)(F.ws + WS_WE1), TT, 1024, D, (size_t)D * D * 2}; \
            pg8::GroupedOrder S_{(const LAS int*)(F.lds + GTAB_OFF), (const LAS int*)(F.lds + GTAB_OFF) + 32, F.G, F.bid}; moe_toktable(F, S_); EpiGateUp E_{rep_ ? RG(F, 6) : (bf16_t*)(F.ws + WS_HID)}; \
            pg8::gemm_phase_gather(F.lds, g_, S_, E_, F.tid, (const LAS int*)(F.lds + GTOK_OFF)); } PHASE_END \
        PHASE_BEGIN(8) if (!(rep_ && (last))) { moe_tables(F, (layer)); pg8::Gemm g_{(const bf16_t*)(F.ws + WS_HID), (const bf16_t*)(F.ws + WS_WE2), XS_ROWS, 1024, DE, (size_t)D * DE * 2}; \
            pg8::GroupedOrder S_{(const LAS int*)(F.lds + GTAB_OFF), (const LAS int*)(F.lds + GTAB_OFF) + 32, F.G, F.bid}; EpiDown E_{rep_ ? RG(F, 6) : (bf16_t*)(F.ws + WS_Y2), (const int*)(F.ws + WS_LIST), (const float*)(F.ws + WS_WLIST)}; pg8::gemm_phase(F.lds, g_, S_, E_, F.tid); } PHASE_END \
        PHASE_BEGIN(9) moe_ln2(F, (layer), nrows_, (last)); PHASE_END } while (0)
#define ATTN_LAYER(layer, j, last) do { \
        PHASE_BEGIN(2) { pg8::Gemm g_{RG(F, 0), (const bf16_t*)(F.ws + WS_WQKV) + (size_t)(j) * 1536 * D, TT, 1536, D, 0}; pg8::StaticOrder S_; S_.init(TT, 1536, F.G, F.bid); \
            EpiQKV E_{RG(F, 1), RG(F, 2), (bf16_t*)((char*)RG(F, 2) + 17 * MiB)}; pg8::gemm_phase(F.lds, g_, S_, E_, F.tid); VM_WAIT(); __syncthreads(); qk_norm_rope(F, (j), S_); } PHASE_END \
        PHASE_BEGIN(3) attn_phase(F, !(last), rep_ ? RG(F, 5) : RG(F, 1)); PHASE_END \
        PHASE_BEGIN(4) { EpiResid E_{rep_ ? RG(F, 6) : hlat, rep_ ? RG(F, 3) : hctx, modrow(F, (layer), 0) + 2048}; GEMM_DENSE(E_, RG(F, 1), (const bf16_t*)(F.ws + WS_WO) + (size_t)(j) * D * D, (last) ? TLAT : TT, D, D); } PHASE_END } while (0)

    ATTN_LAYER(0, 0, false);
    MOE_LAYER(0, false);
    PHASE_BEGIN(10) { EpiGelu E_{RG(F, 1)}; GEMM_DENSE(E_, RG(F, 0), (const bf16_t*)(F.ws + WS_BWIN), TT, 2048, D); } PHASE_END
    PHASE_BEGIN(11) gmlp_spatial(F); PHASE_END
    PHASE_BEGIN(4) { EpiResid E_{rep_ ? RG(F, 6) : hlat, rep_ ? RG(F, 3) : hctx, modrow(F, 1, 0) + 2048}; GEMM_DENSE(E_, RG(F, 0), (const bf16_t*)(F.ws + WS_BWOUT), TT, D, D); } PHASE_END
    MOE_LAYER(1, false);
    PHASE_BEGIN(12) { EpiDeltaIn E_{RG(F, 1), (float*)(F.ws + WS_AB)}; GEMM_DENSE(E_, RG(F, 0), (const bf16_t*)(F.ws + WS_CWIN), TT, CW_NPAD, D); } PHASE_END
    PHASE_BEGIN(13) delta_prep(F); PHASE_END
    PHASE_BEGIN(14) delta_local(F); PHASE_END
    PHASE_BEGIN(15) delta_scan2(F); PHASE_END
    PHASE_BEGIN(16) delta_out(F); PHASE_END
    PHASE_BEGIN(4) { EpiResid E_{rep_ ? RG(F, 6) : hlat, rep_ ? RG(F, 3) : hctx, modrow(F, 2, 0) + 2048}; GEMM_DENSE(E_, RG(F, 5), (const bf16_t*)(F.ws + WS_CWOUT), TT, D, D); } PHASE_END
    MOE_LAYER(2, false);
    ATTN_LAYER(3, 1, true);
    MOE_LAYER(3, true);
    (void)A;
}
constexpr int NPHASES = 2 + (3 + 4) + (3 + 4) + (6 + 4) + (3 + 4);

extern "C" void kernel_launch(void* const* d_in, const int* in_sizes, int n_in, void* d_out, int out_size, void* d_ws, size_t ws_size, hipStream_t stream) {
    static int grid = 0;
    if (grid == 0) {
        if (n_in != 29 || out_size != TLAT * D || ws_size < WS_END) { fprintf(stderr, "kernel_launch: unexpected shapes: n_in %d out %d ws %zu (need %zu)\n", n_in, out_size, ws_size, (size_t)WS_END); grid = -1; return; }
        int dev = 0, cus = 0, per_cu = 0;
        if (hipGetDevice(&dev) != hipSuccess || hipDeviceGetAttribute(&cus, hipDeviceAttributeMultiprocessorCount, dev) != hipSuccess) { grid = -1; return; }
        if (hipFuncSetAttribute((const void*)hybrid_fwd, hipFuncAttributeMaxDynamicSharedMemorySize, LDS_BYTES) != hipSuccess) { fprintf(stderr, "kernel_launch: hipFuncSetAttribute failed\n"); grid = -1; return; }
        if (hipOccupancyMaxActiveBlocksPerMultiprocessor(&per_cu, (const void*)hybrid_fwd, NTHR, LDS_BYTES) != hipSuccess || per_cu < 1) fprintf(stderr, "kernel_launch: occupancy query says %d\n", per_cu);
        (void)hipGetLastError();
        grid = cus < 256 ? cus : 256;
    }
    if (grid < 0) return;
    (void)hipMemsetAsync((char*)d_ws + WS_CTL, 0, CTL_ZERO_BYTES, stream);
    Args a{};
    for (int i = 0; i < 29; ++i) a.in[i] = (const float*)d_in[i];
    a.out = (float*)d_out; a.ws = (unsigned char*)d_ws;
#if MK_ONE_LAUNCH
    a.ph_lo = 0; a.ph_hi = NPHASES;
    hipLaunchKernelGGL(hybrid_fwd, dim3(grid), dim3(NTHR), LDS_BYTES, stream, a);
#else
    for (int p = 0; p < NPHASES; ++p) { a.ph_lo = p; a.ph_hi = p + 1; hipLaunchKernelGGL(hybrid_fwd, dim3(grid), dim3(NTHR), LDS_BYTES, stream, a); }
#endif
    const hipError_t le = hipPeekAtLastError();
    if (le != hipSuccess) fprintf(stderr, "kernel_launch: launch failed: %s\n", hipGetErrorName(le));
}
```

```cpp
#include <hip/hip_runtime.h>
#include <cstdio>
#include <cstdint>

#ifndef PROBE_T
#define PROBE_T 0
#endif
#ifndef PROBE_SITE
#define PROBE_SITE 0
#endif
#ifndef MK_ONE_LAUNCH
#define MK_ONE_LAUNCH 1
#endif

#define GAS __attribute__((address_space(1)))
#define LAS __attribute__((address_space(3)))
typedef unsigned short bf16_t;
typedef short bf16x8 __attribute__((ext_vector_type(8)));
typedef short s16x4 __attribute__((ext_vector_type(4)));
typedef float f32x2 __attribute__((ext_vector_type(2)));
typedef float f32x4 __attribute__((ext_vector_type(4)));
typedef float f32x8 __attribute__((ext_vector_type(8)));
typedef float f32x16 __attribute__((ext_vector_type(16)));
typedef unsigned u32x2 __attribute__((ext_vector_type(2)));
typedef unsigned u32x4 __attribute__((ext_vector_type(4)));
typedef int i32x2 __attribute__((ext_vector_type(2)));
typedef __bf16 bf16x2_t __attribute__((ext_vector_type(2)));

constexpr int D = 1024, NBATCH = 4, SEQ = 8192, CTXL = 256;
constexpr int TLAT = NBATCH * SEQ, TCTX = NBATCH * CTXL, TT = TLAT + TCTX;
constexpr int KVLEN = CTXL + SEQ;
constexpr int NE = 16, DE = 512, NLAYER = 4;
constexpr int CW_N = 4128, CW_NPAD = 4352;
constexpr float DN_ALPHA = 1.6817928305074292f;
constexpr float EPS = 1e-6f;
constexpr int XS_ROWS = 2 * TT + NE * 256;
constexpr int NWAVES = 8, NTHR = 512;

constexpr size_t MiB = 1u << 20;
constexpr size_t WS_CTL = 0, CTL_ZERO_BYTES = 1 * MiB;
constexpr size_t WS_MOD = 1 * MiB;
constexpr size_t WS_ROPE = 2 * MiB;
constexpr size_t WS_HCTX = 6 * MiB;
constexpr size_t WS_ASG = 10 * MiB;
constexpr size_t WS_ASGW = WS_ASG + 512 * 1024;
constexpr size_t WS_POS = WS_ASGW + 512 * 1024;
constexpr size_t WS_ROWMAP = WS_POS + 512 * 1024;
constexpr size_t WS_ROWW = WS_ROWMAP + 512 * 1024;
constexpr size_t WS_WLIST = 10 * MiB;
constexpr size_t WS_LIST = 23 * MiB + 512 * 1024;
constexpr size_t WS_AB = 13 * MiB;
constexpr size_t WS_GC = 18 * MiB;
constexpr size_t WS_BETA = 21 * MiB;
constexpr size_t WS_WQKV = 26 * MiB;
constexpr size_t WS_WO = 32 * MiB;
constexpr size_t WS_BWIN = 36 * MiB;
constexpr size_t WS_BWOUT = 40 * MiB;
constexpr size_t WS_BWS = 42 * MiB;
constexpr size_t WS_CWIN = 43 * MiB;
constexpr size_t WS_CWOUT = 52 * MiB;
constexpr size_t WS_WE1 = 54 * MiB;
constexpr size_t WS_WE2 = 86 * MiB;
constexpr size_t WS_R0 = 102 * MiB, RSZ = 66 * MiB;
constexpr size_t WS_END = WS_R0 + 8 * RSZ;
constexpr size_t WS_XS = WS_R0, WS_HID = WS_R0 + 140 * MiB, WS_Y2 = WS_R0 + 4 * RSZ;
static_assert((size_t)XS_ROWS * 2048 <= 140 * MiB && (size_t)XS_ROWS * 1024 <= 70 * MiB && WS_HID + 70 * MiB <= WS_Y2, "moe overlay");
static_assert((size_t)TT * D * 2 == RSZ, "region size");

constexpr int CW_BAR = 4096;
constexpr int CW_CNT = 16384;

constexpr int LDS_BYTES = 155648;
constexpr int MISC_OFF = LDS_BYTES - 512;
constexpr int GTAB_OFF = 131072;   constexpr int GTOK_OFF = GTAB_OFF + 1024, GTOK_MAXU = 10;
static_assert(GTOK_OFF + GTOK_MAXU * 2048 <= MISC_OFF, "token / destination tables");
constexpr int XX_DUMMY = 0;

#define RLX_AGENT __ATOMIC_RELAXED, __HIP_MEMORY_SCOPE_AGENT
#define LDS_WAIT() asm volatile("s_waitcnt lgkmcnt(0)" ::: "memory")
#define VM_WAIT() asm volatile("s_waitcnt vmcnt(0)" ::: "memory")
__device__ __forceinline__ unsigned pk2(float lo, float hi) { f32x2 v = {lo, hi}; bf16x2_t b = __builtin_convertvector(v, bf16x2_t); return __builtin_bit_cast(unsigned, b); }
__device__ __forceinline__ float bflo(unsigned w) { return __uint_as_float(w << 16); }
__device__ __forceinline__ float bfhi(unsigned w) { return __uint_as_float(w & 0xffff0000u); }
__device__ __forceinline__ float bf1(bf16_t b) { return __uint_as_float((unsigned)b << 16); }
__device__ __forceinline__ float wave_sum(float v) {
#pragma unroll
    for (int o = 1; o < 64; o <<= 1) v += __shfl_xor(v, o);
    return v;
}
__device__ __forceinline__ float sum16(float v) {
#pragma unroll
    for (int o = 1; o < 16; o <<= 1) v += __shfl_xor(v, o);
    return v;
}
__device__ __forceinline__ float sigmoidf_(float x) { return 1.f / (1.f + __expf(-x)); }
__device__ __forceinline__ float siluf_(float x) { return x * __builtin_amdgcn_rcpf(1.f + __builtin_amdgcn_exp2f(-1.4426950408889634f * x)); }
__device__ __forceinline__ int crow(int r, int hi) { return (r & 3) + 8 * (r >> 2) + 4 * hi; }
__device__ __forceinline__ bf16x8 mk8(u32x2 lo, u32x2 hi) { u32x4 w = {lo.x, lo.y, hi.x, hi.y}; return __builtin_bit_cast(bf16x8, w); }
__device__ __forceinline__ bf16x8 mk8w(unsigned a, unsigned b, unsigned c, unsigned d) { u32x4 w = {a, b, c, d}; return __builtin_bit_cast(bf16x8, w); }
#define MFMA32(a, b, c) __builtin_amdgcn_mfma_f32_32x32x16_bf16((a), (b), (c), 0, 0, 0)

#define XB_TMO      128
#define XB_XCNT(j)  (256  + 64 * (j))
#define XB_XSUB(j)  (1280 + 64 * (j))
#define XB_XGEN(j)  (2304 + 64 * (j))
#define XB_TOP      3328
#define XB_TOPGEN   3392
#define XCD_BAR_WORDS 3456
#define XB_SPIN_CAP (1u << 18)

__device__ __forceinline__ unsigned xb_ld(unsigned* p)              { return __hip_atomic_load(p, __ATOMIC_RELAXED, __HIP_MEMORY_SCOPE_AGENT); }
__device__ __forceinline__ unsigned xb_add(unsigned* p, unsigned v) { return __hip_atomic_fetch_add(p, v, __ATOMIC_RELAXED, __HIP_MEMORY_SCOPE_AGENT); }
__device__ __forceinline__ unsigned xb_xcc_id() { return (unsigned)__builtin_amdgcn_s_getreg((3 << 11) | 20) & 0xFu; }
#define XB_SPIN(cond, bar) do { unsigned _sp = 0; while (cond) { __builtin_amdgcn_s_sleep(1); \
    if ((++_sp & 255u) == 0u) { if (xb_ld(&(bar)[XB_TMO])) break; if (_sp > XB_SPIN_CAP) { atomicAdd(&(bar)[XB_TMO], 1u); break; } } } } while (0)

struct XcdBarrier {
    unsigned* bar; unsigned x;
    volatile LAS unsigned* st;
};
__device__ __forceinline__ XcdBarrier xcd_barrier_post(unsigned* bar, volatile LAS unsigned* st, int tid) {
    XcdBarrier b; b.bar = bar; b.x = xb_xcc_id(); b.st = st;
    if (tid == 0) (void)xb_add(&bar[XB_XCNT(b.x)], 1u);
    return b;
}
__device__ __forceinline__ void xcd_barrier_complete(unsigned* bar, unsigned x, unsigned& nloc, unsigned& nx) {
    const unsigned G = gridDim.x * gridDim.y * gridDim.z;
    unsigned sum, cnt, mine, sp = 0u;
    for (;;) {
        sum = 0u; cnt = 0u; mine = 0u;
#pragma unroll
        for (unsigned j = 0; j < 16; ++j) { const unsigned c = xb_ld(&bar[XB_XCNT(j)]); sum += c; cnt += (c > 0u) ? 1u : 0u; mine = (j == x) ? c : mine; }
        if (sum == G) break;
        __builtin_amdgcn_s_sleep(1);
        if ((++sp & 255u) == 0u) { if (xb_ld(&bar[XB_TMO])) break; if (sp > XB_SPIN_CAP) { atomicAdd(&bar[XB_TMO], 1u); break; } }
    }
    nloc = mine > 0u ? mine : 1u; nx = cnt > 0u ? cnt : 1u;
}
__device__ __forceinline__ void xcd_barrier(const XcdBarrier& b, int tid) {
    asm volatile("s_waitcnt vmcnt(0)" ::: "memory");
    __syncthreads();
    if (tid == 0) {
        unsigned* bar = b.bar;
        __builtin_amdgcn_s_waitcnt(0);
        unsigned nloc = b.st[0], nx = b.st[1];
        if (nloc == 0u) { xcd_barrier_complete(bar, b.x, nloc, nx); b.st[0] = nloc; b.st[1] = nx; }
        const unsigned old = xb_add(&bar[XB_XSUB(b.x)], 1u);
        const unsigned gen = old / nloc;
        if (old + 1u == (gen + 1u) * nloc) {
            __builtin_amdgcn_fence(__ATOMIC_RELEASE, "agent");
            asm volatile("s_waitcnt vmcnt(0)" ::: "memory");
            const unsigned og = xb_add(&bar[XB_TOP], 1u);
            const unsigned tg = og / nx;
            if (og + 1u == (tg + 1u) * nx) xb_add(&bar[XB_TOPGEN], 1u);
            else XB_SPIN(xb_ld(&bar[XB_TOPGEN]) == tg, bar);
            __builtin_amdgcn_fence(__ATOMIC_ACQUIRE, "agent");
            xb_add(&bar[XB_XGEN(b.x)], 1u);
            asm volatile("s_waitcnt vmcnt(0)" ::: "memory");
        } else {
            XB_SPIN(xb_ld(&bar[XB_XGEN(b.x)]) == gen, bar);
            __builtin_amdgcn_fence(__ATOMIC_ACQUIRE, "agent");
            asm volatile("s_waitcnt vmcnt(0)" ::: "memory");
        }
    }
    __syncthreads();
}

namespace pg8 {
constexpr int BM = 256, BK = 64, HALF = 128, HTB = HALF * BK * 2, STAGE_BYTES = 8 * HTB, NXCD = 8, WGM = 8;
__host__ __device__ __forceinline__ int lds_byte(int r, int c) { const int st = (r >> 4) * 2 + (c >> 5), rr = r & 15, cc = c & 31, ob = rr * 64 + cc * 2; return st * 1024 + (ob ^ (((ob >> 9) & 1) << 5)); }
__host__ __device__ __forceinline__ void stage_rc(int b, int& R, int& C) { const int st = b / 1024, sb = b % 1024, swz = sb ^ (((sb >> 9) & 1) << 5); R = (st >> 1) * 16 + swz / 64; C = (st & 1) * 32 + (swz % 64) / 2; }
__host__ __device__ __forceinline__ int perm32(int rho) { const int n = rho >> 4, i = rho & 15; return 8 * (i >> 2) + 4 * n + (i & 3); }

struct Unit { int pm, pn, e, nvalid, lbase, ord; };
struct Gemm { const bf16_t* A; const bf16_t* Bt; int M, N, K; size_t bstride; unsigned long long* dbg; };

struct StaticOrder {
    int nM, nN, nwg, G, c;
    __device__ void init(int M, int N, int G_, int c_) { nM = M / BM; nN = N / BM; nwg = nM * nN; G = G_; c = c_; }
    __device__ bool next(int i, Unit& u) const {
        const long L = (long)i * G + c; if (L >= nwg) return false;
        int wgid = (int)L; { const int q = nwg / NXCD, r = nwg % NXCD, xcd = wgid % NXCD, off = wgid / NXCD; wgid = (xcd < r ? xcd * (q + 1) : r * (q + 1) + (xcd - r) * q) + off; }
        const int nig = WGM * nN, gid = wgid / nig, fm = gid * WGM, gsz = (nM - fm) < WGM ? (nM - fm) : WGM;
        u.pm = fm + ((wgid % nig) % gsz); u.pn = (wgid % nig) / gsz; u.e = 0; u.nvalid = 256; u.lbase = 0; u.ord = i; return true;
    }
};
struct GroupedOrder {
    const LAS int* TS; const LAS int* CNT; int G, c;
    __device__ bool next(int i, Unit& u) const {
        int rt, pnn;
        if ((G & 7) == 0) { const int x = c & 7, q = i * (G >> 3) + (c >> 3); rt = (q >> 2) * 8 + x; pnn = q & 3; }
        else { const int L = i * G + c; rt = L >> 2; pnn = L & 3; }
        if (rt >= TS[NE]) return false;
        const int L = pnn; int e = 0;
#pragma unroll 1
        while (rt >= TS[e + 1]) ++e;
        u.pm = rt; u.pn = L & 3; u.e = e; const int tin = rt - TS[e]; u.nvalid = CNT[e] - tin * 256; u.lbase = e * TT + tin * 256; u.ord = i; return true;
    }
};

template <class Epi, class Sched>
__device__ __forceinline__ void gemm_phase(LAS unsigned char* lds, const Gemm g, const Sched& S, const Epi& E, const int tid) {
    const int wid = __builtin_amdgcn_readfirstlane(tid >> 6), lane = tid & 63, wr = wid >> 2, wc = wid & 3, fr = lane & 15, fq = lane >> 4;
    const int K = g.K, nt = K / BK;
    unsigned voffA[2], voffB[2];
#pragma unroll
    for (int i = 0; i < 2; ++i) { int R, C; stage_rc(tid * 16 + i * 8192, R, C); const int Rb = Epi::PERM ? ((R & ~31) + perm32(R & 31)) : R;
        voffA[i] = (unsigned)(R * K + C) * 2u; voffB[i] = (unsigned)(Rb * K + C) * 2u; }
    const size_t kstep = (size_t)(BK * 2);
    const size_t hstep = (size_t)HALF * K * 2;
    const size_t tstep = 2 * hstep;
    const unsigned ldsw = (unsigned)wid * 1024u;
    const int aoff = lds_byte(wr * 64 + fr, fq * 8), boff = lds_byte(wc * 32 + fr, fq * 8);
#define PG8_SA(b, h) (((b) * 2 + (h)) * HTB)
#define PG8_SB(b, h) ((4 + (b) * 2 + (h)) * HTB)
#define PG8_STAGE(bufoff, gbase, voff) do { _Pragma("unroll") for (int _i = 0; _i < 2; ++_i) \
        __builtin_amdgcn_global_load_lds((const unsigned*)((const char*)(gbase) + (voff)[_i]), (LAS unsigned*)(lds + (bufoff) + ldsw + _i * 8192), 16, 0, 0); } while (0)
#define PG8_LDA(dst, b, h) do { _Pragma("unroll") for (int m = 0; m < 4; ++m) _Pragma("unroll") for (int k = 0; k < 2; ++k) dst[m][k] = *(const LAS bf16x8*)(lds + PG8_SA(b, h) + aoff + m * 2048 + k * 1024); } while (0)
#define PG8_LDB(dst, b, h) do { _Pragma("unroll") for (int n = 0; n < 2; ++n) _Pragma("unroll") for (int k = 0; k < 2; ++k) dst[n][k] = *(const LAS bf16x8*)(lds + PG8_SB(b, h) + boff + n * 2048 + k * 1024); } while (0)
#define PG8_MMA(ai, bj, At, Bt) do { __builtin_amdgcn_s_setprio(1); _Pragma("unroll") for (int m = 0; m < 4; ++m) _Pragma("unroll") for (int n = 0; n < 2; ++n) _Pragma("unroll") for (int k = 0; k < 2; ++k) \
        acc[ai][bj][m][n] = __builtin_amdgcn_mfma_f32_16x16x32_bf16(Bt[n][k], At[m][k], acc[ai][bj][m][n], 0, 0, 0); __builtin_amdgcn_s_setprio(0); } while (0)
#define PG8_WAIT_V(n) asm volatile("s_waitcnt vmcnt(" #n ")" ::: "memory")
#define PG8_WAIT_L(n) asm volatile("s_waitcnt lgkmcnt(" #n ")" ::: "memory")
#define PG8_BAR __builtin_amdgcn_s_barrier()
#define PG8_SCHED __builtin_amdgcn_sched_barrier(0)
    Unit cur, nxt; int ui = 0;
#if PROBE_T
    unsigned long long tk_ = 0, te_ = 0, tt0_ = __builtin_amdgcn_s_memrealtime(), ta_ = 0, tb_ = 0; int nu_ = 0;
#endif
    if (!S.next(0, cur)) return;
    f32x4 acc[2][2][4][2];
#pragma unroll
    for (int a = 0; a < 2; ++a)
#pragma unroll
        for (int b = 0; b < 2; ++b)
#pragma unroll
            for (int m = 0; m < 4; ++m)
#pragma unroll
                for (int n = 0; n < 2; ++n) acc[a][b][m][n] = (f32x4){0.f, 0.f, 0.f, 0.f};
    bf16x8 At[4][2], B0[2][2], B1[2][2];
    const char* cA = (const char*)g.A + (size_t)cur.pm * tstep; const char* cB = (const char*)g.Bt + (size_t)cur.e * g.bstride + (size_t)cur.pn * tstep;
    PG8_STAGE(PG8_SB(0, 0), cB, voffB); PG8_STAGE(PG8_SB(0, 1), cB + hstep, voffB); PG8_STAGE(PG8_SA(0, 0), cA, voffA); PG8_STAGE(PG8_SA(0, 1), cA + hstep, voffA);
    if (wr == 1) PG8_BAR;
    PG8_WAIT_V(2); PG8_BAR;
    PG8_STAGE(PG8_SB(1, 0), cB + kstep, voffB); PG8_STAGE(PG8_SA(1, 0), cA + kstep, voffA); PG8_STAGE(PG8_SB(1, 1), cB + hstep + kstep, voffB);
    PG8_WAIT_V(6); PG8_BAR;
    for (;;) {
        const bool has_next = S.next(ui + 1, nxt);
        const char* nA = has_next ? (const char*)g.A + (size_t)nxt.pm * tstep : cA; const char* nB = has_next ? (const char*)g.Bt + (size_t)nxt.e * g.bstride + (size_t)nxt.pn * tstep : cB;
#if PROBE_T
        ta_ = __builtin_amdgcn_s_memrealtime();
#endif
        for (int t = 0; t < nt; t += 2) {
            const bool last = (t == nt - 2);
            const char* a1 = cA + (size_t)(t + 1) * kstep;
            const char* a2 = last ? nA : cA + (size_t)(t + 2) * kstep; const char* b2 = last ? nB : cB + (size_t)(t + 2) * kstep;
            const char* a3 = a2 + kstep; const char* b3 = b2 + kstep;
            PG8_LDB(B0, 0, 0); PG8_LDB(B1, 0, 1); PG8_SCHED; PG8_LDA(At, 0, 0); PG8_STAGE(PG8_SA(1, 1), a1 + hstep, voffA);
            PG8_WAIT_V(8); PG8_WAIT_L(0); PG8_BAR; PG8_MMA(0, 0, At, B0); PG8_MMA(0, 1, At, B1); PG8_BAR; PG8_SCHED;
            PG8_LDA(At, 0, 1); PG8_STAGE(PG8_SB(0, 0), b2, voffB); PG8_STAGE(PG8_SB(0, 1), b2 + hstep, voffB); PG8_STAGE(PG8_SA(0, 0), a2, voffA);
            PG8_WAIT_V(8); PG8_WAIT_L(0); PG8_BAR; PG8_MMA(1, 0, At, B0); PG8_MMA(1, 1, At, B1); PG8_BAR; PG8_SCHED;
            PG8_LDB(B0, 1, 0); PG8_LDB(B1, 1, 1); PG8_SCHED; PG8_LDA(At, 1, 0); PG8_STAGE(PG8_SA(0, 1), a2 + hstep, voffA);
            PG8_WAIT_V(8); PG8_WAIT_L(0); PG8_BAR; PG8_MMA(0, 0, At, B0); PG8_MMA(0, 1, At, B1); PG8_BAR; PG8_SCHED;
            PG8_LDA(At, 1, 1); PG8_STAGE(PG8_SB(1, 0), b3, voffB); PG8_STAGE(PG8_SB(1, 1), b3 + hstep, voffB); PG8_STAGE(PG8_SA(1, 0), a3, voffA);
            PG8_WAIT_V(8); PG8_WAIT_L(0); PG8_BAR; PG8_MMA(1, 0, At, B0); PG8_MMA(1, 1, At, B1); PG8_BAR; PG8_SCHED;
        }
#if PROBE_T
        tb_ = __builtin_amdgcn_s_memrealtime();
#endif
        if (wr == 0) PG8_BAR;
        E(acc, cur, wr, wc, fr, fq);
#if PROBE_T
        { const unsigned long long tc_ = __builtin_amdgcn_s_memrealtime(); tk_ += tb_ - ta_; te_ += tc_ - tb_; ++nu_; }
#endif
        if (!has_next) break;
#pragma unroll
        for (int a = 0; a < 2; ++a)
#pragma unroll
            for (int b = 0; b < 2; ++b)
#pragma unroll
                for (int m = 0; m < 4; ++m)
#pragma unroll
                    for (int n = 0; n < 2; ++n) acc[a][b][m][n] = (f32x4){0.f, 0.f, 0.f, 0.f};
        cur = nxt; cA = nA; cB = nB; ++ui;
        if (wr == 1) PG8_BAR;
    }
    PG8_WAIT_V(0);
    PG8_BAR;
#if PROBE_T
    if (g.dbg && blockIdx.x == 7 && tid == 0) { g.dbg[0] = tk_; g.dbg[1] = te_; g.dbg[2] = (unsigned long long)nu_; g.dbg[3] = __builtin_amdgcn_s_memrealtime() - tt0_; }
#endif
#undef PG8_SA
#undef PG8_SB
#undef PG8_STAGE
#undef PG8_LDA
#undef PG8_LDB
#undef PG8_MMA
#undef PG8_WAIT_V
#undef PG8_WAIT_L
#undef PG8_BAR
#undef PG8_SCHED
}
template <class Epi, class Sched>
__device__ __forceinline__ void gemm_phase_gather(LAS unsigned char* lds, const Gemm g, const Sched& S, const Epi& E, const int tid, const LAS int* toks) {
    const int wid = __builtin_amdgcn_readfirstlane(tid >> 6), lane = tid & 63, wr = wid >> 2, wc = wid & 3, fr = lane & 15, fq = lane >> 4;
    const int K = g.K, nt = K / BK;
    unsigned voffB[2]; int RA[2]; unsigned CA[2];
#pragma unroll
    for (int i = 0; i < 2; ++i) { int R, C; stage_rc(tid * 16 + i * 8192, R, C); const int Rb = Epi::PERM ? ((R & ~31) + perm32(R & 31)) : R;
        RA[i] = R; CA[i] = (unsigned)C * 2u; voffB[i] = (unsigned)(Rb * K + C) * 2u; }
    unsigned roC[2][2], roN[2][2];
#define PG8_TOKS(ro, ui_) do { _Pragma("unroll") for (int hf_ = 0; hf_ < 2; ++hf_) _Pragma("unroll") for (int i_ = 0; i_ < 2; ++i_) \
        ro[hf_][i_] = (unsigned)toks[(ui_) * 256 + hf_ * 128 + RA[i_]] * (unsigned)(K * 2) + CA[i_]; } while (0)
#define PG8_STAGE_AG(bufoff, ktb, ro) do { _Pragma("unroll") for (int _i = 0; _i < 2; ++_i) \
        __builtin_amdgcn_global_load_lds((const unsigned*)((const char*)g.A + (ktb) + (ro)[_i]), (LAS unsigned*)(lds + (bufoff) + ldsw + _i * 8192), 16, 0, 0); } while (0)
    const size_t kstep = (size_t)(BK * 2);
    const size_t hstep = (size_t)HALF * K * 2;
    const size_t tstep = 2 * hstep;
    const unsigned ldsw = (unsigned)wid * 1024u;
    const int aoff = lds_byte(wr * 64 + fr, fq * 8), boff = lds_byte(wc * 32 + fr, fq * 8);
#define PG8_SA(b, h) (((b) * 2 + (h)) * HTB)
#define PG8_SB(b, h) ((4 + (b) * 2 + (h)) * HTB)
#define PG8_STAGE(bufoff, gbase, voff) do { _Pragma("unroll") for (int _i = 0; _i < 2; ++_i) \
        __builtin_amdgcn_global_load_lds((const unsigned*)((const char*)(gbase) + (voff)[_i]), (LAS unsigned*)(lds + (bufoff) + ldsw + _i * 8192), 16, 0, 0); } while (0)
#define PG8_LDA(dst, b, h) do { _Pragma("unroll") for (int m = 0; m < 4; ++m) _Pragma("unroll") for (int k = 0; k < 2; ++k) dst[m][k] = *(const LAS bf16x8*)(lds + PG8_SA(b, h) + aoff + m * 2048 + k * 1024); } while (0)
#define PG8_LDB(dst, b, h) do { _Pragma("unroll") for (int n = 0; n < 2; ++n) _Pragma("unroll") for (int k = 0; k < 2; ++k) dst[n][k] = *(const LAS bf16x8*)(lds + PG8_SB(b, h) + boff + n * 2048 + k * 1024); } while (0)
#define PG8_MMA(ai, bj, At, Bt) do { __builtin_amdgcn_s_setprio(1); _Pragma("unroll") for (int m = 0; m < 4; ++m) _Pragma("unroll") for (int n = 0; n < 2; ++n) _Pragma("unroll") for (int k = 0; k < 2; ++k) \
        acc[ai][bj][m][n] = __builtin_amdgcn_mfma_f32_16x16x32_bf16(Bt[n][k], At[m][k], acc[ai][bj][m][n], 0, 0, 0); __builtin_amdgcn_s_setprio(0); } while (0)
#define PG8_WAIT_V(n) asm volatile("s_waitcnt vmcnt(" #n ")" ::: "memory")
#define PG8_WAIT_L(n) asm volatile("s_waitcnt lgkmcnt(" #n ")" ::: "memory")
#define PG8_BAR __builtin_amdgcn_s_barrier()
#define PG8_SCHED __builtin_amdgcn_sched_barrier(0)
    Unit cur, nxt; int ui = 0;
#if PROBE_T
    unsigned long long tk_ = 0, te_ = 0, tt0_ = __builtin_amdgcn_s_memrealtime(), ta_ = 0, tb_ = 0; int nu_ = 0;
#endif
    if (!S.next(0, cur)) return;
    f32x4 acc[2][2][4][2];
#pragma unroll
    for (int a = 0; a < 2; ++a)
#pragma unroll
        for (int b = 0; b < 2; ++b)
#pragma unroll
            for (int m = 0; m < 4; ++m)
#pragma unroll
                for (int n = 0; n < 2; ++n) acc[a][b][m][n] = (f32x4){0.f, 0.f, 0.f, 0.f};
    bf16x8 At[4][2], B0[2][2], B1[2][2];
    const char* cB = (const char*)g.Bt + (size_t)cur.e * g.bstride + (size_t)cur.pn * tstep;
    PG8_TOKS(roC, 0);
    PG8_STAGE(PG8_SB(0, 0), cB, voffB); PG8_STAGE(PG8_SB(0, 1), cB + hstep, voffB); PG8_STAGE_AG(PG8_SA(0, 0), 0, roC[0]); PG8_STAGE_AG(PG8_SA(0, 1), 0, roC[1]);
    if (wr == 1) PG8_BAR;
    PG8_WAIT_V(2); PG8_BAR;
    PG8_STAGE(PG8_SB(1, 0), cB + kstep, voffB); PG8_STAGE_AG(PG8_SA(1, 0), kstep, roC[0]); PG8_STAGE(PG8_SB(1, 1), cB + hstep + kstep, voffB);
    PG8_WAIT_V(6); PG8_BAR;
    for (;;) {
        const bool has_next = S.next(ui + 1, nxt);
        const char* nB = has_next ? (const char*)g.Bt + (size_t)nxt.e * g.bstride + (size_t)nxt.pn * tstep : cB;
        if (has_next) { PG8_TOKS(roN, ui + 1); } else {
#pragma unroll
            for (int hf_ = 0; hf_ < 2; ++hf_)
#pragma unroll
                for (int i_ = 0; i_ < 2; ++i_) roN[hf_][i_] = roC[hf_][i_]; }
#if PROBE_T
        ta_ = __builtin_amdgcn_s_memrealtime();
#endif
        for (int t = 0; t < nt; t += 2) {
            const bool last = (t == nt - 2);
            const size_t k1 = (size_t)(t + 1) * kstep, k2 = last ? (size_t)0 : (size_t)(t + 2) * kstep, k3 = k2 + kstep;
            const char* b2 = last ? nB : cB + (size_t)(t + 2) * kstep; const char* b3 = b2 + kstep;
            unsigned r20[2], r21[2];
#pragma unroll
            for (int i_ = 0; i_ < 2; ++i_) { r20[i_] = last ? roN[0][i_] : roC[0][i_]; r21[i_] = last ? roN[1][i_] : roC[1][i_]; }
            PG8_LDB(B0, 0, 0); PG8_LDB(B1, 0, 1); PG8_SCHED; PG8_LDA(At, 0, 0); PG8_STAGE_AG(PG8_SA(1, 1), k1, roC[1]);
            PG8_WAIT_V(8); PG8_WAIT_L(0); PG8_BAR; PG8_MMA(0, 0, At, B0); PG8_MMA(0, 1, At, B1); PG8_BAR; PG8_SCHED;
            PG8_LDA(At, 0, 1); PG8_STAGE(PG8_SB(0, 0), b2, voffB); PG8_STAGE(PG8_SB(0, 1), b2 + hstep, voffB); PG8_STAGE_AG(PG8_SA(0, 0), k2, r20);
            PG8_WAIT_V(8); PG8_WAIT_L(0); PG8_BAR; PG8_MMA(1, 0, At, B0); PG8_MMA(1, 1, At, B1); PG8_BAR; PG8_SCHED;
            PG8_LDB(B0, 1, 0); PG8_LDB(B1, 1, 1); PG8_SCHED; PG8_LDA(At, 1, 0); PG8_STAGE_AG(PG8_SA(0, 1), k2, r21);
            PG8_WAIT_V(8); PG8_WAIT_L(0); PG8_BAR; PG8_MMA(0, 0, At, B0); PG8_MMA(0, 1, At, B1); PG8_BAR; PG8_SCHED;
            PG8_LDA(At, 1, 1); PG8_STAGE(PG8_SB(1, 0), b3, voffB); PG8_STAGE(PG8_SB(1, 1), b3 + hstep, voffB); PG8_STAGE_AG(PG8_SA(1, 0), k3, r20);
            PG8_WAIT_V(8); PG8_WAIT_L(0); PG8_BAR; PG8_MMA(1, 0, At, B0); PG8_MMA(1, 1, At, B1); PG8_BAR; PG8_SCHED;
        }
#if PROBE_T
        tb_ = __builtin_amdgcn_s_memrealtime();
#endif
        if (wr == 0) PG8_BAR;
        E(acc, cur, wr, wc, fr, fq);
#if PROBE_T
        { const unsigned long long tc_ = __builtin_amdgcn_s_memrealtime(); tk_ += tb_ - ta_; te_ += tc_ - tb_; ++nu_; }
#endif
        if (!has_next) break;
#pragma unroll
        for (int a = 0; a < 2; ++a)
#pragma unroll
            for (int b = 0; b < 2; ++b)
#pragma unroll
                for (int m = 0; m < 4; ++m)
#pragma unroll
                    for (int n = 0; n < 2; ++n) acc[a][b][m][n] = (f32x4){0.f, 0.f, 0.f, 0.f};
        cur = nxt; cB = nB; ++ui;
#pragma unroll
        for (int hf_ = 0; hf_ < 2; ++hf_)
#pragma unroll
            for (int i_ = 0; i_ < 2; ++i_) roC[hf_][i_] = roN[hf_][i_];
        if (wr == 1) PG8_BAR;
    }
    PG8_WAIT_V(0);
    PG8_BAR;
#if PROBE_T
    if (g.dbg && blockIdx.x == 7 && tid == 0) { g.dbg[0] = tk_; g.dbg[1] = te_; g.dbg[2] = (unsigned long long)nu_; g.dbg[3] = __builtin_amdgcn_s_memrealtime() - tt0_; }
#endif
#undef PG8_TOKS
#undef PG8_STAGE_AG
#undef PG8_SA
#undef PG8_SB
#undef PG8_STAGE
#undef PG8_LDA
#undef PG8_LDB
#undef PG8_MMA
#undef PG8_WAIT_V
#undef PG8_WAIT_L
#undef PG8_BAR
#undef PG8_SCHED
}
}
using pg8::Unit;

typedef f32x4 AccT[2][2][4][2];

__device__ __forceinline__ u32x4 pack8(const f32x4 a, const f32x4 b) { u32x4 w; w.x = pk2(a[0], a[1]); w.y = pk2(a[2], a[3]); w.z = pk2(b[0], b[1]); w.w = pk2(b[2], b[3]); return w; }
struct EpiResid {
    static constexpr bool PERM = true;
    bf16_t* hlat; bf16_t* hctx; const float* gate;
    __device__ __forceinline__ void operator()(const AccT& acc, const Unit& u, int wr, int wc, int fr, int fq) const {
        const int mi = u.pm < 128 ? (u.pm >> 5) : 4;
        bf16_t* hb = u.pm < 128 ? hlat + (size_t)u.pm * 256 * D : hctx + (size_t)(u.pm - 128) * 256 * D;
        const int col0 = u.pn * 256 + wc * 32 + 8 * fq;
        const float* g = gate + mi * 6144 + col0;
        f32x4 gv[2][2];
#pragma unroll
        for (int bj = 0; bj < 2; ++bj)
#pragma unroll
            for (int n = 0; n < 2; ++n) gv[bj][n] = *(const f32x4*)(g + bj * 128 + n * 4);
#pragma unroll
        for (int ai = 0; ai < 2; ++ai)
#pragma unroll
            for (int m = 0; m < 4; ++m) { bf16_t* rowp = hb + (size_t)(ai * 128 + wr * 64 + m * 16 + fr) * D + col0;
#pragma unroll
                for (int bj = 0; bj < 2; ++bj) { const u32x4 hw = *(const u32x4*)(rowp + bj * 128);
                    const f32x4 h0 = {bflo(hw.x), bfhi(hw.x), bflo(hw.y), bfhi(hw.y)}, h1 = {bflo(hw.z), bfhi(hw.z), bflo(hw.w), bfhi(hw.w)};
                    *(u32x4*)(rowp + bj * 128) = pack8(h0 * DN_ALPHA + gv[bj][0] * acc[ai][bj][m][0], h1 * DN_ALPHA + gv[bj][1] * acc[ai][bj][m][1]); } }
    }
};

struct EpiQKV {
    static constexpr bool PERM = true;
    bf16_t* Q; bf16_t* Kb; bf16_t* Vb;
    __device__ __forceinline__ void operator()(const AccT& acc, const Unit& u, int wr, int wc, int fr, int fq) const {
        const int cw = wc * 32 + 8 * fq;
        bf16_t* base; size_t ld; size_t r0;
        if (u.pn < 4) { base = Q + u.pn * 256; ld = D; r0 = (size_t)u.pm * 256; }
        else { base = (u.pn == 4) ? Kb : Vb; ld = 256; r0 = u.pm < 128 ? (size_t)(u.pm >> 5) * KVLEN + CTXL + (size_t)(u.pm & 31) * 256 : (size_t)(u.pm - 128) * KVLEN; }
#pragma unroll
        for (int ai = 0; ai < 2; ++ai)
#pragma unroll
            for (int m = 0; m < 4; ++m) { bf16_t* rowp = base + (r0 + ai * 128 + wr * 64 + m * 16 + fr) * ld + cw;
#pragma unroll
                for (int bj = 0; bj < 2; ++bj) *(u32x4*)(rowp + bj * 128) = pack8(acc[ai][bj][m][0], acc[ai][bj][m][1]); }
    }
};
__device__ __forceinline__ float gelu_tanh(float x) { const float x2 = x * x; const float e = __builtin_amdgcn_exp2f(x * fmaf(x2, -0.10294324f, -2.30220820f)); return x * __builtin_amdgcn_rcpf(1.f + e); }
struct EpiGelu {
    static constexpr bool PERM = true;
    bf16_t* O; f32x2* SP;
    __device__ __forceinline__ void operator()(const AccT& acc, const Unit& u, int wr, int wc, int fr, int fq) const {
        const int col0 = u.pn * 256 + wc * 32 + 8 * fq;
#pragma unroll
        for (int ai = 0; ai < 2; ++ai)
#pragma unroll
            for (int m = 0; m < 4; ++m) { const int row = u.pm * 256 + ai * 128 + wr * 64 + m * 16 + fr; bf16_t* rowp = O + (size_t)row * 2048 + col0;
                float s1 = 0.f, s2 = 0.f;
#pragma unroll
                for (int bj = 0; bj < 2; ++bj) { f32x4 a = acc[ai][bj][m][0], b = acc[ai][bj][m][1];
#pragma unroll
                    for (int i = 0; i < 4; ++i) { a[i] = gelu_tanh(a[i]); b[i] = gelu_tanh(b[i]); s1 += a[i] + b[i]; s2 += a[i] * a[i] + b[i] * b[i]; }
                    *(u32x4*)(rowp + bj * 128) = pack8(a, b); }
                if (u.pn >= 4) { s1 += __shfl_xor(s1, 16); s1 += __shfl_xor(s1, 32); s2 += __shfl_xor(s2, 16); s2 += __shfl_xor(s2, 32);
                    if (fq == 0) SP[(size_t)row * 16 + (u.pn - 4) * 4 + wc] = (f32x2){s1, s2}; } }
    }
};
struct EpiDeltaIn {
    static constexpr bool PERM = true;
    bf16_t* R1; float* AB;
    __device__ __forceinline__ void operator()(const AccT& acc, const Unit& u, int wr, int wc, int fr, int fq) const {
        if (u.pn < 16) {
            bf16_t* base = R1 + (size_t)(u.pn >> 2) * (RSZ / 2) + (u.pn & 3) * 256 + wc * 32 + 8 * fq;
#pragma unroll
            for (int ai = 0; ai < 2; ++ai)
#pragma unroll
                for (int m = 0; m < 4; ++m) { bf16_t* rowp = base + (size_t)(u.pm * 256 + ai * 128 + wr * 64 + m * 16 + fr) * D;
#pragma unroll
                    for (int bj = 0; bj < 2; ++bj) *(u32x4*)(rowp + bj * 128) = pack8(acc[ai][bj][m][0], acc[ai][bj][m][1]); }
        } else if (wc == 0) {
#pragma unroll
            for (int ai = 0; ai < 2; ++ai)
#pragma unroll
                for (int m = 0; m < 4; ++m) { float* rowp = AB + (size_t)(u.pm * 256 + ai * 128 + wr * 64 + m * 16 + fr) * 32 + 8 * fq;
                    *(f32x4*)(rowp) = acc[ai][0][m][0]; *(f32x4*)(rowp + 4) = acc[ai][0][m][1]; }
        }
    }
};
struct EpiGateUp {
    static constexpr bool PERM = true;
    bf16_t* H;
    __device__ __forceinline__ void operator()(const AccT& acc, const Unit& u, int wr, int wc, int fr, int fq) const {
        const int col0 = u.pn * 128 + wc * 32 + 8 * fq;
#pragma unroll
        for (int ai = 0; ai < 2; ++ai)
#pragma unroll
            for (int m = 0; m < 4; ++m) { bf16_t* rowp = H + (size_t)(u.pm * 256 + ai * 128 + wr * 64 + m * 16 + fr) * DE + col0;
                f32x4 a, b;
#pragma unroll
                for (int i = 0; i < 4; ++i) { a[i] = siluf_(acc[ai][0][m][0][i]) * acc[ai][1][m][0][i]; b[i] = siluf_(acc[ai][0][m][1][i]) * acc[ai][1][m][1][i]; }
                *(u32x4*)(rowp) = pack8(a, b); }
    }
};
struct EpiDown {
    static constexpr bool PERM = true;
    bf16_t* Y2; const LAS int* dstl; const LAS float* wl;
    __device__ __forceinline__ void operator()(const AccT& acc, const Unit& u, int wr, int wc, int fr, int fq) const {
        const int col0 = u.pn * 256 + wc * 32 + 8 * fq;
#pragma unroll
        for (int ai = 0; ai < 2; ++ai)
#pragma unroll
            for (int m = 0; m < 4; ++m) { const int r = ai * 128 + wr * 64 + m * 16 + fr;
                if (r < u.nvalid) { const int dst = dstl[u.ord * 256 + r]; const float w = wl[u.ord * 256 + r]; bf16_t* rowp = Y2 + (size_t)dst * D + col0;
#pragma unroll
                    for (int bj = 0; bj < 2; ++bj) *(u32x4*)(rowp + bj * 128) = pack8(acc[ai][bj][m][0] * w, acc[ai][bj][m][1] * w); } }
    }
};

namespace att {
constexpr int DH = 128, NW = 8, QBLK = 32, KVBLK = 64;
constexpr float SCALE = 0.088388347648318440f;
constexpr float THR = 8.f;
constexpr int LDQ = D, LDK = 256, LDO = D;
constexpr size_t SHM_V = KVBLK * DH * 2, SHM_K = KVBLK * DH * 2, SHM_ATTN = 2 * SHM_V + 2 * SHM_K + NW * 64 * 4;
#define KSWZ(row, colB) ((row) * 256 + ((colB) ^ (((row) & 7) << 4)))
#define SBAR() __builtin_amdgcn_sched_barrier(0)
__device__ __forceinline__ unsigned cvtpk(float lo, float hi) { unsigned r; asm volatile("v_cvt_pk_bf16_f32 %0, %1, %2" : "=v"(r) : "v"(lo), "v"(hi)); return r; }
template <bool FAST> __device__ __forceinline__ void partialSM(f32x16& p0, f32x16& p1, float& m_reg, float& mn, float& alpha) {
  if constexpr (FAST) { for (int r = 0; r < 16; ++r) p0[r] = __builtin_amdgcn_exp2f(p0[r]); alpha = 1.f; mn = 0.f; return; }
  constexpr float C = SCALE * 1.4426950408889634f;
  float pmax = p0[0]; for (int r = 1; r < 16; ++r) pmax = fmaxf(pmax, p0[r]); for (int r = 0; r < 16; ++r) pmax = fmaxf(pmax, p1[r]);
  { auto rr = __builtin_amdgcn_permlane32_swap(__float_as_uint(pmax), __float_as_uint(pmax), false, false);
    pmax = fmaxf(__uint_as_float(rr[0]), __uint_as_float(rr[1])); }
  if (__builtin_expect(__all(pmax - m_reg <= THR / SCALE), 1)) { mn = m_reg; alpha = 1.f; }
  else { mn = fmaxf(m_reg, pmax); alpha = __builtin_amdgcn_exp2f((m_reg - mn) * C); m_reg = mn; }
  float mnC = -mn * C;
  for (int r = 0; r < 16; ++r) p0[r] = fmaf(p0[r], C, mnC); for (int r = 0; r < 16; ++r) p1[r] = fmaf(p1[r], C, mnC);
  for (int r = 0; r < 16; ++r) p0[r] = __builtin_amdgcn_exp2f(p0[r]);
}
__device__ __forceinline__ void finishSM(f32x16& p0, f32x16& p1, float alpha, float& l_reg, bf16x8& pa0, bf16x8& pa1, bf16x8& pa2, bf16x8& pa3) {
  for (int r = 0; r < 16; ++r) p1[r] = __builtin_amdgcn_exp2f(p1[r]);
  float ps = 0; for (int r = 0; r < 16; ++r) ps += p0[r]; for (int r = 0; r < 16; ++r) ps += p1[r];
  { auto rr = __builtin_amdgcn_permlane32_swap(__float_as_uint(ps), __float_as_uint(ps), false, false);
    ps = __uint_as_float(rr[0]) + __uint_as_float(rr[1]); }
  l_reg = l_reg * alpha + ps;
#define PK4(P, BASE, OUT) do { unsigned a0 = cvtpk(P[BASE + 0], P[BASE + 1]), a1 = cvtpk(P[BASE + 2], P[BASE + 3]);   \
    unsigned b0 = cvtpk(P[BASE + 4], P[BASE + 5]), b1 = cvtpk(P[BASE + 6], P[BASE + 7]);                              \
    auto r0 = __builtin_amdgcn_permlane32_swap(a0, b0, false, false); auto r1 = __builtin_amdgcn_permlane32_swap(a1, b1, false, false); \
    u32x4 w = {r0[0], r1[0], r0[1], r1[1]}; OUT = *reinterpret_cast<bf16x8*>(&w); } while (0)
  PK4(p0, 0, pa0); PK4(p0, 8, pa1); PK4(p1, 0, pa2); PK4(p1, 8, pa3);
#undef PK4
}
__device__ __forceinline__ void qkt(f32x16& p0, f32x16& p1, const bf16_t* Ks, const bf16x8* qr, int r32, int hi) {
  p0 = f32x16{}; p1 = f32x16{};
  for (int d0 = 0; d0 < 8; ++d0) { int cb = (d0 * 16 + hi * 8) * 2;
    bf16x8 b0 = *reinterpret_cast<const bf16x8*>((const char*)Ks + KSWZ(r32, cb));
    bf16x8 b1 = *reinterpret_cast<const bf16x8*>((const char*)Ks + KSWZ(32 + r32, cb));
    p0 = __builtin_amdgcn_mfma_f32_32x32x16_bf16(b0, qr[d0], p0, 0, 0, 0);
    p1 = __builtin_amdgcn_mfma_f32_32x32x16_bf16(b1, qr[d0], p1, 0, 0, 0); }
}
__device__ __forceinline__ int v_st(int k, int c) { const int kk = (k & ~0xC) | ((k & 4) << 1) | ((k & 8) >> 1); return ((kk >> 3) * 4 + (c >> 5)) * 512 + ((kk & 7) * 32 + (c & 31)) * 2; }
__device__ __forceinline__ int v_rd_base(int lane) { return ((lane & 3) << 3) | (((lane >> 2) & 3) << 6) | (((lane >> 4) & 1) << 5) | (((lane >> 5) & 1) << 8); }
constexpr int v_rd_off(int d0, int ks, int half) { return d0 * 512 + ks * 4096 + half * 2048; }
template <int OFF> __device__ __forceinline__ s16x4 tr_read(int vb) {
  s16x4 r; asm volatile("ds_read_b64_tr_b16 %0, %1 offset:%2" : "=&v"(r) : "v"(vb), "i"(OFF) : "memory"); return r;
}
template <int D0> __device__ __forceinline__ void pv_one(f32x16& od, int vb, bf16x8 pa0, bf16x8 pa1, bf16x8 pa2, bf16x8 pa3) {
  const s16x4 l0 = tr_read<v_rd_off(D0, 0, 0)>(vb), h0 = tr_read<v_rd_off(D0, 0, 1)>(vb), l1 = tr_read<v_rd_off(D0, 1, 0)>(vb), h1 = tr_read<v_rd_off(D0, 1, 1)>(vb);
  const s16x4 l2 = tr_read<v_rd_off(D0, 2, 0)>(vb), h2 = tr_read<v_rd_off(D0, 2, 1)>(vb), l3 = tr_read<v_rd_off(D0, 3, 0)>(vb), h3 = tr_read<v_rd_off(D0, 3, 1)>(vb);
  asm volatile("s_waitcnt lgkmcnt(0)" ::: "memory"); SBAR();
#define PK(L, H) (bf16x8){L[0], L[1], L[2], L[3], H[0], H[1], H[2], H[3]}
  od = __builtin_amdgcn_mfma_f32_32x32x16_bf16(pa0, PK(l0, h0), od, 0, 0, 0);
  od = __builtin_amdgcn_mfma_f32_32x32x16_bf16(pa1, PK(l1, h1), od, 0, 0, 0);
  od = __builtin_amdgcn_mfma_f32_32x32x16_bf16(pa2, PK(l2, h2), od, 0, 0, 0);
  od = __builtin_amdgcn_mfma_f32_32x32x16_bf16(pa3, PK(l3, h3), od, 0, 0, 0);
#undef PK
}
__device__ __forceinline__ void pv_d0(f32x16* o, int vb, bf16x8 pa0, bf16x8 pa1, bf16x8 pa2, bf16x8 pa3) {
  pv_one<0>(o[0], vb, pa0, pa1, pa2, pa3); pv_one<1>(o[1], vb, pa0, pa1, pa2, pa3); pv_one<2>(o[2], vb, pa0, pa1, pa2, pa3); pv_one<3>(o[3], vb, pa0, pa1, pa2, pa3);
}
template <int D0> __device__ __forceinline__ void pv_two(f32x16& oa, f32x16& ob, int vb, bf16x8 pa0, bf16x8 pa1, bf16x8 pa2, bf16x8 pa3) {
  const s16x4 al0 = tr_read<v_rd_off(D0, 0, 0)>(vb), ah0 = tr_read<v_rd_off(D0, 0, 1)>(vb), bl0 = tr_read<v_rd_off(D0 + 1, 0, 0)>(vb), bh0 = tr_read<v_rd_off(D0 + 1, 0, 1)>(vb);
  const s16x4 al1 = tr_read<v_rd_off(D0, 1, 0)>(vb), ah1 = tr_read<v_rd_off(D0, 1, 1)>(vb), bl1 = tr_read<v_rd_off(D0 + 1, 1, 0)>(vb), bh1 = tr_read<v_rd_off(D0 + 1, 1, 1)>(vb);
  const s16x4 al2 = tr_read<v_rd_off(D0, 2, 0)>(vb), ah2 = tr_read<v_rd_off(D0, 2, 1)>(vb), bl2 = tr_read<v_rd_off(D0 + 1, 2, 0)>(vb), bh2 = tr_read<v_rd_off(D0 + 1, 2, 1)>(vb);
  const s16x4 al3 = tr_read<v_rd_off(D0, 3, 0)>(vb), ah3 = tr_read<v_rd_off(D0, 3, 1)>(vb), bl3 = tr_read<v_rd_off(D0 + 1, 3, 0)>(vb), bh3 = tr_read<v_rd_off(D0 + 1, 3, 1)>(vb);
  asm volatile("s_waitcnt lgkmcnt(0)" ::: "memory"); SBAR();
#define PK(L, H) (bf16x8){L[0], L[1], L[2], L[3], H[0], H[1], H[2], H[3]}
  oa = __builtin_amdgcn_mfma_f32_32x32x16_bf16(pa0, PK(al0, ah0), oa, 0, 0, 0); ob = __builtin_amdgcn_mfma_f32_32x32x16_bf16(pa0, PK(bl0, bh0), ob, 0, 0, 0);
  oa = __builtin_amdgcn_mfma_f32_32x32x16_bf16(pa1, PK(al1, ah1), oa, 0, 0, 0); ob = __builtin_amdgcn_mfma_f32_32x32x16_bf16(pa1, PK(bl1, bh1), ob, 0, 0, 0);
  oa = __builtin_amdgcn_mfma_f32_32x32x16_bf16(pa2, PK(al2, ah2), oa, 0, 0, 0); ob = __builtin_amdgcn_mfma_f32_32x32x16_bf16(pa2, PK(bl2, bh2), ob, 0, 0, 0);
  oa = __builtin_amdgcn_mfma_f32_32x32x16_bf16(pa3, PK(al3, ah3), oa, 0, 0, 0); ob = __builtin_amdgcn_mfma_f32_32x32x16_bf16(pa3, PK(bl3, bh3), ob, 0, 0, 0);
#undef PK
}
__device__ __forceinline__ void pv_d0x2(f32x16* o, int vb, bf16x8 pa0, bf16x8 pa1, bf16x8 pa2, bf16x8 pa3) {
  pv_two<0>(o[0], o[1], vb, pa0, pa1, pa2, pa3); pv_two<2>(o[2], o[3], vb, pa0, pa1, pa2, pa3);
}
template <bool FAST> __device__ __forceinline__ void attn_dense_body(const bf16_t* Qb, const bf16_t* __restrict__ Kh, const bf16_t* __restrict__ Vh, bf16_t* Ob, int seq, char* lds, const int tid) {
  constexpr int SDEPTH = 2;
  const int wid = tid >> 6, lane = tid & 63, r32 = lane & 31, hi = lane >> 5;
  bf16_t* V_lds = (bf16_t*)lds; bf16_t* K_lds = (bf16_t*)(lds + 2 * SHM_V);
  float* ws = (float*)(lds + 2 * SHM_V + 2 * SHM_K) + wid * 64; float* li_l = ws; float* al_l = ws + 32;
  float m_reg = -1e30f, l_reg = 0; f32x16 o[4] = {}; bf16x8 qr[8];
  const bf16_t* Qw = Qb + (long)(wid * QBLK + r32) * LDQ + hi * 8;
#pragma unroll
  for (int d0 = 0; d0 < 8; ++d0) qr[d0] = *reinterpret_cast<const bf16x8*>(Qw + d0 * 16);
  const int sr = tid >> 4, sc = (tid & 15) * 8, vst0 = v_st(sr, sc), vst1 = v_st(32 + sr, sc);
  const int vb0 = (int)(uintptr_t)V_lds + v_rd_base(lane);
  struct { bf16x8 vs0, vs1, ks0, ks1; } sr_[SDEPTH];
#define SLOAD(i, k0) do { sr_[i].vs0 = *reinterpret_cast<const bf16x8*>(&Vh[(long)((k0) + sr) * LDK + sc]); sr_[i].vs1 = *reinterpret_cast<const bf16x8*>(&Vh[(long)((k0) + 32 + sr) * LDK + sc]); \
    sr_[i].ks0 = *reinterpret_cast<const bf16x8*>(&Kh[(long)((k0) + sr) * LDK + sc]); sr_[i].ks1 = *reinterpret_cast<const bf16x8*>(&Kh[(long)((k0) + 32 + sr) * LDK + sc]); } while (0)
#define SWRITE(b, i) do { *(bf16x8*)((char*)V_lds + (b) * SHM_V + vst0) = sr_[i].vs0;          \
    *(bf16x8*)((char*)V_lds + (b) * SHM_V + vst1) = sr_[i].vs1; int kc = sc * 2;               \
    *(bf16x8*)((char*)K_lds + (b) * SHM_K + KSWZ(sr, kc)) = sr_[i].ks0;                       \
    *(bf16x8*)((char*)K_lds + (b) * SHM_K + KSWZ(32 + sr, kc)) = sr_[i].ks1; } while (0)
#define SWAIT() do { asm volatile("s_waitcnt vmcnt(4)" ::: "memory"); } while (0)
#define RESC(a) do { if constexpr (!FAST) if (__any((a) < 1.f)) { if (hi == 0) al_l[r32] = (a); asm volatile("s_waitcnt lgkmcnt(0)" ::: "memory"); \
    for (int d = 0; d < 4; ++d) for (int r = 0; r < 16; ++r) o[d][r] *= al_l[crow(r, hi)]; } } while (0)
  f32x16 pA0, pA1, pB0, pB1; float mnA, mnB, alA, alB; bf16x8 pa0, pa1, pa2, pa3; const int NT = seq / KVBLK;
  constexpr int SE = 0, SO = SDEPTH - 1;
  SLOAD(SE, 0); asm volatile("s_waitcnt vmcnt(0)" ::: "memory"); SWRITE(0, SE); __syncthreads();
  qkt(pA0, pA1, K_lds, qr, r32, hi); partialSM<FAST>(pA0, pA1, m_reg, mnA, alA);
  SLOAD(SO, KVBLK); if (2 < NT) SLOAD(SE, 2 * KVBLK);
  SWAIT(); SWRITE(1, SO); __syncthreads();
  for (int j = 1; j + 1 < NT; j += 2) {
    SBAR(); qkt(pB0, pB1, (bf16_t*)((char*)K_lds + SHM_K), qr, r32, hi);
    finishSM(pA0, pA1, alA, l_reg, pa0, pa1, pa2, pa3); SBAR();
    SLOAD(SO, (j + SDEPTH) * KVBLK); SBAR();
    pv_d0(o, vb0, pa0, pa1, pa2, pa3); partialSM<FAST>(pB0, pB1, m_reg, mnB, alB);
    __syncthreads(); SWAIT(); SWRITE(0, SE);
    RESC(alB); __syncthreads();
    SBAR(); qkt(pA0, pA1, K_lds, qr, r32, hi);
    finishSM(pB0, pB1, alB, l_reg, pa0, pa1, pa2, pa3); SBAR();
    if (j + 3 < NT) SLOAD(SE, (j + 1 + SDEPTH) * KVBLK); SBAR();
    pv_d0(o, vb0 + (int)SHM_V, pa0, pa1, pa2, pa3); partialSM<FAST>(pA0, pA1, m_reg, mnA, alA);
    __syncthreads(); SWAIT(); SWRITE(1, SO);
    RESC(alA); __syncthreads();
  }
  SBAR(); qkt(pB0, pB1, (bf16_t*)((char*)K_lds + SHM_K), qr, r32, hi);
  finishSM(pA0, pA1, alA, l_reg, pa0, pa1, pa2, pa3); SBAR();
  pv_d0(o, vb0, pa0, pa1, pa2, pa3); partialSM<FAST>(pB0, pB1, m_reg, mnB, alB);
  __syncthreads(); RESC(alB);
  finishSM(pB0, pB1, alB, l_reg, pa0, pa1, pa2, pa3); SBAR();
  pv_d0(o, vb0 + (int)SHM_V, pa0, pa1, pa2, pa3);
  if (hi == 0) li_l[r32] = l_reg; asm volatile("s_waitcnt lgkmcnt(0)" ::: "memory");
  float rli[16];
#pragma unroll
  for (int r = 0; r < 16; ++r) rli[r] = __builtin_amdgcn_rcpf(li_l[crow(r, hi)]);
  bf16_t* Ow = Ob + (long)(wid * QBLK) * LDO;
#pragma unroll
  for (int r = 0; r < 16; ++r) { int orow = crow(r, hi);
#pragma unroll
    for (int d0 = 0; d0 < 4; ++d0) Ow[(long)orow * LDO + d0 * 32 + r32] = (bf16_t)(pk2(o[d0][r] * rli[r], 0.f) & 0xffffu); }
  asm volatile("s_waitcnt vmcnt(0) lgkmcnt(0)" ::: "memory"); __syncthreads();
#undef SLOAD
#undef SWRITE
#undef SWAIT
#undef RESC
}
constexpr size_t SHM_ATTN3 = 3 * SHM_V + 3 * SHM_K + NW * 64 * 4;
__device__ __forceinline__ void attn_fast3_body(const bf16_t* Qb, const bf16_t* __restrict__ Kh, const bf16_t* __restrict__ Vh, bf16_t* Ob, int seq, char* lds, const int tid) {
  const int wid = tid >> 6, lane = tid & 63, r32 = lane & 31, hi = lane >> 5;
  char* V_lds = lds; char* K_lds = lds + 3 * SHM_V;
  float l_reg = 0; f32x16 o[4] = {}; bf16x8 qr[8];
  const bf16_t* Qw = Qb + (long)(wid * QBLK + r32) * LDQ + hi * 8;
#pragma unroll
  for (int d0 = 0; d0 < 8; ++d0) qr[d0] = *reinterpret_cast<const bf16x8*>(Qw + d0 * 16);
  const int sr = tid >> 4, sc = (tid & 15) * 8, vst0 = v_st(sr, sc), vst1 = v_st(32 + sr, sc);
  const int vb0 = (int)(uintptr_t)V_lds + v_rd_base(lane);
  struct { bf16x8 vs0, vs1, ks0, ks1; } sr_[1];
#define SLOAD(i, k0) do { sr_[i].vs0 = *reinterpret_cast<const bf16x8*>(&Vh[(long)((k0) + sr) * LDK + sc]); sr_[i].vs1 = *reinterpret_cast<const bf16x8*>(&Vh[(long)((k0) + 32 + sr) * LDK + sc]); \
    sr_[i].ks0 = *reinterpret_cast<const bf16x8*>(&Kh[(long)((k0) + sr) * LDK + sc]); sr_[i].ks1 = *reinterpret_cast<const bf16x8*>(&Kh[(long)((k0) + 32 + sr) * LDK + sc]); } while (0)
#define SWRITE(bo, i) do { *(bf16x8*)(V_lds + (bo) + vst0) = sr_[i].vs0; *(bf16x8*)(V_lds + (bo) + vst1) = sr_[i].vs1; const int kc = sc * 2; \
    *(bf16x8*)(K_lds + (bo) + KSWZ(sr, kc)) = sr_[i].ks0; *(bf16x8*)(K_lds + (bo) + KSWZ(32 + sr, kc)) = sr_[i].ks1; } while (0)
#define SWAIT() do { asm volatile("s_waitcnt vmcnt(4)" ::: "memory"); } while (0)
  f32x16 pA0, pA1, pB0, pB1; bf16x8 pa0, pa1, pa2, pa3; const int NT = seq / KVBLK;
  int bprev = 0, bcur = (int)SHM_K, bnext = 2 * (int)SHM_K;
  SLOAD(0, 0); asm volatile("s_waitcnt vmcnt(0)" ::: "memory"); SWRITE(0, 0);
  SLOAD(0, KVBLK);
  __syncthreads();
  qkt(pA0, pA1, (const bf16_t*)K_lds, qr, r32, hi);
  { float mr = 0.f, mn = 0.f, al = 1.f; partialSM<true>(pA0, pA1, mr, mn, al); }
  SWRITE((int)SHM_K, 0); if (2 < NT) SLOAD(0, 2 * KVBLK);
  __syncthreads();
  for (int j = 1; j + 1 < NT; j += 2) {
    SBAR(); qkt(pB0, pB1, (const bf16_t*)(K_lds + bcur), qr, r32, hi);
    finishSM(pA0, pA1, 1.f, l_reg, pa0, pa1, pa2, pa3); SBAR();
    pv_d0x2(o, vb0 + bprev, pa0, pa1, pa2, pa3);
    { float mr = 0.f, mn = 0.f, al = 1.f; partialSM<true>(pB0, pB1, mr, mn, al); }
    SWRITE(bnext, 0); if (j + 2 < NT) SLOAD(0, (j + 2) * KVBLK);
    __syncthreads();
    { const int t_ = bprev; bprev = bcur; bcur = bnext; bnext = t_; }
    SBAR(); qkt(pA0, pA1, (const bf16_t*)(K_lds + bcur), qr, r32, hi);
    finishSM(pB0, pB1, 1.f, l_reg, pa0, pa1, pa2, pa3); SBAR();
    pv_d0x2(o, vb0 + bprev, pa0, pa1, pa2, pa3);
    { float mr = 0.f, mn = 0.f, al = 1.f; partialSM<true>(pA0, pA1, mr, mn, al); }
    if (j + 2 < NT) { SWRITE(bnext, 0); if (j + 3 < NT) SLOAD(0, (j + 3) * KVBLK); }
    __syncthreads();
    { const int t_ = bprev; bprev = bcur; bcur = bnext; bnext = t_; }
  }
  SBAR(); qkt(pB0, pB1, (const bf16_t*)(K_lds + bcur), qr, r32, hi);
  finishSM(pA0, pA1, 1.f, l_reg, pa0, pa1, pa2, pa3); SBAR();
  pv_d0x2(o, vb0 + bprev, pa0, pa1, pa2, pa3);
  { float mr = 0.f, mn = 0.f, al = 1.f; partialSM<true>(pB0, pB1, mr, mn, al); }
  finishSM(pB0, pB1, 1.f, l_reg, pa0, pa1, pa2, pa3); SBAR();
  pv_d0x2(o, vb0 + bcur, pa0, pa1, pa2, pa3);
  { int l2; asm volatile("v_mbcnt_lo_u32_b32 %0, -1, 0\n\tv_mbcnt_hi_u32_b32 %0, -1, %0" : "=v"(l2));
    const int r2 = l2 & 31, h2 = l2 >> 5; float* li_l = (float*)(lds + 3 * SHM_V + 3 * SHM_K) + wid * 64;
    if (h2 == 0) li_l[r2] = l_reg; asm volatile("s_waitcnt lgkmcnt(0)" ::: "memory");
    bf16_t* Ow = Ob + (long)(wid * QBLK) * LDO;
#pragma unroll
    for (int r = 0; r < 16; ++r) { const int orow = crow(r, h2); const float rl = __builtin_amdgcn_rcpf(li_l[orow]);
#pragma unroll
      for (int d0 = 0; d0 < 4; ++d0) Ow[(long)orow * LDO + d0 * 32 + r2] = (bf16_t)(pk2(o[d0][r] * rl, 0.f) & 0xffffu); } }
  asm volatile("s_waitcnt vmcnt(0) lgkmcnt(0)" ::: "memory"); __syncthreads();
#undef SLOAD
#undef SWRITE
#undef SWAIT
}
#define MFMA16(a, b, c) __builtin_amdgcn_mfma_f32_16x16x32_bf16((a), (b), (c), 0, 0, 0)
template <int OFF> __device__ __forceinline__ bf16x8 ldr_o(int addr) { bf16x8 r; asm volatile("ds_read_b128 %0, %1 offset:%2" : "=&v"(r) : "v"(addr), "i"(OFF) : "memory"); return r; }
template <int OFF> __device__ __forceinline__ s16x4 trr_o(int addr) { s16x4 r; asm volatile("ds_read_b64_tr_b16 %0, %1 offset:%2" : "=&v"(r) : "v"(addr), "i"(OFF) : "memory"); return r; }
__device__ __forceinline__ void attn_fast16_body(const bf16_t* Qb, const bf16_t* __restrict__ Kh, const bf16_t* __restrict__ Vh, bf16_t* Ob, int seq, char* lds, const int tid) {
  const int wid = tid >> 6, lane = tid & 63, n = lane & 15, g = lane >> 4;
  constexpr int VB = 3 * (int)SHM_K;
  f32x4 o[2][8], lacc[2]; bf16x8 qf[2][4];
  lacc[0] = (f32x4){0.f, 0.f, 0.f, 0.f}; lacc[1] = (f32x4){0.f, 0.f, 0.f, 0.f};
  const bf16x8 ones_ = (bf16x8){0x3F80, 0x3F80, 0x3F80, 0x3F80, 0x3F80, 0x3F80, 0x3F80, 0x3F80};
#pragma unroll
  for (int qb = 0; qb < 2; ++qb)
#pragma unroll
    for (int db = 0; db < 8; ++db) o[qb][db] = (f32x4){0.f, 0.f, 0.f, 0.f};
#pragma unroll
  for (int qb = 0; qb < 2; ++qb)
#pragma unroll
    for (int ds = 0; ds < 4; ++ds) qf[qb][ds] = *reinterpret_cast<const bf16x8*>(Qb + (long)(wid * QBLK + 16 * qb + n) * LDQ + 32 * ds + 8 * g);
  const int srow = 4 * wid + g, sxk = n ^ (srow & 15), sxv = (((n >> 1) ^ (srow & 7)) << 1) | (n & 1);
  const unsigned koff = (unsigned)(srow * LDK + sxk * 8) * 2u, voff = (unsigned)(srow * LDK + sxv * 8) * 2u;
  char* const sdst = lds + __builtin_amdgcn_readfirstlane(wid) * 1024;
  int kx[4];
#pragma unroll
  for (int ds = 0; ds < 4; ++ds) kx[ds] = (int)(uintptr_t)lds + n * 256 + (((4 * ds + g) ^ n) << 4);
  int vx[8];
  { const int vq = n >> 2, vp = n & 3, vrx = 4 * (g & 1) + vq;
#pragma unroll
    for (int db = 0; db < 8; ++db) vx[db] = (int)(uintptr_t)lds + VB + (4 * g + vq) * 256 + 8 * vp + ((db ^ vrx) << 5); }
#define ADMA(k0, BO) do { const char* kg_ = (const char*)Kh + (size_t)(k0) * (LDK * 2); const char* vg_ = (const char*)Vh + (size_t)(k0) * (LDK * 2); \
    __builtin_amdgcn_global_load_lds((const unsigned*)(kg_ + koff), (LAS unsigned*)(sdst + (BO)), 16, 0, 0); \
    __builtin_amdgcn_global_load_lds((const unsigned*)(kg_ + koff + 32 * LDK * 2), (LAS unsigned*)(sdst + (BO) + 8192), 16, 0, 0); \
    __builtin_amdgcn_global_load_lds((const unsigned*)(vg_ + voff), (LAS unsigned*)(sdst + VB + (BO)), 16, 0, 0); \
    __builtin_amdgcn_global_load_lds((const unsigned*)(vg_ + voff + 32 * LDK * 2), (LAS unsigned*)(sdst + VB + (BO) + 8192), 16, 0, 0); } while (0)
#define AWAIT() asm volatile("s_waitcnt vmcnt(0)" ::: "memory")
#define LW(n_) asm volatile("s_waitcnt lgkmcnt(" #n_ ")" ::: "memory")
#define EXPK(P, kb) do { _Pragma("unroll") for (int qb = 0; qb < 2; ++qb) _Pragma("unroll") for (int r = 0; r < 4; ++r) P[kb][qb][r] = __builtin_amdgcn_exp2f(P[kb][qb][r]); } while (0)
#define KRD1(BO, t) ldr_o<(BO) + ((t) & 3) * 4096>(kx[(t) >> 2])
#define LWR(n_, R) asm volatile("s_waitcnt lgkmcnt(" #n_ ")" : "+v"(R) :: "memory")
#define LWK(t) do { if ((t) <= 12) LW(3); else if ((t) == 13) LW(2); else if ((t) == 14) LW(1); else LW(0); } while (0)
#define MFZ(D, A, B) asm volatile("v_mfma_f32_16x16x32_bf16 %0, %1, %2, 0" : "=&v"(D) : "v"(A), "v"(B))
#define MFA(D, A, B) asm volatile("v_mfma_f32_16x16x32_bf16 %0, %1, %2, %0" : "+v"(D) : "v"(A), "v"(B))
#define QKMM(P, t) do { if ((t) < 4) { MFZ(P[(t) & 3][0], kw_[(t) & 3], qf[0][(t) >> 2]); MFZ(P[(t) & 3][1], kw_[(t) & 3], qf[1][(t) >> 2]); } \
    else { MFA(P[(t) & 3][0], kw_[(t) & 3], qf[0][(t) >> 2]); MFA(P[(t) & 3][1], kw_[(t) & 3], qf[1][(t) >> 2]); } } while (0)
#define QKSTEP(P, BO, t) do { LWK(t); QKMM(P, t); if ((t) + 4 < 16) kw_[(t) & 3] = KRD1(BO, (t) + 4); } while (0)
#define QK4(P, BO, t0) do { QKSTEP(P, BO, t0); QKSTEP(P, BO, (t0) + 1); QKSTEP(P, BO, (t0) + 2); QKSTEP(P, BO, (t0) + 3); } while (0)
#define QKT16(P, BO) do { bf16x8 kw_[4]; \
    kw_[0] = KRD1(BO, 0); kw_[1] = KRD1(BO, 1); kw_[2] = KRD1(BO, 2); kw_[3] = KRD1(BO, 3); QK4(P, BO, 0); QK4(P, BO, 4); QK4(P, BO, 8); QK4(P, BO, 12); SBAR(); } while (0)
#define QKSTEPV(P, BO, t, W_) do { LW(W_); QKMM(P, t); } while (0)
#define QKT16V(P, BO, PRE) do { bf16x8 kw_[4]; \
    kw_[0] = KRD1(BO, 0); kw_[1] = KRD1(BO, 1); kw_[2] = KRD1(BO, 2); kw_[3] = KRD1(BO, 3); QK4(P, BO, 0); QK4(P, BO, 4); QK4(P, BO, 8); \
    QKSTEP(P, BO, 12); PRE; QKSTEPV(P, BO, 13, 10); QKSTEPV(P, BO, 14, 9); QKSTEPV(P, BO, 15, 8); SBAR(); } while (0)
#define VISS(TA, TB, S_, BO, D0) do { _Pragma("unroll") for (int db = 0; db < 4; ++db) { TA[db] = trr_o<(BO) + (S_) * 8192>(vx[(D0) + db]); TB[db] = trr_o<(BO) + (S_) * 8192 + 4096>(vx[(D0) + db]); } } while (0)
#define VMMA(TA, TB, S_, D0) do { _Pragma("unroll") for (int db = 0; db < 4; ++db) { const bf16x8 vf_ = (bf16x8){TA[db][0], TA[db][1], TA[db][2], TA[db][3], TB[db][0], TB[db][1], TB[db][2], TB[db][3]}; \
      o[0][(D0) + db] = MFMA16(pf[0][S_], vf_, o[0][(D0) + db]); o[1][(D0) + db] = MFMA16(pf[1][S_], vf_, o[1][(D0) + db]); } \
    if ((D0) == 0) { lacc[0] = MFMA16(pf[0][S_], ones_, lacc[0]); lacc[1] = MFMA16(pf[1][S_], ones_, lacc[1]); } } while (0)
#define PACKS(P, s_) do { _Pragma("unroll") for (int qb = 0; qb < 2; ++qb) \
      pf[qb][s_] = mk8w(pk2(P[2 * (s_)][qb][0], P[2 * (s_)][qb][1]), pk2(P[2 * (s_)][qb][2], P[2 * (s_)][qb][3]), pk2(P[2 * (s_) + 1][qb][0], P[2 * (s_) + 1][qb][1]), pk2(P[2 * (s_) + 1][qb][2], P[2 * (s_) + 1][qb][3])); } while (0)
#define LWV(n_, TA, TB) asm volatile("s_waitcnt lgkmcnt(" #n_ ")" : "+v"(TA[0]), "+v"(TA[1]), "+v"(TA[2]), "+v"(TA[3]), "+v"(TB[0]), "+v"(TB[1]), "+v"(TB[2]), "+v"(TB[3]) :: "memory")
#define PVX(BO, X0, X1, X2, X3) do { s16x4 ua_[4], ub_[4], uc_[4], ud_[4]; PVXI(BO); PVXB(BO, X0, X1, X2, X3); } while (0)
#define PVXI(BO) do { VISS(ua_, ub_, 0, BO, 0); } while (0)
#define PVXB(BO, X0, X1, X2, X3) do { \
    VISS(uc_, ud_, 0, BO, 4); LW(8); SBAR(); VMMA(ua_, ub_, 0, 0); X0; SBAR(); \
    VISS(ua_, ub_, 1, BO, 0); LW(8); SBAR(); VMMA(uc_, ud_, 0, 4); X1; SBAR(); \
    VISS(uc_, ud_, 1, BO, 4); LW(8); SBAR(); VMMA(ua_, ub_, 1, 0); X2; SBAR(); \
    LW(0); SBAR(); VMMA(uc_, ud_, 1, 4); X3; SBAR(); } while (0)
#define ITER(jj, SC, SP, SN) do { s16x4 ua_[4], ub_[4], uc_[4], ud_[4]; if ((jj) + 1 < NT) ADMA(((jj) + 1) * KVBLK, SN); \
    SBAR(); QKT16V(pS, SC, PVXI(SP)); \
    PVXB(SP, EXPK(pS, 0), EXPK(pS, 1), do { EXPK(pS, 2); PACKS(pS, 0); } while (0), EXPK(pS, 3)); \
    PACKS(pS, 1); AWAIT(); __syncthreads(); } while (0)
#define TAILPV(SP) do { SBAR(); PVX(SP, (void)0, (void)0, (void)0, (void)0); } while (0)
  f32x4 pS[4][2]; bf16x8 pf[2][2]; const int NT = seq / KVBLK;
  ADMA(0, 0); ADMA(KVBLK, 16384);
  asm volatile("s_waitcnt vmcnt(4)" ::: "memory"); __syncthreads();
  QKT16(pS, 0); asm volatile("s_nop 15" ::: "memory"); SBAR(); EXPK(pS, 0); EXPK(pS, 1); EXPK(pS, 2); EXPK(pS, 3); PACKS(pS, 0); PACKS(pS, 1);
  AWAIT(); __syncthreads();
  int j = 1;
  for (; j + 2 < NT; j += 3) { ITER(j, 16384, 0, 32768); ITER(j + 1, 32768, 16384, 0); ITER(j + 2, 0, 32768, 16384); }
  if (j < NT) { ITER(j, 16384, 0, 32768);
    if (j + 1 < NT) { ITER(j + 1, 32768, 16384, 0); TAILPV(32768); } else TAILPV(16384); }
  else TAILPV(0);
  {
    int l2; asm volatile("v_mbcnt_lo_u32_b32 %0, -1, 0\n\tv_mbcnt_hi_u32_b32 %0, -1, %0" : "=v"(l2));
    const int n2 = l2 & 15, g2 = l2 >> 4;
    bf16_t* Ow = Ob + (long)(wid * QBLK) * LDO + n2;
#pragma unroll
    for (int qb = 0; qb < 2; ++qb)
#pragma unroll
      for (int r = 0; r < 4; ++r) { const int row = 16 * qb + 4 * g2 + r; const float rl = __builtin_amdgcn_rcpf(lacc[qb][r]);
#pragma unroll
        for (int db = 0; db < 8; ++db) Ow[(long)row * LDO + 16 * db] = (bf16_t)(pk2(o[qb][db][r] * rl, 0.f) & 0xffffu); } }
  asm volatile("s_waitcnt vmcnt(0) lgkmcnt(0)" ::: "memory"); __syncthreads();
#undef ADMA
#undef AWAIT
#undef EXPK
#undef KRD1
#undef QKSTEP
#undef QK4
#undef LWK
#undef LWR
#undef LWV
#undef QKT16
#undef VISS
#undef VMMA
#undef PACKS
#undef LW
#undef PVX
#undef PVXI
#undef PVXB
#undef QKSTEPV
#undef MFZ
#undef MFA
#undef QKMM
#undef QKT16V
#undef ITER
#undef TAILPV
}
__device__ __forceinline__ void attn_fast16s_body(const bf16_t* Qb, const bf16_t* __restrict__ Kh, const bf16_t* __restrict__ Vh, bf16_t* Ob, int seq, char* lds, const int tid) {
  const int wid = tid >> 6, lane = tid & 63, n = lane & 15, g = lane >> 4;
  constexpr int VB = 4 * (int)SHM_K;
  f32x4 o[2][8], lacc[2]; bf16x8 qf[2][4];
  lacc[0] = (f32x4){0.f, 0.f, 0.f, 0.f}; lacc[1] = (f32x4){0.f, 0.f, 0.f, 0.f};
  const bf16x8 ones_ = (bf16x8){0x3F80, 0x3F80, 0x3F80, 0x3F80, 0x3F80, 0x3F80, 0x3F80, 0x3F80};
#pragma unroll
  for (int qb = 0; qb < 2; ++qb)
#pragma unroll
    for (int db = 0; db < 8; ++db) o[qb][db] = (f32x4){0.f, 0.f, 0.f, 0.f};
#pragma unroll
  for (int qb = 0; qb < 2; ++qb)
#pragma unroll
    for (int ds = 0; ds < 4; ++ds) qf[qb][ds] = *reinterpret_cast<const bf16x8*>(Qb + (long)(wid * QBLK + 16 * qb + n) * LDQ + 32 * ds + 8 * g);
  const int srow = 4 * wid + g, sxk = n ^ (srow & 15), sxv = (((n >> 1) ^ (srow & 7)) << 1) | (n & 1);
  const unsigned koff = (unsigned)(srow * LDK + sxk * 8) * 2u, voff = (unsigned)(srow * LDK + sxv * 8) * 2u;
  char* const sdst = lds + __builtin_amdgcn_readfirstlane(wid) * 1024;
  int kx[4];
#pragma unroll
  for (int ds = 0; ds < 4; ++ds) kx[ds] = (int)(uintptr_t)lds + n * 256 + (((4 * ds + g) ^ n) << 4);
  int vx[8];
  { const int vq = n >> 2, vp = n & 3, vrx = 4 * (g & 1) + vq;
#pragma unroll
    for (int db = 0; db < 8; ++db) vx[db] = (int)(uintptr_t)lds + VB + (4 * g + vq) * 256 + 8 * vp + ((db ^ vrx) << 5); }
  s16x4 ua_[4], ub_[4], uc_[4], ud_[4]; bf16x8 kw_[4];
  const __amdgpu_buffer_rsrc_t rK = __builtin_amdgcn_make_buffer_rsrc((void*)Kh, 0, 0x7fffffff, 0x00020000), rV = __builtin_amdgcn_make_buffer_rsrc((void*)Vh, 0, 0x7fffffff, 0x00020000);
#define ADMA(k0, BO) do { const int so_ = (k0) * (LDK * 2); \
    __builtin_amdgcn_raw_ptr_buffer_load_lds(rK, (LAS void*)(sdst + (BO)), 16, koff, so_, 0, 0); \
    __builtin_amdgcn_raw_ptr_buffer_load_lds(rK, (LAS void*)(sdst + (BO) + 8192), 16, koff, so_ + 32 * LDK * 2, 0, 0); \
    __builtin_amdgcn_raw_ptr_buffer_load_lds(rV, (LAS void*)(sdst + VB + (BO)), 16, voff, so_, 0, 0); \
    __builtin_amdgcn_raw_ptr_buffer_load_lds(rV, (LAS void*)(sdst + VB + (BO) + 8192), 16, voff, so_ + 32 * LDK * 2, 0, 0); } while (0)
#define AWAIT() asm volatile("s_waitcnt vmcnt(0)" ::: "memory")
  const int wsc = __builtin_amdgcn_readfirstlane(wid);
#define PREF(k0) do { int l_; asm volatile("v_mbcnt_lo_u32_b32 %0, -1, 0\n\tv_mbcnt_hi_u32_b32 %0, -1, %0" : "=v"(l_)); const unsigned pfo = (unsigned)((l_ >> 2) * (LDK * 2) + (l_ & 3) * 64); \
    __builtin_amdgcn_raw_ptr_buffer_load_lds(wsc < 4 ? rK : rV, (LAS void*)(lds + 140 * 1024 + wsc * 256), 4, pfo, ((k0) + 16 * (wsc & 3)) * (LDK * 2), 0, 0); } while (0)
#define XBARP() do { asm volatile("s_waitcnt vmcnt(1)" ::: "memory"); __builtin_amdgcn_s_barrier(); asm volatile("" ::: "memory"); } while (0)
#define LW(n_) asm volatile("s_waitcnt lgkmcnt(" #n_ ")" ::: "memory")
#define EXPK(P, kb) do { _Pragma("unroll") for (int qb = 0; qb < 2; ++qb) _Pragma("unroll") for (int r = 0; r < 4; ++r) P[kb][qb][r] = __builtin_amdgcn_exp2f(P[kb][qb][r]); } while (0)
#define KRD1(BO, t) ldr_o<(BO) + ((t) & 3) * 4096>(kx[(t) >> 2])
#define LWR(n_, R) asm volatile("s_waitcnt lgkmcnt(" #n_ ")" : "+v"(R) :: "memory")
#define LWK(t) do { if ((t) <= 12) LW(3); else if ((t) == 13) LW(2); else if ((t) == 14) LW(1); else LW(0); } while (0)
#define MFZ(D, A, B) asm volatile("v_mfma_f32_16x16x32_bf16 %0, %1, %2, 0" : "=&v"(D) : "v"(A), "v"(B))
#define MFA(D, A, B) asm volatile("v_mfma_f32_16x16x32_bf16 %0, %1, %2, %0" : "+v"(D) : "v"(A), "v"(B))
#define QKMM(P, t) do { if ((t) < 4) { MFZ(P[(t) & 3][0], kw_[(t) & 3], qf[0][(t) >> 2]); MFZ(P[(t) & 3][1], kw_[(t) & 3], qf[1][(t) >> 2]); } \
    else { MFA(P[(t) & 3][0], kw_[(t) & 3], qf[0][(t) >> 2]); MFA(P[(t) & 3][1], kw_[(t) & 3], qf[1][(t) >> 2]); } } while (0)
#define QKSTEP(P, BO, t) do { LWK(t); QKMM(P, t); if ((t) + 4 < 16) kw_[(t) & 3] = KRD1(BO, (t) + 4); } while (0)
#define QK4(P, BO, t0) do { QKSTEP(P, BO, t0); QKSTEP(P, BO, (t0) + 1); QKSTEP(P, BO, (t0) + 2); QKSTEP(P, BO, (t0) + 3); } while (0)
#define QKT16(P, BO) do { \
    kw_[0] = KRD1(BO, 0); kw_[1] = KRD1(BO, 1); kw_[2] = KRD1(BO, 2); kw_[3] = KRD1(BO, 3); QK4(P, BO, 0); QK4(P, BO, 4); QK4(P, BO, 8); QK4(P, BO, 12); SBAR(); } while (0)
#define QKSTEPV(P, BO, t, W_) do { LW(W_); QKMM(P, t); } while (0)
#define QKT16V(P, BO, PRE) do { \
    kw_[0] = KRD1(BO, 0); kw_[1] = KRD1(BO, 1); kw_[2] = KRD1(BO, 2); kw_[3] = KRD1(BO, 3); QK4(P, BO, 0); QK4(P, BO, 4); QK4(P, BO, 8); \
    QKSTEP(P, BO, 12); PRE; QKSTEPV(P, BO, 13, 10); QKSTEPV(P, BO, 14, 9); QKSTEPV(P, BO, 15, 8); SBAR(); } while (0)
#define VISS(TA, TB, S_, BO, D0) do { _Pragma("unroll") for (int db = 0; db < 4; ++db) { TA[db] = trr_o<(BO) + (S_) * 8192>(vx[(D0) + db]); TB[db] = trr_o<(BO) + (S_) * 8192 + 4096>(vx[(D0) + db]); } } while (0)
#define VMMA(TA, TB, S_, D0) do { _Pragma("unroll") for (int db = 0; db < 4; ++db) { const bf16x8 vf_ = (bf16x8){TA[db][0], TA[db][1], TA[db][2], TA[db][3], TB[db][0], TB[db][1], TB[db][2], TB[db][3]}; \
      o[0][(D0) + db] = MFMA16(pf[0][S_], vf_, o[0][(D0) + db]); o[1][(D0) + db] = MFMA16(pf[1][S_], vf_, o[1][(D0) + db]); } \
    if ((D0) == 0) { lacc[0] = MFMA16(pf[0][S_], ones_, lacc[0]); lacc[1] = MFMA16(pf[1][S_], ones_, lacc[1]); } } while (0)
#define PACKS(P, s_) do { _Pragma("unroll") for (int qb = 0; qb < 2; ++qb) \
      pf[qb][s_] = mk8w(pk2(P[2 * (s_)][qb][0], P[2 * (s_)][qb][1]), pk2(P[2 * (s_)][qb][2], P[2 * (s_)][qb][3]), pk2(P[2 * (s_) + 1][qb][0], P[2 * (s_) + 1][qb][1]), pk2(P[2 * (s_) + 1][qb][2], P[2 * (s_) + 1][qb][3])); } while (0)
#define LWV(n_, TA, TB) asm volatile("s_waitcnt lgkmcnt(" #n_ ")" : "+v"(TA[0]), "+v"(TA[1]), "+v"(TA[2]), "+v"(TA[3]), "+v"(TB[0]), "+v"(TB[1]), "+v"(TB[2]), "+v"(TB[3]) :: "memory")
#define PVXI(BO) do { VISS(ua_, ub_, 0, BO, 0); } while (0)
#define PVXB(BO, X0, X1, X2, X3) do { \
    VISS(uc_, ud_, 0, BO, 4); LW(8); SBAR(); VMMA(ua_, ub_, 0, 0); X0; SBAR(); \
    VISS(ua_, ub_, 1, BO, 0); LW(8); SBAR(); VMMA(uc_, ud_, 0, 4); X1; SBAR(); \
    VISS(uc_, ud_, 1, BO, 4); LW(8); SBAR(); VMMA(ua_, ub_, 1, 0); X2; SBAR(); \
    LW(0); SBAR(); VMMA(uc_, ud_, 1, 4); X3; SBAR(); } while (0)
#define PVXK(BO, SK, X0, X1, X2, X3) do { \
    VISS(uc_, ud_, 0, BO, 4); LW(8); SBAR(); VMMA(ua_, ub_, 0, 0); X0; SBAR(); \
    VISS(ua_, ub_, 1, BO, 0); LW(8); SBAR(); VMMA(uc_, ud_, 0, 4); X1; SBAR(); \
    VISS(uc_, ud_, 1, BO, 4); LW(8); SBAR(); VMMA(ua_, ub_, 1, 0); X2; SBAR(); \
    kw_[0] = KRD1(SK, 0); kw_[1] = KRD1(SK, 1); kw_[2] = KRD1(SK, 2); kw_[3] = KRD1(SK, 3); LW(4); SBAR(); VMMA(uc_, ud_, 1, 4); X3; SBAR(); } while (0)
#define QKTU(P, BO, PRE) do { QK4(P, BO, 0); QK4(P, BO, 4); QK4(P, BO, 8); \
    QKSTEP(P, BO, 12); PRE; QKSTEPV(P, BO, 13, 10); QKSTEPV(P, BO, 14, 9); QKSTEPV(P, BO, 15, 8); SBAR(); } while (0)
#define XBAR() do { AWAIT(); __builtin_amdgcn_s_barrier(); asm volatile("" ::: "memory"); } while (0)
#define EXPS4(XS) EXPK(pS, 0), EXPK(pS, 1), do { EXPK(pS, 2); PACKS(pS, 0); } while (0), EXPK(pS, 3)
#define L_INT(jj, SK, SD, S1, PF) do { if ((jj) + 1 < NT) ADMA(((jj) + 1) * KVBLK, SD); if (PF) PREF(((jj) + 2) * KVBLK); SBAR(); \
    kw_[0] = KRD1(SK, 0); kw_[1] = KRD1(SK, 1); kw_[2] = KRD1(SK, 2); kw_[3] = KRD1(SK, 3); QKTU(pS, SK, PVXI(S1)); \
    __builtin_amdgcn_s_setprio(1); PVXB(S1, EXPK(pS, 0), EXPK(pS, 1), do { EXPK(pS, 2); PACKS(pS, 0); } while (0), EXPK(pS, 3)); PACKS(pS, 1); __builtin_amdgcn_s_setprio(0); } while (0)
#define U_INT(jj, SK, SD, S1, S2, PF) do { if ((jj) + 1 < NT) ADMA(((jj) + 1) * KVBLK, SD); if (PF) PREF(((jj) + 2) * KVBLK); SBAR(); \
    __builtin_amdgcn_s_setprio(1); PVXK(S2, SK, EXPK(pS, 0), EXPK(pS, 1), do { EXPK(pS, 2); PACKS(pS, 0); } while (0), EXPK(pS, 3)); PACKS(pS, 1); __builtin_amdgcn_s_setprio(0); \
    QKTU(pS, SK, PVXI(S1)); } while (0)
#define S0_ 0
#define S1_ 16384
#define S2_ 32768
#define S3_ 49152
  f32x4 pS[4][2]; bf16x8 pf[2][2]; const int NT = seq / KVBLK;
  ADMA(0, S0_); ADMA(KVBLK, S1_);
  asm volatile("s_waitcnt vmcnt(4)" ::: "memory"); __builtin_amdgcn_s_barrier(); asm volatile("" ::: "memory");
  if (__builtin_amdgcn_readfirstlane(wid) < 4) {
    QKT16(pS, S0_); asm volatile("s_nop 15" ::: "memory"); SBAR(); EXPK(pS, 0); EXPK(pS, 1); EXPK(pS, 2); EXPK(pS, 3); PACKS(pS, 0); PACKS(pS, 1);
    XBAR();
    L_INT(1, S1_, S2_, S0_, 0); XBAR();
    for (int j = 2; j + 3 < NT; j += 4) { L_INT(j, S2_, S3_, S1_, 0); XBAR(); L_INT(j + 1, S3_, S0_, S2_, 0); XBAR(); L_INT(j + 2, S0_, S1_, S3_, 0); XBAR(); L_INT(j + 3, S1_, S2_, S0_, 0); XBAR(); }
    L_INT(NT - 2, S2_, S3_, S1_, 0); XBAR();
    L_INT(NT - 1, S3_, S0_, S2_, 0);
    SBAR(); PVXI(S3_); PVXB(S3_, (void)0, (void)0, (void)0, (void)0);
  } else {
    QKT16(pS, S0_);
    XBAR();
    ADMA(2 * KVBLK, S2_); asm volatile("s_nop 15" ::: "memory"); SBAR(); EXPK(pS, 0); EXPK(pS, 1); EXPK(pS, 2); EXPK(pS, 3); PACKS(pS, 0); PACKS(pS, 1);
    kw_[0] = KRD1(S1_, 0); kw_[1] = KRD1(S1_, 1); kw_[2] = KRD1(S1_, 2); kw_[3] = KRD1(S1_, 3); QKTU(pS, S1_, PVXI(S0_));
    XBAR();
    for (int j = 2; j + 3 < NT; j += 4) { U_INT(j, S2_, S3_, S1_, S0_, 0); XBAR(); U_INT(j + 1, S3_, S0_, S2_, S1_, 0); XBAR(); U_INT(j + 2, S0_, S1_, S3_, S2_, 0); XBAR(); U_INT(j + 3, S1_, S2_, S0_, S3_, 0); XBAR(); }
    U_INT(NT - 2, S2_, S3_, S1_, S0_, 0); XBAR();
    U_INT(NT - 1, S3_, S0_, S2_, S1_, 0);
    PVXB(S2_, EXPK(pS, 0), EXPK(pS, 1), do { EXPK(pS, 2); PACKS(pS, 0); } while (0), EXPK(pS, 3)); PACKS(pS, 1);
    SBAR(); PVXI(S3_); PVXB(S3_, (void)0, (void)0, (void)0, (void)0);
  }
  {
    int l2; asm volatile("v_mbcnt_lo_u32_b32 %0, -1, 0\n\tv_mbcnt_hi_u32_b32 %0, -1, %0" : "=v"(l2));
    const int n2 = l2 & 15, g2 = l2 >> 4;
    LAS unsigned char* pw = (LAS unsigned char*)(lds + __builtin_amdgcn_readfirstlane(wid) * 4352);
    bf16_t* Og = Ob + (long)(wid * QBLK + g2) * LDO + n2 * 8;
#pragma unroll
    for (int qb = 0; qb < 2; ++qb) {
#pragma unroll
      for (int r = 0; r < 4; ++r) { const float rl = __builtin_amdgcn_rcpf(lacc[qb][r]);
#pragma unroll
        for (int db = 0; db < 8; ++db) *(LAS bf16_t*)(pw + (4 * g2 + r) * 272 + (16 * db + n2) * 2) = (bf16_t)(pk2(o[qb][db][r] * rl, 0.f) & 0xffffu); }
      asm volatile("s_waitcnt lgkmcnt(0)" ::: "memory");
      u32x4 rowv[4];
#pragma unroll
      for (int i = 0; i < 4; ++i) rowv[i] = *(const LAS u32x4*)(pw + (4 * i + g2) * 272 + n2 * 16);
#pragma unroll
      for (int i = 0; i < 4; ++i) *(u32x4*)(Og + (long)(16 * qb + 4 * i) * LDO) = rowv[i];
      asm volatile("s_waitcnt lgkmcnt(0)" ::: "memory"); } }
  asm volatile("s_waitcnt vmcnt(0) lgkmcnt(0)" ::: "memory"); __syncthreads();
#undef ADMA
#undef AWAIT
#undef EXPK
#undef KRD1
#undef QKSTEP
#undef QK4
#undef LWK
#undef LWR
#undef LWV
#undef QKT16
#undef VISS
#undef VMMA
#undef PACKS
#undef LW
#undef PVXK
#undef QKTU
#undef XBAR
#undef XBARP
#undef PREF
#undef EXPS4
#undef L_INT
#undef U_INT
#undef S0_
#undef S1_
#undef S2_
#undef S3_
#undef PVXI
#undef PVXB
#undef QKSTEPV
#undef MFZ
#undef MFA
#undef QKMM
#undef QKT16V
}
}

struct Args {
    const float* in[29]; float* out; unsigned char* ws; int ph_lo, ph_hi;
};
enum { I_X = 0, I_C, I_CTX, I_CCTX, I_WADA, I_BADA, I_LNG, I_LNB, I_AWQKV, I_AQG, I_AKG, I_AWO, I_BWIN, I_BVG, I_BVB, I_BWS, I_BBS, I_BWOUT,
       I_CWIN, I_CCONV, I_CALOG, I_CDTB, I_CNG, I_CWOUT, I_WROUTER, I_RBIAS, I_EGATE, I_EUP, I_EDOWN };

struct Frame {
    LAS unsigned char* lds; char* ldsg;
    int tid, lane, wave, bid, G, gw, NGW;
    const Args* a;
    unsigned char* ws; float* out;
};
#define FRAME_REFRESH(F) do { int l_; asm volatile("v_mbcnt_lo_u32_b32 %0, -1, 0\n\tv_mbcnt_hi_u32_b32 %0, -1, %0" : "=v"(l_)); (F).lane = l_; (F).tid = (F).wave * 64 + l_; } while (0)
__device__ __forceinline__ bf16_t* hlat_base(const Frame& F) { return (bf16_t*)((char*)F.out + 64 * MiB); }
__device__ __forceinline__ bf16_t* hrow(const Frame& F, int t) { return t < TLAT ? hlat_base(F) + (size_t)t * D : (bf16_t*)(F.ws + WS_HCTX) + (size_t)(t - TLAT) * D; }
__device__ __forceinline__ bf16_t* RG(const Frame& F, int i) { return (bf16_t*)(F.ws + WS_R0 + (size_t)i * RSZ); }
__device__ __forceinline__ const float* modrow(const Frame& F, int layer, int mi) { return (const float*)(F.ws + WS_MOD) + (size_t)(layer * 5 + mi) * 6144; }

__device__ __forceinline__ void transpose_item(const float* W, size_t sld, bf16_t* WT, size_t dld, int drow0, int k0, int n0, LAS float* scr, int lane) {
#pragma unroll 8
    for (int i = 0; i < 32; ++i) { const int kk = 2 * i + (lane >> 5); scr[kk * 33 + (lane & 31)] = W[(size_t)(k0 + kk) * sld + n0 + (lane & 31)]; }
    LDS_WAIT(); asm volatile("" ::: "memory");
    const int c = lane & 7;
#pragma unroll
    for (int j = 0; j < 4; ++j) { const int n = (lane >> 3) + 8 * j; const LAS float* s = scr + (8 * c) * 33 + n;
        u32x4 o; o.x = pk2(s[0 * 33], s[1 * 33]); o.y = pk2(s[2 * 33], s[3 * 33]); o.z = pk2(s[4 * 33], s[5 * 33]); o.w = pk2(s[6 * 33], s[7 * 33]);
        *(u32x4*)(WT + (size_t)(drow0 + n) * dld + k0 + 8 * c) = o; }
    LDS_WAIT(); asm volatile("" ::: "memory");
}
__device__ __forceinline__ bool dense_item(int& r, const float* W, int K, int N, bf16_t* WT, LAS float* scr, int lane) {
    const int nblk = N / 32, items = (K / 64) * nblk;
    if (r >= items) { r -= items; return false; }
    const int kb = r / nblk, nb = r % nblk;
    transpose_item(W, (size_t)N, WT, (size_t)K, 32 * nb, 64 * kb, 32 * nb, scr, lane);
    return true;
}
__device__ __forceinline__ void p0_prologue(Frame& F) {
    const Args& A = *F.a;
    LAS float* scr = (LAS float*)(F.lds + F.wave * 16384);
    const int ngv = (F.G >= 256) ? 192 : F.G / 2;
    constexpr int NITEMS = 2 * (16 * 48) + 2 * (16 * 32) + 16 * 64 + 16 * 32 + 16 * 129 + 16 * 32;
    if (F.bid >= ngv)
    for (int it = (F.bid - ngv) * NWAVES + F.wave; it < NITEMS; it += (F.G - ngv) * NWAVES) {
        int r = it;
        if (dense_item(r, A.in[I_AWQKV], D, 1536, (bf16_t*)(F.ws + WS_WQKV), scr, F.lane)) continue;
        if (dense_item(r, A.in[I_AWQKV] + (size_t)D * 1536, D, 1536, (bf16_t*)(F.ws + WS_WQKV) + (size_t)1536 * D, scr, F.lane)) continue;
        if (dense_item(r, A.in[I_AWO], D, D, (bf16_t*)(F.ws + WS_WO), scr, F.lane)) continue;
        if (dense_item(r, A.in[I_AWO] + (size_t)D * D, D, D, (bf16_t*)(F.ws + WS_WO) + (size_t)D * D, scr, F.lane)) continue;
        if (dense_item(r, A.in[I_BWIN], D, 2048, (bf16_t*)(F.ws + WS_BWIN), scr, F.lane)) continue;
        if (dense_item(r, A.in[I_BWOUT], D, D, (bf16_t*)(F.ws + WS_BWOUT), scr, F.lane)) continue;
        if (dense_item(r, A.in[I_CWIN], D, CW_N, (bf16_t*)(F.ws + WS_CWIN), scr, F.lane)) continue;
        dense_item(r, A.in[I_CWOUT], D, D, (bf16_t*)(F.ws + WS_CWOUT), scr, F.lane);
    }
    FRAME_REFRESH(F);
    const int gt = F.bid * NTHR + F.tid, NGT = F.G * NTHR;
    { u32x4* z = (u32x4*)((bf16_t*)(F.ws + WS_CWIN) + (size_t)CW_N * D); const int n16 = (CW_NPAD - CW_N) * D * 2 / 16;
      for (int i = gt; i < n16; i += NGT) z[i] = (u32x4){0u, 0u, 0u, 0u}; }
    { const float* s = A.in[I_BWS]; unsigned* d = (unsigned*)(F.ws + WS_BWS);
      for (int i = gt; i < 8 * 128 * 128 / 2; i += NGT) d[i] = pk2(s[2 * i], s[2 * i + 1]); }
    { f32x2* rt = (f32x2*)(F.ws + WS_ROPE);
      for (int i = gt; i < SEQ * 64; i += NGT) { const int n = i >> 6, p = i & 63; const int pp = p & 31;
        const float inv = 1.0f / powf(10000.0f, (float)(2 * pp) / 64.0f);
        const float pos = (p < 32) ? (float)(n >> 6) : (float)(n & 63);
        const float ang = pos * inv; float sn, cs; sincosf(ang, &sn, &cs); rt[i] = (f32x2){cs, sn}; } }
    __syncthreads();
    FRAME_REFRESH(F);
    if (F.bid < ngv) {
        LAS float* sc = (LAS float*)F.lds;
        LAS f32x4* red = (LAS f32x4*)(F.lds + 32768);
        for (int i = F.tid; i < 5 * D; i += NTHR) { const float v = (i < 4 * D) ? A.in[I_C][i] : A.in[I_CCTX][i - 4 * D]; sc[i] = siluf_(v); }
        __syncthreads();
        for (int item = F.bid; item < 192; item += ngv) {
            const int l = item / 48, cb = item % 48, half = F.lane >> 5, cl = F.lane & 31, col0 = cb * 128 + 4 * cl;
            const float* wp = A.in[I_WADA] + ((size_t)l * D + F.wave * 128 + half) * 6144 + col0;
            f32x4 acc[5];
#pragma unroll
            for (int mi = 0; mi < 5; ++mi) acc[mi] = (f32x4){0.f, 0.f, 0.f, 0.f};
#pragma unroll 8
            for (int k = 0; k < 64; ++k) { const f32x4 w = *(const f32x4*)(wp + (size_t)(2 * k) * 6144);
#pragma unroll
                for (int mi = 0; mi < 5; ++mi) acc[mi] += w * sc[mi * D + F.wave * 128 + 2 * k + half]; }
#pragma unroll
            for (int mi = 0; mi < 5; ++mi) red[((F.wave * 2 + half) * 5 + mi) * 32 + cl] = acc[mi];
            __syncthreads();
            for (int o = F.tid; o < 5 * 128; o += NTHR) { const int mi = o >> 7, c = o & 127; float s = A.in[I_BADA][l * 6144 + cb * 128 + c];
                const LAS float* rf = (const LAS float*)red;
#pragma unroll
                for (int w = 0; w < 16; ++w) s += rf[((w * 5 + mi) * 32 + (c >> 2)) * 4 + (c & 3)];
                ((float*)(F.ws + WS_MOD))[(size_t)(l * 5 + mi) * 6144 + cb * 128 + c] = s; }
            __syncthreads();
        }
    }
}
__device__ __forceinline__ void p1_init(Frame& F) {
    const Args& A = *F.a; bf16_t* U = RG(F, 0);
    const int per = (TT + F.G - 1) / F.G, r0 = F.bid * per, r1 = (r0 + per < TT) ? r0 + per : TT;
    f32x4 scv[4], shv[4], xc[4], xn[4]; int cur_mi = -1;
#pragma unroll
    for (int j = 0; j < 4; ++j) { scv[j] = (f32x4){0.f, 0.f, 0.f, 0.f}; shv[j] = scv[j]; xc[j] = scv[j]; xn[j] = scv[j]; }
#define P1_LOAD(X, t_) do { const float* src_ = (t_) < TLAT ? A.in[I_X] + (size_t)(t_) * D : A.in[I_CTX] + (size_t)((t_) - TLAT) * D; \
        _Pragma("unroll") for (int j = 0; j < 4; ++j) X[j] = *(const f32x4*)(src_ + 256 * j + 4 * F.lane); } while (0)
    if (r0 + F.wave < r1) P1_LOAD(xc, r0 + F.wave);
    for (int t = r0 + F.wave; t < r1; t += NWAVES) {
        FRAME_REFRESH(F);
        if (t + NWAVES < r1) P1_LOAD(xn, t + NWAVES);
        bf16_t* hp = hrow(F, t); const int mi = t < TLAT ? (t >> 13) : 4;
        if (mi != cur_mi) { cur_mi = mi; const float* mp = modrow(F, 0, mi);
#pragma unroll
            for (int j = 0; j < 4; ++j) { shv[j] = *(const f32x4*)(mp + 256 * j + 4 * F.lane); scv[j] = *(const f32x4*)(mp + 1024 + 256 * j + 4 * F.lane) + 1.0f; } }
#pragma unroll
        for (int j = 0; j < 4; ++j) { const int col = 256 * j + 4 * F.lane; const f32x4 v = xc[j];
            *(u32x2*)(hp + col) = (u32x2){pk2(v[0], v[1]), pk2(v[2], v[3])};
            const f32x4 u = v * scv[j] + shv[j];
            *(u32x2*)(U + (size_t)t * D + col) = (u32x2){pk2(u[0], u[1]), pk2(u[2], u[3])}; }
#pragma unroll
        for (int j = 0; j < 4; ++j) xc[j] = xn[j];
    }
#undef P1_LOAD
}

__device__ __forceinline__ void moe_convert(Frame& F, int layer, int first) {
    const Args& A = *F.a;
    if (F.G <= 2 * first) first = 0;
    const int nw = (F.G - first) * NWAVES, gw = (F.bid - first) * NWAVES + F.wave;
    if (F.bid >= first) {
      LAS float* scr = (LAS float*)(F.lds + F.wave * 16384);
      const float* eg = A.in[I_EGATE] + (size_t)layer * NE * D * DE; const float* eu = A.in[I_EUP] + (size_t)layer * NE * D * DE; const float* ed = A.in[I_EDOWN] + (size_t)layer * NE * DE * D;
      bf16_t* W1 = (bf16_t*)(F.ws + WS_WE1); bf16_t* W2 = (bf16_t*)(F.ws + WS_WE2);
      for (int it = gw; it < NE * 768; it += nw) { const int e = it / 768, r = it % 768;
        if (r < 512) { const int up = r >> 8, q = r & 255, kb = q >> 4, nb = q & 15, n0 = 32 * nb;
            transpose_item((up ? eu : eg) + (size_t)e * D * DE, DE, W1 + (size_t)e * D * D, D, (n0 >> 7) * 256 + (n0 & 127) + up * 128, 64 * kb, n0, scr, F.lane); }
        else { const int q = r - 512, kb = q >> 5, nb = q & 31;
            transpose_item(ed + (size_t)e * DE * D, D, W2 + (size_t)e * D * DE, DE, 32 * nb, 64 * kb, 32 * nb, scr, F.lane); } }
    }
}
__device__ __forceinline__ void moe_route(Frame& F, int layer, int nrows, bool last) {
    const Args& A = *F.a;
    LAS float* WR = (LAS float*)F.lds;
    LAS int* CNT = (LAS int*)(F.lds + 65536); LAS int* BASE = CNT + 16; LAS int* EID = CNT + 64; LAS int* RK = EID + 2 * 272; LAS float* WT = (LAS float*)(RK + 2 * 272); LAS float* LG = (LAS float*)(F.lds + 65536 + 8192);
    for (int idx = F.tid; idx < D * NE; idx += NTHR) { const int k = idx >> 4, e = idx & 15, j = k >> 8, ln = (k >> 2) & 63, i = k & 3, q = e >> 2;
        WR[((((j * 4 + i) * 4 + q) * 64 + ln) << 2) + (e & 3)] = A.in[I_WROUTER][idx]; }
    if (F.tid < 16) CNT[F.tid] = 0;
    __syncthreads();
    const int per = (nrows + F.G - 1) / F.G, r0 = F.bid * per, r1 = (r0 + per < nrows) ? r0 + per : nrows;
    const float* lg = A.in[I_LNG] + (size_t)(layer * 2 + 0) * D; const float* lb = A.in[I_LNB] + (size_t)(layer * 2 + 0) * D;
    bf16_t* U2 = RG(F, 0); int* LIST = (int*)(F.ws + WS_LIST); float* WLIST = (float*)(F.ws + WS_WLIST);
    float rb[16];
#pragma unroll
    for (int e = 0; e < 16; ++e) rb[e] = A.in[I_RBIAS][e];
    u32x2 zc[4], zn[4];
    f32x4 lgv[4], lbv[4], scv[4], shv[4]; int cur_mi = -1;
#pragma unroll
    for (int j = 0; j < 4; ++j) { lgv[j] = *(const f32x4*)(lg + 256 * j + 4 * F.lane); lbv[j] = *(const f32x4*)(lb + 256 * j + 4 * F.lane); scv[j] = lgv[j]; shv[j] = lgv[j]; }
    { const int t = r0 + F.wave; if (t < r1) { const bf16_t* zp = hrow(F, t);
#pragma unroll
        for (int j = 0; j < 4; ++j) zc[j] = *(const u32x2*)(zp + 256 * j + 4 * F.lane); } }
    for (int t = r0 + F.wave; t < r1; t += NWAVES) {
        FRAME_REFRESH(F);
        if (t + NWAVES < r1) { const bf16_t* zq = hrow(F, t + NWAVES);
#pragma unroll
            for (int j = 0; j < 4; ++j) zn[j] = *(const u32x2*)(zq + 256 * j + 4 * F.lane); }
        bf16_t* hp = last ? RG(F, 6) + (size_t)t * D : hrow(F, t); const int mi = t < TLAT ? (t >> 13) : 4;
        if (mi != cur_mi) { cur_mi = mi; const float* mp = modrow(F, layer, mi);
#pragma unroll
            for (int j = 0; j < 4; ++j) { scv[j] = *(const f32x4*)(mp + 4096 + 256 * j + 4 * F.lane) + 1.0f; shv[j] = *(const f32x4*)(mp + 3072 + 256 * j + 4 * F.lane); } }
        f32x4 v[4]; float s = 0.f;
#pragma unroll
        for (int j = 0; j < 4; ++j) { const u32x2 zw = zc[j]; v[j] = (f32x4){bflo(zw.x), bfhi(zw.x), bflo(zw.y), bfhi(zw.y)}; s += (v[j][0] + v[j][1]) + (v[j][2] + v[j][3]); }
        const float mean = wave_sum(s) * (1.f / D); float s2 = 0.f;
#pragma unroll
        for (int j = 0; j < 4; ++j) { v[j] = v[j] - mean; s2 += (v[j][0] * v[j][0] + v[j][1] * v[j][1]) + (v[j][2] * v[j][2] + v[j][3] * v[j][3]); }
        const float rstd = 1.f / sqrtf(wave_sum(s2) * (1.f / D) + EPS);
        f32x2 acc2[8];
#pragma unroll
        for (int e = 0; e < 8; ++e) acc2[e] = (f32x2){0.f, 0.f};
#pragma unroll
        for (int j = 0; j < 4; ++j) { const int col = 256 * j + 4 * F.lane;
            const f32x4 hn = v[j] * rstd * lgv[j] + lbv[j];
            *(u32x2*)(hp + col) = (u32x2){pk2(hn[0], hn[1]), pk2(hn[2], hn[3])};
            const f32x4 u2 = hn * scv[j] + shv[j];
            *(u32x2*)(U2 + (size_t)t * D + col) = (u32x2){pk2(u2[0], u2[1]), pk2(u2[2], u2[3])};
#pragma unroll
            for (int i = 0; i < 4; ++i)
#pragma unroll
                for (int q = 0; q < 4; ++q) { const f32x4 w = *(const LAS f32x4*)(WR + ((((j * 4 + i) * 4 + q) * 64 + F.lane) << 2));
                    const f32x2 uu = {u2[i], u2[i]};
                    acc2[2 * q] += uu * (f32x2){w[0], w[1]}; acc2[2 * q + 1] += uu * (f32x2){w[2], w[3]}; } }
        float a8[8], a4[4], a2[2], lg1;
        { const bool hi5 = (F.lane & 32) != 0, hi4 = (F.lane & 16) != 0, hi3 = (F.lane & 8) != 0, hi2 = (F.lane & 4) != 0;
#pragma unroll
          for (int e = 0; e < 8; ++e) { const float lo = acc2[e >> 1][e & 1], hi = acc2[4 + (e >> 1)][e & 1]; a8[e] = (hi5 ? hi : lo) + __shfl_xor(hi5 ? lo : hi, 32); }
#pragma unroll
          for (int e = 0; e < 4; ++e) a4[e] = (hi4 ? a8[e + 4] : a8[e]) + __shfl_xor(hi4 ? a8[e] : a8[e + 4], 16);
#pragma unroll
          for (int e = 0; e < 2; ++e) a2[e] = (hi3 ? a4[e + 2] : a4[e]) + __shfl_xor(hi3 ? a4[e] : a4[e + 2], 8);
          lg1 = (hi2 ? a2[1] : a2[0]) + __shfl_xor(hi2 ? a2[0] : a2[1], 4);
          lg1 += __shfl_xor(lg1, 2); lg1 += __shfl_xor(lg1, 1); }
        if ((F.lane & 3) == 0) LG[(t - r0) * 16 + (F.lane >> 2)] = lg1;
#pragma unroll
        for (int j = 0; j < 4; ++j) zc[j] = zn[j];
    }
    FRAME_REFRESH(F);
    __syncthreads();
    for (int rl = F.tid; rl < r1 - r0; rl += NTHR) {
        float sc[16], sel[16];
#pragma unroll
        for (int q = 0; q < 4; ++q) { const f32x4 l4 = *(const LAS f32x4*)(LG + rl * 16 + 4 * q);
#pragma unroll
            for (int i = 0; i < 4; ++i) { sc[4 * q + i] = 1.f / (1.f + expf(-l4[i])); sel[4 * q + i] = sc[4 * q + i] + rb[4 * q + i]; } }
        float gs[4];
#pragma unroll
        for (int g = 0; g < 4; ++g) { const float a = sel[4 * g], b = sel[4 * g + 1], c = sel[4 * g + 2], d = sel[4 * g + 3];
            const float hi1 = fmaxf(a, b), lo1 = fminf(a, b), hi2 = fmaxf(c, d), lo2 = fminf(c, d);
            const float m1 = fmaxf(hi1, hi2), m2 = fmaxf(fminf(hi1, hi2), fmaxf(lo1, lo2)); gs[g] = m1 + m2; }
        int bg = 0; float bgs = gs[0];
#pragma unroll
        for (int g = 1; g < 4; ++g) if (gs[g] > bgs) { bgs = gs[g]; bg = g; }
        float s4[4], c4[4];
#pragma unroll
        for (int i = 0; i < 4; ++i) { s4[i] = bg == 0 ? sel[i] : bg == 1 ? sel[4 + i] : bg == 2 ? sel[8 + i] : sel[12 + i]; c4[i] = bg == 0 ? sc[i] : bg == 1 ? sc[4 + i] : bg == 2 ? sc[8 + i] : sc[12 + i]; }
        int i1 = 0; float b1 = s4[0], w1 = c4[0];
#pragma unroll
        for (int i = 1; i < 4; ++i) if (s4[i] > b1) { b1 = s4[i]; i1 = i; w1 = c4[i]; }
        int i2 = -1; float b2 = -3.0e38f, w2 = 0.f;
#pragma unroll
        for (int i = 0; i < 4; ++i) if (i != i1 && s4[i] > b2) { b2 = s4[i]; i2 = i; w2 = c4[i]; }
        const int e1 = bg * 4 + i1, e2 = bg * 4 + i2; const float wn = 1.f / (w1 + w2);
        const int k1 = __hip_atomic_fetch_add(CNT + e1, 1, __ATOMIC_RELAXED, __HIP_MEMORY_SCOPE_WORKGROUP);
        const int k2 = __hip_atomic_fetch_add(CNT + e2, 1, __ATOMIC_RELAXED, __HIP_MEMORY_SCOPE_WORKGROUP);
        EID[2 * rl] = e1; EID[2 * rl + 1] = e2; RK[2 * rl] = k1; RK[2 * rl + 1] = k2; WT[2 * rl] = w1 * wn; WT[2 * rl + 1] = w2 * wn;
    }
    __syncthreads();
    if (F.tid < 16) BASE[F.tid] = (int)__hip_atomic_fetch_add((unsigned*)(F.ws + WS_CTL) + CW_CNT + layer * 16 + F.tid, (unsigned)CNT[F.tid], RLX_AGENT);
    __syncthreads();
    for (int rl = F.tid; rl < r1 - r0; rl += NTHR) { const int t = r0 + rl; const int e1 = EID[2 * rl], e2 = EID[2 * rl + 1];
        const int p1 = e1 * TT + BASE[e1] + RK[2 * rl], p2 = e2 * TT + BASE[e2] + RK[2 * rl + 1];
        LIST[p1] = 2 * t; WLIST[p1] = WT[2 * rl]; LIST[p2] = 2 * t + 1; WLIST[p2] = WT[2 * rl + 1]; }
}
__device__ __forceinline__ void moe_tables(Frame& F, int layer) {
    LAS int* TS = (LAS int*)(F.lds + GTAB_OFF); LAS int* CN = TS + 32;
    if (F.tid == 0) { const unsigned* gc = (const unsigned*)(F.ws + WS_CTL) + CW_CNT + layer * 16; int acc = 0;
        for (int e = 0; e < NE; ++e) { const int c = (int)gc[e]; TS[e] = acc; CN[e] = c; acc += (c + 255) >> 8; } TS[NE] = acc; }
    __syncthreads();
}
__device__ __forceinline__ void moe_toktable(Frame& F, const pg8::GroupedOrder& S) {
    const int* LIST = (const int*)(F.ws + WS_LIST); LAS int* TOK = (LAS int*)(F.lds + GTOK_OFF);
    Unit u;
    for (int i = 0; i < GTOK_MAXU && S.next(i, u); ++i)
        if (F.tid < 256) TOK[i * 256 + F.tid] = (F.tid < u.nvalid) ? (LIST[u.lbase + F.tid] >> 1) : 0;
    __syncthreads();
}
__device__ __forceinline__ void moe_dsttable(Frame& F, const pg8::GroupedOrder& S) {
    const int* LIST = (const int*)(F.ws + WS_LIST); const float* WLIST = (const float*)(F.ws + WS_WLIST);
    LAS int* DSTL = (LAS int*)(F.lds + GTOK_OFF); LAS float* WL = (LAS float*)(F.lds + GTOK_OFF + GTOK_MAXU * 1024);
    Unit u;
    for (int i = 0; i < GTOK_MAXU && S.next(i, u); ++i)
        if (F.tid < 256) { const bool ok = F.tid < u.nvalid; DSTL[i * 256 + F.tid] = ok ? LIST[u.lbase + F.tid] : 0; WL[i * 256 + F.tid] = ok ? WLIST[u.lbase + F.tid] : 0.f; }
    __syncthreads();
}
__device__ __forceinline__ void moe_scatter(Frame& F, int layer, int nrows, bool last) {
    moe_tables(F, layer);
    const LAS int* TS = (const LAS int*)(F.lds + GTAB_OFF);
    bf16_t* XS = (bf16_t*)(F.ws + WS_XS); int* rowmap = (int*)(F.ws + WS_ROWMAP); float* roww = (float*)(F.ws + WS_ROWW);
    for (int t = F.gw; t < nrows; t += F.NGW) {
        const bf16_t* hp = last ? RG(F, 6) + (size_t)t * D : hrow(F, t); const int mi = t < TLAT ? (t >> 13) : 4; const float* mp = modrow(F, layer, mi);
        const i32x2 ee = ((const i32x2*)(F.ws + WS_ASG))[t]; const i32x2 pp = ((const i32x2*)(F.ws + WS_POS))[t]; const f32x2 ww = ((const f32x2*)(F.ws + WS_ASGW))[t];
        const int d0 = TS[ee.x] * 256 + pp.x, d1 = TS[ee.y] * 256 + pp.y;
#pragma unroll
        for (int j = 0; j < 4; ++j) { const int col = 256 * j + 4 * F.lane; const u32x2 hw = *(const u32x2*)(hp + col); const f32x4 hn = {bflo(hw.x), bfhi(hw.x), bflo(hw.y), bfhi(hw.y)};
            const f32x4 u = hn * (*(const f32x4*)(mp + 4096 + col) + 1.0f) + *(const f32x4*)(mp + 3072 + col);
            const u32x2 w = {pk2(u[0], u[1]), pk2(u[2], u[3])};
            *(u32x2*)(XS + (size_t)d0 * D + col) = w; *(u32x2*)(XS + (size_t)d1 * D + col) = w; }
        if (F.lane == 0) { rowmap[d0] = 2 * t; rowmap[d1] = 2 * t + 1; roww[d0] = ww.x; roww[d1] = ww.y; }
    }
}
__device__ __forceinline__ void moe_ln2(Frame& F, int layer, int nrows, bool last) {
    const Args& A = *F.a; const bf16_t* Y2 = (const bf16_t*)(F.ws + WS_Y2); bf16_t* U = RG(F, 0);
    const float* lg = A.in[I_LNG] + (size_t)(layer * 2 + 1) * D; const float* lb = A.in[I_LNB] + (size_t)(layer * 2 + 1) * D;
    const int per = (nrows + F.G - 1) / F.G, r0 = F.bid * per, r1 = (r0 + per < nrows) ? r0 + per : nrows;
    f32x4 lgv[4], lbv[4], g2v[4], scv[4], shv[4]; int cur_mi = -1;
#pragma unroll
    for (int j = 0; j < 4; ++j) { lgv[j] = *(const f32x4*)(lg + 256 * j + 4 * F.lane); lbv[j] = *(const f32x4*)(lb + 256 * j + 4 * F.lane); g2v[j] = lgv[j]; scv[j] = lgv[j]; shv[j] = lgv[j]; }
    u32x2 hc[4], ya[4], yb[4], hn_[4], yan[4], ybn[4];
#define LN2_LOAD(H, YA, YB, t_) do { const bf16_t* hin_ = last ? RG(F, 6) + (size_t)(t_) * D : hrow(F, (t_)); \
        _Pragma("unroll") for (int j = 0; j < 4; ++j) { const int col = 256 * j + 4 * F.lane; H[j] = *(const u32x2*)(hin_ + col); \
            YA[j] = *(const u32x2*)(Y2 + (size_t)(2 * (t_)) * D + col); YB[j] = *(const u32x2*)(Y2 + (size_t)(2 * (t_) + 1) * D + col); } } while (0)
    if (r0 + F.wave < r1) LN2_LOAD(hc, ya, yb, r0 + F.wave);
    for (int t = r0 + F.wave; t < r1; t += NWAVES) {
        FRAME_REFRESH(F);
        if (t + NWAVES < r1) LN2_LOAD(hn_, yan, ybn, t + NWAVES);
        bf16_t* hp = hrow(F, t); const int mi = t < TLAT ? (t >> 13) : 4;
        if (mi != cur_mi) { cur_mi = mi; const float* mp = modrow(F, layer, mi); const float* mn = modrow(F, last ? layer : layer + 1, mi);
#pragma unroll
            for (int j = 0; j < 4; ++j) { const int col = 256 * j + 4 * F.lane; g2v[j] = *(const f32x4*)(mp + 5120 + col); scv[j] = *(const f32x4*)(mn + 1024 + col) + 1.0f; shv[j] = *(const f32x4*)(mn + col); } }
        f32x4 v[4]; float s = 0.f;
#pragma unroll
        for (int j = 0; j < 4; ++j) { const f32x4 hv = {bflo(hc[j].x), bfhi(hc[j].x), bflo(hc[j].y), bfhi(hc[j].y)};
            const f32x4 y = {bflo(ya[j].x) + bflo(yb[j].x), bfhi(ya[j].x) + bfhi(yb[j].x), bflo(ya[j].y) + bflo(yb[j].y), bfhi(ya[j].y) + bfhi(yb[j].y)};
            v[j] = hv * DN_ALPHA + g2v[j] * y; s += (v[j][0] + v[j][1]) + (v[j][2] + v[j][3]); }
        const float mean = wave_sum(s) * (1.f / D); float s2 = 0.f;
#pragma unroll
        for (int j = 0; j < 4; ++j) { v[j] = v[j] - mean; s2 += (v[j][0] * v[j][0] + v[j][1] * v[j][1]) + (v[j][2] * v[j][2] + v[j][3] * v[j][3]); }
        const float rstd = 1.f / sqrtf(wave_sum(s2) * (1.f / D) + EPS);
#pragma unroll
        for (int j = 0; j < 4; ++j) { const int col = 256 * j + 4 * F.lane;
            const f32x4 hn = v[j] * rstd * lgv[j] + lbv[j];
#if PROBE_T
            if (last) { const unsigned long long* dg = (const unsigned long long*)(F.ws + WS_CTL + 512 * 1024); const float nu = (float)(dg[2] ? dg[2] : 1ull);
                float c = PROBE_T == 1 ? (float)dg[0] / nu * 0.01f : PROBE_T == 2 ? (float)dg[1] / nu * 0.01f : (PROBE_T == 4 ? (float)dg[3] / nu * 0.0025f : PROBE_T == 5 ? (float)dg[3] * 0.000625f : (float)dg[3] * 0.0025f); c = floorf((c + 1.0f) * 0.5f) * 2.0f; *(f32x4*)(F.out + (size_t)t * D + col) = (f32x4){c, c, c, c}; } else
#else
            if (last) *(f32x4*)(F.out + (size_t)t * D + col) = hn; else
#endif
            *(u32x2*)(hp + col) = (u32x2){pk2(hn[0], hn[1]), pk2(hn[2], hn[3])};
            if (!last) { const f32x4 u = hn * scv[j] + shv[j];
                *(u32x2*)(U + (size_t)t * D + col) = (u32x2){pk2(u[0], u[1]), pk2(u[2], u[3])}; } }
#pragma unroll
        for (int j = 0; j < 4; ++j) { hc[j] = hn_[j]; ya[j] = yan[j]; yb[j] = ybn[j]; }
    }
#undef LN2_LOAD
}

__device__ __forceinline__ bool attn_fast_ok(const Frame& F, int j) {
    const float* qg = F.a->in[I_AQG] + j * 128; const float* kg = F.a->in[I_AKG] + j * 128; float mq = 0.f, mk = 0.f;
    for (int i = 0; i < 128; ++i) { mq = fmaxf(mq, fabsf(qg[i])); mk = fmaxf(mk, fabsf(kg[i])); }
    return att::SCALE * 1.4426950408889634f * 128.f * mq * mk < 96.f;
}
__device__ __forceinline__ void qk_norm_rope(Frame& F, int j, const pg8::StaticOrder& S) {
    const Args& A = *F.a; const float* qg = A.in[I_AQG] + j * 128; const float* kg = A.in[I_AKG] + j * 128;
    bf16_t* Q = RG(F, 1); bf16_t* Kb = RG(F, 2); const f32x2* rope = (const f32x2*)(F.ws + WS_ROPE);
    const int sub = F.lane >> 4, l16 = F.lane & 15; const bool fast = attn_fast_ok(F, j);
    Unit u;
    for (int i = 0; S.next(i, u); ++i) {
        if (u.pn >= 5) continue;
        const float* gn = u.pn < 4 ? qg : kg; const float qs = (u.pn < 4 && fast) ? att::SCALE * 1.4426950408889634f : 1.f;
        float gv[8];
#pragma unroll
        for (int e = 0; e < 8; ++e) gv[e] = gn[l16 * 8 + e] * qs;
        bf16_t* base; size_t ld; size_t r0;
        if (u.pn < 4) { base = Q + u.pn * 256; ld = D; r0 = (size_t)u.pm * 256; }
        else { base = Kb; ld = 256; r0 = u.pm < 128 ? (size_t)(u.pm >> 5) * KVLEN + CTXL + (size_t)(u.pm & 31) * 256 : (size_t)(u.pm - 128) * KVLEN; }
        const bool lat = u.pm < 128;
#pragma unroll 1
        for (int it0 = 0; it0 < 16; it0 += 8) {
            u32x4 wv[8]; f32x2 cs[8][4];
#pragma unroll
            for (int k = 0; k < 8; ++k) { const int pi = (it0 + k) * 32 + F.wave * 4 + sub, row = pi >> 1, hh = pi & 1;
                wv[k] = *(const u32x4*)(base + (r0 + row) * ld + hh * 128 + l16 * 8);
                if (lat) { const int n = (u.pm & 31) * 256 + row;
#pragma unroll
                    for (int e = 0; e < 4; ++e) cs[k][e] = rope[(size_t)n * 64 + l16 * 4 + e]; } }
#pragma unroll
            for (int k = 0; k < 8; ++k) { const int pi = (it0 + k) * 32 + F.wave * 4 + sub, row = pi >> 1, hh = pi & 1;
                bf16_t* p = base + (r0 + row) * ld + hh * 128 + l16 * 8; const u32x4 w = wv[k];
                float x[8] = {bflo(w.x), bfhi(w.x), bflo(w.y), bfhi(w.y), bflo(w.z), bfhi(w.z), bflo(w.w), bfhi(w.w)};
                float ss = 0.f;
#pragma unroll
                for (int e = 0; e < 8; ++e) ss += x[e] * x[e];
                ss = sum16(ss);
                const float rs = 1.f / sqrtf(ss * (1.f / 128.f) + EPS);
#pragma unroll
                for (int e = 0; e < 8; ++e) x[e] = x[e] * rs * gv[e];
                if (lat) {
#pragma unroll
                    for (int e = 0; e < 4; ++e) { const float a = x[2 * e], bb = x[2 * e + 1]; x[2 * e] = a * cs[k][e].x - bb * cs[k][e].y; x[2 * e + 1] = a * cs[k][e].y + bb * cs[k][e].x; } }
                *(u32x4*)p = (u32x4){pk2(x[0], x[1]), pk2(x[2], x[3]), pk2(x[4], x[5]), pk2(x[6], x[7])}; }
        }
    }
}
template <bool FAST> __device__ __forceinline__ void attn_units(Frame& F, bool need_ctx, bf16_t* Oout) {
    const bf16_t* Q = RG(F, 1); const bf16_t* Kb = RG(F, 2); const bf16_t* Vb = (const bf16_t*)((const char*)RG(F, 2) + 17 * MiB);
    const int nunits = 1024 + (need_ctx ? 32 : 0);
    FRAME_REFRESH(F);
    for (int L = F.bid; L < nunits; L += F.G) {
        int b, h, t0, seq;
        if (L < 1024) { int qb;
            if (F.G == 256) { b = L >> 8; h = F.bid & 7; qb = F.bid >> 3; }
            else { qb = L & 31; h = (L >> 5) & 7; b = L >> 8; }
            t0 = b * SEQ + qb * 256; seq = KVLEN; }
        else { const int i = L - 1024; b = i >> 3; h = i & 7; t0 = TLAT + b * CTXL; seq = CTXL; }
        const bf16_t* Qp = Q + (size_t)t0 * D + h * 128;
        const size_t kvo = (size_t)b * KVLEN * 256 + (h >> 2) * 128;
        int tid_; { int l_; asm volatile("v_mbcnt_lo_u32_b32 %0, -1, 0\n\tv_mbcnt_hi_u32_b32 %0, -1, %0" : "=v"(l_)); tid_ = F.wave * 64 + l_; }
        if constexpr (FAST) { if (((seq >> 6) & 3) == 0) att::attn_fast16s_body(Qp, Kb + kvo, Vb + kvo, Oout + (size_t)t0 * D + h * 128, seq, F.ldsg, tid_);
                              else att::attn_fast16_body(Qp, Kb + kvo, Vb + kvo, Oout + (size_t)t0 * D + h * 128, seq, F.ldsg, tid_); }
        else att::attn_dense_body<false>(Qp, Kb + kvo, Vb + kvo, Oout + (size_t)t0 * D + h * 128, seq, F.ldsg, F.tid);
    }
}
__device__ __forceinline__ void attn_phase(Frame& F, bool need_ctx, bf16_t* Oout, int j) {
    if (attn_fast_ok(F, j)) attn_units<true>(F, need_ctx, Oout); else attn_units<false>(F, need_ctx, Oout);
}

__device__ __forceinline__ unsigned off_b2(unsigned row, unsigned ch) { return 256u * row + 16u * (ch ^ (((row & 3) << 2) | ((row >> 2) & 3))); }
__device__ __forceinline__ void gmlp_spatial(Frame& F) {
    const Args& A = *F.a; const bf16_t* ZB = RG(F, 1); bf16_t* P = RG(F, 0); const bf16_t* WS_ = (const bf16_t*)(F.ws + WS_BWS); const f32x2* SP = (const f32x2*)(F.ws + WS_AB);
    LAS float* ST = (LAS float*)(F.lds + 32768);
    LAS unsigned char* VT = F.lds;
    const unsigned vbase = (unsigned)(uintptr_t)F.ldsg;
    u32x4 vnext[4];
#define SPT_VLOAD(V, un_) do { const int ck_ = (un_) >> 3, g_ = (un_) & 7; _Pragma("unroll") for (int e_ = 0; e_ < 4; ++e_) { const int id_ = F.tid + 512 * e_, row_ = id_ >> 4, ch_ = id_ & 15; \
        V[e_] = *(const u32x4*)(ZB + (size_t)(ck_ * 128 + row_) * 2048 + 1024 + g_ * 128 + ch_ * 8); } } while (0)
    if (F.bid < 264 * 8) SPT_VLOAD(vnext, F.bid);
    for (int un = F.bid; un < 264 * 8; un += F.G) {
        FRAME_REFRESH(F);
        const int lane = F.lane, r = lane & 31, hh = lane >> 5, wr = F.wave >> 1, wc = F.wave & 1;
        const int ck = un >> 3, g = un & 7, t0 = ck * 128;
        if (F.tid < 128) { const f32x4* sp = (const f32x4*)(SP + (size_t)(t0 + F.tid) * 16); float s1 = 0.f, s2 = 0.f;
#pragma unroll
            for (int i = 0; i < 8; ++i) { const f32x4 v = sp[i]; s1 += v[0] + v[2]; s2 += v[1] + v[3]; }
            const float mean = s1 * (1.f / 1024.f), var = fmaxf(s2 * (1.f / 1024.f) - mean * mean, 0.f);
            ST[2 * F.tid] = mean; ST[2 * F.tid + 1] = 1.f / sqrtf(var + EPS); }
        u32x4 vraw[4];
#pragma unroll
        for (int e = 0; e < 4; ++e) vraw[e] = vnext[e];
        bf16x8 afr[8];
        { const bf16_t* wp0 = WS_ + ((size_t)g * 128 + wr * 32 + r) * 128 + hh * 8;
#pragma unroll
          for (int ks = 0; ks < 8; ++ks) afr[ks] = *(const bf16x8*)(wp0 + ks * 16); }
        __syncthreads();
#pragma unroll
        for (int e = 0; e < 4; ++e) { const int id = F.tid + 512 * e, row = id >> 4, ch = id & 15; const float mean = ST[2 * row], rstd = ST[2 * row + 1];
            const u32x4 w = vraw[e]; const float x[8] = {bflo(w.x), bfhi(w.x), bflo(w.y), bfhi(w.y), bflo(w.z), bfhi(w.z), bflo(w.w), bfhi(w.w)};
            const float* vg = A.in[I_BVG] + g * 128 + ch * 8; const float* vb = A.in[I_BVB] + g * 128 + ch * 8; float y[8];
#pragma unroll
            for (int c = 0; c < 8; ++c) y[c] = (x[c] - mean) * rstd * vg[c] + vb[c];
            *(LAS u32x4*)(VT + off_b2(row, ch)) = (u32x4){pk2(y[0], y[1]), pk2(y[2], y[3]), pk2(y[4], y[5]), pk2(y[6], y[7])}; }
        __syncthreads();
        f32x16 acc[2] = {};
        bf16_t uval[2][16]; float bsv[16];
#pragma unroll
        for (int reg = 0; reg < 16; ++reg) { const int tl = wr * 32 + crow(reg, hh); bsv[reg] = A.in[I_BBS][g * 128 + tl];
#pragma unroll
            for (int cb = 0; cb < 2; ++cb) uval[cb][reg] = ZB[(size_t)(t0 + tl) * 2048 + g * 128 + wc * 64 + cb * 32 + r]; }
        if (un + F.G < 264 * 8) SPT_VLOAD(vnext, un + F.G);
        { const unsigned blk = (lane >> 4) & 1, q = (lane & 15) >> 2, p = lane & 3;
#pragma unroll
          for (int ks = 0; ks < 8; ++ks) { const bf16x8 af = afr[ks];
              s16x4 bt[2][2];
#pragma unroll
              for (int cb = 0; cb < 2; ++cb)
#pragma unroll
                  for (int t = 0; t < 2; ++t) { s16x4 rr; const unsigned addr = vbase + off_b2(16 * ks + 8 * hh + 4 * t + q, 4 * (2 * wc + cb) + 2 * blk + (p >> 1)) + 8 * (p & 1);
                      asm volatile("ds_read_b64_tr_b16 %0, %1" : "=&v"(rr) : "v"(addr) : "memory"); bt[cb][t] = rr; }
              asm volatile("s_waitcnt lgkmcnt(0)" ::: "memory"); __builtin_amdgcn_sched_barrier(0);
#pragma unroll
              for (int cb = 0; cb < 2; ++cb) { const bf16x8 bfr = (bf16x8){bt[cb][0][0], bt[cb][0][1], bt[cb][0][2], bt[cb][0][3], bt[cb][1][0], bt[cb][1][1], bt[cb][1][2], bt[cb][1][3]};
                  acc[cb] = MFMA32(af, bfr, acc[cb]); } } }
#pragma unroll
        for (int cb = 0; cb < 2; ++cb)
#pragma unroll
            for (int reg = 0; reg < 16; ++reg) { const int tl = wr * 32 + crow(reg, hh), c = g * 128 + wc * 64 + cb * 32 + r;
                const float mixed = acc[cb][reg] + bsv[reg];
                const float uu = bf1(uval[cb][reg]);
                P[(size_t)(t0 + tl) * D + c] = (bf16_t)(pk2(uu * mixed, 0.f) & 0xffffu); }
        __syncthreads();
    }
#undef SPT_VLOAD
}

__device__ __forceinline__ void delta_prep(Frame& F) {
    const Args& A = *F.a; const float* cw = A.in[I_CCONV];
    for (int wu = F.gw; wu < 528 * 6; wu += F.NGW) {
        const int ck = wu / 6, slab = wu % 6, buf = slab >> 1, ch = (slab & 1) * 512 + 8 * F.lane, t0 = ck * 64;
        const bf16_t* src = RG(F, 1 + buf) + ch; bf16_t* dst = RG(F, 5 + buf) + ch;
        float w0[8], w1[8], w2[8];
#pragma unroll
        for (int e = 0; e < 8; ++e) { const int cg = buf * 1024 + ch + e; w0[e] = cw[cg]; w1[e] = cw[3072 + cg]; w2[e] = cw[6144 + cg]; }
        const int seqlen = t0 < TLAT ? SEQ : CTXL, n0 = t0 < TLAT ? (t0 & (SEQ - 1)) : ((t0 - TLAT) & (CTXL - 1));
        u32x4 prev = {0u, 0u, 0u, 0u}, cur;
        if (n0 > 0) prev = *(const u32x4*)(src + (size_t)(t0 - 1) * D);
        cur = *(const u32x4*)(src + (size_t)t0 * D);
#pragma unroll 1
        for (int r8 = 0; r8 < 64; r8 += 8) {
            u32x4 nx[8];
#pragma unroll
            for (int e = 0; e < 8; ++e) { nx[e] = (u32x4){0u, 0u, 0u, 0u}; if (n0 + r8 + e + 1 < seqlen) nx[e] = *(const u32x4*)(src + (size_t)(t0 + r8 + e + 1) * D); }
#pragma unroll
            for (int e = 0; e < 8; ++e) {
                const int t = t0 + r8 + e; const u32x4 nxt = nx[e];
                const float xp[8] = {bflo(prev.x), bfhi(prev.x), bflo(prev.y), bfhi(prev.y), bflo(prev.z), bfhi(prev.z), bflo(prev.w), bfhi(prev.w)};
                const float xc[8] = {bflo(cur.x), bfhi(cur.x), bflo(cur.y), bfhi(cur.y), bflo(cur.z), bfhi(cur.z), bflo(cur.w), bfhi(cur.w)};
                const float xn[8] = {bflo(nxt.x), bfhi(nxt.x), bflo(nxt.y), bfhi(nxt.y), bflo(nxt.z), bfhi(nxt.z), bflo(nxt.w), bfhi(nxt.w)};
                float y[8]; float ss = 0.f;
#pragma unroll
                for (int c = 0; c < 8; ++c) { y[c] = siluf_(w0[c] * xp[c] + w1[c] * xc[c] + w2[c] * xn[c]); ss += y[c] * y[c]; }
                if (buf < 2) { ss = sum16(ss); const float rs = (1.f / sqrtf(ss + EPS)) * (buf == 0 ? 0.08838834764831845f : 1.f);
#pragma unroll
                    for (int c = 0; c < 8; ++c) y[c] *= rs; }
                *(u32x4*)(dst + (size_t)t * D) = (u32x4){pk2(y[0], y[1]), pk2(y[2], y[3]), pk2(y[4], y[5]), pk2(y[6], y[7])};
                prev = cur; cur = nxt;
            }
        }
    }
}
__device__ __forceinline__ void delta_local(Frame& F) {
    const Args& A = *F.a; const float* AB = (const float*)(F.ws + WS_AB); float* GC = (float*)(F.ws + WS_GC); float* BETA = (float*)(F.ws + WS_BETA);
    const bf16_t* QN = RG(F, 5); const bf16_t* KN = RG(F, 6); bf16_t* TB = RG(F, 1); bf16_t* ATT = RG(F, 2);
    LAS float* Aw = (LAS float*)(F.lds + F.wave * 17408);
    for (int wu = F.gw; wu < 528 * 16; wu += F.NGW) {
        int lane = F.lane; asm volatile("" : "+v"(lane));
        const int r = lane & 31, hh = lane >> 5;
        const int dir = wu & 1, h = (wu >> 1) & 7, ck = wu >> 4, t0 = ck * 64;
        const int tok = dir ? t0 + 63 - lane : t0 + lane;
        const float a = AB[(size_t)tok * 32 + dir * 8 + h], bb = AB[(size_t)tok * 32 + 16 + dir * 8 + h];
        const float x = a + A.in[I_CDTB][dir * 8 + h];
        const float sp = fmaxf(x, 0.f) + log1pf(expf(-fabsf(x)));
        const float g = -expf(A.in[I_CALOG][dir * 8 + h]) * sp;
        const float beta = 1.f / (1.f + expf(-bb));
        float gc = g;
#pragma unroll
        for (int o = 1; o < 64; o <<= 1) { const float tv = __shfl_up(gc, o); if (lane >= o) gc += tv; }
        GC[(size_t)(dir * 8 + h) * TT + tok] = gc; BETA[(size_t)(dir * 8 + h) * TT + tok] = beta;
        const int tk0 = dir ? t0 + 63 - r : t0 + r, tk1 = dir ? t0 + 31 - r : t0 + 32 + r;
        const bf16_t* kp0 = KN + (size_t)tk0 * D + h * 128 + hh * 8; const bf16_t* kp1 = KN + (size_t)tk1 * D + h * 128 + hh * 8;
        const bf16_t* qp0 = QN + (size_t)tk0 * D + h * 128 + hh * 8; const bf16_t* qp1 = QN + (size_t)tk1 * D + h * 128 + hh * 8;
        bf16x8 kf0[8], kf1[8];
#pragma unroll
        for (int ks = 0; ks < 8; ++ks) { kf0[ks] = *(const bf16x8*)(kp0 + ks * 16); kf1[ks] = *(const bf16x8*)(kp1 + ks * 16); }
        const float gcj0 = __shfl(gc, r), gcj1 = __shfl(gc, 32 + r);
        bf16_t* attp = ATT + (size_t)wu * 4096;
        {   f32x16 s00 = {}, s10 = {}, s11 = {};
#pragma unroll
            for (int ks = 0; ks < 8; ++ks) { s00 = MFMA32(kf0[ks], kf0[ks], s00); s10 = MFMA32(kf1[ks], kf0[ks], s10); s11 = MFMA32(kf1[ks], kf1[ks], s11); }
#pragma unroll
            for (int reg = 0; reg < 16; ++reg) { const int il = crow(reg, hh);
                const float gci0 = __shfl(gc, il), gci1 = __shfl(gc, 32 + il), bt0 = __shfl(beta, il), bt1 = __shfl(beta, 32 + il);
                const float d00 = (il > r) ? __expf(gci0 - gcj0) : 0.f, d10 = __expf(gci1 - gcj0), d11 = (il > r) ? __expf(gci1 - gcj1) : 0.f;
                Aw[r * 68 + il] = bt0 * s00[reg] * d00;
                Aw[r * 68 + 32 + il] = bt1 * s10[reg] * d10;
                Aw[(32 + r) * 68 + 32 + il] = bt1 * s11[reg] * d11; }
        }
        asm volatile("" ::: "memory"); __builtin_amdgcn_sched_barrier(0);
        {   f32x16 q00 = {}, q10 = {}, q11 = {};
#pragma unroll
            for (int ks = 0; ks < 8; ++ks) { const bf16x8 q0 = *(const bf16x8*)(qp0 + ks * 16), q1 = *(const bf16x8*)(qp1 + ks * 16);
                q00 = MFMA32(q0, kf0[ks], q00); q10 = MFMA32(q1, kf0[ks], q10); q11 = MFMA32(q1, kf1[ks], q11); }
#pragma unroll
            for (int reg = 0; reg < 16; ++reg) { const int il = crow(reg, hh);
                const float gci0 = __shfl(gc, il), gci1 = __shfl(gc, 32 + il);
                const float d00 = (il >= r) ? __expf(gci0 - gcj0) : 0.f, d10 = __expf(gci1 - gcj0), d11 = (il >= r) ? __expf(gci1 - gcj1) : 0.f;
                attp[il * 64 + r] = (bf16_t)(pk2(q00[reg] * d00, 0.f) & 0xffffu);
                attp[il * 64 + 32 + r] = 0;
                attp[(32 + il) * 64 + r] = (bf16_t)(pk2(q10[reg] * d10, 0.f) & 0xffffu);
                attp[(32 + il) * 64 + 32 + r] = (bf16_t)(pk2(q11[reg] * d11, 0.f) & 0xffffu); }
        }
        asm volatile("" ::: "memory"); __builtin_amdgcn_sched_barrier(0);
        LDS_WAIT(); asm volatile("" ::: "memory");
        float Tc[64]; bf16_t* tp = TB + (size_t)wu * 4096 + lane;
#pragma unroll
        for (int i = 0; i < 64; ++i) Tc[i] = (i == lane) ? 1.f : 0.f;
        f32x4 cur[16], nxt[16];
#pragma unroll
        for (int p4 = 0; p4 < 16; ++p4) cur[p4] = *(const LAS f32x4*)(Aw + 4 * p4);
#pragma unroll
        for (int j = 0; j < 64; ++j) {
            if (j + 1 < 64) {
#pragma unroll
                for (int p4 = (j + 2) / 4; p4 < 16; ++p4) nxt[p4] = *(const LAS f32x4*)(Aw + (j + 1) * 68 + 4 * p4); }
            const float tj = Tc[j]; tp[j * 64] = (bf16_t)(pk2(tj, 0.f) & 0xffffu);
#pragma unroll
            for (int p4 = (j + 1) / 4; p4 < 16; ++p4)
#pragma unroll
                for (int e2 = 0; e2 < 4; ++e2) if (4 * p4 + e2 > j) Tc[4 * p4 + e2] -= cur[p4][e2] * tj;
#pragma unroll
            for (int p4 = 0; p4 < 16; ++p4) cur[p4] = nxt[p4];
            asm volatile("" ::: "memory"); __builtin_amdgcn_sched_barrier(0); }
        LDS_WAIT(); asm volatile("" ::: "memory");
    }
}
constexpr int SC_QT = 0, SC_KT = 16896, SC_KTT = 33792, SC_TT = 51200, SC_AT = 59904, SC_VT = 68608, SC_TAB = 76800, SC_XP = 77824, SC_OP = 110592;
static_assert(SC_OP + 32768 <= MISC_OFF, "scan LDS");
__device__ __forceinline__ bf16x8 lds_frag(const LAS unsigned char* p) { return mk8(*(const LAS u32x2*)p, *(const LAS u32x2*)(p + 16)); }
__device__ __forceinline__ bf16x8 pack_acc(const f32x16& v, int s) { return mk8w(pk2(v[8 * s], v[8 * s + 1]), pk2(v[8 * s + 2], v[8 * s + 3]), pk2(v[8 * s + 4], v[8 * s + 5]), pk2(v[8 * s + 6], v[8 * s + 7])); }
__device__ __forceinline__ void delta_scan(Frame& F) {
    const bf16_t* QN = RG(F, 5); const bf16_t* KN = RG(F, 6); const bf16_t* VN = RG(F, 7); const bf16_t* TB = RG(F, 1); const bf16_t* ATT = RG(F, 2);
    const float* GC = (const float*)(F.ws + WS_GC); const float* BETA = (const float*)(F.ws + WS_BETA);
    LAS unsigned char* L = F.lds; const int w = F.wave;
    LAS float* TAB = (LAS float*)(L + SC_TAB); LAS float* XP = (LAS float*)(L + SC_XP); LAS float* OP = (LAS float*)(L + SC_OP); LAS float* VT = (LAS float*)(L + SC_VT);
    for (int item = F.bid; item < 256; item += F.G) {
        const int ch = item >> 2, dvs = item & 3, b = ch >> 4, h = (ch >> 1) & 7, dir = ch & 1;
        bf16_t* OB = RG(F, dir ? 3 : 0);
        f32x16 S = {};
        u32x4 sq[2], sk[2], st, sa, sv; float sgc = 0.f, sbt = 0.f;
#define SCAN_CK(step) ((step) < 4 ? 512 + b * 4 + (dir ? 3 - (step) : (step)) : b * 128 + (dir ? 131 - (step) : (step) - 4))
#define SCAN_LOAD(step) do { const int ck_ = SCAN_CK(step); const int t0_ = ck_ * 64; const size_t un_ = ((size_t)ck_ * 8 + h) * 2 + dir; \
        _Pragma("unroll") for (int e_ = 0; e_ < 2; ++e_) { const int id_ = tid + 512 * e_, row_ = id_ >> 4, c16_ = id_ & 15; const int tk_ = dir ? t0_ + 63 - row_ : t0_ + row_; \
            sq[e_] = *(const u32x4*)(QN + (size_t)tk_ * D + h * 128 + c16_ * 8); sk[e_] = *(const u32x4*)(KN + (size_t)tk_ * D + h * 128 + c16_ * 8); } \
        st = *(const u32x4*)(TB + un_ * 4096 + tid * 8); sa = *(const u32x4*)(ATT + un_ * 4096 + tid * 8); \
        if (tid < 256) { const int row_ = tid >> 2, c_ = tid & 3; const int tk_ = dir ? t0_ + 63 - row_ : t0_ + row_; sv = *(const u32x4*)(VN + (size_t)tk_ * D + h * 128 + dvs * 32 + c_ * 8); } \
        if (tid < 64) { const int tk_ = dir ? t0_ + 63 - tid : t0_ + tid; sgc = GC[(size_t)(dir * 8 + h) * TT + tk_]; sbt = BETA[(size_t)(dir * 8 + h) * TT + tk_]; } } while (0)
#define SCAN_STORE() do { \
        _Pragma("unroll") for (int e_ = 0; e_ < 2; ++e_) { const int id_ = tid + 512 * e_, row_ = id_ >> 4, c16_ = id_ & 15; \
            *(LAS u32x2*)(L + SC_QT + row_ * 264 + c16_ * 16) = (u32x2){sq[e_].x, sq[e_].y}; *(LAS u32x2*)(L + SC_QT + row_ * 264 + c16_ * 16 + 8) = (u32x2){sq[e_].z, sq[e_].w}; \
            *(LAS u32x2*)(L + SC_KT + row_ * 264 + c16_ * 16) = (u32x2){sk[e_].x, sk[e_].y}; *(LAS u32x2*)(L + SC_KT + row_ * 264 + c16_ * 16 + 8) = (u32x2){sk[e_].z, sk[e_].w}; \
            LAS bf16_t* kt_ = (LAS bf16_t*)(L + SC_KTT) + (c16_ * 8) * 68 + row_; \
            kt_[0 * 68] = (bf16_t)(sk[e_].x & 0xffffu); kt_[1 * 68] = (bf16_t)(sk[e_].x >> 16); kt_[2 * 68] = (bf16_t)(sk[e_].y & 0xffffu); kt_[3 * 68] = (bf16_t)(sk[e_].y >> 16); \
            kt_[4 * 68] = (bf16_t)(sk[e_].z & 0xffffu); kt_[5 * 68] = (bf16_t)(sk[e_].z >> 16); kt_[6 * 68] = (bf16_t)(sk[e_].w & 0xffffu); kt_[7 * 68] = (bf16_t)(sk[e_].w >> 16); } \
        { const int row_ = tid >> 3, c16_ = tid & 7; \
          *(LAS u32x2*)(L + SC_TT + row_ * 136 + c16_ * 16) = (u32x2){st.x, st.y}; *(LAS u32x2*)(L + SC_TT + row_ * 136 + c16_ * 16 + 8) = (u32x2){st.z, st.w}; \
          *(LAS u32x2*)(L + SC_AT + row_ * 136 + c16_ * 16) = (u32x2){sa.x, sa.y}; *(LAS u32x2*)(L + SC_AT + row_ * 136 + c16_ * 16 + 8) = (u32x2){sa.z, sa.w}; } \
        if (tid < 256) { const int row_ = tid >> 2, c_ = tid & 3; LAS f32x4* vp_ = (LAS f32x4*)(VT + row_ * 32 + c_ * 8); \
            vp_[0] = (f32x4){bflo(sv.x), bfhi(sv.x), bflo(sv.y), bfhi(sv.y)}; vp_[1] = (f32x4){bflo(sv.z), bfhi(sv.z), bflo(sv.w), bfhi(sv.w)}; } \
        if (tid < 64) { const float gl_ = __shfl(sgc, 63); TAB[tid] = expf(sgc); TAB[64 + tid] = expf(gl_ - sgc); TAB[128 + tid] = sbt; if (tid == 0) TAB[192] = expf(gl_); } } while (0)
        int tid = F.tid; asm volatile("" : "+v"(tid));
        SCAN_LOAD(0); VM_WAIT(); SCAN_STORE(); __syncthreads();
#pragma unroll 1
        for (int step = 0; step < 132; ++step) {
            tid = F.tid; asm volatile("" : "+v"(tid));
            const int lane = tid & 63, r = lane & 31, hh = lane >> 5;
            const int ck = SCAN_CK(step), t0 = ck * 64;
            if (step + 1 < 132) SCAN_LOAD(step + 1);
            if (w < 4) {
                const bf16x8 Sb0 = pack_acc(S, 0), Sb1 = pack_acc(S, 1);
#pragma unroll
                for (int bi = 0; bi < 2; ++bi) { const int off = (32 * bi + r) * 264 + (32 * w + 4 * hh) * 2;
                    { f32x16 X = {}; const bf16x8 k0 = lds_frag(L + SC_KT + off), k1 = lds_frag(L + SC_KT + off + 32);
                      X = MFMA32(k0, Sb0, X); X = MFMA32(k1, Sb1, X);
#pragma unroll
                      for (int reg = 0; reg < 16; ++reg) XP[((w * 2 + bi) * 16 + reg) * 64 + lane] = X[reg]; }
                    { f32x16 X = {}; const bf16x8 q0 = lds_frag(L + SC_QT + off), q1 = lds_frag(L + SC_QT + off + 32);
                      X = MFMA32(q0, Sb0, X); X = MFMA32(q1, Sb1, X);
#pragma unroll
                      for (int reg = 0; reg < 16; ++reg) OP[((w * 2 + bi) * 16 + reg) * 64 + lane] = X[reg]; }
                    asm volatile("" ::: "memory"); }
            }
            __syncthreads();
            if (w < 4) {
                bf16x8 Rp[2][2];
#pragma unroll
                for (int bi = 0; bi < 2; ++bi)
#pragma unroll
                    for (int sh = 0; sh < 2; ++sh) { float R[8];
#pragma unroll
                        for (int e = 0; e < 8; ++e) { const int reg = 8 * sh + e; const int i = 32 * bi + crow(reg, hh);
                            const float X = (XP[((0 * 2 + bi) * 16 + reg) * 64 + lane] + XP[((1 * 2 + bi) * 16 + reg) * 64 + lane]) + (XP[((2 * 2 + bi) * 16 + reg) * 64 + lane] + XP[((3 * 2 + bi) * 16 + reg) * 64 + lane]);
                            R[e] = TAB[128 + i] * (VT[i * 32 + r] - TAB[i] * X); }
                        Rp[bi][sh] = mk8w(pk2(R[0], R[1]), pk2(R[2], R[3]), pk2(R[4], R[5]), pk2(R[6], R[7]));
                        asm volatile("" ::: "memory"); __builtin_amdgcn_sched_barrier(0); }
                f32x16 Vn0 = {}, Vn1 = {};
                { const int o0 = r * 136 + (4 * hh) * 2, o1 = (32 + r) * 136 + (4 * hh) * 2;
                  Vn0 = MFMA32(lds_frag(L + SC_TT + o0), Rp[0][0], Vn0); Vn0 = MFMA32(lds_frag(L + SC_TT + o0 + 32), Rp[0][1], Vn0);
                  Vn1 = MFMA32(lds_frag(L + SC_TT + o1), Rp[0][0], Vn1); Vn1 = MFMA32(lds_frag(L + SC_TT + o1 + 32), Rp[0][1], Vn1);
                  Vn1 = MFMA32(lds_frag(L + SC_TT + o1 + 64), Rp[1][0], Vn1); Vn1 = MFMA32(lds_frag(L + SC_TT + o1 + 96), Rp[1][1], Vn1); }
                asm volatile("" ::: "memory");
                bf16x8 Vsp[2][2];
                { f32x16 Vs;
#pragma unroll
                  for (int reg = 0; reg < 16; ++reg) Vs[reg] = Vn0[reg] * TAB[64 + crow(reg, hh)];
                  Vsp[0][0] = pack_acc(Vs, 0); Vsp[0][1] = pack_acc(Vs, 1);
#pragma unroll
                  for (int reg = 0; reg < 16; ++reg) Vs[reg] = Vn1[reg] * TAB[64 + 32 + crow(reg, hh)];
                  Vsp[1][0] = pack_acc(Vs, 0); Vsp[1][1] = pack_acc(Vs, 1); }
                const float gl = TAB[192];
#pragma unroll
                for (int reg = 0; reg < 16; ++reg) S[reg] *= gl;
                { const int o = (32 * w + r) * 136 + (4 * hh) * 2;
                  S = MFMA32(lds_frag(L + SC_KTT + o), Vsp[0][0], S); S = MFMA32(lds_frag(L + SC_KTT + o + 32), Vsp[0][1], S);
                  S = MFMA32(lds_frag(L + SC_KTT + o + 64), Vsp[1][0], S); S = MFMA32(lds_frag(L + SC_KTT + o + 96), Vsp[1][1], S); }
                asm volatile("" ::: "memory");
                if (w < 2) { f32x16 O = {};
                    const int o = (32 * w + r) * 136 + (4 * hh) * 2;
                    O = MFMA32(lds_frag(L + SC_AT + o), pack_acc(Vn0, 0), O); O = MFMA32(lds_frag(L + SC_AT + o + 32), pack_acc(Vn0, 1), O);
                    if (w == 1) { O = MFMA32(lds_frag(L + SC_AT + o + 64), pack_acc(Vn1, 0), O); O = MFMA32(lds_frag(L + SC_AT + o + 96), pack_acc(Vn1, 1), O); }
#pragma unroll
                    for (int sh = 0; sh < 2; ++sh) {
#pragma unroll
                        for (int e = 0; e < 8; ++e) { const int reg = 8 * sh + e; const int i = 32 * w + crow(reg, hh);
                            const float o1 = (OP[((0 * 2 + w) * 16 + reg) * 64 + lane] + OP[((1 * 2 + w) * 16 + reg) * 64 + lane]) + (OP[((2 * 2 + w) * 16 + reg) * 64 + lane] + OP[((3 * 2 + w) * 16 + reg) * 64 + lane]);
                            const float ov = O[reg] + TAB[i] * o1; const int tk = dir ? t0 + 63 - i : t0 + i;
                            OB[(size_t)tk * D + h * 128 + dvs * 32 + r] = (bf16_t)(pk2(ov, 0.f) & 0xffffu); }
                        asm volatile("" ::: "memory"); __builtin_amdgcn_sched_barrier(0); } }
            }
            __syncthreads();
            if (step + 1 < 132) { VM_WAIT(); SCAN_STORE(); }
            __syncthreads();
        }
#undef SCAN_CK
#undef SCAN_LOAD
#undef SCAN_STORE
    }
}
constexpr int S2_QT = 0, S2_KT = 16384, S2_VT = 32768, S2_TT = 49152, S2_AT = 57344, S2_TAB = 65536, S2_BUF = 66560;
static_assert(2 * S2_BUF <= MISC_OFF, "scan2 LDS");
__device__ __forceinline__ unsigned off_b(unsigned row, unsigned ch) { return 256u * row + 16u * (ch ^ (((row & 3) << 2) | ((row >> 2) & 3))); }
__device__ __forceinline__ bf16x8 pka(const f32x16& P, const int BASE) {
    const unsigned a0 = pk2(P[BASE + 0], P[BASE + 1]), a1 = pk2(P[BASE + 2], P[BASE + 3]), b0 = pk2(P[BASE + 4], P[BASE + 5]), b1 = pk2(P[BASE + 6], P[BASE + 7]);
    auto r0 = __builtin_amdgcn_permlane32_swap(a0, b0, false, false); auto r1 = __builtin_amdgcn_permlane32_swap(a1, b1, false, false);
    return mk8w(r0[0], r1[0], r0[1], r1[1]);
}
__device__ __forceinline__ s16x4 trr(unsigned addr) { s16x4 r; asm volatile("ds_read_b64_tr_b16 %0, %1" : "=&v"(r) : "v"(addr) : "memory"); return r; }
#define GLDS16(gp, lp) __builtin_amdgcn_global_load_lds((const unsigned*)(gp), (LAS unsigned*)(lp), 16, 0, 0)
__device__ __forceinline__ void delta_scan2(Frame& F) {
    const bf16_t* QN = RG(F, 5); const bf16_t* KN = RG(F, 6); const bf16_t* VN = RG(F, 7); const bf16_t* TB = RG(F, 1); const bf16_t* ATT = RG(F, 2);
    const float* GC = (const float*)(F.ws + WS_GC); const float* BETA = (const float*)(F.ws + WS_BETA);
    LAS unsigned char* L = F.lds; const int w = F.wave;
    const unsigned lbase = (unsigned)(uintptr_t)F.ldsg;
    for (int ch = F.bid; ch < 64; ch += F.G) {
        const int b = ch >> 4, h = (ch >> 1) & 7, dir = ch & 1;
        bf16_t* OB = RG(F, dir ? 3 : 0);
        const float* gcp = GC + (size_t)(dir * 8 + h) * TT; const float* btp = BETA + (size_t)(dir * 8 + h) * TT;
#define S2_CK(step) ((step) < 4 ? 512 + b * 4 + (dir ? 3 - (step) : (step)) : b * 128 + (dir ? 131 - (step) : (step) - 4))
#define S2_FILL(step, buf) do { const int lane_ = F.lane, lw_ = w - 4; const int ck_ = S2_CK(step), t0_ = ck_ * 64; const size_t un_ = ((size_t)ck_ * 8 + h) * 2 + dir; \
        LAS unsigned char* Bf_ = L + (buf) * S2_BUF; \
        _Pragma("unroll") for (int e_ = 0; e_ < 4; ++e_) { const int pc_ = 4 * lw_ + e_; const unsigned row_ = 4 * pc_ + (lane_ >> 4), ch_ = (lane_ & 15) ^ (((row_ & 3) << 2) | ((row_ >> 2) & 3)); \
            const size_t go_ = (size_t)(dir ? t0_ + 63 - (int)row_ : t0_ + (int)row_) * D + h * 128 + ch_ * 8; \
            GLDS16(QN + go_, Bf_ + S2_QT + pc_ * 1024); GLDS16(KN + go_, Bf_ + S2_KT + pc_ * 1024); GLDS16(VN + go_, Bf_ + S2_VT + pc_ * 1024); } \
        _Pragma("unroll") for (int e_ = 0; e_ < 2; ++e_) { const int pc_ = 2 * lw_ + e_; const unsigned R_ = 4 * pc_ + (lane_ >> 4), c_ = (lane_ & 15) ^ (((R_ & 3) << 2) | ((R_ >> 2) & 3)); \
            const size_t go_ = un_ * 4096 + (size_t)(32 * (c_ >> 3) + R_) * 64 + (c_ & 7) * 8; \
            GLDS16(TB + go_, Bf_ + S2_TT + pc_ * 1024); GLDS16(ATT + go_, Bf_ + S2_AT + pc_ * 1024); } \
        if (lw_ == 0) { const int tk_ = dir ? t0_ + 63 - lane_ : t0_ + lane_; const float g_ = gcp[tk_], b_ = btp[tk_], l_ = gcp[dir ? t0_ : t0_ + 63]; \
            LAS float* tb_ = (LAS float*)(Bf_ + S2_TAB); tb_[lane_] = expf(g_); tb_[64 + lane_] = expf(l_ - g_); tb_[128 + lane_] = b_; if (lane_ == 0) tb_[192] = expf(l_); } } while (0)
        f32x16 S[4];
#pragma unroll
        for (int kb = 0; kb < 4; ++kb) S[kb] = (f32x16){};
        FRAME_REFRESH(F);
        if (w >= 4) { S2_FILL(0, 0); }
        asm volatile("s_waitcnt vmcnt(0) lgkmcnt(0)" ::: "memory"); __builtin_amdgcn_s_barrier(); asm volatile("" ::: "memory");
#pragma unroll 1
        for (int s2 = 0; s2 < 132; s2 += 2) {
#pragma unroll
            for (int par = 0; par < 2; ++par) {
                const int step = s2 + par;
                FRAME_REFRESH(F);
                if (w >= 4) { if (step + 1 < 132) { S2_FILL(step + 1, par ^ 1); } asm volatile("s_waitcnt vmcnt(0) lgkmcnt(0)" ::: "memory"); }
                else {
                    const int lane = F.lane, r = lane & 31, hh = lane >> 5;
                    LAS unsigned char* Bf = L + par * S2_BUF; const unsigned ab = lbase + par * S2_BUF;
                    const LAS float* tab = (const LAS float*)(Bf + S2_TAB);
                    const int ck = S2_CK(step), t0 = ck * 64;
                    bf16x8 Sb[4][2];
#pragma unroll
                    for (int kb = 0; kb < 4; ++kb) { Sb[kb][0] = pka(S[kb], 0); Sb[kb][1] = pka(S[kb], 8); }
                    f32x16 X[2] = {}, O1[2] = {};
                    { bf16x8 kc[2], qc[2], kn[2], qn[2];
#pragma unroll
                      for (int bi = 0; bi < 2; ++bi) { const unsigned o = off_b(32 * bi + r, hh); kc[bi] = *(const LAS bf16x8*)(Bf + S2_KT + o); qc[bi] = *(const LAS bf16x8*)(Bf + S2_QT + o); }
#pragma unroll
                      for (int ks = 0; ks < 8; ++ks) {
                          if (ks < 7) {
#pragma unroll
                              for (int bi = 0; bi < 2; ++bi) { const unsigned o = off_b(32 * bi + r, 2 * (ks + 1) + hh); kn[bi] = *(const LAS bf16x8*)(Bf + S2_KT + o); qn[bi] = *(const LAS bf16x8*)(Bf + S2_QT + o); } }
                          __builtin_amdgcn_sched_barrier(0);
#pragma unroll
                          for (int bi = 0; bi < 2; ++bi) { X[bi] = MFMA32(kc[bi], Sb[ks >> 1][ks & 1], X[bi]); O1[bi] = MFMA32(qc[bi], Sb[ks >> 1][ks & 1], O1[bi]); }
#pragma unroll
                          for (int bi = 0; bi < 2; ++bi) { kc[bi] = kn[bi]; qc[bi] = qn[bi]; }
                          __builtin_amdgcn_sched_barrier(0); } }
                    bf16x8 tf0[2], tf1[4];
#pragma unroll
                    for (int ks = 0; ks < 4; ++ks) { if (ks < 2) tf0[ks] = *(const LAS bf16x8*)(Bf + S2_TT + off_b(r, 2 * ks + hh)); tf1[ks] = *(const LAS bf16x8*)(Bf + S2_TT + off_b(r, 8 + 2 * ks + hh)); }
                    bf16x8 Rp[2][2];
                    { const int ql = (lane & 15) >> 2, p = lane & 3, rh = (lane >> 4) & 1;
                      s16x4 vv[2][4];
#pragma unroll
                      for (int bi = 0; bi < 2; ++bi)
#pragma unroll
                          for (int q4 = 0; q4 < 4; ++q4) vv[bi][q4] = trr(ab + S2_VT + off_b(32 * bi + 8 * q4 + 4 * hh + ql, 4 * w + 2 * rh + (p >> 1)) + 8 * (p & 1));
                      asm volatile("s_waitcnt lgkmcnt(0)" ::: "memory"); __builtin_amdgcn_sched_barrier(0);
#pragma unroll
                      for (int bi = 0; bi < 2; ++bi) { f32x16 R;
                          f32x4 egv[4], btv[4];
#pragma unroll
                          for (int q4 = 0; q4 < 4; ++q4) { egv[q4] = *(const LAS f32x4*)(tab + 32 * bi + 8 * q4 + 4 * hh); btv[q4] = *(const LAS f32x4*)(tab + 128 + 32 * bi + 8 * q4 + 4 * hh); }
                          __builtin_amdgcn_sched_barrier(0);
#pragma unroll
                          for (int q4 = 0; q4 < 4; ++q4) { const f32x4 eg = egv[q4], bt = btv[q4];
#pragma unroll
                              for (int e = 0; e < 4; ++e) R[4 * q4 + e] = bt[e] * (bf1((bf16_t)vv[bi][q4][e]) - eg[e] * X[bi][4 * q4 + e]); }
                          Rp[bi][0] = pka(R, 0); Rp[bi][1] = pka(R, 8); } }
                    f32x16 Vn[2] = {};
#pragma unroll
                    for (int ks = 0; ks < 4; ++ks) {
                        if (ks < 2) Vn[0] = MFMA32(tf0[ks], Rp[ks >> 1][ks & 1], Vn[0]);
                        Vn[1] = MFMA32(tf1[ks], Rp[ks >> 1][ks & 1], Vn[1]); }
                    const unsigned blk = (lane >> 4) & 1, q = (lane & 15) >> 2, p = lane & 3;
                    s16x4 kt[2][4][2];
#define S2_KT_ISSUE(kb0) do { _Pragma("unroll") for (int kk_ = 0; kk_ < 2; ++kk_) _Pragma("unroll") for (int ks_ = 0; ks_ < 4; ++ks_) _Pragma("unroll") for (int t_ = 0; t_ < 2; ++t_) \
                        kt[kk_][ks_][t_] = trr(ab + S2_KT + off_b(16 * ks_ + 8 * hh + 4 * t_ + q, 4 * ((kb0) + kk_) + 2 * blk + (p >> 1)) + 8 * (p & 1)); } while (0)
#define S2_KT_MMA(kb0) do { _Pragma("unroll") for (int ks_ = 0; ks_ < 4; ++ks_) _Pragma("unroll") for (int kk_ = 0; kk_ < 2; ++kk_) { \
                        const bf16x8 kf_ = (bf16x8){kt[kk_][ks_][0][0], kt[kk_][ks_][0][1], kt[kk_][ks_][0][2], kt[kk_][ks_][0][3], kt[kk_][ks_][1][0], kt[kk_][ks_][1][1], kt[kk_][ks_][1][2], kt[kk_][ks_][1][3]}; \
                        S[(kb0) + kk_] = MFMA32(kf_, Vs[ks_ >> 1][ks_ & 1], S[(kb0) + kk_]); } } while (0)
                    S2_KT_ISSUE(0);
                    { bf16x8 af0[2], af1[4];
#pragma unroll
                      for (int ks = 0; ks < 4; ++ks) { if (ks < 2) af0[ks] = *(const LAS bf16x8*)(Bf + S2_AT + off_b(r, 2 * ks + hh)); af1[ks] = *(const LAS bf16x8*)(Bf + S2_AT + off_b(r, 8 + 2 * ks + hh)); }
                      __builtin_amdgcn_sched_barrier(0);
                      bf16x8 Vp[2][2];
#pragma unroll
                      for (int bi = 0; bi < 2; ++bi) { Vp[bi][0] = pka(Vn[bi], 0); Vp[bi][1] = pka(Vn[bi], 8); }
                      f32x16 O2[2] = {};
#pragma unroll
                      for (int ks = 0; ks < 4; ++ks) {
                          if (ks < 2) O2[0] = MFMA32(af0[ks], Vp[ks >> 1][ks & 1], O2[0]);
                          O2[1] = MFMA32(af1[ks], Vp[ks >> 1][ks & 1], O2[1]); }
                      const unsigned ob32 = (unsigned)(((dir ? t0 + 63 - 4 * hh : t0 + 4 * hh) * D + h * 128 + 32 * w + r) * 2);
#pragma unroll
                      for (int bi = 0; bi < 2; ++bi) { f32x4 ego[4];
#pragma unroll
                          for (int q4 = 0; q4 < 4; ++q4) ego[q4] = *(const LAS f32x4*)(tab + 32 * bi + 8 * q4 + 4 * hh);
                          __builtin_amdgcn_sched_barrier(0);
#pragma unroll
                          for (int q4 = 0; q4 < 4; ++q4) { const f32x4 eg = ego[q4];
#pragma unroll
                              for (int e = 0; e < 4; ++e) { const unsigned ro = (unsigned)((32 * bi + 8 * q4 + e) * D * 2);
                                  *(bf16_t*)((char*)OB + (dir ? ob32 - ro : ob32 + ro)) = (bf16_t)(pk2(O2[bi][4 * q4 + e] + eg[e] * O1[bi][4 * q4 + e], 0.f) & 0xffffu); } } } }
                    { bf16x8 Vs[2][2];
                      f32x4 edv[2][4]; const float gl = tab[192];
#pragma unroll
                      for (int bi = 0; bi < 2; ++bi)
#pragma unroll
                          for (int q4 = 0; q4 < 4; ++q4) edv[bi][q4] = *(const LAS f32x4*)(tab + 64 + 32 * bi + 8 * q4 + 4 * hh);
                      __builtin_amdgcn_sched_barrier(0);
#pragma unroll
                      for (int bi = 0; bi < 2; ++bi) { f32x16 T2;
#pragma unroll
                          for (int q4 = 0; q4 < 4; ++q4) { const f32x4 ed = edv[bi][q4];
#pragma unroll
                              for (int e = 0; e < 4; ++e) T2[4 * q4 + e] = Vn[bi][4 * q4 + e] * ed[e]; }
                          Vs[bi][0] = pka(T2, 0); Vs[bi][1] = pka(T2, 8); }
#pragma unroll
                      for (int kb = 0; kb < 4; ++kb)
#pragma unroll
                          for (int reg = 0; reg < 16; ++reg) S[kb][reg] *= gl;
                      asm volatile("s_waitcnt lgkmcnt(0)" ::: "memory"); __builtin_amdgcn_sched_barrier(0);
                      S2_KT_MMA(0);
                      __builtin_amdgcn_sched_barrier(0);
                      S2_KT_ISSUE(2);
                      asm volatile("s_waitcnt lgkmcnt(0)" ::: "memory"); __builtin_amdgcn_sched_barrier(0);
                      S2_KT_MMA(2); }
#undef S2_KT_ISSUE
#undef S2_KT_MMA
                    asm volatile("s_waitcnt lgkmcnt(0)" ::: "memory");
                }
                __builtin_amdgcn_s_barrier(); asm volatile("" ::: "memory");
            }
        }
        asm volatile("s_waitcnt vmcnt(0)" ::: "memory");
#undef S2_CK
#undef S2_FILL
    }
}
__device__ __forceinline__ void delta_out(Frame& F) {
    const Args& A = *F.a; const bf16_t* OF = RG(F, 0); const bf16_t* OBk = RG(F, 3); const bf16_t* Z = RG(F, 4); bf16_t* Y = RG(F, 5);
    const int per = (TT + F.G - 1) / F.G, r0 = F.bid * per, r1 = (r0 + per < TT) ? r0 + per : TT;
    float ng[8];
#pragma unroll
    for (int e = 0; e < 8; ++e) ng[e] = A.in[I_CNG][((8 * F.lane) & 127) + e];
    u32x4 ac[2], bc[2], zc[2], an[2], bn[2], zn[2];
#define DO_LOAD(AA, BB, ZZ, t_) do { _Pragma("unroll") for (int j = 0; j < 2; ++j) { const size_t off_ = (size_t)(t_) * D + j * 512 + 8 * F.lane; \
        AA[j] = *(const u32x4*)(OF + off_); BB[j] = *(const u32x4*)(OBk + off_); ZZ[j] = *(const u32x4*)(Z + off_); } } while (0)
    if (r0 + F.wave < r1) DO_LOAD(ac, bc, zc, r0 + F.wave);
    for (int t = r0 + F.wave; t < r1; t += NWAVES) {
        FRAME_REFRESH(F);
        if (t + NWAVES < r1) DO_LOAD(an, bn, zn, t + NWAVES);
#pragma unroll
        for (int j = 0; j < 2; ++j) { const int col = j * 512 + 8 * F.lane; const size_t off = (size_t)t * D + col;
            const u32x4 a = ac[j], bq = bc[j], z = zc[j];
            float o[8] = {bflo(a.x) + bflo(bq.x), bfhi(a.x) + bfhi(bq.x), bflo(a.y) + bflo(bq.y), bfhi(a.y) + bfhi(bq.y), bflo(a.z) + bflo(bq.z), bfhi(a.z) + bfhi(bq.z), bflo(a.w) + bflo(bq.w), bfhi(a.w) + bfhi(bq.w)};
            const float zz[8] = {bflo(z.x), bfhi(z.x), bflo(z.y), bfhi(z.y), bflo(z.z), bfhi(z.z), bflo(z.w), bfhi(z.w)};
            float ss = 0.f;
#pragma unroll
            for (int e = 0; e < 8; ++e) ss += o[e] * o[e];
            ss = sum16(ss); const float rs = 1.f / sqrtf(ss * (1.f / 128.f) + EPS);
#pragma unroll
            for (int e = 0; e < 8; ++e) o[e] = o[e] * rs * ng[e] * siluf_(zz[e]);
            *(u32x4*)(Y + off) = (u32x4){pk2(o[0], o[1]), pk2(o[2], o[3]), pk2(o[4], o[5]), pk2(o[6], o[7])}; }
#pragma unroll
        for (int j = 0; j < 2; ++j) { ac[j] = an[j]; bc[j] = bn[j]; zc[j] = zn[j]; }
    }
#undef DO_LOAD
}

__global__ void __launch_bounds__(NTHR, 2) hybrid_fwd(Args args) {
    extern __shared__ __attribute__((aligned(16))) unsigned char lds[];
    Frame F;
    F.lds = (LAS unsigned char*)lds; F.ldsg = (char*)lds;
    F.wave = __builtin_amdgcn_readfirstlane((int)threadIdx.x >> 6);
#define REFRESH() FRAME_REFRESH(F)
    REFRESH();
    F.bid = blockIdx.x; F.G = gridDim.x; F.gw = F.bid * NWAVES + F.wave; F.NGW = F.G * NWAVES;
    F.a = &args; F.ws = args.ws; F.out = args.out;
    volatile LAS unsigned* MISC = (volatile LAS unsigned*)(F.lds + MISC_OFF);
    if (F.tid < 4) MISC[F.tid] = 0u;
    __syncthreads();
    const int lo = args.ph_lo, hi = args.ph_hi;
    XcdBarrier bar; bar.bar = (unsigned*)(args.ws + WS_CTL) + CW_BAR; bar.x = 0; bar.st = MISC;
    if (hi - lo > 1) bar = xcd_barrier_post((unsigned*)(args.ws + WS_CTL) + CW_BAR, MISC, F.tid);
    int ph = 0;
#ifndef PHMASK
#define PHMASK 0xFFFFFFFFu
#endif
#ifndef REPMASK
#define REPMASK 0u
#endif
#define PHASE_BEGIN(cls) if (((PHMASK >> (cls)) & 1u) && ph >= lo && ph < hi) { PH_T0(cls); for (int rep_ = 0; rep_ < 1 + (int)((REPMASK >> (cls)) & 1u); ++rep_) { REFRESH();
#if PROBE_T == 4
    unsigned long long pht0_ = 0; int phc_ = -1;
#define PH_T0(cls) do { phc_ = (cls); if ((cls) == PROBE_SITE) pht0_ = __builtin_amdgcn_s_memrealtime(); } while (0)
#define PH_T1() do { if (phc_ == PROBE_SITE) { asm volatile("s_waitcnt vmcnt(0) lgkmcnt(0)" ::: "memory"); __syncthreads(); if (blockIdx.x == 7 && F.wave == 0 && F.lane == 0) { unsigned long long* dg_ = (unsigned long long*)(F.ws + WS_CTL + 512 * 1024); dg_[3] += __builtin_amdgcn_s_memrealtime() - pht0_; dg_[2] += 1ull; } } } while (0)
#else
#define PH_T0(cls) do { } while (0)
#define PH_T1() do { } while (0)
#endif
#if PROBE_T == 5
#define BAR_T(stmt) do { const unsigned long long b0_ = __builtin_amdgcn_s_memrealtime(); stmt; if (blockIdx.x == PROBE_SITE && F.wave == 0 && F.lane == 0) { unsigned long long* dg_ = (unsigned long long*)(F.ws + WS_CTL + 512 * 1024); dg_[3] += __builtin_amdgcn_s_memrealtime() - b0_; dg_[2] = 1ull; } } while (0)
#else
#define BAR_T(stmt) do { stmt; } while (0)
#endif
#define PHASE_END   } PH_T1(); if (ph + 1 < hi) { REFRESH(); BAR_T(xcd_barrier(bar, F.tid)); } } ++ph;
    const Args& A = args;
    bf16_t* hctx = (bf16_t*)(F.ws + WS_HCTX); bf16_t* hlat = hlat_base(F);

    PHASE_BEGIN(0) p0_prologue(F); PHASE_END
    PHASE_BEGIN(1) p1_init(F); PHASE_END

#define DBGP(site) ((PROBE_T && (site) == PROBE_SITE) ? (unsigned long long*)(F.ws + WS_CTL + 512 * 1024) : (unsigned long long*)nullptr)
#define GEMM_DENSE(EPI, Aptr, Bptr, M_, N_, K_, SITE_) do { pg8::Gemm g_{(Aptr), (Bptr), (M_), (N_), (K_), 0, DBGP(SITE_)}; pg8::StaticOrder S_; S_.init((M_), (N_), F.G, F.bid); \
        pg8::gemm_phase(F.lds, g_, S_, EPI, F.tid); } while (0)
#define MOE_LAYER(layer, last) do { const int nrows_ = (last) ? TLAT : TT; \
        PHASE_BEGIN(5) moe_route(F, (layer), nrows_, (last)); PHASE_END \
        PHASE_BEGIN(7) if (!(rep_ && (last))) { moe_tables(F, (layer)); pg8::Gemm g_{RG(F, 0), (const bf16_t*)(F.ws + WS_WE1), TT, 1024, D, (size_t)D * D * 2, DBGP(40 + (layer))}; \
            pg8::GroupedOrder S_{(const LAS int*)(F.lds + GTAB_OFF), (const LAS int*)(F.lds + GTAB_OFF) + 32, F.G, F.bid}; moe_toktable(F, S_); EpiGateUp E_{rep_ ? RG(F, 6) : (bf16_t*)(F.ws + WS_HID)}; \
            pg8::gemm_phase_gather(F.lds, g_, S_, E_, F.tid, (const LAS int*)(F.lds + GTOK_OFF)); } PHASE_END \
        PHASE_BEGIN(8) if (!(rep_ && (last))) { moe_tables(F, (layer)); pg8::Gemm g_{(const bf16_t*)(F.ws + WS_HID), (const bf16_t*)(F.ws + WS_WE2), XS_ROWS, 1024, DE, (size_t)D * DE * 2, DBGP(50 + (layer))}; \
            pg8::GroupedOrder S_{(const LAS int*)(F.lds + GTAB_OFF), (const LAS int*)(F.lds + GTAB_OFF) + 32, F.G, F.bid}; moe_dsttable(F, S_); EpiDown E_{rep_ ? RG(F, 6) : (bf16_t*)(F.ws + WS_Y2), (const LAS int*)(F.lds + GTOK_OFF), (const LAS float*)(F.lds + GTOK_OFF + GTOK_MAXU * 1024)}; pg8::gemm_phase(F.lds, g_, S_, E_, F.tid); } PHASE_END \
        PHASE_BEGIN(9) moe_ln2(F, (layer), nrows_, (last)); PHASE_END } while (0)
#define ATTN_LAYER(layer, j, last) do { \
        PHASE_BEGIN(2) { pg8::Gemm g_{RG(F, 0), (const bf16_t*)(F.ws + WS_WQKV) + (size_t)(j) * 1536 * D, TT, 1536, D, 0, DBGP(10 + (layer))}; pg8::StaticOrder S_; S_.init(TT, 1536, F.G, F.bid); \
            EpiQKV E_{RG(F, 1), RG(F, 2), (bf16_t*)((char*)RG(F, 2) + 17 * MiB)}; pg8::gemm_phase(F.lds, g_, S_, E_, F.tid); VM_WAIT(); __syncthreads(); qk_norm_rope(F, (j), S_); } PHASE_END \
        PHASE_BEGIN(3) attn_phase(F, !(last), rep_ ? RG(F, 5) : RG(F, 1), (j)); PHASE_END \
        PHASE_BEGIN(4) { EpiResid E_{rep_ ? RG(F, 6) : hlat, rep_ ? RG(F, 3) : hctx, modrow(F, (layer), 0) + 2048}; GEMM_DENSE(E_, RG(F, 1), (const bf16_t*)(F.ws + WS_WO) + (size_t)(j) * D * D, (last) ? TLAT : TT, D, D, 20 + (layer)); if (!rep_) moe_convert(F, (layer), (last) ? 0 : 16); } PHASE_END } while (0)

    ATTN_LAYER(0, 0, false);
    MOE_LAYER(0, false);
    PHASE_BEGIN(10) { EpiGelu E_{RG(F, 1), (f32x2*)(F.ws + WS_AB)}; GEMM_DENSE(E_, RG(F, 0), (const bf16_t*)(F.ws + WS_BWIN), TT, 2048, D, 30); } PHASE_END
    PHASE_BEGIN(11) gmlp_spatial(F); PHASE_END
    PHASE_BEGIN(4) { EpiResid E_{rep_ ? RG(F, 6) : hlat, rep_ ? RG(F, 3) : hctx, modrow(F, 1, 0) + 2048}; GEMM_DENSE(E_, RG(F, 0), (const bf16_t*)(F.ws + WS_BWOUT), TT, D, D, 21); if (!rep_) moe_convert(F, 1, 16); } PHASE_END
    MOE_LAYER(1, false);
    PHASE_BEGIN(12) { EpiDeltaIn E_{RG(F, 1), (float*)(F.ws + WS_AB)}; GEMM_DENSE(E_, RG(F, 0), (const bf16_t*)(F.ws + WS_CWIN), TT, CW_NPAD, D, 31); } PHASE_END
    PHASE_BEGIN(13) delta_prep(F); PHASE_END
    PHASE_BEGIN(14) delta_local(F); PHASE_END
    PHASE_BEGIN(15) delta_scan2(F); PHASE_END
    PHASE_BEGIN(16) delta_out(F); PHASE_END
    PHASE_BEGIN(4) { EpiResid E_{rep_ ? RG(F, 6) : hlat, rep_ ? RG(F, 3) : hctx, modrow(F, 2, 0) + 2048}; GEMM_DENSE(E_, RG(F, 5), (const bf16_t*)(F.ws + WS_CWOUT), TT, D, D, 22); if (!rep_) moe_convert(F, 2, 16); } PHASE_END
    MOE_LAYER(2, false);
    ATTN_LAYER(3, 1, true);
    MOE_LAYER(3, true);
    (void)A;
}
constexpr int NPHASES = 2 + (3 + 4) + (3 + 4) + (6 + 4) + (3 + 4);

extern "C" void kernel_launch(void* const* d_in, const int* in_sizes, int n_in, void* d_out, int out_size, void* d_ws, size_t ws_size, hipStream_t stream) {
    static int grid = 0;
    if (grid == 0) {
        if (n_in != 29 || out_size != TLAT * D || ws_size < WS_END) { fprintf(stderr, "kernel_launch: unexpected shapes: n_in %d out %d ws %zu (need %zu)\n", n_in, out_size, ws_size, (size_t)WS_END); grid = -1; return; }
        int dev = 0, cus = 0, per_cu = 0;
        if (hipGetDevice(&dev) != hipSuccess || hipDeviceGetAttribute(&cus, hipDeviceAttributeMultiprocessorCount, dev) != hipSuccess) { grid = -1; return; }
        if (hipFuncSetAttribute((const void*)hybrid_fwd, hipFuncAttributeMaxDynamicSharedMemorySize, LDS_BYTES) != hipSuccess) { fprintf(stderr, "kernel_launch: hipFuncSetAttribute failed\n"); grid = -1; return; }
        if (hipOccupancyMaxActiveBlocksPerMultiprocessor(&per_cu, (const void*)hybrid_fwd, NTHR, LDS_BYTES) != hipSuccess || per_cu < 1) fprintf(stderr, "kernel_launch: occupancy query says %d\n", per_cu);
        (void)hipGetLastError();
        grid = cus < 256 ? cus : 256;
    }
    if (grid < 0) return;
    (void)hipMemsetAsync((char*)d_ws + WS_CTL, 0, CTL_ZERO_BYTES, stream);
    Args a{};
    for (int i = 0; i < 29; ++i) a.in[i] = (const float*)d_in[i];
    a.out = (float*)d_out; a.ws = (unsigned char*)d_ws;
#if MK_ONE_LAUNCH
    a.ph_lo = 0; a.ph_hi = NPHASES;
    hipLaunchKernelGGL(hybrid_fwd, dim3(grid), dim3(NTHR), LDS_BYTES, stream, a);
#else
    for (int p = 0; p < NPHASES; ++p) { a.ph_lo = p; a.ph_hi = p + 1; hipLaunchKernelGGL(hybrid_fwd, dim3(grid), dim3(NTHR), LDS_BYTES, stream, a); }
#endif
    const hipError_t le = hipPeekAtLastError();
    if (le != hipSuccess) fprintf(stderr, "kernel_launch: launch failed: %s\n", hipGetErrorName(le));
}
```

```cpp
#include <hip/hip_runtime.h>
#include <cstdio>
#include <cstdint>

#ifndef PROBE_T
#define PROBE_T 0
#endif
#ifndef PROBE_SITE
#define PROBE_SITE 0
#endif
#ifndef MK_ONE_LAUNCH
#define MK_ONE_LAUNCH 1
#endif

#define GAS __attribute__((address_space(1)))
#define LAS __attribute__((address_space(3)))
typedef unsigned short bf16_t;
typedef short bf16x8 __attribute__((ext_vector_type(8)));
typedef short s16x4 __attribute__((ext_vector_type(4)));
typedef float f32x2 __attribute__((ext_vector_type(2)));
typedef float f32x4 __attribute__((ext_vector_type(4)));
typedef float f32x8 __attribute__((ext_vector_type(8)));
typedef float f32x16 __attribute__((ext_vector_type(16)));
typedef unsigned u32x2 __attribute__((ext_vector_type(2)));
typedef unsigned u32x4 __attribute__((ext_vector_type(4)));
typedef int i32x2 __attribute__((ext_vector_type(2)));
typedef __bf16 bf16x2_t __attribute__((ext_vector_type(2)));

constexpr int D = 1024, NBATCH = 4, SEQ = 8192, CTXL = 256;
constexpr int TLAT = NBATCH * SEQ, TCTX = NBATCH * CTXL, TT = TLAT + TCTX;
constexpr int KVLEN = CTXL + SEQ;
constexpr int NE = 16, DE = 512, NLAYER = 4;
constexpr int CW_N = 4128, CW_NPAD = 4352;
constexpr float DN_ALPHA = 1.6817928305074292f;
constexpr float EPS = 1e-6f;
constexpr int XS_ROWS = 2 * TT + NE * 256;
constexpr int NWAVES = 8, NTHR = 512;

constexpr size_t MiB = 1u << 20;
constexpr size_t WS_CTL = 0, CTL_ZERO_BYTES = 1 * MiB;
constexpr size_t WS_MOD = 1 * MiB;
constexpr size_t WS_ROPE = 2 * MiB;
constexpr size_t WS_HCTX = 6 * MiB;
constexpr size_t WS_ASG = 10 * MiB;
constexpr size_t WS_ASGW = WS_ASG + 512 * 1024;
constexpr size_t WS_POS = WS_ASGW + 512 * 1024;
constexpr size_t WS_ROWMAP = WS_POS + 512 * 1024;
constexpr size_t WS_ROWW = WS_ROWMAP + 512 * 1024;
constexpr size_t WS_WLIST = 10 * MiB;
constexpr size_t WS_LIST = 23 * MiB + 512 * 1024;
constexpr size_t WS_AB = 13 * MiB;
constexpr size_t WS_GC = 18 * MiB;
constexpr size_t WS_BETA = 21 * MiB;
constexpr size_t WS_WQKV = 26 * MiB;
constexpr size_t WS_WO = 32 * MiB;
constexpr size_t WS_BWIN = 36 * MiB;
constexpr size_t WS_BWOUT = 40 * MiB;
constexpr size_t WS_BWS = 42 * MiB;
constexpr size_t WS_CWIN = 43 * MiB;
constexpr size_t WS_CWOUT = 52 * MiB;
constexpr size_t WS_WE1 = 54 * MiB;
constexpr size_t WS_WE2 = 86 * MiB;
constexpr size_t WS_R0 = 102 * MiB, RSZ = 66 * MiB;
constexpr size_t WS_END = WS_R0 + 8 * RSZ;
constexpr size_t WS_XS = WS_R0, WS_HID = WS_R0 + 140 * MiB, WS_Y2 = WS_R0 + 4 * RSZ;
static_assert((size_t)XS_ROWS * 2048 <= 140 * MiB && (size_t)XS_ROWS * 1024 <= 70 * MiB && WS_HID + 70 * MiB <= WS_Y2, "moe overlay");
static_assert((size_t)TT * D * 2 == RSZ, "region size");

constexpr int CW_BAR = 4096;
constexpr int CW_CNT = 16384;

constexpr int LDS_BYTES = 155648;
constexpr int MISC_OFF = LDS_BYTES - 512;
constexpr int GTAB_OFF = 131072;   constexpr int GTOK_OFF = GTAB_OFF + 1024, GTOK_MAXU = 10;
static_assert(GTOK_OFF + GTOK_MAXU * 2048 <= MISC_OFF, "token / destination tables");
constexpr int XX_DUMMY = 0;

#define RLX_AGENT __ATOMIC_RELAXED, __HIP_MEMORY_SCOPE_AGENT
#define LDS_WAIT() asm volatile("s_waitcnt lgkmcnt(0)" ::: "memory")
#define VM_WAIT() asm volatile("s_waitcnt vmcnt(0)" ::: "memory")
__device__ __forceinline__ unsigned pk2(float lo, float hi) { f32x2 v = {lo, hi}; bf16x2_t b = __builtin_convertvector(v, bf16x2_t); return __builtin_bit_cast(unsigned, b); }
__device__ __forceinline__ float bflo(unsigned w) { return __uint_as_float(w << 16); }
__device__ __forceinline__ float bfhi(unsigned w) { return __uint_as_float(w & 0xffff0000u); }
__device__ __forceinline__ float bf1(bf16_t b) { return __uint_as_float((unsigned)b << 16); }
__device__ __forceinline__ float wave_sum(float v) {
#pragma unroll
    for (int o = 1; o < 64; o <<= 1) v += __shfl_xor(v, o);
    return v;
}
__device__ __forceinline__ float sum16(float v) {
#pragma unroll
    for (int o = 1; o < 16; o <<= 1) v += __shfl_xor(v, o);
    return v;
}
__device__ __forceinline__ float sigmoidf_(float x) { return 1.f / (1.f + __expf(-x)); }
__device__ __forceinline__ float siluf_(float x) { return x * __builtin_amdgcn_rcpf(1.f + __builtin_amdgcn_exp2f(-1.4426950408889634f * x)); }
__device__ __forceinline__ int crow(int r, int hi) { return (r & 3) + 8 * (r >> 2) + 4 * hi; }
__device__ __forceinline__ bf16x8 mk8(u32x2 lo, u32x2 hi) { u32x4 w = {lo.x, lo.y, hi.x, hi.y}; return __builtin_bit_cast(bf16x8, w); }
__device__ __forceinline__ bf16x8 mk8w(unsigned a, unsigned b, unsigned c, unsigned d) { u32x4 w = {a, b, c, d}; return __builtin_bit_cast(bf16x8, w); }
#define MFMA32(a, b, c) __builtin_amdgcn_mfma_f32_32x32x16_bf16((a), (b), (c), 0, 0, 0)

#define XB_TMO      128
#define XB_XCNT(j)  (256  + 64 * (j))
#define XB_XSUB(j)  (1280 + 64 * (j))
#define XB_XGEN(j)  (2304 + 64 * (j))
#define XB_TOP      3328
#define XB_TOPGEN   3392
#define XCD_BAR_WORDS 3456
#define XB_SPIN_CAP (1u << 18)

__device__ __forceinline__ unsigned xb_ld(unsigned* p)              { return __hip_atomic_load(p, __ATOMIC_RELAXED, __HIP_MEMORY_SCOPE_AGENT); }
__device__ __forceinline__ unsigned xb_add(unsigned* p, unsigned v) { return __hip_atomic_fetch_add(p, v, __ATOMIC_RELAXED, __HIP_MEMORY_SCOPE_AGENT); }
__device__ __forceinline__ unsigned xb_xcc_id() { return (unsigned)__builtin_amdgcn_s_getreg((3 << 11) | 20) & 0xFu; }
#define XB_SPIN(cond, bar) do { unsigned _sp = 0; while (cond) { __builtin_amdgcn_s_sleep(1); \
    if ((++_sp & 255u) == 0u) { if (xb_ld(&(bar)[XB_TMO])) break; if (_sp > XB_SPIN_CAP) { atomicAdd(&(bar)[XB_TMO], 1u); break; } } } } while (0)

struct XcdBarrier {
    unsigned* bar; unsigned x;
    volatile LAS unsigned* st;
};
__device__ __forceinline__ XcdBarrier xcd_barrier_post(unsigned* bar, volatile LAS unsigned* st, int tid) {
    XcdBarrier b; b.bar = bar; b.x = xb_xcc_id(); b.st = st;
    if (tid == 0) (void)xb_add(&bar[XB_XCNT(b.x)], 1u);
    return b;
}
__device__ __forceinline__ void xcd_barrier_complete(unsigned* bar, unsigned x, unsigned& nloc, unsigned& nx) {
    const unsigned G = gridDim.x * gridDim.y * gridDim.z;
    unsigned sum, cnt, mine, sp = 0u;
    for (;;) {
        sum = 0u; cnt = 0u; mine = 0u;
#pragma unroll
        for (unsigned j = 0; j < 16; ++j) { const unsigned c = xb_ld(&bar[XB_XCNT(j)]); sum += c; cnt += (c > 0u) ? 1u : 0u; mine = (j == x) ? c : mine; }
        if (sum == G) break;
        __builtin_amdgcn_s_sleep(1);
        if ((++sp & 255u) == 0u) { if (xb_ld(&bar[XB_TMO])) break; if (sp > XB_SPIN_CAP) { atomicAdd(&bar[XB_TMO], 1u); break; } }
    }
    nloc = mine > 0u ? mine : 1u; nx = cnt > 0u ? cnt : 1u;
}
__device__ __forceinline__ void xcd_barrier(const XcdBarrier& b, int tid) {
    asm volatile("s_waitcnt vmcnt(0)" ::: "memory");
    __syncthreads();
    if (tid == 0) {
        unsigned* bar = b.bar;
        __builtin_amdgcn_s_waitcnt(0);
        unsigned nloc = b.st[0], nx = b.st[1];
        if (nloc == 0u) { xcd_barrier_complete(bar, b.x, nloc, nx); b.st[0] = nloc; b.st[1] = nx; }
        const unsigned old = xb_add(&bar[XB_XSUB(b.x)], 1u);
        const unsigned gen = old / nloc;
        if (old + 1u == (gen + 1u) * nloc) {
            __builtin_amdgcn_fence(__ATOMIC_RELEASE, "agent");
            asm volatile("s_waitcnt vmcnt(0)" ::: "memory");
            const unsigned og = xb_add(&bar[XB_TOP], 1u);
            const unsigned tg = og / nx;
            if (og + 1u == (tg + 1u) * nx) xb_add(&bar[XB_TOPGEN], 1u);
            else XB_SPIN(xb_ld(&bar[XB_TOPGEN]) == tg, bar);
            __builtin_amdgcn_fence(__ATOMIC_ACQUIRE, "agent");
            xb_add(&bar[XB_XGEN(b.x)], 1u);
            asm volatile("s_waitcnt vmcnt(0)" ::: "memory");
        } else {
            XB_SPIN(xb_ld(&bar[XB_XGEN(b.x)]) == gen, bar);
            __builtin_amdgcn_fence(__ATOMIC_ACQUIRE, "agent");
            asm volatile("s_waitcnt vmcnt(0)" ::: "memory");
        }
    }
    __syncthreads();
}

namespace pg8 {
constexpr int BM = 256, BK = 64, HALF = 128, HTB = HALF * BK * 2, STAGE_BYTES = 8 * HTB, NXCD = 8, WGM = 8;
__host__ __device__ __forceinline__ int lds_byte(int r, int c) { const int st = (r >> 4) * 2 + (c >> 5), rr = r & 15, cc = c & 31, ob = rr * 64 + cc * 2; return st * 1024 + (ob ^ (((ob >> 9) & 1) << 5)); }
__host__ __device__ __forceinline__ void stage_rc(int b, int& R, int& C) { const int st = b / 1024, sb = b % 1024, swz = sb ^ (((sb >> 9) & 1) << 5); R = (st >> 1) * 16 + swz / 64; C = (st & 1) * 32 + (swz % 64) / 2; }
__host__ __device__ __forceinline__ int perm32(int rho) { const int n = rho >> 4, i = rho & 15; return 8 * (i >> 2) + 4 * n + (i & 3); }

struct Unit { int pm, pn, e, nvalid, lbase, ord; };
struct Gemm { const bf16_t* A; const bf16_t* Bt; int M, N, K; size_t bstride; unsigned long long* dbg; };

struct StaticOrder {
    int nM, nN, nwg, G, c;
    __device__ void init(int M, int N, int G_, int c_) { nM = M / BM; nN = N / BM; nwg = nM * nN; G = G_; c = c_; }
    __device__ bool next(int i, Unit& u) const {
        const long L = (long)i * G + c; if (L >= nwg) return false;
        int wgid = (int)L; { const int q = nwg / NXCD, r = nwg % NXCD, xcd = wgid % NXCD, off = wgid / NXCD; wgid = (xcd < r ? xcd * (q + 1) : r * (q + 1) + (xcd - r) * q) + off; }
        const int nig = WGM * nN, gid = wgid / nig, fm = gid * WGM, gsz = (nM - fm) < WGM ? (nM - fm) : WGM;
        u.pm = fm + ((wgid % nig) % gsz); u.pn = (wgid % nig) / gsz; u.e = 0; u.nvalid = 256; u.lbase = 0; u.ord = i; return true;
    }
};
struct GroupedOrder {
    const LAS int* TS; const LAS int* CNT; int G, c;
    __device__ bool next(int i, Unit& u) const {
        int rt, pnn;
        if ((G & 7) == 0) { const int x = c & 7, q = i * (G >> 3) + (c >> 3); rt = (q >> 2) * 8 + x; pnn = q & 3; }
        else { const int L = i * G + c; rt = L >> 2; pnn = L & 3; }
        if (rt >= TS[NE]) return false;
        const int L = pnn; int e = 0;
#pragma unroll 1
        while (rt >= TS[e + 1]) ++e;
        u.pm = rt; u.pn = L & 3; u.e = e; const int tin = rt - TS[e]; u.nvalid = CNT[e] - tin * 256; u.lbase = e * TT + tin * 256; u.ord = i; return true;
    }
};

template <class Epi, class Sched>
__device__ __forceinline__ void gemm_phase(LAS unsigned char* lds, const Gemm g, const Sched& S, const Epi& E, const int tid) {
    const int wid = __builtin_amdgcn_readfirstlane(tid >> 6), lane = tid & 63, wr = wid >> 2, wc = wid & 3, fr = lane & 15, fq = lane >> 4;
    const int K = g.K, nt = K / BK;
    unsigned voffA[2], voffB[2];
#pragma unroll
    for (int i = 0; i < 2; ++i) { int R, C; stage_rc(tid * 16 + i * 8192, R, C); const int Rb = Epi::PERM ? ((R & ~31) + perm32(R & 31)) : R;
        voffA[i] = (unsigned)(R * K + C) * 2u; voffB[i] = (unsigned)(Rb * K + C) * 2u; }
    const size_t kstep = (size_t)(BK * 2);
    const size_t hstep = (size_t)HALF * K * 2;
    const size_t tstep = 2 * hstep;
    const unsigned ldsw = (unsigned)wid * 1024u;
    const int aoff = lds_byte(wr * 64 + fr, fq * 8), boff = lds_byte(wc * 32 + fr, fq * 8);
#define PG8_SA(b, h) (((b) * 2 + (h)) * HTB)
#define PG8_SB(b, h) ((4 + (b) * 2 + (h)) * HTB)
#define PG8_STAGE(bufoff, gbase, voff) do { _Pragma("unroll") for (int _i = 0; _i < 2; ++_i) \
        __builtin_amdgcn_global_load_lds((const unsigned*)((const char*)(gbase) + (voff)[_i]), (LAS unsigned*)(lds + (bufoff) + ldsw + _i * 8192), 16, 0, 0); } while (0)
#define PG8_LDA(dst, b, h) do { _Pragma("unroll") for (int m = 0; m < 4; ++m) _Pragma("unroll") for (int k = 0; k < 2; ++k) dst[m][k] = *(const LAS bf16x8*)(lds + PG8_SA(b, h) + aoff + m * 2048 + k * 1024); } while (0)
#define PG8_LDB(dst, b, h) do { _Pragma("unroll") for (int n = 0; n < 2; ++n) _Pragma("unroll") for (int k = 0; k < 2; ++k) dst[n][k] = *(const LAS bf16x8*)(lds + PG8_SB(b, h) + boff + n * 2048 + k * 1024); } while (0)
#define PG8_MMA(ai, bj, At, Bt) do { __builtin_amdgcn_s_setprio(1); _Pragma("unroll") for (int m = 0; m < 4; ++m) _Pragma("unroll") for (int n = 0; n < 2; ++n) _Pragma("unroll") for (int k = 0; k < 2; ++k) \
        acc[ai][bj][m][n] = __builtin_amdgcn_mfma_f32_16x16x32_bf16(Bt[n][k], At[m][k], acc[ai][bj][m][n], 0, 0, 0); __builtin_amdgcn_s_setprio(0); } while (0)
#define PG8_WAIT_V(n) asm volatile("s_waitcnt vmcnt(" #n ")" ::: "memory")
#define PG8_WAIT_L(n) asm volatile("s_waitcnt lgkmcnt(" #n ")" ::: "memory")
#define PG8_BAR __builtin_amdgcn_s_barrier()
#define PG8_SCHED __builtin_amdgcn_sched_barrier(0)
    Unit cur, nxt; int ui = 0;
#if PROBE_T
    unsigned long long tk_ = 0, te_ = 0, tt0_ = __builtin_amdgcn_s_memrealtime(), ta_ = 0, tb_ = 0; int nu_ = 0;
#endif
    if (!S.next(0, cur)) return;
    f32x4 acc[2][2][4][2];
#pragma unroll
    for (int a = 0; a < 2; ++a)
#pragma unroll
        for (int b = 0; b < 2; ++b)
#pragma unroll
            for (int m = 0; m < 4; ++m)
#pragma unroll
                for (int n = 0; n < 2; ++n) acc[a][b][m][n] = (f32x4){0.f, 0.f, 0.f, 0.f};
    bf16x8 At[4][2], B0[2][2], B1[2][2];
    const char* cA = (const char*)g.A + (size_t)cur.pm * tstep; const char* cB = (const char*)g.Bt + (size_t)cur.e * g.bstride + (size_t)cur.pn * tstep;
    PG8_STAGE(PG8_SB(0, 0), cB, voffB); PG8_STAGE(PG8_SB(0, 1), cB + hstep, voffB); PG8_STAGE(PG8_SA(0, 0), cA, voffA); PG8_STAGE(PG8_SA(0, 1), cA + hstep, voffA);
    if (wr == 1) PG8_BAR;
    PG8_WAIT_V(2); PG8_BAR;
    PG8_STAGE(PG8_SB(1, 0), cB + kstep, voffB); PG8_STAGE(PG8_SA(1, 0), cA + kstep, voffA); PG8_STAGE(PG8_SB(1, 1), cB + hstep + kstep, voffB);
    PG8_WAIT_V(6); PG8_BAR;
    for (;;) {
        const bool has_next = S.next(ui + 1, nxt);
        const char* nA = has_next ? (const char*)g.A + (size_t)nxt.pm * tstep : cA; const char* nB = has_next ? (const char*)g.Bt + (size_t)nxt.e * g.bstride + (size_t)nxt.pn * tstep : cB;
#if PROBE_T
        ta_ = __builtin_amdgcn_s_memrealtime();
#endif
        for (int t = 0; t < nt; t += 2) {
            const bool last = (t == nt - 2);
            const char* a1 = cA + (size_t)(t + 1) * kstep;
            const char* a2 = last ? nA : cA + (size_t)(t + 2) * kstep; const char* b2 = last ? nB : cB + (size_t)(t + 2) * kstep;
            const char* a3 = a2 + kstep; const char* b3 = b2 + kstep;
            PG8_LDB(B0, 0, 0); PG8_LDB(B1, 0, 1); PG8_SCHED; PG8_LDA(At, 0, 0); PG8_STAGE(PG8_SA(1, 1), a1 + hstep, voffA);
            PG8_WAIT_V(8); PG8_WAIT_L(0); PG8_BAR; PG8_MMA(0, 0, At, B0); PG8_MMA(0, 1, At, B1); PG8_BAR; PG8_SCHED;
            PG8_LDA(At, 0, 1); PG8_STAGE(PG8_SB(0, 0), b2, voffB); PG8_STAGE(PG8_SB(0, 1), b2 + hstep, voffB); PG8_STAGE(PG8_SA(0, 0), a2, voffA);
            PG8_WAIT_V(8); PG8_WAIT_L(0); PG8_BAR; PG8_MMA(1, 0, At, B0); PG8_MMA(1, 1, At, B1); PG8_BAR; PG8_SCHED;
            PG8_LDB(B0, 1, 0); PG8_LDB(B1, 1, 1); PG8_SCHED; PG8_LDA(At, 1, 0); PG8_STAGE(PG8_SA(0, 1), a2 + hstep, voffA);
            PG8_WAIT_V(8); PG8_WAIT_L(0); PG8_BAR; PG8_MMA(0, 0, At, B0); PG8_MMA(0, 1, At, B1); PG8_BAR; PG8_SCHED;
            PG8_LDA(At, 1, 1); PG8_STAGE(PG8_SB(1, 0), b3, voffB); PG8_STAGE(PG8_SB(1, 1), b3 + hstep, voffB); PG8_STAGE(PG8_SA(1, 0), a3, voffA);
            PG8_WAIT_V(8); PG8_WAIT_L(0); PG8_BAR; PG8_MMA(1, 0, At, B0); PG8_MMA(1, 1, At, B1); PG8_BAR; PG8_SCHED;
        }
#if PROBE_T
        tb_ = __builtin_amdgcn_s_memrealtime();
#endif
        if (wr == 0) PG8_BAR;
        E(acc, cur, wr, wc, fr, fq);
#if PROBE_T
        { const unsigned long long tc_ = __builtin_amdgcn_s_memrealtime(); tk_ += tb_ - ta_; te_ += tc_ - tb_; ++nu_; }
#endif
        if (!has_next) break;
#pragma unroll
        for (int a = 0; a < 2; ++a)
#pragma unroll
            for (int b = 0; b < 2; ++b)
#pragma unroll
                for (int m = 0; m < 4; ++m)
#pragma unroll
                    for (int n = 0; n < 2; ++n) acc[a][b][m][n] = (f32x4){0.f, 0.f, 0.f, 0.f};
        cur = nxt; cA = nA; cB = nB; ++ui;
        if (wr == 1) PG8_BAR;
    }
    PG8_WAIT_V(0);
    PG8_BAR;
#if PROBE_T
    if (g.dbg && blockIdx.x == 7 && tid == 0) { g.dbg[0] = tk_; g.dbg[1] = te_; g.dbg[2] = (unsigned long long)nu_; g.dbg[3] = __builtin_amdgcn_s_memrealtime() - tt0_; }
#endif
#undef PG8_SA
#undef PG8_SB
#undef PG8_STAGE
#undef PG8_LDA
#undef PG8_LDB
#undef PG8_MMA
#undef PG8_WAIT_V
#undef PG8_WAIT_L
#undef PG8_BAR
#undef PG8_SCHED
}
template <class Epi, class Sched>
__device__ __forceinline__ void gemm_phase_gather(LAS unsigned char* lds, const Gemm g, const Sched& S, const Epi& E, const int tid, const LAS int* toks) {
    const int wid = __builtin_amdgcn_readfirstlane(tid >> 6), lane = tid & 63, wr = wid >> 2, wc = wid & 3, fr = lane & 15, fq = lane >> 4;
    const int K = g.K, nt = K / BK;
    unsigned voffB[2]; int RA[2]; unsigned CA[2];
#pragma unroll
    for (int i = 0; i < 2; ++i) { int R, C; stage_rc(tid * 16 + i * 8192, R, C); const int Rb = Epi::PERM ? ((R & ~31) + perm32(R & 31)) : R;
        RA[i] = R; CA[i] = (unsigned)C * 2u; voffB[i] = (unsigned)(Rb * K + C) * 2u; }
    unsigned roC[2][2], roN[2][2];
#define PG8_TOKS(ro, ui_) do { _Pragma("unroll") for (int hf_ = 0; hf_ < 2; ++hf_) _Pragma("unroll") for (int i_ = 0; i_ < 2; ++i_) \
        ro[hf_][i_] = (unsigned)toks[(ui_) * 256 + hf_ * 128 + RA[i_]] * (unsigned)(K * 2) + CA[i_]; } while (0)
#define PG8_STAGE_AG(bufoff, ktb, ro) do { _Pragma("unroll") for (int _i = 0; _i < 2; ++_i) \
        __builtin_amdgcn_global_load_lds((const unsigned*)((const char*)g.A + (ktb) + (ro)[_i]), (LAS unsigned*)(lds + (bufoff) + ldsw + _i * 8192), 16, 0, 0); } while (0)
    const size_t kstep = (size_t)(BK * 2);
    const size_t hstep = (size_t)HALF * K * 2;
    const size_t tstep = 2 * hstep;
    const unsigned ldsw = (unsigned)wid * 1024u;
    const int aoff = lds_byte(wr * 64 + fr, fq * 8), boff = lds_byte(wc * 32 + fr, fq * 8);
#define PG8_SA(b, h) (((b) * 2 + (h)) * HTB)
#define PG8_SB(b, h) ((4 + (b) * 2 + (h)) * HTB)
#define PG8_STAGE(bufoff, gbase, voff) do { _Pragma("unroll") for (int _i = 0; _i < 2; ++_i) \
        __builtin_amdgcn_global_load_lds((const unsigned*)((const char*)(gbase) + (voff)[_i]), (LAS unsigned*)(lds + (bufoff) + ldsw + _i * 8192), 16, 0, 0); } while (0)
#define PG8_LDA(dst, b, h) do { _Pragma("unroll") for (int m = 0; m < 4; ++m) _Pragma("unroll") for (int k = 0; k < 2; ++k) dst[m][k] = *(const LAS bf16x8*)(lds + PG8_SA(b, h) + aoff + m * 2048 + k * 1024); } while (0)
#define PG8_LDB(dst, b, h) do { _Pragma("unroll") for (int n = 0; n < 2; ++n) _Pragma("unroll") for (int k = 0; k < 2; ++k) dst[n][k] = *(const LAS bf16x8*)(lds + PG8_SB(b, h) + boff + n * 2048 + k * 1024); } while (0)
#define PG8_MMA(ai, bj, At, Bt) do { __builtin_amdgcn_s_setprio(1); _Pragma("unroll") for (int m = 0; m < 4; ++m) _Pragma("unroll") for (int n = 0; n < 2; ++n) _Pragma("unroll") for (int k = 0; k < 2; ++k) \
        acc[ai][bj][m][n] = __builtin_amdgcn_mfma_f32_16x16x32_bf16(Bt[n][k], At[m][k], acc[ai][bj][m][n], 0, 0, 0); __builtin_amdgcn_s_setprio(0); } while (0)
#define PG8_WAIT_V(n) asm volatile("s_waitcnt vmcnt(" #n ")" ::: "memory")
#define PG8_WAIT_L(n) asm volatile("s_waitcnt lgkmcnt(" #n ")" ::: "memory")
#define PG8_BAR __builtin_amdgcn_s_barrier()
#define PG8_SCHED __builtin_amdgcn_sched_barrier(0)
    Unit cur, nxt; int ui = 0;
#if PROBE_T
    unsigned long long tk_ = 0, te_ = 0, tt0_ = __builtin_amdgcn_s_memrealtime(), ta_ = 0, tb_ = 0; int nu_ = 0;
#endif
    if (!S.next(0, cur)) return;
    f32x4 acc[2][2][4][2];
#pragma unroll
    for (int a = 0; a < 2; ++a)
#pragma unroll
        for (int b = 0; b < 2; ++b)
#pragma unroll
            for (int m = 0; m < 4; ++m)
#pragma unroll
                for (int n = 0; n < 2; ++n) acc[a][b][m][n] = (f32x4){0.f, 0.f, 0.f, 0.f};
    bf16x8 At[4][2], B0[2][2], B1[2][2];
    const char* cB = (const char*)g.Bt + (size_t)cur.e * g.bstride + (size_t)cur.pn * tstep;
    PG8_TOKS(roC, 0);
    PG8_STAGE(PG8_SB(0, 0), cB, voffB); PG8_STAGE(PG8_SB(0, 1), cB + hstep, voffB); PG8_STAGE_AG(PG8_SA(0, 0), 0, roC[0]); PG8_STAGE_AG(PG8_SA(0, 1), 0, roC[1]);
    if (wr == 1) PG8_BAR;
    PG8_WAIT_V(2); PG8_BAR;
    PG8_STAGE(PG8_SB(1, 0), cB + kstep, voffB); PG8_STAGE_AG(PG8_SA(1, 0), kstep, roC[0]); PG8_STAGE(PG8_SB(1, 1), cB + hstep + kstep, voffB);
    PG8_WAIT_V(6); PG8_BAR;
    for (;;) {
        const bool has_next = S.next(ui + 1, nxt);
        const char* nB = has_next ? (const char*)g.Bt + (size_t)nxt.e * g.bstride + (size_t)nxt.pn * tstep : cB;
        if (has_next) { PG8_TOKS(roN, ui + 1); } else {
#pragma unroll
            for (int hf_ = 0; hf_ < 2; ++hf_)
#pragma unroll
                for (int i_ = 0; i_ < 2; ++i_) roN[hf_][i_] = roC[hf_][i_]; }
#if PROBE_T
        ta_ = __builtin_amdgcn_s_memrealtime();
#endif
        for (int t = 0; t < nt; t += 2) {
            const bool last = (t == nt - 2);
            const size_t k1 = (size_t)(t + 1) * kstep, k2 = last ? (size_t)0 : (size_t)(t + 2) * kstep, k3 = k2 + kstep;
            const char* b2 = last ? nB : cB + (size_t)(t + 2) * kstep; const char* b3 = b2 + kstep;
            unsigned r20[2], r21[2];
#pragma unroll
            for (int i_ = 0; i_ < 2; ++i_) { r20[i_] = last ? roN[0][i_] : roC[0][i_]; r21[i_] = last ? roN[1][i_] : roC[1][i_]; }
            PG8_LDB(B0, 0, 0); PG8_LDB(B1, 0, 1); PG8_SCHED; PG8_LDA(At, 0, 0); PG8_STAGE_AG(PG8_SA(1, 1), k1, roC[1]);
            PG8_WAIT_V(8); PG8_WAIT_L(0); PG8_BAR; PG8_MMA(0, 0, At, B0); PG8_MMA(0, 1, At, B1); PG8_BAR; PG8_SCHED;
            PG8_LDA(At, 0, 1); PG8_STAGE(PG8_SB(0, 0), b2, voffB); PG8_STAGE(PG8_SB(0, 1), b2 + hstep, voffB); PG8_STAGE_AG(PG8_SA(0, 0), k2, r20);
            PG8_WAIT_V(8); PG8_WAIT_L(0); PG8_BAR; PG8_MMA(1, 0, At, B0); PG8_MMA(1, 1, At, B1); PG8_BAR; PG8_SCHED;
            PG8_LDB(B0, 1, 0); PG8_LDB(B1, 1, 1); PG8_SCHED; PG8_LDA(At, 1, 0); PG8_STAGE_AG(PG8_SA(0, 1), k2, r21);
            PG8_WAIT_V(8); PG8_WAIT_L(0); PG8_BAR; PG8_MMA(0, 0, At, B0); PG8_MMA(0, 1, At, B1); PG8_BAR; PG8_SCHED;
            PG8_LDA(At, 1, 1); PG8_STAGE(PG8_SB(1, 0), b3, voffB); PG8_STAGE(PG8_SB(1, 1), b3 + hstep, voffB); PG8_STAGE_AG(PG8_SA(1, 0), k3, r20);
            PG8_WAIT_V(8); PG8_WAIT_L(0); PG8_BAR; PG8_MMA(1, 0, At, B0); PG8_MMA(1, 1, At, B1); PG8_BAR; PG8_SCHED;
        }
#if PROBE_T
        tb_ = __builtin_amdgcn_s_memrealtime();
#endif
        if (wr == 0) PG8_BAR;
        E(acc, cur, wr, wc, fr, fq);
#if PROBE_T
        { const unsigned long long tc_ = __builtin_amdgcn_s_memrealtime(); tk_ += tb_ - ta_; te_ += tc_ - tb_; ++nu_; }
#endif
        if (!has_next) break;
#pragma unroll
        for (int a = 0; a < 2; ++a)
#pragma unroll
            for (int b = 0; b < 2; ++b)
#pragma unroll
                for (int m = 0; m < 4; ++m)
#pragma unroll
                    for (int n = 0; n < 2; ++n) acc[a][b][m][n] = (f32x4){0.f, 0.f, 0.f, 0.f};
        cur = nxt; cB = nB; ++ui;
#pragma unroll
        for (int hf_ = 0; hf_ < 2; ++hf_)
#pragma unroll
            for (int i_ = 0; i_ < 2; ++i_) roC[hf_][i_] = roN[hf_][i_];
        if (wr == 1) PG8_BAR;
    }
    PG8_WAIT_V(0);
    PG8_BAR;
#if PROBE_T
    if (g.dbg && blockIdx.x == 7 && tid == 0) { g.dbg[0] = tk_; g.dbg[1] = te_; g.dbg[2] = (unsigned long long)nu_; g.dbg[3] = __builtin_amdgcn_s_memrealtime() - tt0_; }
#endif
#undef PG8_TOKS
#undef PG8_STAGE_AG
#undef PG8_SA
#undef PG8_SB
#undef PG8_STAGE
#undef PG8_LDA
#undef PG8_LDB
#undef PG8_MMA
#undef PG8_WAIT_V
#undef PG8_WAIT_L
#undef PG8_BAR
#undef PG8_SCHED
}
}
using pg8::Unit;

typedef f32x4 AccT[2][2][4][2];

__device__ __forceinline__ u32x4 pack8(const f32x4 a, const f32x4 b) { u32x4 w; w.x = pk2(a[0], a[1]); w.y = pk2(a[2], a[3]); w.z = pk2(b[0], b[1]); w.w = pk2(b[2], b[3]); return w; }
struct EpiResid {
    static constexpr bool PERM = true;
    bf16_t* hlat; bf16_t* hctx; const float* gate;
    __device__ __forceinline__ void operator()(const AccT& acc, const Unit& u, int wr, int wc, int fr, int fq) const {
        const int mi = u.pm < 128 ? (u.pm >> 5) : 4;
        bf16_t* hb = u.pm < 128 ? hlat + (size_t)u.pm * 256 * D : hctx + (size_t)(u.pm - 128) * 256 * D;
        const int col0 = u.pn * 256 + wc * 32 + 8 * fq;
        const float* g = gate + mi * 6144 + col0;
        f32x4 gv[2][2];
#pragma unroll
        for (int bj = 0; bj < 2; ++bj)
#pragma unroll
            for (int n = 0; n < 2; ++n) gv[bj][n] = *(const f32x4*)(g + bj * 128 + n * 4);
#pragma unroll
        for (int ai = 0; ai < 2; ++ai)
#pragma unroll
            for (int m = 0; m < 4; ++m) { bf16_t* rowp = hb + (size_t)(ai * 128 + wr * 64 + m * 16 + fr) * D + col0;
#pragma unroll
                for (int bj = 0; bj < 2; ++bj) { const u32x4 hw = *(const u32x4*)(rowp + bj * 128);
                    const f32x4 h0 = {bflo(hw.x), bfhi(hw.x), bflo(hw.y), bfhi(hw.y)}, h1 = {bflo(hw.z), bfhi(hw.z), bflo(hw.w), bfhi(hw.w)};
                    *(u32x4*)(rowp + bj * 128) = pack8(h0 * DN_ALPHA + gv[bj][0] * acc[ai][bj][m][0], h1 * DN_ALPHA + gv[bj][1] * acc[ai][bj][m][1]); } }
    }
};

struct EpiQKV {
    static constexpr bool PERM = true;
    bf16_t* Q; bf16_t* Kb; bf16_t* Vb;
    __device__ __forceinline__ void operator()(const AccT& acc, const Unit& u, int wr, int wc, int fr, int fq) const {
        const int cw = wc * 32 + 8 * fq;
        bf16_t* base; size_t ld; size_t r0;
        if (u.pn < 4) { base = Q + u.pn * 256; ld = D; r0 = (size_t)u.pm * 256; }
        else { base = (u.pn == 4) ? Kb : Vb; ld = 256; r0 = u.pm < 128 ? (size_t)(u.pm >> 5) * KVLEN + CTXL + (size_t)(u.pm & 31) * 256 : (size_t)(u.pm - 128) * KVLEN; }
#pragma unroll
        for (int ai = 0; ai < 2; ++ai)
#pragma unroll
            for (int m = 0; m < 4; ++m) { bf16_t* rowp = base + (r0 + ai * 128 + wr * 64 + m * 16 + fr) * ld + cw;
#pragma unroll
                for (int bj = 0; bj < 2; ++bj) *(u32x4*)(rowp + bj * 128) = pack8(acc[ai][bj][m][0], acc[ai][bj][m][1]); }
    }
};
__device__ __forceinline__ float gelu_tanh(float x) { const float x2 = x * x; const float e = __builtin_amdgcn_exp2f(x * fmaf(x2, -0.10294324f, -2.30220820f)); return x * __builtin_amdgcn_rcpf(1.f + e); }
struct EpiGelu {
    static constexpr bool PERM = true;
    bf16_t* O; f32x2* SP;
    __device__ __forceinline__ void operator()(const AccT& acc, const Unit& u, int wr, int wc, int fr, int fq) const {
        const int col0 = u.pn * 256 + wc * 32 + 8 * fq;
#pragma unroll
        for (int ai = 0; ai < 2; ++ai)
#pragma unroll
            for (int m = 0; m < 4; ++m) { const int row = u.pm * 256 + ai * 128 + wr * 64 + m * 16 + fr; bf16_t* rowp = O + (size_t)row * 2048 + col0;
                float s1 = 0.f, s2 = 0.f;
#pragma unroll
                for (int bj = 0; bj < 2; ++bj) { f32x4 a = acc[ai][bj][m][0], b = acc[ai][bj][m][1];
#pragma unroll
                    for (int i = 0; i < 4; ++i) { a[i] = gelu_tanh(a[i]); b[i] = gelu_tanh(b[i]); s1 += a[i] + b[i]; s2 += a[i] * a[i] + b[i] * b[i]; }
                    *(u32x4*)(rowp + bj * 128) = pack8(a, b); }
                if (u.pn >= 4) { s1 += __shfl_xor(s1, 16); s1 += __shfl_xor(s1, 32); s2 += __shfl_xor(s2, 16); s2 += __shfl_xor(s2, 32);
                    if (fq == 0) SP[(size_t)row * 16 + (u.pn - 4) * 4 + wc] = (f32x2){s1, s2}; } }
    }
};
struct EpiDeltaIn {
    static constexpr bool PERM = true;
    bf16_t* R1; float* AB;
    __device__ __forceinline__ void operator()(const AccT& acc, const Unit& u, int wr, int wc, int fr, int fq) const {
        if (u.pn < 16) {
            bf16_t* base = R1 + (size_t)(u.pn >> 2) * (RSZ / 2) + (u.pn & 3) * 256 + wc * 32 + 8 * fq;
#pragma unroll
            for (int ai = 0; ai < 2; ++ai)
#pragma unroll
                for (int m = 0; m < 4; ++m) { bf16_t* rowp = base + (size_t)(u.pm * 256 + ai * 128 + wr * 64 + m * 16 + fr) * D;
#pragma unroll
                    for (int bj = 0; bj < 2; ++bj) *(u32x4*)(rowp + bj * 128) = pack8(acc[ai][bj][m][0], acc[ai][bj][m][1]); }
        } else if (wc == 0) {
#pragma unroll
            for (int ai = 0; ai < 2; ++ai)
#pragma unroll
                for (int m = 0; m < 4; ++m) { float* rowp = AB + (size_t)(u.pm * 256 + ai * 128 + wr * 64 + m * 16 + fr) * 32 + 8 * fq;
                    *(f32x4*)(rowp) = acc[ai][0][m][0]; *(f32x4*)(rowp + 4) = acc[ai][0][m][1]; }
        }
    }
};
struct EpiGateUp {
    static constexpr bool PERM = true;
    bf16_t* H;
    __device__ __forceinline__ void operator()(const AccT& acc, const Unit& u, int wr, int wc, int fr, int fq) const {
        const int col0 = u.pn * 128 + wc * 32 + 8 * fq;
#pragma unroll
        for (int ai = 0; ai < 2; ++ai)
#pragma unroll
            for (int m = 0; m < 4; ++m) { bf16_t* rowp = H + (size_t)(u.pm * 256 + ai * 128 + wr * 64 + m * 16 + fr) * DE + col0;
                f32x4 a, b;
#pragma unroll
                for (int i = 0; i < 4; ++i) { a[i] = siluf_(acc[ai][0][m][0][i]) * acc[ai][1][m][0][i]; b[i] = siluf_(acc[ai][0][m][1][i]) * acc[ai][1][m][1][i]; }
                *(u32x4*)(rowp) = pack8(a, b); }
    }
};
struct EpiDown {
    static constexpr bool PERM = true;
    bf16_t* Y2; const LAS int* dstl; const LAS float* wl;
    __device__ __forceinline__ void operator()(const AccT& acc, const Unit& u, int wr, int wc, int fr, int fq) const {
        const int col0 = u.pn * 256 + wc * 32 + 8 * fq;
#pragma unroll
        for (int ai = 0; ai < 2; ++ai)
#pragma unroll
            for (int m = 0; m < 4; ++m) { const int r = ai * 128 + wr * 64 + m * 16 + fr;
                if (r < u.nvalid) { const int dst = dstl[u.ord * 256 + r]; const float w = wl[u.ord * 256 + r]; bf16_t* rowp = Y2 + (size_t)dst * D + col0;
#pragma unroll
                    for (int bj = 0; bj < 2; ++bj) *(u32x4*)(rowp + bj * 128) = pack8(acc[ai][bj][m][0] * w, acc[ai][bj][m][1] * w); } }
    }
};

namespace att {
constexpr int DH = 128, NW = 8, QBLK = 32, KVBLK = 64;
constexpr float SCALE = 0.088388347648318440f;
constexpr float THR = 8.f;
constexpr int LDQ = D, LDK = 256, LDO = D;
constexpr size_t SHM_V = KVBLK * DH * 2, SHM_K = KVBLK * DH * 2, SHM_ATTN = 2 * SHM_V + 2 * SHM_K + NW * 64 * 4;
#define KSWZ(row, colB) ((row) * 256 + ((colB) ^ (((row) & 7) << 4)))
#define SBAR() __builtin_amdgcn_sched_barrier(0)
__device__ __forceinline__ unsigned cvtpk(float lo, float hi) { unsigned r; asm volatile("v_cvt_pk_bf16_f32 %0, %1, %2" : "=v"(r) : "v"(lo), "v"(hi)); return r; }
template <bool FAST> __device__ __forceinline__ void partialSM(f32x16& p0, f32x16& p1, float& m_reg, float& mn, float& alpha) {
  if constexpr (FAST) { for (int r = 0; r < 16; ++r) p0[r] = __builtin_amdgcn_exp2f(p0[r]); alpha = 1.f; mn = 0.f; return; }
  constexpr float C = SCALE * 1.4426950408889634f;
  float pmax = p0[0]; for (int r = 1; r < 16; ++r) pmax = fmaxf(pmax, p0[r]); for (int r = 0; r < 16; ++r) pmax = fmaxf(pmax, p1[r]);
  { auto rr = __builtin_amdgcn_permlane32_swap(__float_as_uint(pmax), __float_as_uint(pmax), false, false);
    pmax = fmaxf(__uint_as_float(rr[0]), __uint_as_float(rr[1])); }
  if (__builtin_expect(__all(pmax - m_reg <= THR / SCALE), 1)) { mn = m_reg; alpha = 1.f; }
  else { mn = fmaxf(m_reg, pmax); alpha = __builtin_amdgcn_exp2f((m_reg - mn) * C); m_reg = mn; }
  float mnC = -mn * C;
  for (int r = 0; r < 16; ++r) p0[r] = fmaf(p0[r], C, mnC); for (int r = 0; r < 16; ++r) p1[r] = fmaf(p1[r], C, mnC);
  for (int r = 0; r < 16; ++r) p0[r] = __builtin_amdgcn_exp2f(p0[r]);
}
__device__ __forceinline__ void finishSM(f32x16& p0, f32x16& p1, float alpha, float& l_reg, bf16x8& pa0, bf16x8& pa1, bf16x8& pa2, bf16x8& pa3) {
  for (int r = 0; r < 16; ++r) p1[r] = __builtin_amdgcn_exp2f(p1[r]);
  float ps = 0; for (int r = 0; r < 16; ++r) ps += p0[r]; for (int r = 0; r < 16; ++r) ps += p1[r];
  { auto rr = __builtin_amdgcn_permlane32_swap(__float_as_uint(ps), __float_as_uint(ps), false, false);
    ps = __uint_as_float(rr[0]) + __uint_as_float(rr[1]); }
  l_reg = l_reg * alpha + ps;
#define PK4(P, BASE, OUT) do { unsigned a0 = cvtpk(P[BASE + 0], P[BASE + 1]), a1 = cvtpk(P[BASE + 2], P[BASE + 3]);   \
    unsigned b0 = cvtpk(P[BASE + 4], P[BASE + 5]), b1 = cvtpk(P[BASE + 6], P[BASE + 7]);                              \
    auto r0 = __builtin_amdgcn_permlane32_swap(a0, b0, false, false); auto r1 = __builtin_amdgcn_permlane32_swap(a1, b1, false, false); \
    u32x4 w = {r0[0], r1[0], r0[1], r1[1]}; OUT = *reinterpret_cast<bf16x8*>(&w); } while (0)
  PK4(p0, 0, pa0); PK4(p0, 8, pa1); PK4(p1, 0, pa2); PK4(p1, 8, pa3);
#undef PK4
}
__device__ __forceinline__ void qkt(f32x16& p0, f32x16& p1, const bf16_t* Ks, const bf16x8* qr, int r32, int hi) {
  p0 = f32x16{}; p1 = f32x16{};
  for (int d0 = 0; d0 < 8; ++d0) { int cb = (d0 * 16 + hi * 8) * 2;
    bf16x8 b0 = *reinterpret_cast<const bf16x8*>((const char*)Ks + KSWZ(r32, cb));
    bf16x8 b1 = *reinterpret_cast<const bf16x8*>((const char*)Ks + KSWZ(32 + r32, cb));
    p0 = __builtin_amdgcn_mfma_f32_32x32x16_bf16(b0, qr[d0], p0, 0, 0, 0);
    p1 = __builtin_amdgcn_mfma_f32_32x32x16_bf16(b1, qr[d0], p1, 0, 0, 0); }
}
__device__ __forceinline__ int v_st(int k, int c) { const int kk = (k & ~0xC) | ((k & 4) << 1) | ((k & 8) >> 1); return ((kk >> 3) * 4 + (c >> 5)) * 512 + ((kk & 7) * 32 + (c & 31)) * 2; }
__device__ __forceinline__ int v_rd_base(int lane) { return ((lane & 3) << 3) | (((lane >> 2) & 3) << 6) | (((lane >> 4) & 1) << 5) | (((lane >> 5) & 1) << 8); }
constexpr int v_rd_off(int d0, int ks, int half) { return d0 * 512 + ks * 4096 + half * 2048; }
template <int OFF> __device__ __forceinline__ s16x4 tr_read(int vb) {
  s16x4 r; asm volatile("ds_read_b64_tr_b16 %0, %1 offset:%2" : "=&v"(r) : "v"(vb), "i"(OFF) : "memory"); return r;
}
template <int D0> __device__ __forceinline__ void pv_one(f32x16& od, int vb, bf16x8 pa0, bf16x8 pa1, bf16x8 pa2, bf16x8 pa3) {
  const s16x4 l0 = tr_read<v_rd_off(D0, 0, 0)>(vb), h0 = tr_read<v_rd_off(D0, 0, 1)>(vb), l1 = tr_read<v_rd_off(D0, 1, 0)>(vb), h1 = tr_read<v_rd_off(D0, 1, 1)>(vb);
  const s16x4 l2 = tr_read<v_rd_off(D0, 2, 0)>(vb), h2 = tr_read<v_rd_off(D0, 2, 1)>(vb), l3 = tr_read<v_rd_off(D0, 3, 0)>(vb), h3 = tr_read<v_rd_off(D0, 3, 1)>(vb);
  asm volatile("s_waitcnt lgkmcnt(0)" ::: "memory"); SBAR();
#define PK(L, H) (bf16x8){L[0], L[1], L[2], L[3], H[0], H[1], H[2], H[3]}
  od = __builtin_amdgcn_mfma_f32_32x32x16_bf16(pa0, PK(l0, h0), od, 0, 0, 0);
  od = __builtin_amdgcn_mfma_f32_32x32x16_bf16(pa1, PK(l1, h1), od, 0, 0, 0);
  od = __builtin_amdgcn_mfma_f32_32x32x16_bf16(pa2, PK(l2, h2), od, 0, 0, 0);
  od = __builtin_amdgcn_mfma_f32_32x32x16_bf16(pa3, PK(l3, h3), od, 0, 0, 0);
#undef PK
}
__device__ __forceinline__ void pv_d0(f32x16* o, int vb, bf16x8 pa0, bf16x8 pa1, bf16x8 pa2, bf16x8 pa3) {
  pv_one<0>(o[0], vb, pa0, pa1, pa2, pa3); pv_one<1>(o[1], vb, pa0, pa1, pa2, pa3); pv_one<2>(o[2], vb, pa0, pa1, pa2, pa3); pv_one<3>(o[3], vb, pa0, pa1, pa2, pa3);
}
template <int D0> __device__ __forceinline__ void pv_two(f32x16& oa, f32x16& ob, int vb, bf16x8 pa0, bf16x8 pa1, bf16x8 pa2, bf16x8 pa3) {
  const s16x4 al0 = tr_read<v_rd_off(D0, 0, 0)>(vb), ah0 = tr_read<v_rd_off(D0, 0, 1)>(vb), bl0 = tr_read<v_rd_off(D0 + 1, 0, 0)>(vb), bh0 = tr_read<v_rd_off(D0 + 1, 0, 1)>(vb);
  const s16x4 al1 = tr_read<v_rd_off(D0, 1, 0)>(vb), ah1 = tr_read<v_rd_off(D0, 1, 1)>(vb), bl1 = tr_read<v_rd_off(D0 + 1, 1, 0)>(vb), bh1 = tr_read<v_rd_off(D0 + 1, 1, 1)>(vb);
  const s16x4 al2 = tr_read<v_rd_off(D0, 2, 0)>(vb), ah2 = tr_read<v_rd_off(D0, 2, 1)>(vb), bl2 = tr_read<v_rd_off(D0 + 1, 2, 0)>(vb), bh2 = tr_read<v_rd_off(D0 + 1, 2, 1)>(vb);
  const s16x4 al3 = tr_read<v_rd_off(D0, 3, 0)>(vb), ah3 = tr_read<v_rd_off(D0, 3, 1)>(vb), bl3 = tr_read<v_rd_off(D0 + 1, 3, 0)>(vb), bh3 = tr_read<v_rd_off(D0 + 1, 3, 1)>(vb);
  asm volatile("s_waitcnt lgkmcnt(0)" ::: "memory"); SBAR();
#define PK(L, H) (bf16x8){L[0], L[1], L[2], L[3], H[0], H[1], H[2], H[3]}
  oa = __builtin_amdgcn_mfma_f32_32x32x16_bf16(pa0, PK(al0, ah0), oa, 0, 0, 0); ob = __builtin_amdgcn_mfma_f32_32x32x16_bf16(pa0, PK(bl0, bh0), ob, 0, 0, 0);
  oa = __builtin_amdgcn_mfma_f32_32x32x16_bf16(pa1, PK(al1, ah1), oa, 0, 0, 0); ob = __builtin_amdgcn_mfma_f32_32x32x16_bf16(pa1, PK(bl1, bh1), ob, 0, 0, 0);
  oa = __builtin_amdgcn_mfma_f32_32x32x16_bf16(pa2, PK(al2, ah2), oa, 0, 0, 0); ob = __builtin_amdgcn_mfma_f32_32x32x16_bf16(pa2, PK(bl2, bh2), ob, 0, 0, 0);
  oa = __builtin_amdgcn_mfma_f32_32x32x16_bf16(pa3, PK(al3, ah3), oa, 0, 0, 0); ob = __builtin_amdgcn_mfma_f32_32x32x16_bf16(pa3, PK(bl3, bh3), ob, 0, 0, 0);
#undef PK
}
__device__ __forceinline__ void pv_d0x2(f32x16* o, int vb, bf16x8 pa0, bf16x8 pa1, bf16x8 pa2, bf16x8 pa3) {
  pv_two<0>(o[0], o[1], vb, pa0, pa1, pa2, pa3); pv_two<2>(o[2], o[3], vb, pa0, pa1, pa2, pa3);
}
template <bool FAST> __device__ __forceinline__ void attn_dense_body(const bf16_t* Qb, const bf16_t* __restrict__ Kh, const bf16_t* __restrict__ Vh, bf16_t* Ob, int seq, char* lds, const int tid) {
  constexpr int SDEPTH = 2;
  const int wid = tid >> 6, lane = tid & 63, r32 = lane & 31, hi = lane >> 5;
  bf16_t* V_lds = (bf16_t*)lds; bf16_t* K_lds = (bf16_t*)(lds + 2 * SHM_V);
  float* ws = (float*)(lds + 2 * SHM_V + 2 * SHM_K) + wid * 64; float* li_l = ws; float* al_l = ws + 32;
  float m_reg = -1e30f, l_reg = 0; f32x16 o[4] = {}; bf16x8 qr[8];
  const bf16_t* Qw = Qb + (long)(wid * QBLK + r32) * LDQ + hi * 8;
#pragma unroll
  for (int d0 = 0; d0 < 8; ++d0) qr[d0] = *reinterpret_cast<const bf16x8*>(Qw + d0 * 16);
  const int sr = tid >> 4, sc = (tid & 15) * 8, vst0 = v_st(sr, sc), vst1 = v_st(32 + sr, sc);
  const int vb0 = (int)(uintptr_t)V_lds + v_rd_base(lane);
  struct { bf16x8 vs0, vs1, ks0, ks1; } sr_[SDEPTH];
#define SLOAD(i, k0) do { sr_[i].vs0 = *reinterpret_cast<const bf16x8*>(&Vh[(long)((k0) + sr) * LDK + sc]); sr_[i].vs1 = *reinterpret_cast<const bf16x8*>(&Vh[(long)((k0) + 32 + sr) * LDK + sc]); \
    sr_[i].ks0 = *reinterpret_cast<const bf16x8*>(&Kh[(long)((k0) + sr) * LDK + sc]); sr_[i].ks1 = *reinterpret_cast<const bf16x8*>(&Kh[(long)((k0) + 32 + sr) * LDK + sc]); } while (0)
#define SWRITE(b, i) do { *(bf16x8*)((char*)V_lds + (b) * SHM_V + vst0) = sr_[i].vs0;          \
    *(bf16x8*)((char*)V_lds + (b) * SHM_V + vst1) = sr_[i].vs1; int kc = sc * 2;               \
    *(bf16x8*)((char*)K_lds + (b) * SHM_K + KSWZ(sr, kc)) = sr_[i].ks0;                       \
    *(bf16x8*)((char*)K_lds + (b) * SHM_K + KSWZ(32 + sr, kc)) = sr_[i].ks1; } while (0)
#define SWAIT() do { asm volatile("s_waitcnt vmcnt(4)" ::: "memory"); } while (0)
#define RESC(a) do { if constexpr (!FAST) if (__any((a) < 1.f)) { if (hi == 0) al_l[r32] = (a); asm volatile("s_waitcnt lgkmcnt(0)" ::: "memory"); \
    for (int d = 0; d < 4; ++d) for (int r = 0; r < 16; ++r) o[d][r] *= al_l[crow(r, hi)]; } } while (0)
  f32x16 pA0, pA1, pB0, pB1; float mnA, mnB, alA, alB; bf16x8 pa0, pa1, pa2, pa3; const int NT = seq / KVBLK;
  constexpr int SE = 0, SO = SDEPTH - 1;
  SLOAD(SE, 0); asm volatile("s_waitcnt vmcnt(0)" ::: "memory"); SWRITE(0, SE); __syncthreads();
  qkt(pA0, pA1, K_lds, qr, r32, hi); partialSM<FAST>(pA0, pA1, m_reg, mnA, alA);
  SLOAD(SO, KVBLK); if (2 < NT) SLOAD(SE, 2 * KVBLK);
  SWAIT(); SWRITE(1, SO); __syncthreads();
  for (int j = 1; j + 1 < NT; j += 2) {
    SBAR(); qkt(pB0, pB1, (bf16_t*)((char*)K_lds + SHM_K), qr, r32, hi);
    finishSM(pA0, pA1, alA, l_reg, pa0, pa1, pa2, pa3); SBAR();
    SLOAD(SO, (j + SDEPTH) * KVBLK); SBAR();
    pv_d0(o, vb0, pa0, pa1, pa2, pa3); partialSM<FAST>(pB0, pB1, m_reg, mnB, alB);
    __syncthreads(); SWAIT(); SWRITE(0, SE);
    RESC(alB); __syncthreads();
    SBAR(); qkt(pA0, pA1, K_lds, qr, r32, hi);
    finishSM(pB0, pB1, alB, l_reg, pa0, pa1, pa2, pa3); SBAR();
    if (j + 3 < NT) SLOAD(SE, (j + 1 + SDEPTH) * KVBLK); SBAR();
    pv_d0(o, vb0 + (int)SHM_V, pa0, pa1, pa2, pa3); partialSM<FAST>(pA0, pA1, m_reg, mnA, alA);
    __syncthreads(); SWAIT(); SWRITE(1, SO);
    RESC(alA); __syncthreads();
  }
  SBAR(); qkt(pB0, pB1, (bf16_t*)((char*)K_lds + SHM_K), qr, r32, hi);
  finishSM(pA0, pA1, alA, l_reg, pa0, pa1, pa2, pa3); SBAR();
  pv_d0(o, vb0, pa0, pa1, pa2, pa3); partialSM<FAST>(pB0, pB1, m_reg, mnB, alB);
  __syncthreads(); RESC(alB);
  finishSM(pB0, pB1, alB, l_reg, pa0, pa1, pa2, pa3); SBAR();
  pv_d0(o, vb0 + (int)SHM_V, pa0, pa1, pa2, pa3);
  if (hi == 0) li_l[r32] = l_reg; asm volatile("s_waitcnt lgkmcnt(0)" ::: "memory");
  float rli[16];
#pragma unroll
  for (int r = 0; r < 16; ++r) rli[r] = __builtin_amdgcn_rcpf(li_l[crow(r, hi)]);
  bf16_t* Ow = Ob + (long)(wid * QBLK) * LDO;
#pragma unroll
  for (int r = 0; r < 16; ++r) { int orow = crow(r, hi);
#pragma unroll
    for (int d0 = 0; d0 < 4; ++d0) Ow[(long)orow * LDO + d0 * 32 + r32] = (bf16_t)(pk2(o[d0][r] * rli[r], 0.f) & 0xffffu); }
  asm volatile("s_waitcnt vmcnt(0) lgkmcnt(0)" ::: "memory"); __syncthreads();
#undef SLOAD
#undef SWRITE
#undef SWAIT
#undef RESC
}
constexpr size_t SHM_ATTN3 = 3 * SHM_V + 3 * SHM_K + NW * 64 * 4;
__device__ __forceinline__ void attn_fast3_body(const bf16_t* Qb, const bf16_t* __restrict__ Kh, const bf16_t* __restrict__ Vh, bf16_t* Ob, int seq, char* lds, const int tid) {
  const int wid = tid >> 6, lane = tid & 63, r32 = lane & 31, hi = lane >> 5;
  char* V_lds = lds; char* K_lds = lds + 3 * SHM_V;
  float l_reg = 0; f32x16 o[4] = {}; bf16x8 qr[8];
  const bf16_t* Qw = Qb + (long)(wid * QBLK + r32) * LDQ + hi * 8;
#pragma unroll
  for (int d0 = 0; d0 < 8; ++d0) qr[d0] = *reinterpret_cast<const bf16x8*>(Qw + d0 * 16);
  const int sr = tid >> 4, sc = (tid & 15) * 8, vst0 = v_st(sr, sc), vst1 = v_st(32 + sr, sc);
  const int vb0 = (int)(uintptr_t)V_lds + v_rd_base(lane);
  struct { bf16x8 vs0, vs1, ks0, ks1; } sr_[1];
#define SLOAD(i, k0) do { sr_[i].vs0 = *reinterpret_cast<const bf16x8*>(&Vh[(long)((k0) + sr) * LDK + sc]); sr_[i].vs1 = *reinterpret_cast<const bf16x8*>(&Vh[(long)((k0) + 32 + sr) * LDK + sc]); \
    sr_[i].ks0 = *reinterpret_cast<const bf16x8*>(&Kh[(long)((k0) + sr) * LDK + sc]); sr_[i].ks1 = *reinterpret_cast<const bf16x8*>(&Kh[(long)((k0) + 32 + sr) * LDK + sc]); } while (0)
#define SWRITE(bo, i) do { *(bf16x8*)(V_lds + (bo) + vst0) = sr_[i].vs0; *(bf16x8*)(V_lds + (bo) + vst1) = sr_[i].vs1; const int kc = sc * 2; \
    *(bf16x8*)(K_lds + (bo) + KSWZ(sr, kc)) = sr_[i].ks0; *(bf16x8*)(K_lds + (bo) + KSWZ(32 + sr, kc)) = sr_[i].ks1; } while (0)
#define SWAIT() do { asm volatile("s_waitcnt vmcnt(4)" ::: "memory"); } while (0)
  f32x16 pA0, pA1, pB0, pB1; bf16x8 pa0, pa1, pa2, pa3; const int NT = seq / KVBLK;
  int bprev = 0, bcur = (int)SHM_K, bnext = 2 * (int)SHM_K;
  SLOAD(0, 0); asm volatile("s_waitcnt vmcnt(0)" ::: "memory"); SWRITE(0, 0);
  SLOAD(0, KVBLK);
  __syncthreads();
  qkt(pA0, pA1, (const bf16_t*)K_lds, qr, r32, hi);
  { float mr = 0.f, mn = 0.f, al = 1.f; partialSM<true>(pA0, pA1, mr, mn, al); }
  SWRITE((int)SHM_K, 0); if (2 < NT) SLOAD(0, 2 * KVBLK);
  __syncthreads();
  for (int j = 1; j + 1 < NT; j += 2) {
    SBAR(); qkt(pB0, pB1, (const bf16_t*)(K_lds + bcur), qr, r32, hi);
    finishSM(pA0, pA1, 1.f, l_reg, pa0, pa1, pa2, pa3); SBAR();
    pv_d0x2(o, vb0 + bprev, pa0, pa1, pa2, pa3);
    { float mr = 0.f, mn = 0.f, al = 1.f; partialSM<true>(pB0, pB1, mr, mn, al); }
    SWRITE(bnext, 0); if (j + 2 < NT) SLOAD(0, (j + 2) * KVBLK);
    __syncthreads();
    { const int t_ = bprev; bprev = bcur; bcur = bnext; bnext = t_; }
    SBAR(); qkt(pA0, pA1, (const bf16_t*)(K_lds + bcur), qr, r32, hi);
    finishSM(pB0, pB1, 1.f, l_reg, pa0, pa1, pa2, pa3); SBAR();
    pv_d0x2(o, vb0 + bprev, pa0, pa1, pa2, pa3);
    { float mr = 0.f, mn = 0.f, al = 1.f; partialSM<true>(pA0, pA1, mr, mn, al); }
    if (j + 2 < NT) { SWRITE(bnext, 0); if (j + 3 < NT) SLOAD(0, (j + 3) * KVBLK); }
    __syncthreads();
    { const int t_ = bprev; bprev = bcur; bcur = bnext; bnext = t_; }
  }
  SBAR(); qkt(pB0, pB1, (const bf16_t*)(K_lds + bcur), qr, r32, hi);
  finishSM(pA0, pA1, 1.f, l_reg, pa0, pa1, pa2, pa3); SBAR();
  pv_d0x2(o, vb0 + bprev, pa0, pa1, pa2, pa3);
  { float mr = 0.f, mn = 0.f, al = 1.f; partialSM<true>(pB0, pB1, mr, mn, al); }
  finishSM(pB0, pB1, 1.f, l_reg, pa0, pa1, pa2, pa3); SBAR();
  pv_d0x2(o, vb0 + bcur, pa0, pa1, pa2, pa3);
  { int l2; asm volatile("v_mbcnt_lo_u32_b32 %0, -1, 0\n\tv_mbcnt_hi_u32_b32 %0, -1, %0" : "=v"(l2));
    const int r2 = l2 & 31, h2 = l2 >> 5; float* li_l = (float*)(lds + 3 * SHM_V + 3 * SHM_K) + wid * 64;
    if (h2 == 0) li_l[r2] = l_reg; asm volatile("s_waitcnt lgkmcnt(0)" ::: "memory");
    bf16_t* Ow = Ob + (long)(wid * QBLK) * LDO;
#pragma unroll
    for (int r = 0; r < 16; ++r) { const int orow = crow(r, h2); const float rl = __builtin_amdgcn_rcpf(li_l[orow]);
#pragma unroll
      for (int d0 = 0; d0 < 4; ++d0) Ow[(long)orow * LDO + d0 * 32 + r2] = (bf16_t)(pk2(o[d0][r] * rl, 0.f) & 0xffffu); } }
  asm volatile("s_waitcnt vmcnt(0) lgkmcnt(0)" ::: "memory"); __syncthreads();
#undef SLOAD
#undef SWRITE
#undef SWAIT
}
#define MFMA16(a, b, c) __builtin_amdgcn_mfma_f32_16x16x32_bf16((a), (b), (c), 0, 0, 0)
template <int OFF> __device__ __forceinline__ bf16x8 ldr_o(int addr) { bf16x8 r; asm volatile("ds_read_b128 %0, %1 offset:%2" : "=&v"(r) : "v"(addr), "i"(OFF) : "memory"); return r; }
template <int OFF> __device__ __forceinline__ s16x4 trr_o(int addr) { s16x4 r; asm volatile("ds_read_b64_tr_b16 %0, %1 offset:%2" : "=&v"(r) : "v"(addr), "i"(OFF) : "memory"); return r; }
__device__ __forceinline__ void attn_fast16_body(const bf16_t* Qb, const bf16_t* __restrict__ Kh, const bf16_t* __restrict__ Vh, bf16_t* Ob, int seq, char* lds, const int tid) {
  const int wid = tid >> 6, lane = tid & 63, n = lane & 15, g = lane >> 4;
  constexpr int VB = 3 * (int)SHM_K;
  f32x4 o[2][8], lacc[2]; bf16x8 qf[2][4];
  lacc[0] = (f32x4){0.f, 0.f, 0.f, 0.f}; lacc[1] = (f32x4){0.f, 0.f, 0.f, 0.f};
  const bf16x8 ones_ = (bf16x8){0x3F80, 0x3F80, 0x3F80, 0x3F80, 0x3F80, 0x3F80, 0x3F80, 0x3F80};
#pragma unroll
  for (int qb = 0; qb < 2; ++qb)
#pragma unroll
    for (int db = 0; db < 8; ++db) o[qb][db] = (f32x4){0.f, 0.f, 0.f, 0.f};
#pragma unroll
  for (int qb = 0; qb < 2; ++qb)
#pragma unroll
    for (int ds = 0; ds < 4; ++ds) qf[qb][ds] = *reinterpret_cast<const bf16x8*>(Qb + (long)(wid * QBLK + 16 * qb + n) * LDQ + 32 * ds + 8 * g);
  const int srow = 4 * wid + g, sxk = n ^ (srow & 15), sxv = (((n >> 1) ^ (srow & 7)) << 1) | (n & 1);
  const unsigned koff = (unsigned)(srow * LDK + sxk * 8) * 2u, voff = (unsigned)(srow * LDK + sxv * 8) * 2u;
  char* const sdst = lds + __builtin_amdgcn_readfirstlane(wid) * 1024;
  int kx[4];
#pragma unroll
  for (int ds = 0; ds < 4; ++ds) kx[ds] = (int)(uintptr_t)lds + n * 256 + (((4 * ds + g) ^ n) << 4);
  int vx[8];
  { const int vq = n >> 2, vp = n & 3, vrx = 4 * (g & 1) + vq;
#pragma unroll
    for (int db = 0; db < 8; ++db) vx[db] = (int)(uintptr_t)lds + VB + (4 * g + vq) * 256 + 8 * vp + ((db ^ vrx) << 5); }
#define ADMA(k0, BO) do { const char* kg_ = (const char*)Kh + (size_t)(k0) * (LDK * 2); const char* vg_ = (const char*)Vh + (size_t)(k0) * (LDK * 2); \
    __builtin_amdgcn_global_load_lds((const unsigned*)(kg_ + koff), (LAS unsigned*)(sdst + (BO)), 16, 0, 0); \
    __builtin_amdgcn_global_load_lds((const unsigned*)(kg_ + koff + 32 * LDK * 2), (LAS unsigned*)(sdst + (BO) + 8192), 16, 0, 0); \
    __builtin_amdgcn_global_load_lds((const unsigned*)(vg_ + voff), (LAS unsigned*)(sdst + VB + (BO)), 16, 0, 0); \
    __builtin_amdgcn_global_load_lds((const unsigned*)(vg_ + voff + 32 * LDK * 2), (LAS unsigned*)(sdst + VB + (BO) + 8192), 16, 0, 0); } while (0)
#define AWAIT() asm volatile("s_waitcnt vmcnt(0)" ::: "memory")
#define LW(n_) asm volatile("s_waitcnt lgkmcnt(" #n_ ")" ::: "memory")
#define EXPK(P, kb) do { _Pragma("unroll") for (int qb = 0; qb < 2; ++qb) _Pragma("unroll") for (int r = 0; r < 4; ++r) P[kb][qb][r] = __builtin_amdgcn_exp2f(P[kb][qb][r]); } while (0)
#define KRD1(BO, t) ldr_o<(BO) + ((t) & 3) * 4096>(kx[(t) >> 2])
#define LWR(n_, R) asm volatile("s_waitcnt lgkmcnt(" #n_ ")" : "+v"(R) :: "memory")
#define LWK(t) do { if ((t) <= 12) LW(3); else if ((t) == 13) LW(2); else if ((t) == 14) LW(1); else LW(0); } while (0)
#define MFZ(D, A, B) asm volatile("v_mfma_f32_16x16x32_bf16 %0, %1, %2, 0" : "=&v"(D) : "v"(A), "v"(B))
#define MFA(D, A, B) asm volatile("v_mfma_f32_16x16x32_bf16 %0, %1, %2, %0" : "+v"(D) : "v"(A), "v"(B))
#define QKMM(P, t) do { if ((t) < 4) { MFZ(P[(t) & 3][0], kw_[(t) & 3], qf[0][(t) >> 2]); MFZ(P[(t) & 3][1], kw_[(t) & 3], qf[1][(t) >> 2]); } \
    else { MFA(P[(t) & 3][0], kw_[(t) & 3], qf[0][(t) >> 2]); MFA(P[(t) & 3][1], kw_[(t) & 3], qf[1][(t) >> 2]); } } while (0)
#define QKSTEP(P, BO, t) do { LWK(t); QKMM(P, t); if ((t) + 4 < 16) kw_[(t) & 3] = KRD1(BO, (t) + 4); } while (0)
#define QK4(P, BO, t0) do { QKSTEP(P, BO, t0); QKSTEP(P, BO, (t0) + 1); QKSTEP(P, BO, (t0) + 2); QKSTEP(P, BO, (t0) + 3); } while (0)
#define QKT16(P, BO) do { bf16x8 kw_[4]; \
    kw_[0] = KRD1(BO, 0); kw_[1] = KRD1(BO, 1); kw_[2] = KRD1(BO, 2); kw_[3] = KRD1(BO, 3); QK4(P, BO, 0); QK4(P, BO, 4); QK4(P, BO, 8); QK4(P, BO, 12); SBAR(); } while (0)
#define QKSTEPV(P, BO, t, W_) do { LW(W_); QKMM(P, t); } while (0)
#define QKT16V(P, BO, PRE) do { bf16x8 kw_[4]; \
    kw_[0] = KRD1(BO, 0); kw_[1] = KRD1(BO, 1); kw_[2] = KRD1(BO, 2); kw_[3] = KRD1(BO, 3); QK4(P, BO, 0); QK4(P, BO, 4); QK4(P, BO, 8); \
    QKSTEP(P, BO, 12); PRE; QKSTEPV(P, BO, 13, 10); QKSTEPV(P, BO, 14, 9); QKSTEPV(P, BO, 15, 8); SBAR(); } while (0)
#define VISS(TA, TB, S_, BO, D0) do { _Pragma("unroll") for (int db = 0; db < 4; ++db) { TA[db] = trr_o<(BO) + (S_) * 8192>(vx[(D0) + db]); TB[db] = trr_o<(BO) + (S_) * 8192 + 4096>(vx[(D0) + db]); } } while (0)
#define VMMA(TA, TB, S_, D0) do { _Pragma("unroll") for (int db = 0; db < 4; ++db) { const bf16x8 vf_ = (bf16x8){TA[db][0], TA[db][1], TA[db][2], TA[db][3], TB[db][0], TB[db][1], TB[db][2], TB[db][3]}; \
      o[0][(D0) + db] = MFMA16(pf[0][S_], vf_, o[0][(D0) + db]); o[1][(D0) + db] = MFMA16(pf[1][S_], vf_, o[1][(D0) + db]); } \
    if ((D0) == 0) { lacc[0] = MFMA16(pf[0][S_], ones_, lacc[0]); lacc[1] = MFMA16(pf[1][S_], ones_, lacc[1]); } } while (0)
#define PACKS(P, s_) do { _Pragma("unroll") for (int qb = 0; qb < 2; ++qb) \
      pf[qb][s_] = mk8w(pk2(P[2 * (s_)][qb][0], P[2 * (s_)][qb][1]), pk2(P[2 * (s_)][qb][2], P[2 * (s_)][qb][3]), pk2(P[2 * (s_) + 1][qb][0], P[2 * (s_) + 1][qb][1]), pk2(P[2 * (s_) + 1][qb][2], P[2 * (s_) + 1][qb][3])); } while (0)
#define LWV(n_, TA, TB) asm volatile("s_waitcnt lgkmcnt(" #n_ ")" : "+v"(TA[0]), "+v"(TA[1]), "+v"(TA[2]), "+v"(TA[3]), "+v"(TB[0]), "+v"(TB[1]), "+v"(TB[2]), "+v"(TB[3]) :: "memory")
#define PVX(BO, X0, X1, X2, X3) do { s16x4 ua_[4], ub_[4], uc_[4], ud_[4]; PVXI(BO); PVXB(BO, X0, X1, X2, X3); } while (0)
#define PVXI(BO) do { VISS(ua_, ub_, 0, BO, 0); } while (0)
#define PVXB(BO, X0, X1, X2, X3) do { \
    VISS(uc_, ud_, 0, BO, 4); LW(8); SBAR(); VMMA(ua_, ub_, 0, 0); X0; SBAR(); \
    VISS(ua_, ub_, 1, BO, 0); LW(8); SBAR(); VMMA(uc_, ud_, 0, 4); X1; SBAR(); \
    VISS(uc_, ud_, 1, BO, 4); LW(8); SBAR(); VMMA(ua_, ub_, 1, 0); X2; SBAR(); \
    LW(0); SBAR(); VMMA(uc_, ud_, 1, 4); X3; SBAR(); } while (0)
#define ITER(jj, SC, SP, SN) do { s16x4 ua_[4], ub_[4], uc_[4], ud_[4]; if ((jj) + 1 < NT) ADMA(((jj) + 1) * KVBLK, SN); \
    SBAR(); QKT16V(pS, SC, PVXI(SP)); \
    PVXB(SP, EXPK(pS, 0), EXPK(pS, 1), do { EXPK(pS, 2); PACKS(pS, 0); } while (0), EXPK(pS, 3)); \
    PACKS(pS, 1); AWAIT(); __syncthreads(); } while (0)
#define TAILPV(SP) do { SBAR(); PVX(SP, (void)0, (void)0, (void)0, (void)0); } while (0)
  f32x4 pS[4][2]; bf16x8 pf[2][2]; const int NT = seq / KVBLK;
  ADMA(0, 0); ADMA(KVBLK, 16384);
  asm volatile("s_waitcnt vmcnt(4)" ::: "memory"); __syncthreads();
  QKT16(pS, 0); asm volatile("s_nop 15" ::: "memory"); SBAR(); EXPK(pS, 0); EXPK(pS, 1); EXPK(pS, 2); EXPK(pS, 3); PACKS(pS, 0); PACKS(pS, 1);
  AWAIT(); __syncthreads();
  int j = 1;
  for (; j + 2 < NT; j += 3) { ITER(j, 16384, 0, 32768); ITER(j + 1, 32768, 16384, 0); ITER(j + 2, 0, 32768, 16384); }
  if (j < NT) { ITER(j, 16384, 0, 32768);
    if (j + 1 < NT) { ITER(j + 1, 32768, 16384, 0); TAILPV(32768); } else TAILPV(16384); }
  else TAILPV(0);
  {
    int l2; asm volatile("v_mbcnt_lo_u32_b32 %0, -1, 0\n\tv_mbcnt_hi_u32_b32 %0, -1, %0" : "=v"(l2));
    const int n2 = l2 & 15, g2 = l2 >> 4;
    bf16_t* Ow = Ob + (long)(wid * QBLK) * LDO + n2;
#pragma unroll
    for (int qb = 0; qb < 2; ++qb)
#pragma unroll
      for (int r = 0; r < 4; ++r) { const int row = 16 * qb + 4 * g2 + r; const float rl = __builtin_amdgcn_rcpf(lacc[qb][r]);
#pragma unroll
        for (int db = 0; db < 8; ++db) Ow[(long)row * LDO + 16 * db] = (bf16_t)(pk2(o[qb][db][r] * rl, 0.f) & 0xffffu); } }
  asm volatile("s_waitcnt vmcnt(0) lgkmcnt(0)" ::: "memory"); __syncthreads();
#undef ADMA
#undef AWAIT
#undef EXPK
#undef KRD1
#undef QKSTEP
#undef QK4
#undef LWK
#undef LWR
#undef LWV
#undef QKT16
#undef VISS
#undef VMMA
#undef PACKS
#undef LW
#undef PVX
#undef PVXI
#undef PVXB
#undef QKSTEPV
#undef MFZ
#undef MFA
#undef QKMM
#undef QKT16V
#undef ITER
#undef TAILPV
}
__device__ __forceinline__ void attn_fast16s_body(const bf16_t* Qb, const bf16_t* __restrict__ Kh, const bf16_t* __restrict__ Vh, bf16_t* Ob, int seq, char* lds, const int tid) {
  const int wid = tid >> 6, lane = tid & 63, n = lane & 15, g = lane >> 4;
  constexpr int VB = 4 * (int)SHM_K;
  f32x4 o[2][8], lacc[2]; bf16x8 qf[2][4];
  lacc[0] = (f32x4){0.f, 0.f, 0.f, 0.f}; lacc[1] = (f32x4){0.f, 0.f, 0.f, 0.f};
  const bf16x8 ones_ = (bf16x8){0x3F80, 0x3F80, 0x3F80, 0x3F80, 0x3F80, 0x3F80, 0x3F80, 0x3F80};
#pragma unroll
  for (int qb = 0; qb < 2; ++qb)
#pragma unroll
    for (int db = 0; db < 8; ++db) o[qb][db] = (f32x4){0.f, 0.f, 0.f, 0.f};
#pragma unroll
  for (int qb = 0; qb < 2; ++qb)
#pragma unroll
    for (int ds = 0; ds < 4; ++ds) qf[qb][ds] = *reinterpret_cast<const bf16x8*>(Qb + (long)(wid * QBLK + 16 * qb + n) * LDQ + 32 * ds + 8 * g);
  const int srow = 4 * wid + g, sxk = n ^ (srow & 15), sxv = (((n >> 1) ^ (srow & 7)) << 1) | (n & 1);
  const unsigned koff = (unsigned)(srow * LDK + sxk * 8) * 2u, voff = (unsigned)(srow * LDK + sxv * 8) * 2u;
  char* const sdst = lds + __builtin_amdgcn_readfirstlane(wid) * 1024;
  int kx[4];
#pragma unroll
  for (int ds = 0; ds < 4; ++ds) kx[ds] = (int)(uintptr_t)lds + n * 256 + (((4 * ds + g) ^ n) << 4);
  int vx[8];
  { const int vq = n >> 2, vp = n & 3, vrx = 4 * (g & 1) + vq;
#pragma unroll
    for (int db = 0; db < 8; ++db) vx[db] = (int)(uintptr_t)lds + VB + (4 * g + vq) * 256 + 8 * vp + ((db ^ vrx) << 5); }
  s16x4 ua_[4], ub_[4], uc_[4], ud_[4]; bf16x8 kw_[4];
  const __amdgpu_buffer_rsrc_t rK = __builtin_amdgcn_make_buffer_rsrc((void*)Kh, 0, 0x7fffffff, 0x00020000), rV = __builtin_amdgcn_make_buffer_rsrc((void*)Vh, 0, 0x7fffffff, 0x00020000);
#define ADMA(k0, BO) do { const int so_ = (k0) * (LDK * 2); \
    __builtin_amdgcn_raw_ptr_buffer_load_lds(rK, (LAS void*)(sdst + (BO)), 16, koff, so_, 0, 0); \
    __builtin_amdgcn_raw_ptr_buffer_load_lds(rK, (LAS void*)(sdst + (BO) + 8192), 16, koff, so_ + 32 * LDK * 2, 0, 0); \
    __builtin_amdgcn_raw_ptr_buffer_load_lds(rV, (LAS void*)(sdst + VB + (BO)), 16, voff, so_, 0, 0); \
    __builtin_amdgcn_raw_ptr_buffer_load_lds(rV, (LAS void*)(sdst + VB + (BO) + 8192), 16, voff, so_ + 32 * LDK * 2, 0, 0); } while (0)
#define AWAIT() asm volatile("s_waitcnt vmcnt(0)" ::: "memory")
  const int wsc = __builtin_amdgcn_readfirstlane(wid);
#define PREF(k0) do { int l_; asm volatile("v_mbcnt_lo_u32_b32 %0, -1, 0\n\tv_mbcnt_hi_u32_b32 %0, -1, %0" : "=v"(l_)); const unsigned pfo = (unsigned)((l_ >> 2) * (LDK * 2) + (l_ & 3) * 64); \
    __builtin_amdgcn_raw_ptr_buffer_load_lds(wsc < 4 ? rK : rV, (LAS void*)(lds + 140 * 1024 + wsc * 256), 4, pfo, ((k0) + 16 * (wsc & 3)) * (LDK * 2), 0, 0); } while (0)
#define XBARP() do { asm volatile("s_waitcnt vmcnt(1)" ::: "memory"); __builtin_amdgcn_s_barrier(); asm volatile("" ::: "memory"); } while (0)
#define LW(n_) asm volatile("s_waitcnt lgkmcnt(" #n_ ")" ::: "memory")
#define EXPK(P, kb) do { _Pragma("unroll") for (int qb = 0; qb < 2; ++qb) _Pragma("unroll") for (int r = 0; r < 4; ++r) P[kb][qb][r] = __builtin_amdgcn_exp2f(P[kb][qb][r]); } while (0)
#define KRD1(BO, t) ldr_o<(BO) + ((t) & 3) * 4096>(kx[(t) >> 2])
#define LWR(n_, R) asm volatile("s_waitcnt lgkmcnt(" #n_ ")" : "+v"(R) :: "memory")
#define LWK(t) do { if ((t) <= 12) LW(3); else if ((t) == 13) LW(2); else if ((t) == 14) LW(1); else LW(0); } while (0)
#define MFZ(D, A, B) asm volatile("v_mfma_f32_16x16x32_bf16 %0, %1, %2, 0" : "=&v"(D) : "v"(A), "v"(B))
#define MFA(D, A, B) asm volatile("v_mfma_f32_16x16x32_bf16 %0, %1, %2, %0" : "+v"(D) : "v"(A), "v"(B))
#define QKMM(P, t) do { if ((t) < 4) { MFZ(P[(t) & 3][0], kw_[(t) & 3], qf[0][(t) >> 2]); MFZ(P[(t) & 3][1], kw_[(t) & 3], qf[1][(t) >> 2]); } \
    else { MFA(P[(t) & 3][0], kw_[(t) & 3], qf[0][(t) >> 2]); MFA(P[(t) & 3][1], kw_[(t) & 3], qf[1][(t) >> 2]); } } while (0)
#define QKSTEP(P, BO, t) do { LWK(t); QKMM(P, t); if ((t) + 4 < 16) kw_[(t) & 3] = KRD1(BO, (t) + 4); } while (0)
#define QK4(P, BO, t0) do { QKSTEP(P, BO, t0); QKSTEP(P, BO, (t0) + 1); QKSTEP(P, BO, (t0) + 2); QKSTEP(P, BO, (t0) + 3); } while (0)
#define QKT16(P, BO) do { \
    kw_[0] = KRD1(BO, 0); kw_[1] = KRD1(BO, 1); kw_[2] = KRD1(BO, 2); kw_[3] = KRD1(BO, 3); QK4(P, BO, 0); QK4(P, BO, 4); QK4(P, BO, 8); QK4(P, BO, 12); SBAR(); } while (0)
#define QKSTEPV(P, BO, t, W_) do { LW(W_); QKMM(P, t); } while (0)
#define QKT16V(P, BO, PRE) do { \
    kw_[0] = KRD1(BO, 0); kw_[1] = KRD1(BO, 1); kw_[2] = KRD1(BO, 2); kw_[3] = KRD1(BO, 3); QK4(P, BO, 0); QK4(P, BO, 4); QK4(P, BO, 8); \
    QKSTEP(P, BO, 12); PRE; QKSTEPV(P, BO, 13, 10); QKSTEPV(P, BO, 14, 9); QKSTEPV(P, BO, 15, 8); SBAR(); } while (0)
#define VISS(TA, TB, S_, BO, D0) do { _Pragma("unroll") for (int db = 0; db < 4; ++db) { TA[db] = trr_o<(BO) + (S_) * 8192>(vx[(D0) + db]); TB[db] = trr_o<(BO) + (S_) * 8192 + 4096>(vx[(D0) + db]); } } while (0)
#define VMMA(TA, TB, S_, D0) do { _Pragma("unroll") for (int db = 0; db < 4; ++db) { const bf16x8 vf_ = (bf16x8){TA[db][0], TA[db][1], TA[db][2], TA[db][3], TB[db][0], TB[db][1], TB[db][2], TB[db][3]}; \
      o[0][(D0) + db] = MFMA16(pf[0][S_], vf_, o[0][(D0) + db]); o[1][(D0) + db] = MFMA16(pf[1][S_], vf_, o[1][(D0) + db]); } \
    if ((D0) == 0) { lacc[0] = MFMA16(pf[0][S_], ones_, lacc[0]); lacc[1] = MFMA16(pf[1][S_], ones_, lacc[1]); } } while (0)
#define PACKS(P, s_) do { _Pragma("unroll") for (int qb = 0; qb < 2; ++qb) \
      pf[qb][s_] = mk8w(pk2(P[2 * (s_)][qb][0], P[2 * (s_)][qb][1]), pk2(P[2 * (s_)][qb][2], P[2 * (s_)][qb][3]), pk2(P[2 * (s_) + 1][qb][0], P[2 * (s_) + 1][qb][1]), pk2(P[2 * (s_) + 1][qb][2], P[2 * (s_) + 1][qb][3])); } while (0)
#define LWV(n_, TA, TB) asm volatile("s_waitcnt lgkmcnt(" #n_ ")" : "+v"(TA[0]), "+v"(TA[1]), "+v"(TA[2]), "+v"(TA[3]), "+v"(TB[0]), "+v"(TB[1]), "+v"(TB[2]), "+v"(TB[3]) :: "memory")
#define PVXI(BO) do { VISS(ua_, ub_, 0, BO, 0); } while (0)
#define PVXB(BO, X0, X1, X2, X3) do { \
    VISS(uc_, ud_, 0, BO, 4); LW(8); SBAR(); VMMA(ua_, ub_, 0, 0); X0; SBAR(); \
    VISS(ua_, ub_, 1, BO, 0); LW(8); SBAR(); VMMA(uc_, ud_, 0, 4); X1; SBAR(); \
    VISS(uc_, ud_, 1, BO, 4); LW(8); SBAR(); VMMA(ua_, ub_, 1, 0); X2; SBAR(); \
    LW(0); SBAR(); VMMA(uc_, ud_, 1, 4); X3; SBAR(); } while (0)
#define PVXK(BO, SK, X0, X1, X2, X3) do { \
    VISS(uc_, ud_, 0, BO, 4); LW(8); SBAR(); VMMA(ua_, ub_, 0, 0); X0; SBAR(); \
    VISS(ua_, ub_, 1, BO, 0); LW(8); SBAR(); VMMA(uc_, ud_, 0, 4); X1; SBAR(); \
    VISS(uc_, ud_, 1, BO, 4); LW(8); SBAR(); VMMA(ua_, ub_, 1, 0); X2; SBAR(); \
    kw_[0] = KRD1(SK, 0); kw_[1] = KRD1(SK, 1); kw_[2] = KRD1(SK, 2); kw_[3] = KRD1(SK, 3); LW(4); SBAR(); VMMA(uc_, ud_, 1, 4); X3; SBAR(); } while (0)
#define QKTU(P, BO, PRE) do { QK4(P, BO, 0); QK4(P, BO, 4); QK4(P, BO, 8); \
    QKSTEP(P, BO, 12); PRE; QKSTEPV(P, BO, 13, 10); QKSTEPV(P, BO, 14, 9); QKSTEPV(P, BO, 15, 8); SBAR(); } while (0)
#define XBAR() do { AWAIT(); __builtin_amdgcn_s_barrier(); asm volatile("" ::: "memory"); } while (0)
#define EXPS4(XS) EXPK(pS, 0), EXPK(pS, 1), do { EXPK(pS, 2); PACKS(pS, 0); } while (0), EXPK(pS, 3)
#define L_INT(jj, SK, SD, S1, PF) do { if ((jj) + 1 < NT) ADMA(((jj) + 1) * KVBLK, SD); if (PF) PREF(((jj) + 2) * KVBLK); SBAR(); \
    kw_[0] = KRD1(SK, 0); kw_[1] = KRD1(SK, 1); kw_[2] = KRD1(SK, 2); kw_[3] = KRD1(SK, 3); QKTU(pS, SK, PVXI(S1)); \
    __builtin_amdgcn_s_setprio(1); PVXB(S1, EXPK(pS, 0), EXPK(pS, 1), do { EXPK(pS, 2); PACKS(pS, 0); } while (0), EXPK(pS, 3)); PACKS(pS, 1); __builtin_amdgcn_s_setprio(0); } while (0)
#define U_INT(jj, SK, SD, S1, S2, PF) do { if ((jj) + 1 < NT) ADMA(((jj) + 1) * KVBLK, SD); if (PF) PREF(((jj) + 2) * KVBLK); SBAR(); \
    __builtin_amdgcn_s_setprio(1); PVXK(S2, SK, EXPK(pS, 0), EXPK(pS, 1), do { EXPK(pS, 2); PACKS(pS, 0); } while (0), EXPK(pS, 3)); PACKS(pS, 1); __builtin_amdgcn_s_setprio(0); \
    QKTU(pS, SK, PVXI(S1)); } while (0)
#define S0_ 0
#define S1_ 16384
#define S2_ 32768
#define S3_ 49152
  f32x4 pS[4][2]; bf16x8 pf[2][2]; const int NT = seq / KVBLK;
  ADMA(0, S0_); ADMA(KVBLK, S1_);
  asm volatile("s_waitcnt vmcnt(4)" ::: "memory"); __builtin_amdgcn_s_barrier(); asm volatile("" ::: "memory");
  if (__builtin_amdgcn_readfirstlane(wid) < 4) {
    QKT16(pS, S0_); asm volatile("s_nop 15" ::: "memory"); SBAR(); EXPK(pS, 0); EXPK(pS, 1); EXPK(pS, 2); EXPK(pS, 3); PACKS(pS, 0); PACKS(pS, 1);
    XBAR();
    L_INT(1, S1_, S2_, S0_, 0); XBAR();
    for (int j = 2; j + 3 < NT; j += 4) { L_INT(j, S2_, S3_, S1_, 0); XBAR(); L_INT(j + 1, S3_, S0_, S2_, 0); XBAR(); L_INT(j + 2, S0_, S1_, S3_, 0); XBAR(); L_INT(j + 3, S1_, S2_, S0_, 0); XBAR(); }
    L_INT(NT - 2, S2_, S3_, S1_, 0); XBAR();
    L_INT(NT - 1, S3_, S0_, S2_, 0);
    SBAR(); PVXI(S3_); PVXB(S3_, (void)0, (void)0, (void)0, (void)0);
  } else {
    QKT16(pS, S0_);
    XBAR();
    ADMA(2 * KVBLK, S2_); asm volatile("s_nop 15" ::: "memory"); SBAR(); EXPK(pS, 0); EXPK(pS, 1); EXPK(pS, 2); EXPK(pS, 3); PACKS(pS, 0); PACKS(pS, 1);
    kw_[0] = KRD1(S1_, 0); kw_[1] = KRD1(S1_, 1); kw_[2] = KRD1(S1_, 2); kw_[3] = KRD1(S1_, 3); QKTU(pS, S1_, PVXI(S0_));
    XBAR();
    for (int j = 2; j + 3 < NT; j += 4) { U_INT(j, S2_, S3_, S1_, S0_, 0); XBAR(); U_INT(j + 1, S3_, S0_, S2_, S1_, 0); XBAR(); U_INT(j + 2, S0_, S1_, S3_, S2_, 0); XBAR(); U_INT(j + 3, S1_, S2_, S0_, S3_, 0); XBAR(); }
    U_INT(NT - 2, S2_, S3_, S1_, S0_, 0); XBAR();
    U_INT(NT - 1, S3_, S0_, S2_, S1_, 0);
    PVXB(S2_, EXPK(pS, 0), EXPK(pS, 1), do { EXPK(pS, 2); PACKS(pS, 0); } while (0), EXPK(pS, 3)); PACKS(pS, 1);
    SBAR(); PVXI(S3_); PVXB(S3_, (void)0, (void)0, (void)0, (void)0);
  }
  {
    int l2; asm volatile("v_mbcnt_lo_u32_b32 %0, -1, 0\n\tv_mbcnt_hi_u32_b32 %0, -1, %0" : "=v"(l2));
    const int n2 = l2 & 15, g2 = l2 >> 4;
    LAS unsigned char* pw = (LAS unsigned char*)(lds + __builtin_amdgcn_readfirstlane(wid) * 4352);
    bf16_t* Og = Ob + (long)(wid * QBLK + g2) * LDO + n2 * 8;
#pragma unroll
    for (int qb = 0; qb < 2; ++qb) {
#pragma unroll
      for (int r = 0; r < 4; ++r) { const float rl = __builtin_amdgcn_rcpf(lacc[qb][r]);
#pragma unroll
        for (int db = 0; db < 8; ++db) *(LAS bf16_t*)(pw + (4 * g2 + r) * 272 + (16 * db + n2) * 2) = (bf16_t)(pk2(o[qb][db][r] * rl, 0.f) & 0xffffu); }
      asm volatile("s_waitcnt lgkmcnt(0)" ::: "memory");
      u32x4 rowv[4];
#pragma unroll
      for (int i = 0; i < 4; ++i) rowv[i] = *(const LAS u32x4*)(pw + (4 * i + g2) * 272 + n2 * 16);
#pragma unroll
      for (int i = 0; i < 4; ++i) *(u32x4*)(Og + (long)(16 * qb + 4 * i) * LDO) = rowv[i];
      asm volatile("s_waitcnt lgkmcnt(0)" ::: "memory"); } }
  asm volatile("s_waitcnt vmcnt(0) lgkmcnt(0)" ::: "memory"); __syncthreads();
#undef ADMA
#undef AWAIT
#undef EXPK
#undef KRD1
#undef QKSTEP
#undef QK4
#undef LWK
#undef LWR
#undef LWV
#undef QKT16
#undef VISS
#undef VMMA
#undef PACKS
#undef LW
#undef PVXK
#undef QKTU
#undef XBAR
#undef XBARP
#undef PREF
#undef EXPS4
#undef L_INT
#undef U_INT
#undef S0_
#undef S1_
#undef S2_
#undef S3_
#undef PVXI
#undef PVXB
#undef QKSTEPV
#undef MFZ
#undef MFA
#undef QKMM
#undef QKT16V
}
}

struct Args {
    const float* in[29]; float* out; unsigned char* ws; int ph_lo, ph_hi;
};
enum { I_X = 0, I_C, I_CTX, I_CCTX, I_WADA, I_BADA, I_LNG, I_LNB, I_AWQKV, I_AQG, I_AKG, I_AWO, I_BWIN, I_BVG, I_BVB, I_BWS, I_BBS, I_BWOUT,
       I_CWIN, I_CCONV, I_CALOG, I_CDTB, I_CNG, I_CWOUT, I_WROUTER, I_RBIAS, I_EGATE, I_EUP, I_EDOWN };

struct Frame {
    LAS unsigned char* lds; char* ldsg;
    int tid, lane, wave, bid, G, gw, NGW;
    const Args* a;
    unsigned char* ws; float* out;
};
#define FRAME_REFRESH(F) do { int l_; asm volatile("v_mbcnt_lo_u32_b32 %0, -1, 0\n\tv_mbcnt_hi_u32_b32 %0, -1, %0" : "=v"(l_)); (F).lane = l_; (F).tid = (F).wave * 64 + l_; } while (0)
__device__ __forceinline__ bf16_t* hlat_base(const Frame& F) { return (bf16_t*)((char*)F.out + 64 * MiB); }
__device__ __forceinline__ bf16_t* hrow(const Frame& F, int t) { return t < TLAT ? hlat_base(F) + (size_t)t * D : (bf16_t*)(F.ws + WS_HCTX) + (size_t)(t - TLAT) * D; }
__device__ __forceinline__ bf16_t* RG(const Frame& F, int i) { return (bf16_t*)(F.ws + WS_R0 + (size_t)i * RSZ); }
__device__ __forceinline__ const float* modrow(const Frame& F, int layer, int mi) { return (const float*)(F.ws + WS_MOD) + (size_t)(layer * 5 + mi) * 6144; }

__device__ __forceinline__ void transpose_item(const float* W, size_t sld, bf16_t* WT, size_t dld, int drow0, int k0, int n0, LAS float* scr, int lane) {
#pragma unroll 8
    for (int i = 0; i < 32; ++i) { const int kk = 2 * i + (lane >> 5); scr[kk * 33 + (lane & 31)] = W[(size_t)(k0 + kk) * sld + n0 + (lane & 31)]; }
    LDS_WAIT(); asm volatile("" ::: "memory");
    const int c = lane & 7;
#pragma unroll
    for (int j = 0; j < 4; ++j) { const int n = (lane >> 3) + 8 * j; const LAS float* s = scr + (8 * c) * 33 + n;
        u32x4 o; o.x = pk2(s[0 * 33], s[1 * 33]); o.y = pk2(s[2 * 33], s[3 * 33]); o.z = pk2(s[4 * 33], s[5 * 33]); o.w = pk2(s[6 * 33], s[7 * 33]);
        *(u32x4*)(WT + (size_t)(drow0 + n) * dld + k0 + 8 * c) = o; }
    LDS_WAIT(); asm volatile("" ::: "memory");
}
__device__ __forceinline__ bool dense_item(int& r, const float* W, int K, int N, bf16_t* WT, LAS float* scr, int lane) {
    const int nblk = N / 32, items = (K / 64) * nblk;
    if (r >= items) { r -= items; return false; }
    const int kb = r / nblk, nb = r % nblk;
    transpose_item(W, (size_t)N, WT, (size_t)K, 32 * nb, 64 * kb, 32 * nb, scr, lane);
    return true;
}
__device__ __forceinline__ void p0_prologue(Frame& F) {
    const Args& A = *F.a;
    LAS float* scr = (LAS float*)(F.lds + F.wave * 16384);
    const int ngv = (F.G >= 256) ? 192 : F.G / 2;
    constexpr int NITEMS = 2 * (16 * 48) + 2 * (16 * 32) + 16 * 64 + 16 * 32 + 16 * 129 + 16 * 32;
    if (F.bid >= ngv)
    for (int it = (F.bid - ngv) * NWAVES + F.wave; it < NITEMS; it += (F.G - ngv) * NWAVES) {
        int r = it;
        if (dense_item(r, A.in[I_AWQKV], D, 1536, (bf16_t*)(F.ws + WS_WQKV), scr, F.lane)) continue;
        if (dense_item(r, A.in[I_AWQKV] + (size_t)D * 1536, D, 1536, (bf16_t*)(F.ws + WS_WQKV) + (size_t)1536 * D, scr, F.lane)) continue;
        if (dense_item(r, A.in[I_AWO], D, D, (bf16_t*)(F.ws + WS_WO), scr, F.lane)) continue;
        if (dense_item(r, A.in[I_AWO] + (size_t)D * D, D, D, (bf16_t*)(F.ws + WS_WO) + (size_t)D * D, scr, F.lane)) continue;
        if (dense_item(r, A.in[I_BWIN], D, 2048, (bf16_t*)(F.ws + WS_BWIN), scr, F.lane)) continue;
        if (dense_item(r, A.in[I_BWOUT], D, D, (bf16_t*)(F.ws + WS_BWOUT), scr, F.lane)) continue;
        if (dense_item(r, A.in[I_CWIN], D, CW_N, (bf16_t*)(F.ws + WS_CWIN), scr, F.lane)) continue;
        dense_item(r, A.in[I_CWOUT], D, D, (bf16_t*)(F.ws + WS_CWOUT), scr, F.lane);
    }
    FRAME_REFRESH(F);
    const int gt = F.bid * NTHR + F.tid, NGT = F.G * NTHR;
    { u32x4* z = (u32x4*)((bf16_t*)(F.ws + WS_CWIN) + (size_t)CW_N * D); const int n16 = (CW_NPAD - CW_N) * D * 2 / 16;
      for (int i = gt; i < n16; i += NGT) z[i] = (u32x4){0u, 0u, 0u, 0u}; }
    { const float* s = A.in[I_BWS]; unsigned* d = (unsigned*)(F.ws + WS_BWS);
      for (int i = gt; i < 8 * 128 * 128 / 2; i += NGT) d[i] = pk2(s[2 * i], s[2 * i + 1]); }
    { f32x2* rt = (f32x2*)(F.ws + WS_ROPE);
      for (int i = gt; i < SEQ * 64; i += NGT) { const int n = i >> 6, p = i & 63; const int pp = p & 31;
        const float inv = 1.0f / powf(10000.0f, (float)(2 * pp) / 64.0f);
        const float pos = (p < 32) ? (float)(n >> 6) : (float)(n & 63);
        const float ang = pos * inv; float sn, cs; sincosf(ang, &sn, &cs); rt[i] = (f32x2){cs, sn}; } }
    __syncthreads();
    FRAME_REFRESH(F);
    if (F.bid < ngv) {
        LAS float* sc = (LAS float*)F.lds;
        LAS f32x4* red = (LAS f32x4*)(F.lds + 32768);
        for (int i = F.tid; i < 5 * D; i += NTHR) { const float v = (i < 4 * D) ? A.in[I_C][i] : A.in[I_CCTX][i - 4 * D]; sc[i] = siluf_(v); }
        __syncthreads();
        for (int item = F.bid; item < 192; item += ngv) {
            const int l = item / 48, cb = item % 48, half = F.lane >> 5, cl = F.lane & 31, col0 = cb * 128 + 4 * cl;
            const float* wp = A.in[I_WADA] + ((size_t)l * D + F.wave * 128 + half) * 6144 + col0;
            f32x4 acc[5];
#pragma unroll
            for (int mi = 0; mi < 5; ++mi) acc[mi] = (f32x4){0.f, 0.f, 0.f, 0.f};
#pragma unroll 8
            for (int k = 0; k < 64; ++k) { const f32x4 w = *(const f32x4*)(wp + (size_t)(2 * k) * 6144);
#pragma unroll
                for (int mi = 0; mi < 5; ++mi) acc[mi] += w * sc[mi * D + F.wave * 128 + 2 * k + half]; }
#pragma unroll
            for (int mi = 0; mi < 5; ++mi) red[((F.wave * 2 + half) * 5 + mi) * 32 + cl] = acc[mi];
            __syncthreads();
            for (int o = F.tid; o < 5 * 128; o += NTHR) { const int mi = o >> 7, c = o & 127; float s = A.in[I_BADA][l * 6144 + cb * 128 + c];
                const LAS float* rf = (const LAS float*)red;
#pragma unroll
                for (int w = 0; w < 16; ++w) s += rf[((w * 5 + mi) * 32 + (c >> 2)) * 4 + (c & 3)];
                ((float*)(F.ws + WS_MOD))[(size_t)(l * 5 + mi) * 6144 + cb * 128 + c] = s; }
            __syncthreads();
        }
    }
}
__device__ __forceinline__ void p1_init(Frame& F) {
    const Args& A = *F.a; bf16_t* U = RG(F, 0);
    const int per = (TT + F.G - 1) / F.G, r0 = F.bid * per, r1 = (r0 + per < TT) ? r0 + per : TT;
    f32x4 scv[4], shv[4], xc[4], xn[4]; int cur_mi = -1;
#pragma unroll
    for (int j = 0; j < 4; ++j) { scv[j] = (f32x4){0.f, 0.f, 0.f, 0.f}; shv[j] = scv[j]; xc[j] = scv[j]; xn[j] = scv[j]; }
#define P1_LOAD(X, t_) do { const float* src_ = (t_) < TLAT ? A.in[I_X] + (size_t)(t_) * D : A.in[I_CTX] + (size_t)((t_) - TLAT) * D; \
        _Pragma("unroll") for (int j = 0; j < 4; ++j) X[j] = *(const f32x4*)(src_ + 256 * j + 4 * F.lane); } while (0)
    if (r0 + F.wave < r1) P1_LOAD(xc, r0 + F.wave);
    for (int t = r0 + F.wave; t < r1; t += NWAVES) {
        FRAME_REFRESH(F);
        if (t + NWAVES < r1) P1_LOAD(xn, t + NWAVES);
        bf16_t* hp = hrow(F, t); const int mi = t < TLAT ? (t >> 13) : 4;
        if (mi != cur_mi) { cur_mi = mi; const float* mp = modrow(F, 0, mi);
#pragma unroll
            for (int j = 0; j < 4; ++j) { shv[j] = *(const f32x4*)(mp + 256 * j + 4 * F.lane); scv[j] = *(const f32x4*)(mp + 1024 + 256 * j + 4 * F.lane) + 1.0f; } }
#pragma unroll
        for (int j = 0; j < 4; ++j) { const int col = 256 * j + 4 * F.lane; const f32x4 v = xc[j];
            *(u32x2*)(hp + col) = (u32x2){pk2(v[0], v[1]), pk2(v[2], v[3])};
            const f32x4 u = v * scv[j] + shv[j];
            *(u32x2*)(U + (size_t)t * D + col) = (u32x2){pk2(u[0], u[1]), pk2(u[2], u[3])}; }
#pragma unroll
        for (int j = 0; j < 4; ++j) xc[j] = xn[j];
    }
#undef P1_LOAD
}

__device__ __forceinline__ void moe_convert(Frame& F, int layer, int first) {
    const Args& A = *F.a;
    if (F.G <= 2 * first) first = 0;
    const int nw = (F.G - first) * NWAVES, gw = (F.bid - first) * NWAVES + F.wave;
    if (F.bid >= first) {
      LAS float* scr = (LAS float*)(F.lds + F.wave * 16384);
      const float* eg = A.in[I_EGATE] + (size_t)layer * NE * D * DE; const float* eu = A.in[I_EUP] + (size_t)layer * NE * D * DE; const float* ed = A.in[I_EDOWN] + (size_t)layer * NE * DE * D;
      bf16_t* W1 = (bf16_t*)(F.ws + WS_WE1); bf16_t* W2 = (bf16_t*)(F.ws + WS_WE2);
      for (int it = gw; it < NE * 768; it += nw) { const int e = it / 768, r = it % 768;
        if (r < 512) { const int up = r >> 8, q = r & 255, kb = q >> 4, nb = q & 15, n0 = 32 * nb;
            transpose_item((up ? eu : eg) + (size_t)e * D * DE, DE, W1 + (size_t)e * D * D, D, (n0 >> 7) * 256 + (n0 & 127) + up * 128, 64 * kb, n0, scr, F.lane); }
        else { const int q = r - 512, kb = q >> 5, nb = q & 31;
            transpose_item(ed + (size_t)e * DE * D, D, W2 + (size_t)e * D * DE, DE, 32 * nb, 64 * kb, 32 * nb, scr, F.lane); } }
    }
}
__device__ __forceinline__ void moe_route(Frame& F, int layer, int nrows, bool last) {
    const Args& A = *F.a;
    LAS float* WR = (LAS float*)F.lds;
    LAS int* CNT = (LAS int*)(F.lds + 65536); LAS int* BASE = CNT + 16; LAS int* EID = CNT + 64; LAS int* RK = EID + 2 * 272; LAS float* WT = (LAS float*)(RK + 2 * 272); LAS float* LG = (LAS float*)(F.lds + 65536 + 8192);
    for (int idx = F.tid; idx < D * NE; idx += NTHR) { const int k = idx >> 4, e = idx & 15, j = k >> 8, ln = (k >> 2) & 63, i = k & 3, q = e >> 2;
        WR[((((j * 4 + i) * 4 + q) * 64 + ln) << 2) + (e & 3)] = A.in[I_WROUTER][idx]; }
    if (F.tid < 16) CNT[F.tid] = 0;
    __syncthreads();
    const int per = (nrows + F.G - 1) / F.G, r0 = F.bid * per, r1 = (r0 + per < nrows) ? r0 + per : nrows;
    const float* lg = A.in[I_LNG] + (size_t)(layer * 2 + 0) * D; const float* lb = A.in[I_LNB] + (size_t)(layer * 2 + 0) * D;
    bf16_t* U2 = RG(F, 0); int* LIST = (int*)(F.ws + WS_LIST); float* WLIST = (float*)(F.ws + WS_WLIST);
    float rb[16];
#pragma unroll
    for (int e = 0; e < 16; ++e) rb[e] = A.in[I_RBIAS][e];
    u32x2 zc[4], zn[4];
    f32x4 lgv[4], lbv[4], scv[4], shv[4]; int cur_mi = -1;
#pragma unroll
    for (int j = 0; j < 4; ++j) { lgv[j] = *(const f32x4*)(lg + 256 * j + 4 * F.lane); lbv[j] = *(const f32x4*)(lb + 256 * j + 4 * F.lane); scv[j] = lgv[j]; shv[j] = lgv[j]; }
    { const int t = r0 + F.wave; if (t < r1) { const bf16_t* zp = hrow(F, t);
#pragma unroll
        for (int j = 0; j < 4; ++j) zc[j] = *(const u32x2*)(zp + 256 * j + 4 * F.lane); } }
    for (int t = r0 + F.wave; t < r1; t += NWAVES) {
        FRAME_REFRESH(F);
        if (t + NWAVES < r1) { const bf16_t* zq = hrow(F, t + NWAVES);
#pragma unroll
            for (int j = 0; j < 4; ++j) zn[j] = *(const u32x2*)(zq + 256 * j + 4 * F.lane); }
        bf16_t* hp = last ? RG(F, 6) + (size_t)t * D : hrow(F, t); const int mi = t < TLAT ? (t >> 13) : 4;
        if (mi != cur_mi) { cur_mi = mi; const float* mp = modrow(F, layer, mi);
#pragma unroll
            for (int j = 0; j < 4; ++j) { scv[j] = *(const f32x4*)(mp + 4096 + 256 * j + 4 * F.lane) + 1.0f; shv[j] = *(const f32x4*)(mp + 3072 + 256 * j + 4 * F.lane); } }
        f32x4 v[4]; float s = 0.f;
#pragma unroll
        for (int j = 0; j < 4; ++j) { const u32x2 zw = zc[j]; v[j] = (f32x4){bflo(zw.x), bfhi(zw.x), bflo(zw.y), bfhi(zw.y)}; s += (v[j][0] + v[j][1]) + (v[j][2] + v[j][3]); }
        const float mean = wave_sum(s) * (1.f / D); float s2 = 0.f;
#pragma unroll
        for (int j = 0; j < 4; ++j) { v[j] = v[j] - mean; s2 += (v[j][0] * v[j][0] + v[j][1] * v[j][1]) + (v[j][2] * v[j][2] + v[j][3] * v[j][3]); }
        const float rstd = 1.f / sqrtf(wave_sum(s2) * (1.f / D) + EPS);
        f32x2 acc2[8];
#pragma unroll
        for (int e = 0; e < 8; ++e) acc2[e] = (f32x2){0.f, 0.f};
#pragma unroll
        for (int j = 0; j < 4; ++j) { const int col = 256 * j + 4 * F.lane;
            const f32x4 hn = v[j] * rstd * lgv[j] + lbv[j];
            *(u32x2*)(hp + col) = (u32x2){pk2(hn[0], hn[1]), pk2(hn[2], hn[3])};
            const f32x4 u2 = hn * scv[j] + shv[j];
            *(u32x2*)(U2 + (size_t)t * D + col) = (u32x2){pk2(u2[0], u2[1]), pk2(u2[2], u2[3])};
#pragma unroll
            for (int i = 0; i < 4; ++i)
#pragma unroll
                for (int q = 0; q < 4; ++q) { const f32x4 w = *(const LAS f32x4*)(WR + ((((j * 4 + i) * 4 + q) * 64 + F.lane) << 2));
                    const f32x2 uu = {u2[i], u2[i]};
                    acc2[2 * q] += uu * (f32x2){w[0], w[1]}; acc2[2 * q + 1] += uu * (f32x2){w[2], w[3]}; } }
        float a8[8], a4[4], a2[2], lg1;
        { const bool hi5 = (F.lane & 32) != 0, hi4 = (F.lane & 16) != 0, hi3 = (F.lane & 8) != 0, hi2 = (F.lane & 4) != 0;
#pragma unroll
          for (int e = 0; e < 8; ++e) { const float lo = acc2[e >> 1][e & 1], hi = acc2[4 + (e >> 1)][e & 1]; a8[e] = (hi5 ? hi : lo) + __shfl_xor(hi5 ? lo : hi, 32); }
#pragma unroll
          for (int e = 0; e < 4; ++e) a4[e] = (hi4 ? a8[e + 4] : a8[e]) + __shfl_xor(hi4 ? a8[e] : a8[e + 4], 16);
#pragma unroll
          for (int e = 0; e < 2; ++e) a2[e] = (hi3 ? a4[e + 2] : a4[e]) + __shfl_xor(hi3 ? a4[e] : a4[e + 2], 8);
          lg1 = (hi2 ? a2[1] : a2[0]) + __shfl_xor(hi2 ? a2[0] : a2[1], 4);
          lg1 += __shfl_xor(lg1, 2); lg1 += __shfl_xor(lg1, 1); }
        if ((F.lane & 3) == 0) LG[(t - r0) * 16 + (F.lane >> 2)] = lg1;
#pragma unroll
        for (int j = 0; j < 4; ++j) zc[j] = zn[j];
    }
    FRAME_REFRESH(F);
    __syncthreads();
    for (int rl = F.tid; rl < r1 - r0; rl += NTHR) {
        float sc[16], sel[16];
#pragma unroll
        for (int q = 0; q < 4; ++q) { const f32x4 l4 = *(const LAS f32x4*)(LG + rl * 16 + 4 * q);
#pragma unroll
            for (int i = 0; i < 4; ++i) { sc[4 * q + i] = 1.f / (1.f + expf(-l4[i])); sel[4 * q + i] = sc[4 * q + i] + rb[4 * q + i]; } }
        float gs[4];
#pragma unroll
        for (int g = 0; g < 4; ++g) { const float a = sel[4 * g], b = sel[4 * g + 1], c = sel[4 * g + 2], d = sel[4 * g + 3];
            const float hi1 = fmaxf(a, b), lo1 = fminf(a, b), hi2 = fmaxf(c, d), lo2 = fminf(c, d);
            const float m1 = fmaxf(hi1, hi2), m2 = fmaxf(fminf(hi1, hi2), fmaxf(lo1, lo2)); gs[g] = m1 + m2; }
        int bg = 0; float bgs = gs[0];
#pragma unroll
        for (int g = 1; g < 4; ++g) if (gs[g] > bgs) { bgs = gs[g]; bg = g; }
        float s4[4], c4[4];
#pragma unroll
        for (int i = 0; i < 4; ++i) { s4[i] = bg == 0 ? sel[i] : bg == 1 ? sel[4 + i] : bg == 2 ? sel[8 + i] : sel[12 + i]; c4[i] = bg == 0 ? sc[i] : bg == 1 ? sc[4 + i] : bg == 2 ? sc[8 + i] : sc[12 + i]; }
        int i1 = 0; float b1 = s4[0], w1 = c4[0];
#pragma unroll
        for (int i = 1; i < 4; ++i) if (s4[i] > b1) { b1 = s4[i]; i1 = i; w1 = c4[i]; }
        int i2 = -1; float b2 = -3.0e38f, w2 = 0.f;
#pragma unroll
        for (int i = 0; i < 4; ++i) if (i != i1 && s4[i] > b2) { b2 = s4[i]; i2 = i; w2 = c4[i]; }
        const int e1 = bg * 4 + i1, e2 = bg * 4 + i2; const float wn = 1.f / (w1 + w2);
        const int k1 = __hip_atomic_fetch_add(CNT + e1, 1, __ATOMIC_RELAXED, __HIP_MEMORY_SCOPE_WORKGROUP);
        const int k2 = __hip_atomic_fetch_add(CNT + e2, 1, __ATOMIC_RELAXED, __HIP_MEMORY_SCOPE_WORKGROUP);
        EID[2 * rl] = e1; EID[2 * rl + 1] = e2; RK[2 * rl] = k1; RK[2 * rl + 1] = k2; WT[2 * rl] = w1 * wn; WT[2 * rl + 1] = w2 * wn;
    }
    __syncthreads();
    if (F.tid < 16) BASE[F.tid] = (int)__hip_atomic_fetch_add((unsigned*)(F.ws + WS_CTL) + CW_CNT + layer * 16 + F.tid, (unsigned)CNT[F.tid], RLX_AGENT);
    __syncthreads();
    for (int rl = F.tid; rl < r1 - r0; rl += NTHR) { const int t = r0 + rl; const int e1 = EID[2 * rl], e2 = EID[2 * rl + 1];
        const int p1 = e1 * TT + BASE[e1] + RK[2 * rl], p2 = e2 * TT + BASE[e2] + RK[2 * rl + 1];
        LIST[p1] = 2 * t; WLIST[p1] = WT[2 * rl]; LIST[p2] = 2 * t + 1; WLIST[p2] = WT[2 * rl + 1]; }
}
__device__ __forceinline__ void moe_tables(Frame& F, int layer) {
    LAS int* TS = (LAS int*)(F.lds + GTAB_OFF); LAS int* CN = TS + 32;
    if (F.tid == 0) { const unsigned* gc = (const unsigned*)(F.ws + WS_CTL) + CW_CNT + layer * 16; int acc = 0;
        for (int e = 0; e < NE; ++e) { const int c = (int)gc[e]; TS[e] = acc; CN[e] = c; acc += (c + 255) >> 8; } TS[NE] = acc; }
    __syncthreads();
}
__device__ __forceinline__ void moe_toktable(Frame& F, const pg8::GroupedOrder& S) {
    const int* LIST = (const int*)(F.ws + WS_LIST); LAS int* TOK = (LAS int*)(F.lds + GTOK_OFF);
    Unit u;
    for (int i = 0; i < GTOK_MAXU && S.next(i, u); ++i)
        if (F.tid < 256) TOK[i * 256 + F.tid] = (F.tid < u.nvalid) ? (LIST[u.lbase + F.tid] >> 1) : 0;
    __syncthreads();
}
__device__ __forceinline__ void moe_dsttable(Frame& F, const pg8::GroupedOrder& S) {
    const int* LIST = (const int*)(F.ws + WS_LIST); const float* WLIST = (const float*)(F.ws + WS_WLIST);
    LAS int* DSTL = (LAS int*)(F.lds + GTOK_OFF); LAS float* WL = (LAS float*)(F.lds + GTOK_OFF + GTOK_MAXU * 1024);
    Unit u;
    for (int i = 0; i < GTOK_MAXU && S.next(i, u); ++i)
        if (F.tid < 256) { const bool ok = F.tid < u.nvalid; DSTL[i * 256 + F.tid] = ok ? LIST[u.lbase + F.tid] : 0; WL[i * 256 + F.tid] = ok ? WLIST[u.lbase + F.tid] : 0.f; }
    __syncthreads();
}
__device__ __forceinline__ void moe_scatter(Frame& F, int layer, int nrows, bool last) {
    moe_tables(F, layer);
    const LAS int* TS = (const LAS int*)(F.lds + GTAB_OFF);
    bf16_t* XS = (bf16_t*)(F.ws + WS_XS); int* rowmap = (int*)(F.ws + WS_ROWMAP); float* roww = (float*)(F.ws + WS_ROWW);
    for (int t = F.gw; t < nrows; t += F.NGW) {
        const bf16_t* hp = last ? RG(F, 6) + (size_t)t * D : hrow(F, t); const int mi = t < TLAT ? (t >> 13) : 4; const float* mp = modrow(F, layer, mi);
        const i32x2 ee = ((const i32x2*)(F.ws + WS_ASG))[t]; const i32x2 pp = ((const i32x2*)(F.ws + WS_POS))[t]; const f32x2 ww = ((const f32x2*)(F.ws + WS_ASGW))[t];
        const int d0 = TS[ee.x] * 256 + pp.x, d1 = TS[ee.y] * 256 + pp.y;
#pragma unroll
        for (int j = 0; j < 4; ++j) { const int col = 256 * j + 4 * F.lane; const u32x2 hw = *(const u32x2*)(hp + col); const f32x4 hn = {bflo(hw.x), bfhi(hw.x), bflo(hw.y), bfhi(hw.y)};
            const f32x4 u = hn * (*(const f32x4*)(mp + 4096 + col) + 1.0f) + *(const f32x4*)(mp + 3072 + col);
            const u32x2 w = {pk2(u[0], u[1]), pk2(u[2], u[3])};
            *(u32x2*)(XS + (size_t)d0 * D + col) = w; *(u32x2*)(XS + (size_t)d1 * D + col) = w; }
        if (F.lane == 0) { rowmap[d0] = 2 * t; rowmap[d1] = 2 * t + 1; roww[d0] = ww.x; roww[d1] = ww.y; }
    }
}
__device__ __forceinline__ void moe_ln2(Frame& F, int layer, int nrows, bool last) {
    const Args& A = *F.a; const bf16_t* Y2 = (const bf16_t*)(F.ws + WS_Y2); bf16_t* U = RG(F, 0);
    const float* lg = A.in[I_LNG] + (size_t)(layer * 2 + 1) * D; const float* lb = A.in[I_LNB] + (size_t)(layer * 2 + 1) * D;
    const int per = (nrows + F.G - 1) / F.G, r0 = F.bid * per, r1 = (r0 + per < nrows) ? r0 + per : nrows;
    f32x4 lgv[4], lbv[4], g2v[4], scv[4], shv[4]; int cur_mi = -1;
#pragma unroll
    for (int j = 0; j < 4; ++j) { lgv[j] = *(const f32x4*)(lg + 256 * j + 4 * F.lane); lbv[j] = *(const f32x4*)(lb + 256 * j + 4 * F.lane); g2v[j] = lgv[j]; scv[j] = lgv[j]; shv[j] = lgv[j]; }
    u32x2 hc[4], ya[4], yb[4], hn_[4], yan[4], ybn[4];
#define LN2_LOAD(H, YA, YB, t_) do { const bf16_t* hin_ = last ? RG(F, 6) + (size_t)(t_) * D : hrow(F, (t_)); \
        _Pragma("unroll") for (int j = 0; j < 4; ++j) { const int col = 256 * j + 4 * F.lane; H[j] = *(const u32x2*)(hin_ + col); \
            YA[j] = *(const u32x2*)(Y2 + (size_t)(2 * (t_)) * D + col); YB[j] = *(const u32x2*)(Y2 + (size_t)(2 * (t_) + 1) * D + col); } } while (0)
    if (r0 + F.wave < r1) LN2_LOAD(hc, ya, yb, r0 + F.wave);
    for (int t = r0 + F.wave; t < r1; t += NWAVES) {
        FRAME_REFRESH(F);
        if (t + NWAVES < r1) LN2_LOAD(hn_, yan, ybn, t + NWAVES);
        bf16_t* hp = hrow(F, t); const int mi = t < TLAT ? (t >> 13) : 4;
        if (mi != cur_mi) { cur_mi = mi; const float* mp = modrow(F, layer, mi); const float* mn = modrow(F, last ? layer : layer + 1, mi);
#pragma unroll
            for (int j = 0; j < 4; ++j) { const int col = 256 * j + 4 * F.lane; g2v[j] = *(const f32x4*)(mp + 5120 + col); scv[j] = *(const f32x4*)(mn + 1024 + col) + 1.0f; shv[j] = *(const f32x4*)(mn + col); } }
        f32x4 v[4]; float s = 0.f;
#pragma unroll
        for (int j = 0; j < 4; ++j) { const f32x4 hv = {bflo(hc[j].x), bfhi(hc[j].x), bflo(hc[j].y), bfhi(hc[j].y)};
            const f32x4 y = {bflo(ya[j].x) + bflo(yb[j].x), bfhi(ya[j].x) + bfhi(yb[j].x), bflo(ya[j].y) + bflo(yb[j].y), bfhi(ya[j].y) + bfhi(yb[j].y)};
            v[j] = hv * DN_ALPHA + g2v[j] * y; s += (v[j][0] + v[j][1]) + (v[j][2] + v[j][3]); }
        const float mean = wave_sum(s) * (1.f / D); float s2 = 0.f;
#pragma unroll
        for (int j = 0; j < 4; ++j) { v[j] = v[j] - mean; s2 += (v[j][0] * v[j][0] + v[j][1] * v[j][1]) + (v[j][2] * v[j][2] + v[j][3] * v[j][3]); }
        const float rstd = 1.f / sqrtf(wave_sum(s2) * (1.f / D) + EPS);
#pragma unroll
        for (int j = 0; j < 4; ++j) { const int col = 256 * j + 4 * F.lane;
            const f32x4 hn = v[j] * rstd * lgv[j] + lbv[j];
#if PROBE_T
            if (last) { const unsigned long long* dg = (const unsigned long long*)(F.ws + WS_CTL + 512 * 1024); const float nu = (float)(dg[2] ? dg[2] : 1ull);
                float c = PROBE_T == 1 ? (float)dg[0] / nu * 0.01f : PROBE_T == 2 ? (float)dg[1] / nu * 0.01f : (PROBE_T == 4 ? (float)dg[3] / nu * 0.0025f : PROBE_T == 5 ? (float)dg[3] * 0.000625f : (float)dg[3] * 0.0025f); c = floorf((c + 1.0f) * 0.5f) * 2.0f; *(f32x4*)(F.out + (size_t)t * D + col) = (f32x4){c, c, c, c}; } else
#else
            if (last) *(f32x4*)(F.out + (size_t)t * D + col) = hn; else
#endif
            *(u32x2*)(hp + col) = (u32x2){pk2(hn[0], hn[1]), pk2(hn[2], hn[3])};
            if (!last) { const f32x4 u = hn * scv[j] + shv[j];
                *(u32x2*)(U + (size_t)t * D + col) = (u32x2){pk2(u[0], u[1]), pk2(u[2], u[3])}; } }
#pragma unroll
        for (int j = 0; j < 4; ++j) { hc[j] = hn_[j]; ya[j] = yan[j]; yb[j] = ybn[j]; }
    }
#undef LN2_LOAD
}

__device__ __forceinline__ bool attn_fast_ok(const Frame& F, int j) {
    const float* qg = F.a->in[I_AQG] + j * 128; const float* kg = F.a->in[I_AKG] + j * 128; float mq = 0.f, mk = 0.f;
    for (int i = 0; i < 128; ++i) { mq = fmaxf(mq, fabsf(qg[i])); mk = fmaxf(mk, fabsf(kg[i])); }
    return att::SCALE * 1.4426950408889634f * 128.f * mq * mk < 96.f;
}
__device__ __forceinline__ void qk_norm_rope(Frame& F, int j, const pg8::StaticOrder& S) {
    const Args& A = *F.a; const float* qg = A.in[I_AQG] + j * 128; const float* kg = A.in[I_AKG] + j * 128;
    bf16_t* Q = RG(F, 1); bf16_t* Kb = RG(F, 2); const f32x2* rope = (const f32x2*)(F.ws + WS_ROPE);
    const int sub = F.lane >> 4, l16 = F.lane & 15; const bool fast = attn_fast_ok(F, j);
    Unit u;
    for (int i = 0; S.next(i, u); ++i) {
        if (u.pn >= 5) continue;
        const float* gn = u.pn < 4 ? qg : kg; const float qs = (u.pn < 4 && fast) ? att::SCALE * 1.4426950408889634f : 1.f;
        float gv[8];
#pragma unroll
        for (int e = 0; e < 8; ++e) gv[e] = gn[l16 * 8 + e] * qs;
        bf16_t* base; size_t ld; size_t r0;
        if (u.pn < 4) { base = Q + u.pn * 256; ld = D; r0 = (size_t)u.pm * 256; }
        else { base = Kb; ld = 256; r0 = u.pm < 128 ? (size_t)(u.pm >> 5) * KVLEN + CTXL + (size_t)(u.pm & 31) * 256 : (size_t)(u.pm - 128) * KVLEN; }
        const bool lat = u.pm < 128;
#pragma unroll 1
        for (int it0 = 0; it0 < 16; it0 += 8) {
            u32x4 wv[8]; f32x2 cs[8][4];
#pragma unroll
            for (int k = 0; k < 8; ++k) { const int pi = (it0 + k) * 32 + F.wave * 4 + sub, row = pi >> 1, hh = pi & 1;
                wv[k] = *(const u32x4*)(base + (r0 + row) * ld + hh * 128 + l16 * 8);
                if (lat) { const int n = (u.pm & 31) * 256 + row;
#pragma unroll
                    for (int e = 0; e < 4; ++e) cs[k][e] = rope[(size_t)n * 64 + l16 * 4 + e]; } }
#pragma unroll
            for (int k = 0; k < 8; ++k) { const int pi = (it0 + k) * 32 + F.wave * 4 + sub, row = pi >> 1, hh = pi & 1;
                bf16_t* p = base + (r0 + row) * ld + hh * 128 + l16 * 8; const u32x4 w = wv[k];
                float x[8] = {bflo(w.x), bfhi(w.x), bflo(w.y), bfhi(w.y), bflo(w.z), bfhi(w.z), bflo(w.w), bfhi(w.w)};
                float ss = 0.f;
#pragma unroll
                for (int e = 0; e < 8; ++e) ss += x[e] * x[e];
                ss = sum16(ss);
                const float rs = 1.f / sqrtf(ss * (1.f / 128.f) + EPS);
#pragma unroll
                for (int e = 0; e < 8; ++e) x[e] = x[e] * rs * gv[e];
                if (lat) {
#pragma unroll
                    for (int e = 0; e < 4; ++e) { const float a = x[2 * e], bb = x[2 * e + 1]; x[2 * e] = a * cs[k][e].x - bb * cs[k][e].y; x[2 * e + 1] = a * cs[k][e].y + bb * cs[k][e].x; } }
                *(u32x4*)p = (u32x4){pk2(x[0], x[1]), pk2(x[2], x[3]), pk2(x[4], x[5]), pk2(x[6], x[7])}; }
        }
    }
}
template <bool FAST> __device__ __forceinline__ void attn_units(Frame& F, bool need_ctx, bf16_t* Oout) {
    const bf16_t* Q = RG(F, 1); const bf16_t* Kb = RG(F, 2); const bf16_t* Vb = (const bf16_t*)((const char*)RG(F, 2) + 17 * MiB);
    const int nunits = 1024 + (need_ctx ? 32 : 0);
    FRAME_REFRESH(F);
    for (int L = F.bid; L < nunits; L += F.G) {
        int b, h, t0, seq;
        if (L < 1024) { int qb;
            if (F.G == 256) { b = L >> 8; h = F.bid & 7; qb = F.bid >> 3; }
            else { qb = L & 31; h = (L >> 5) & 7; b = L >> 8; }
            t0 = b * SEQ + qb * 256; seq = KVLEN; }
        else { const int i = L - 1024; b = i >> 3; h = i & 7; t0 = TLAT + b * CTXL; seq = CTXL; }
        const bf16_t* Qp = Q + (size_t)t0 * D + h * 128;
        const size_t kvo = (size_t)b * KVLEN * 256 + (h >> 2) * 128;
        int tid_; { int l_; asm volatile("v_mbcnt_lo_u32_b32 %0, -1, 0\n\tv_mbcnt_hi_u32_b32 %0, -1, %0" : "=v"(l_)); tid_ = F.wave * 64 + l_; }
        if constexpr (FAST) { if (((seq >> 6) & 3) == 0) att::attn_fast16s_body(Qp, Kb + kvo, Vb + kvo, Oout + (size_t)t0 * D + h * 128, seq, F.ldsg, tid_);
                              else att::attn_fast16_body(Qp, Kb + kvo, Vb + kvo, Oout + (size_t)t0 * D + h * 128, seq, F.ldsg, tid_); }
        else att::attn_dense_body<false>(Qp, Kb + kvo, Vb + kvo, Oout + (size_t)t0 * D + h * 128, seq, F.ldsg, F.tid);
    }
}
__device__ __forceinline__ void attn_phase(Frame& F, bool need_ctx, bf16_t* Oout, int j) {
    if (attn_fast_ok(F, j)) attn_units<true>(F, need_ctx, Oout); else attn_units<false>(F, need_ctx, Oout);
}

__device__ __forceinline__ unsigned off_b2(unsigned row, unsigned ch) { return 256u * row + 16u * (ch ^ (((row & 3) << 2) | ((row >> 2) & 3))); }
__device__ __forceinline__ void gmlp_spatial(Frame& F) {
    const Args& A = *F.a; const bf16_t* ZB = RG(F, 1); bf16_t* P = RG(F, 0); const bf16_t* WS_ = (const bf16_t*)(F.ws + WS_BWS); const f32x2* SP = (const f32x2*)(F.ws + WS_AB);
    LAS float* ST = (LAS float*)(F.lds + 32768);
    LAS unsigned char* VT = F.lds;
    const unsigned vbase = (unsigned)(uintptr_t)F.ldsg;
    for (int un = F.bid; un < 264 * 8; un += F.G) {
        FRAME_REFRESH(F);
        const int lane = F.lane, r = lane & 31, hh = lane >> 5, wr = F.wave >> 1, wc = F.wave & 1;
        const int ck = un >> 3, g = un & 7, t0 = ck * 128;
        if (F.tid < 128) { const f32x4* sp = (const f32x4*)(SP + (size_t)(t0 + F.tid) * 16); float s1 = 0.f, s2 = 0.f;
#pragma unroll
            for (int i = 0; i < 8; ++i) { const f32x4 v = sp[i]; s1 += v[0] + v[2]; s2 += v[1] + v[3]; }
            const float mean = s1 * (1.f / 1024.f), var = fmaxf(s2 * (1.f / 1024.f) - mean * mean, 0.f);
            ST[2 * F.tid] = mean; ST[2 * F.tid + 1] = 1.f / sqrtf(var + EPS); }
        u32x4 vraw[4];
#pragma unroll
        for (int e = 0; e < 4; ++e) { const int id = F.tid + 512 * e, row = id >> 4, ch = id & 15; vraw[e] = *(const u32x4*)(ZB + (size_t)(t0 + row) * 2048 + 1024 + g * 128 + ch * 8); }
        bf16x8 afr[8];
        { const bf16_t* wp0 = WS_ + ((size_t)g * 128 + wr * 32 + r) * 128 + hh * 8;
#pragma unroll
          for (int ks = 0; ks < 8; ++ks) afr[ks] = *(const bf16x8*)(wp0 + ks * 16); }
        __syncthreads();
#pragma unroll
        for (int e = 0; e < 4; ++e) { const int id = F.tid + 512 * e, row = id >> 4, ch = id & 15; const float mean = ST[2 * row], rstd = ST[2 * row + 1];
            const u32x4 w = vraw[e]; const float x[8] = {bflo(w.x), bfhi(w.x), bflo(w.y), bfhi(w.y), bflo(w.z), bfhi(w.z), bflo(w.w), bfhi(w.w)};
            const float* vg = A.in[I_BVG] + g * 128 + ch * 8; const float* vb = A.in[I_BVB] + g * 128 + ch * 8; float y[8];
#pragma unroll
            for (int c = 0; c < 8; ++c) y[c] = (x[c] - mean) * rstd * vg[c] + vb[c];
            *(LAS u32x4*)(VT + off_b2(row, ch)) = (u32x4){pk2(y[0], y[1]), pk2(y[2], y[3]), pk2(y[4], y[5]), pk2(y[6], y[7])}; }
        __syncthreads();
        f32x16 acc[2] = {};
        bf16_t uval[2][16]; float bsv[16];
#pragma unroll
        for (int reg = 0; reg < 16; ++reg) { const int tl = wr * 32 + crow(reg, hh); bsv[reg] = A.in[I_BBS][g * 128 + tl];
#pragma unroll
            for (int cb = 0; cb < 2; ++cb) uval[cb][reg] = ZB[(size_t)(t0 + tl) * 2048 + g * 128 + wc * 64 + cb * 32 + r]; }
        { const unsigned blk = (lane >> 4) & 1, q = (lane & 15) >> 2, p = lane & 3;
#pragma unroll
          for (int ks = 0; ks < 8; ++ks) { const bf16x8 af = afr[ks];
              s16x4 bt[2][2];
#pragma unroll
              for (int cb = 0; cb < 2; ++cb)
#pragma unroll
                  for (int t = 0; t < 2; ++t) { s16x4 rr; const unsigned addr = vbase + off_b2(16 * ks + 8 * hh + 4 * t + q, 4 * (2 * wc + cb) + 2 * blk + (p >> 1)) + 8 * (p & 1);
                      asm volatile("ds_read_b64_tr_b16 %0, %1" : "=&v"(rr) : "v"(addr) : "memory"); bt[cb][t] = rr; }
              asm volatile("s_waitcnt lgkmcnt(0)" ::: "memory"); __builtin_amdgcn_sched_barrier(0);
#pragma unroll
              for (int cb = 0; cb < 2; ++cb) { const bf16x8 bfr = (bf16x8){bt[cb][0][0], bt[cb][0][1], bt[cb][0][2], bt[cb][0][3], bt[cb][1][0], bt[cb][1][1], bt[cb][1][2], bt[cb][1][3]};
                  acc[cb] = MFMA32(af, bfr, acc[cb]); } } }
#pragma unroll
        for (int cb = 0; cb < 2; ++cb)
#pragma unroll
            for (int reg = 0; reg < 16; ++reg) { const int tl = wr * 32 + crow(reg, hh), c = g * 128 + wc * 64 + cb * 32 + r;
                const float mixed = acc[cb][reg] + bsv[reg];
                const float uu = bf1(uval[cb][reg]);
                P[(size_t)(t0 + tl) * D + c] = (bf16_t)(pk2(uu * mixed, 0.f) & 0xffffu); }
        __syncthreads();
    }
}

__device__ __forceinline__ void delta_prep(Frame& F) {
    const Args& A = *F.a; const float* cw = A.in[I_CCONV];
    for (int wu = F.gw; wu < 528 * 6; wu += F.NGW) {
        const int ck = wu / 6, slab = wu % 6, buf = slab >> 1, ch = (slab & 1) * 512 + 8 * F.lane, t0 = ck * 64;
        const bf16_t* src = RG(F, 1 + buf) + ch; bf16_t* dst = RG(F, 5 + buf) + ch;
        float w0[8], w1[8], w2[8];
#pragma unroll
        for (int e = 0; e < 8; ++e) { const int cg = buf * 1024 + ch + e; w0[e] = cw[cg]; w1[e] = cw[3072 + cg]; w2[e] = cw[6144 + cg]; }
        const int seqlen = t0 < TLAT ? SEQ : CTXL, n0 = t0 < TLAT ? (t0 & (SEQ - 1)) : ((t0 - TLAT) & (CTXL - 1));
        u32x4 prev = {0u, 0u, 0u, 0u}, cur;
        if (n0 > 0) prev = *(const u32x4*)(src + (size_t)(t0 - 1) * D);
        cur = *(const u32x4*)(src + (size_t)t0 * D);
#pragma unroll 1
        for (int r8 = 0; r8 < 64; r8 += 8) {
            u32x4 nx[8];
#pragma unroll
            for (int e = 0; e < 8; ++e) { nx[e] = (u32x4){0u, 0u, 0u, 0u}; if (n0 + r8 + e + 1 < seqlen) nx[e] = *(const u32x4*)(src + (size_t)(t0 + r8 + e + 1) * D); }
#pragma unroll
            for (int e = 0; e < 8; ++e) {
                const int t = t0 + r8 + e; const u32x4 nxt = nx[e];
                const float xp[8] = {bflo(prev.x), bfhi(prev.x), bflo(prev.y), bfhi(prev.y), bflo(prev.z), bfhi(prev.z), bflo(prev.w), bfhi(prev.w)};
                const float xc[8] = {bflo(cur.x), bfhi(cur.x), bflo(cur.y), bfhi(cur.y), bflo(cur.z), bfhi(cur.z), bflo(cur.w), bfhi(cur.w)};
                const float xn[8] = {bflo(nxt.x), bfhi(nxt.x), bflo(nxt.y), bfhi(nxt.y), bflo(nxt.z), bfhi(nxt.z), bflo(nxt.w), bfhi(nxt.w)};
                float y[8]; float ss = 0.f;
#pragma unroll
                for (int c = 0; c < 8; ++c) { y[c] = siluf_(w0[c] * xp[c] + w1[c] * xc[c] + w2[c] * xn[c]); ss += y[c] * y[c]; }
                if (buf < 2) { ss = sum16(ss); const float rs = (1.f / sqrtf(ss + EPS)) * (buf == 0 ? 0.08838834764831845f : 1.f);
#pragma unroll
                    for (int c = 0; c < 8; ++c) y[c] *= rs; }
                *(u32x4*)(dst + (size_t)t * D) = (u32x4){pk2(y[0], y[1]), pk2(y[2], y[3]), pk2(y[4], y[5]), pk2(y[6], y[7])};
                prev = cur; cur = nxt;
            }
        }
    }
}
__device__ __forceinline__ void delta_local(Frame& F) {
    const Args& A = *F.a; const float* AB = (const float*)(F.ws + WS_AB); float* GC = (float*)(F.ws + WS_GC); float* BETA = (float*)(F.ws + WS_BETA);
    const bf16_t* QN = RG(F, 5); const bf16_t* KN = RG(F, 6); bf16_t* TB = RG(F, 1); bf16_t* ATT = RG(F, 2);
    LAS float* Aw = (LAS float*)(F.lds + F.wave * 17408);
    for (int wu = F.gw; wu < 528 * 16; wu += F.NGW) {
        int lane = F.lane; asm volatile("" : "+v"(lane));
        const int r = lane & 31, hh = lane >> 5;
        const int dir = wu & 1, h = (wu >> 1) & 7, ck = wu >> 4, t0 = ck * 64;
        const int tok = dir ? t0 + 63 - lane : t0 + lane;
        const float a = AB[(size_t)tok * 32 + dir * 8 + h], bb = AB[(size_t)tok * 32 + 16 + dir * 8 + h];
        const float x = a + A.in[I_CDTB][dir * 8 + h];
        const float sp = fmaxf(x, 0.f) + log1pf(expf(-fabsf(x)));
        const float g = -expf(A.in[I_CALOG][dir * 8 + h]) * sp;
        const float beta = 1.f / (1.f + expf(-bb));
        float gc = g;
#pragma unroll
        for (int o = 1; o < 64; o <<= 1) { const float tv = __shfl_up(gc, o); if (lane >= o) gc += tv; }
        GC[(size_t)(dir * 8 + h) * TT + tok] = gc; BETA[(size_t)(dir * 8 + h) * TT + tok] = beta;
        const int tk0 = dir ? t0 + 63 - r : t0 + r, tk1 = dir ? t0 + 31 - r : t0 + 32 + r;
        const bf16_t* kp0 = KN + (size_t)tk0 * D + h * 128 + hh * 8; const bf16_t* kp1 = KN + (size_t)tk1 * D + h * 128 + hh * 8;
        const bf16_t* qp0 = QN + (size_t)tk0 * D + h * 128 + hh * 8; const bf16_t* qp1 = QN + (size_t)tk1 * D + h * 128 + hh * 8;
        bf16x8 kf0[8], kf1[8];
#pragma unroll
        for (int ks = 0; ks < 8; ++ks) { kf0[ks] = *(const bf16x8*)(kp0 + ks * 16); kf1[ks] = *(const bf16x8*)(kp1 + ks * 16); }
        const float gcj0 = __shfl(gc, r), gcj1 = __shfl(gc, 32 + r);
        bf16_t* attp = ATT + (size_t)wu * 4096;
        {   f32x16 s00 = {}, s10 = {}, s11 = {};
#pragma unroll
            for (int ks = 0; ks < 8; ++ks) { s00 = MFMA32(kf0[ks], kf0[ks], s00); s10 = MFMA32(kf1[ks], kf0[ks], s10); s11 = MFMA32(kf1[ks], kf1[ks], s11); }
#pragma unroll
            for (int reg = 0; reg < 16; ++reg) { const int il = crow(reg, hh);
                const float gci0 = __shfl(gc, il), gci1 = __shfl(gc, 32 + il), bt0 = __shfl(beta, il), bt1 = __shfl(beta, 32 + il);
                const float d00 = (il > r) ? __expf(gci0 - gcj0) : 0.f, d10 = __expf(gci1 - gcj0), d11 = (il > r) ? __expf(gci1 - gcj1) : 0.f;
                Aw[r * 68 + il] = bt0 * s00[reg] * d00;
                Aw[r * 68 + 32 + il] = bt1 * s10[reg] * d10;
                Aw[(32 + r) * 68 + 32 + il] = bt1 * s11[reg] * d11; }
        }
        asm volatile("" ::: "memory"); __builtin_amdgcn_sched_barrier(0);
        {   f32x16 q00 = {}, q10 = {}, q11 = {};
#pragma unroll
            for (int ks = 0; ks < 8; ++ks) { const bf16x8 q0 = *(const bf16x8*)(qp0 + ks * 16), q1 = *(const bf16x8*)(qp1 + ks * 16);
                q00 = MFMA32(q0, kf0[ks], q00); q10 = MFMA32(q1, kf0[ks], q10); q11 = MFMA32(q1, kf1[ks], q11); }
#pragma unroll
            for (int reg = 0; reg < 16; ++reg) { const int il = crow(reg, hh);
                const float gci0 = __shfl(gc, il), gci1 = __shfl(gc, 32 + il);
                const float d00 = (il >= r) ? __expf(gci0 - gcj0) : 0.f, d10 = __expf(gci1 - gcj0), d11 = (il >= r) ? __expf(gci1 - gcj1) : 0.f;
                attp[il * 64 + r] = (bf16_t)(pk2(q00[reg] * d00, 0.f) & 0xffffu);
                attp[il * 64 + 32 + r] = 0;
                attp[(32 + il) * 64 + r] = (bf16_t)(pk2(q10[reg] * d10, 0.f) & 0xffffu);
                attp[(32 + il) * 64 + 32 + r] = (bf16_t)(pk2(q11[reg] * d11, 0.f) & 0xffffu); }
        }
        asm volatile("" ::: "memory"); __builtin_amdgcn_sched_barrier(0);
        LDS_WAIT(); asm volatile("" ::: "memory");
        float Tc[64]; bf16_t* tp = TB + (size_t)wu * 4096 + lane;
#pragma unroll
        for (int i = 0; i < 64; ++i) Tc[i] = (i == lane) ? 1.f : 0.f;
        f32x4 cur[16], nxt[16];
#pragma unroll
        for (int p4 = 0; p4 < 16; ++p4) cur[p4] = *(const LAS f32x4*)(Aw + 4 * p4);
#pragma unroll
        for (int j = 0; j < 64; ++j) {
            if (j + 1 < 64) {
#pragma unroll
                for (int p4 = (j + 2) / 4; p4 < 16; ++p4) nxt[p4] = *(const LAS f32x4*)(Aw + (j + 1) * 68 + 4 * p4); }
            const float tj = Tc[j]; tp[j * 64] = (bf16_t)(pk2(tj, 0.f) & 0xffffu);
#pragma unroll
            for (int p4 = (j + 1) / 4; p4 < 16; ++p4)
#pragma unroll
                for (int e2 = 0; e2 < 4; ++e2) if (4 * p4 + e2 > j) Tc[4 * p4 + e2] -= cur[p4][e2] * tj;
#pragma unroll
            for (int p4 = 0; p4 < 16; ++p4) cur[p4] = nxt[p4];
            asm volatile("" ::: "memory"); __builtin_amdgcn_sched_barrier(0); }
        LDS_WAIT(); asm volatile("" ::: "memory");
    }
}
constexpr int SC_QT = 0, SC_KT = 16896, SC_KTT = 33792, SC_TT = 51200, SC_AT = 59904, SC_VT = 68608, SC_TAB = 76800, SC_XP = 77824, SC_OP = 110592;
static_assert(SC_OP + 32768 <= MISC_OFF, "scan LDS");
__device__ __forceinline__ bf16x8 lds_frag(const LAS unsigned char* p) { return mk8(*(const LAS u32x2*)p, *(const LAS u32x2*)(p + 16)); }
__device__ __forceinline__ bf16x8 pack_acc(const f32x16& v, int s) { return mk8w(pk2(v[8 * s], v[8 * s + 1]), pk2(v[8 * s + 2], v[8 * s + 3]), pk2(v[8 * s + 4], v[8 * s + 5]), pk2(v[8 * s + 6], v[8 * s + 7])); }
__device__ __forceinline__ void delta_scan(Frame& F) {
    const bf16_t* QN = RG(F, 5); const bf16_t* KN = RG(F, 6); const bf16_t* VN = RG(F, 7); const bf16_t* TB = RG(F, 1); const bf16_t* ATT = RG(F, 2);
    const float* GC = (const float*)(F.ws + WS_GC); const float* BETA = (const float*)(F.ws + WS_BETA);
    LAS unsigned char* L = F.lds; const int w = F.wave;
    LAS float* TAB = (LAS float*)(L + SC_TAB); LAS float* XP = (LAS float*)(L + SC_XP); LAS float* OP = (LAS float*)(L + SC_OP); LAS float* VT = (LAS float*)(L + SC_VT);
    for (int item = F.bid; item < 256; item += F.G) {
        const int ch = item >> 2, dvs = item & 3, b = ch >> 4, h = (ch >> 1) & 7, dir = ch & 1;
        bf16_t* OB = RG(F, dir ? 3 : 0);
        f32x16 S = {};
        u32x4 sq[2], sk[2], st, sa, sv; float sgc = 0.f, sbt = 0.f;
#define SCAN_CK(step) ((step) < 4 ? 512 + b * 4 + (dir ? 3 - (step) : (step)) : b * 128 + (dir ? 131 - (step) : (step) - 4))
#define SCAN_LOAD(step) do { const int ck_ = SCAN_CK(step); const int t0_ = ck_ * 64; const size_t un_ = ((size_t)ck_ * 8 + h) * 2 + dir; \
        _Pragma("unroll") for (int e_ = 0; e_ < 2; ++e_) { const int id_ = tid + 512 * e_, row_ = id_ >> 4, c16_ = id_ & 15; const int tk_ = dir ? t0_ + 63 - row_ : t0_ + row_; \
            sq[e_] = *(const u32x4*)(QN + (size_t)tk_ * D + h * 128 + c16_ * 8); sk[e_] = *(const u32x4*)(KN + (size_t)tk_ * D + h * 128 + c16_ * 8); } \
        st = *(const u32x4*)(TB + un_ * 4096 + tid * 8); sa = *(const u32x4*)(ATT + un_ * 4096 + tid * 8); \
        if (tid < 256) { const int row_ = tid >> 2, c_ = tid & 3; const int tk_ = dir ? t0_ + 63 - row_ : t0_ + row_; sv = *(const u32x4*)(VN + (size_t)tk_ * D + h * 128 + dvs * 32 + c_ * 8); } \
        if (tid < 64) { const int tk_ = dir ? t0_ + 63 - tid : t0_ + tid; sgc = GC[(size_t)(dir * 8 + h) * TT + tk_]; sbt = BETA[(size_t)(dir * 8 + h) * TT + tk_]; } } while (0)
#define SCAN_STORE() do { \
        _Pragma("unroll") for (int e_ = 0; e_ < 2; ++e_) { const int id_ = tid + 512 * e_, row_ = id_ >> 4, c16_ = id_ & 15; \
            *(LAS u32x2*)(L + SC_QT + row_ * 264 + c16_ * 16) = (u32x2){sq[e_].x, sq[e_].y}; *(LAS u32x2*)(L + SC_QT + row_ * 264 + c16_ * 16 + 8) = (u32x2){sq[e_].z, sq[e_].w}; \
            *(LAS u32x2*)(L + SC_KT + row_ * 264 + c16_ * 16) = (u32x2){sk[e_].x, sk[e_].y}; *(LAS u32x2*)(L + SC_KT + row_ * 264 + c16_ * 16 + 8) = (u32x2){sk[e_].z, sk[e_].w}; \
            LAS bf16_t* kt_ = (LAS bf16_t*)(L + SC_KTT) + (c16_ * 8) * 68 + row_; \
            kt_[0 * 68] = (bf16_t)(sk[e_].x & 0xffffu); kt_[1 * 68] = (bf16_t)(sk[e_].x >> 16); kt_[2 * 68] = (bf16_t)(sk[e_].y & 0xffffu); kt_[3 * 68] = (bf16_t)(sk[e_].y >> 16); \
            kt_[4 * 68] = (bf16_t)(sk[e_].z & 0xffffu); kt_[5 * 68] = (bf16_t)(sk[e_].z >> 16); kt_[6 * 68] = (bf16_t)(sk[e_].w & 0xffffu); kt_[7 * 68] = (bf16_t)(sk[e_].w >> 16); } \
        { const int row_ = tid >> 3, c16_ = tid & 7; \
          *(LAS u32x2*)(L + SC_TT + row_ * 136 + c16_ * 16) = (u32x2){st.x, st.y}; *(LAS u32x2*)(L + SC_TT + row_ * 136 + c16_ * 16 + 8) = (u32x2){st.z, st.w}; \
          *(LAS u32x2*)(L + SC_AT + row_ * 136 + c16_ * 16) = (u32x2){sa.x, sa.y}; *(LAS u32x2*)(L + SC_AT + row_ * 136 + c16_ * 16 + 8) = (u32x2){sa.z, sa.w}; } \
        if (tid < 256) { const int row_ = tid >> 2, c_ = tid & 3; LAS f32x4* vp_ = (LAS f32x4*)(VT + row_ * 32 + c_ * 8); \
            vp_[0] = (f32x4){bflo(sv.x), bfhi(sv.x), bflo(sv.y), bfhi(sv.y)}; vp_[1] = (f32x4){bflo(sv.z), bfhi(sv.z), bflo(sv.w), bfhi(sv.w)}; } \
        if (tid < 64) { const float gl_ = __shfl(sgc, 63); TAB[tid] = expf(sgc); TAB[64 + tid] = expf(gl_ - sgc); TAB[128 + tid] = sbt; if (tid == 0) TAB[192] = expf(gl_); } } while (0)
        int tid = F.tid; asm volatile("" : "+v"(tid));
        SCAN_LOAD(0); VM_WAIT(); SCAN_STORE(); __syncthreads();
#pragma unroll 1
        for (int step = 0; step < 132; ++step) {
            tid = F.tid; asm volatile("" : "+v"(tid));
            const int lane = tid & 63, r = lane & 31, hh = lane >> 5;
            const int ck = SCAN_CK(step), t0 = ck * 64;
            if (step + 1 < 132) SCAN_LOAD(step + 1);
            if (w < 4) {
                const bf16x8 Sb0 = pack_acc(S, 0), Sb1 = pack_acc(S, 1);
#pragma unroll
                for (int bi = 0; bi < 2; ++bi) { const int off = (32 * bi + r) * 264 + (32 * w + 4 * hh) * 2;
                    { f32x16 X = {}; const bf16x8 k0 = lds_frag(L + SC_KT + off), k1 = lds_frag(L + SC_KT + off + 32);
                      X = MFMA32(k0, Sb0, X); X = MFMA32(k1, Sb1, X);
#pragma unroll
                      for (int reg = 0; reg < 16; ++reg) XP[((w * 2 + bi) * 16 + reg) * 64 + lane] = X[reg]; }
                    { f32x16 X = {}; const bf16x8 q0 = lds_frag(L + SC_QT + off), q1 = lds_frag(L + SC_QT + off + 32);
                      X = MFMA32(q0, Sb0, X); X = MFMA32(q1, Sb1, X);
#pragma unroll
                      for (int reg = 0; reg < 16; ++reg) OP[((w * 2 + bi) * 16 + reg) * 64 + lane] = X[reg]; }
                    asm volatile("" ::: "memory"); }
            }
            __syncthreads();
            if (w < 4) {
                bf16x8 Rp[2][2];
#pragma unroll
                for (int bi = 0; bi < 2; ++bi)
#pragma unroll
                    for (int sh = 0; sh < 2; ++sh) { float R[8];
#pragma unroll
                        for (int e = 0; e < 8; ++e) { const int reg = 8 * sh + e; const int i = 32 * bi + crow(reg, hh);
                            const float X = (XP[((0 * 2 + bi) * 16 + reg) * 64 + lane] + XP[((1 * 2 + bi) * 16 + reg) * 64 + lane]) + (XP[((2 * 2 + bi) * 16 + reg) * 64 + lane] + XP[((3 * 2 + bi) * 16 + reg) * 64 + lane]);
                            R[e] = TAB[128 + i] * (VT[i * 32 + r] - TAB[i] * X); }
                        Rp[bi][sh] = mk8w(pk2(R[0], R[1]), pk2(R[2], R[3]), pk2(R[4], R[5]), pk2(R[6], R[7]));
                        asm volatile("" ::: "memory"); __builtin_amdgcn_sched_barrier(0); }
                f32x16 Vn0 = {}, Vn1 = {};
                { const int o0 = r * 136 + (4 * hh) * 2, o1 = (32 + r) * 136 + (4 * hh) * 2;
                  Vn0 = MFMA32(lds_frag(L + SC_TT + o0), Rp[0][0], Vn0); Vn0 = MFMA32(lds_frag(L + SC_TT + o0 + 32), Rp[0][1], Vn0);
                  Vn1 = MFMA32(lds_frag(L + SC_TT + o1), Rp[0][0], Vn1); Vn1 = MFMA32(lds_frag(L + SC_TT + o1 + 32), Rp[0][1], Vn1);
                  Vn1 = MFMA32(lds_frag(L + SC_TT + o1 + 64), Rp[1][0], Vn1); Vn1 = MFMA32(lds_frag(L + SC_TT + o1 + 96), Rp[1][1], Vn1); }
                asm volatile("" ::: "memory");
                bf16x8 Vsp[2][2];
                { f32x16 Vs;
#pragma unroll
                  for (int reg = 0; reg < 16; ++reg) Vs[reg] = Vn0[reg] * TAB[64 + crow(reg, hh)];
                  Vsp[0][0] = pack_acc(Vs, 0); Vsp[0][1] = pack_acc(Vs, 1);
#pragma unroll
                  for (int reg = 0; reg < 16; ++reg) Vs[reg] = Vn1[reg] * TAB[64 + 32 + crow(reg, hh)];
                  Vsp[1][0] = pack_acc(Vs, 0); Vsp[1][1] = pack_acc(Vs, 1); }
                const float gl = TAB[192];
#pragma unroll
                for (int reg = 0; reg < 16; ++reg) S[reg] *= gl;
                { const int o = (32 * w + r) * 136 + (4 * hh) * 2;
                  S = MFMA32(lds_frag(L + SC_KTT + o), Vsp[0][0], S); S = MFMA32(lds_frag(L + SC_KTT + o + 32), Vsp[0][1], S);
                  S = MFMA32(lds_frag(L + SC_KTT + o + 64), Vsp[1][0], S); S = MFMA32(lds_frag(L + SC_KTT + o + 96), Vsp[1][1], S); }
                asm volatile("" ::: "memory");
                if (w < 2) { f32x16 O = {};
                    const int o = (32 * w + r) * 136 + (4 * hh) * 2;
                    O = MFMA32(lds_frag(L + SC_AT + o), pack_acc(Vn0, 0), O); O = MFMA32(lds_frag(L + SC_AT + o + 32), pack_acc(Vn0, 1), O);
                    if (w == 1) { O = MFMA32(lds_frag(L + SC_AT + o + 64), pack_acc(Vn1, 0), O); O = MFMA32(lds_frag(L + SC_AT + o + 96), pack_acc(Vn1, 1), O); }
#pragma unroll
                    for (int sh = 0; sh < 2; ++sh) {
#pragma unroll
                        for (int e = 0; e < 8; ++e) { const int reg = 8 * sh + e; const int i = 32 * w + crow(reg, hh);
                            const float o1 = (OP[((0 * 2 + w) * 16 + reg) * 64 + lane] + OP[((1 * 2 + w) * 16 + reg) * 64 + lane]) + (OP[((2 * 2 + w) * 16 + reg) * 64 + lane] + OP[((3 * 2 + w) * 16 + reg) * 64 + lane]);
                            const float ov = O[reg] + TAB[i] * o1; const int tk = dir ? t0 + 63 - i : t0 + i;
                            OB[(size_t)tk * D + h * 128 + dvs * 32 + r] = (bf16_t)(pk2(ov, 0.f) & 0xffffu); }
                        asm volatile("" ::: "memory"); __builtin_amdgcn_sched_barrier(0); } }
            }
            __syncthreads();
            if (step + 1 < 132) { VM_WAIT(); SCAN_STORE(); }
            __syncthreads();
        }
#undef SCAN_CK
#undef SCAN_LOAD
#undef SCAN_STORE
    }
}
constexpr int S2_QT = 0, S2_KT = 16384, S2_VT = 32768, S2_TT = 49152, S2_AT = 57344, S2_TAB = 65536, S2_BUF = 66560;
static_assert(2 * S2_BUF <= MISC_OFF, "scan2 LDS");
__device__ __forceinline__ unsigned off_b(unsigned row, unsigned ch) { return 256u * row + 16u * (ch ^ (((row & 3) << 2) | ((row >> 2) & 3))); }
__device__ __forceinline__ bf16x8 pka(const f32x16& P, const int BASE) {
    const unsigned a0 = pk2(P[BASE + 0], P[BASE + 1]), a1 = pk2(P[BASE + 2], P[BASE + 3]), b0 = pk2(P[BASE + 4], P[BASE + 5]), b1 = pk2(P[BASE + 6], P[BASE + 7]);
    auto r0 = __builtin_amdgcn_permlane32_swap(a0, b0, false, false); auto r1 = __builtin_amdgcn_permlane32_swap(a1, b1, false, false);
    return mk8w(r0[0], r1[0], r0[1], r1[1]);
}
__device__ __forceinline__ s16x4 trr(unsigned addr) { s16x4 r; asm volatile("ds_read_b64_tr_b16 %0, %1" : "=&v"(r) : "v"(addr) : "memory"); return r; }
#define GLDS16(gp, lp) __builtin_amdgcn_global_load_lds((const unsigned*)(gp), (LAS unsigned*)(lp), 16, 0, 0)
__device__ __forceinline__ void delta_scan2(Frame& F) {
    const bf16_t* QN = RG(F, 5); const bf16_t* KN = RG(F, 6); const bf16_t* VN = RG(F, 7); const bf16_t* TB = RG(F, 1); const bf16_t* ATT = RG(F, 2);
    const float* GC = (const float*)(F.ws + WS_GC); const float* BETA = (const float*)(F.ws + WS_BETA);
    LAS unsigned char* L = F.lds; const int w = F.wave;
    const unsigned lbase = (unsigned)(uintptr_t)F.ldsg;
    for (int ch = F.bid; ch < 64; ch += F.G) {
        const int b = ch >> 4, h = (ch >> 1) & 7, dir = ch & 1;
        bf16_t* OB = RG(F, dir ? 3 : 0);
        const float* gcp = GC + (size_t)(dir * 8 + h) * TT; const float* btp = BETA + (size_t)(dir * 8 + h) * TT;
#define S2_CK(step) ((step) < 4 ? 512 + b * 4 + (dir ? 3 - (step) : (step)) : b * 128 + (dir ? 131 - (step) : (step) - 4))
#define S2_FILL(step, buf) do { const int lane_ = F.lane, lw_ = w - 4; const int ck_ = S2_CK(step), t0_ = ck_ * 64; const size_t un_ = ((size_t)ck_ * 8 + h) * 2 + dir; \
        LAS unsigned char* Bf_ = L + (buf) * S2_BUF; \
        _Pragma("unroll") for (int e_ = 0; e_ < 4; ++e_) { const int pc_ = 4 * lw_ + e_; const unsigned row_ = 4 * pc_ + (lane_ >> 4), ch_ = (lane_ & 15) ^ (((row_ & 3) << 2) | ((row_ >> 2) & 3)); \
            const size_t go_ = (size_t)(dir ? t0_ + 63 - (int)row_ : t0_ + (int)row_) * D + h * 128 + ch_ * 8; \
            GLDS16(QN + go_, Bf_ + S2_QT + pc_ * 1024); GLDS16(KN + go_, Bf_ + S2_KT + pc_ * 1024); GLDS16(VN + go_, Bf_ + S2_VT + pc_ * 1024); } \
        _Pragma("unroll") for (int e_ = 0; e_ < 2; ++e_) { const int pc_ = 2 * lw_ + e_; const unsigned R_ = 4 * pc_ + (lane_ >> 4), c_ = (lane_ & 15) ^ (((R_ & 3) << 2) | ((R_ >> 2) & 3)); \
            const size_t go_ = un_ * 4096 + (size_t)(32 * (c_ >> 3) + R_) * 64 + (c_ & 7) * 8; \
            GLDS16(TB + go_, Bf_ + S2_TT + pc_ * 1024); GLDS16(ATT + go_, Bf_ + S2_AT + pc_ * 1024); } \
        if (lw_ == 0) { LAS float* tb_ = (LAS float*)(Bf_ + S2_TAB); tb_[lane_] = expf(pg_); tb_[64 + lane_] = expf(pl_ - pg_); tb_[128 + lane_] = pb_; if (lane_ == 0) tb_[192] = expf(pl_); } } while (0)
#define S2_TLOAD(step) do { if (w == 4) { const int ck_ = S2_CK(step), t0_ = ck_ * 64, tk_ = dir ? t0_ + 63 - F.lane : t0_ + F.lane; pg_ = gcp[tk_]; pb_ = btp[tk_]; pl_ = gcp[dir ? t0_ : t0_ + 63]; } } while (0)
        float pg_ = 0.f, pb_ = 0.f, pl_ = 0.f;
        f32x16 S[4];
#pragma unroll
        for (int kb = 0; kb < 4; ++kb) S[kb] = (f32x16){};
        FRAME_REFRESH(F);
        if (w >= 4) { S2_TLOAD(0); __builtin_amdgcn_s_waitcnt(0x0070); S2_FILL(0, 0); S2_TLOAD(1); __builtin_amdgcn_s_waitcnt(0x0070); }
        asm volatile("s_waitcnt vmcnt(0) lgkmcnt(0)" ::: "memory"); __builtin_amdgcn_s_barrier(); asm volatile("" ::: "memory");
#pragma unroll 1
        for (int s2 = 0; s2 < 132; s2 += 2) {
#pragma unroll
            for (int par = 0; par < 2; ++par) {
                const int step = s2 + par;
                FRAME_REFRESH(F);
                if (w >= 4) { if (step + 1 < 132) { S2_FILL(step + 1, par ^ 1); if (step + 2 < 132) S2_TLOAD(step + 2); } __builtin_amdgcn_s_waitcnt(0x0070); asm volatile("" ::: "memory"); }
                else {
                    const int lane = F.lane, r = lane & 31, hh = lane >> 5;
                    LAS unsigned char* Bf = L + par * S2_BUF; const unsigned ab = lbase + par * S2_BUF;
                    const LAS float* tab = (const LAS float*)(Bf + S2_TAB);
                    const int ck = S2_CK(step), t0 = ck * 64;
                    bf16x8 Sb[4][2];
#pragma unroll
                    for (int kb = 0; kb < 4; ++kb) { Sb[kb][0] = pka(S[kb], 0); Sb[kb][1] = pka(S[kb], 8); }
                    f32x16 X[2] = {}, O1[2] = {};
                    { bf16x8 kc[2], qc[2], kn[2], qn[2];
#pragma unroll
                      for (int bi = 0; bi < 2; ++bi) { const unsigned o = off_b(32 * bi + r, hh); kc[bi] = *(const LAS bf16x8*)(Bf + S2_KT + o); qc[bi] = *(const LAS bf16x8*)(Bf + S2_QT + o); }
#pragma unroll
                      for (int ks = 0; ks < 8; ++ks) {
                          if (ks < 7) {
#pragma unroll
                              for (int bi = 0; bi < 2; ++bi) { const unsigned o = off_b(32 * bi + r, 2 * (ks + 1) + hh); kn[bi] = *(const LAS bf16x8*)(Bf + S2_KT + o); qn[bi] = *(const LAS bf16x8*)(Bf + S2_QT + o); } }
                          __builtin_amdgcn_sched_barrier(0);
#pragma unroll
                          for (int bi = 0; bi < 2; ++bi) { X[bi] = MFMA32(kc[bi], Sb[ks >> 1][ks & 1], X[bi]); O1[bi] = MFMA32(qc[bi], Sb[ks >> 1][ks & 1], O1[bi]); }
#pragma unroll
                          for (int bi = 0; bi < 2; ++bi) { kc[bi] = kn[bi]; qc[bi] = qn[bi]; }
                          __builtin_amdgcn_sched_barrier(0); } }
                    bf16x8 tf0[2], tf1[4];
#pragma unroll
                    for (int ks = 0; ks < 4; ++ks) { if (ks < 2) tf0[ks] = *(const LAS bf16x8*)(Bf + S2_TT + off_b(r, 2 * ks + hh)); tf1[ks] = *(const LAS bf16x8*)(Bf + S2_TT + off_b(r, 8 + 2 * ks + hh)); }
                    bf16x8 Rp[2][2];
                    { const int ql = (lane & 15) >> 2, p = lane & 3, rh = (lane >> 4) & 1;
                      s16x4 vv[2][4];
#pragma unroll
                      for (int bi = 0; bi < 2; ++bi)
#pragma unroll
                          for (int q4 = 0; q4 < 4; ++q4) vv[bi][q4] = trr(ab + S2_VT + off_b(32 * bi + 8 * q4 + 4 * hh + ql, 4 * w + 2 * rh + (p >> 1)) + 8 * (p & 1));
                      asm volatile("s_waitcnt lgkmcnt(0)" ::: "memory"); __builtin_amdgcn_sched_barrier(0);
#pragma unroll
                      for (int bi = 0; bi < 2; ++bi) { f32x16 R;
                          f32x4 egv[4], btv[4];
#pragma unroll
                          for (int q4 = 0; q4 < 4; ++q4) { egv[q4] = *(const LAS f32x4*)(tab + 32 * bi + 8 * q4 + 4 * hh); btv[q4] = *(const LAS f32x4*)(tab + 128 + 32 * bi + 8 * q4 + 4 * hh); }
                          __builtin_amdgcn_sched_barrier(0);
#pragma unroll
                          for (int q4 = 0; q4 < 4; ++q4) { const f32x4 eg = egv[q4], bt = btv[q4];
#pragma unroll
                              for (int e = 0; e < 4; ++e) R[4 * q4 + e] = bt[e] * (bf1((bf16_t)vv[bi][q4][e]) - eg[e] * X[bi][4 * q4 + e]); }
                          Rp[bi][0] = pka(R, 0); Rp[bi][1] = pka(R, 8); } }
                    f32x16 Vn[2] = {};
#pragma unroll
                    for (int ks = 0; ks < 4; ++ks) {
                        if (ks < 2) Vn[0] = MFMA32(tf0[ks], Rp[ks >> 1][ks & 1], Vn[0]);
                        Vn[1] = MFMA32(tf1[ks], Rp[ks >> 1][ks & 1], Vn[1]); }
                    const unsigned blk = (lane >> 4) & 1, q = (lane & 15) >> 2, p = lane & 3;
                    s16x4 kt[2][4][2];
#define S2_KT_ISSUE(kb0) do { _Pragma("unroll") for (int kk_ = 0; kk_ < 2; ++kk_) _Pragma("unroll") for (int ks_ = 0; ks_ < 4; ++ks_) _Pragma("unroll") for (int t_ = 0; t_ < 2; ++t_) \
                        kt[kk_][ks_][t_] = trr(ab + S2_KT + off_b(16 * ks_ + 8 * hh + 4 * t_ + q, 4 * ((kb0) + kk_) + 2 * blk + (p >> 1)) + 8 * (p & 1)); } while (0)
#define S2_KT_MMA(kb0) do { _Pragma("unroll") for (int ks_ = 0; ks_ < 4; ++ks_) _Pragma("unroll") for (int kk_ = 0; kk_ < 2; ++kk_) { \
                        const bf16x8 kf_ = (bf16x8){kt[kk_][ks_][0][0], kt[kk_][ks_][0][1], kt[kk_][ks_][0][2], kt[kk_][ks_][0][3], kt[kk_][ks_][1][0], kt[kk_][ks_][1][1], kt[kk_][ks_][1][2], kt[kk_][ks_][1][3]}; \
                        S[(kb0) + kk_] = MFMA32(kf_, Vs[ks_ >> 1][ks_ & 1], S[(kb0) + kk_]); } } while (0)
                    S2_KT_ISSUE(0);
                    { bf16x8 af0[2], af1[4];
#pragma unroll
                      for (int ks = 0; ks < 4; ++ks) { if (ks < 2) af0[ks] = *(const LAS bf16x8*)(Bf + S2_AT + off_b(r, 2 * ks + hh)); af1[ks] = *(const LAS bf16x8*)(Bf + S2_AT + off_b(r, 8 + 2 * ks + hh)); }
                      __builtin_amdgcn_sched_barrier(0);
                      bf16x8 Vp[2][2];
#pragma unroll
                      for (int bi = 0; bi < 2; ++bi) { Vp[bi][0] = pka(Vn[bi], 0); Vp[bi][1] = pka(Vn[bi], 8); }
                      f32x16 O2[2] = {};
#pragma unroll
                      for (int ks = 0; ks < 4; ++ks) {
                          if (ks < 2) O2[0] = MFMA32(af0[ks], Vp[ks >> 1][ks & 1], O2[0]);
                          O2[1] = MFMA32(af1[ks], Vp[ks >> 1][ks & 1], O2[1]); }
                      const unsigned ob32 = (unsigned)(((dir ? t0 + 63 - 4 * hh : t0 + 4 * hh) * D + h * 128 + 32 * w + r) * 2);
#pragma unroll
                      for (int bi = 0; bi < 2; ++bi) { f32x4 ego[4];
#pragma unroll
                          for (int q4 = 0; q4 < 4; ++q4) ego[q4] = *(const LAS f32x4*)(tab + 32 * bi + 8 * q4 + 4 * hh);
                          __builtin_amdgcn_sched_barrier(0);
#pragma unroll
                          for (int q4 = 0; q4 < 4; ++q4) { const f32x4 eg = ego[q4];
#pragma unroll
                              for (int e = 0; e < 4; ++e) { const unsigned ro = (unsigned)((32 * bi + 8 * q4 + e) * D * 2);
                                  *(bf16_t*)((char*)OB + (dir ? ob32 - ro : ob32 + ro)) = (bf16_t)(pk2(O2[bi][4 * q4 + e] + eg[e] * O1[bi][4 * q4 + e], 0.f) & 0xffffu); } } } }
                    { bf16x8 Vs[2][2];
                      f32x4 edv[2][4]; const float gl = tab[192];
#pragma unroll
                      for (int bi = 0; bi < 2; ++bi)
#pragma unroll
                          for (int q4 = 0; q4 < 4; ++q4) edv[bi][q4] = *(const LAS f32x4*)(tab + 64 + 32 * bi + 8 * q4 + 4 * hh);
                      __builtin_amdgcn_sched_barrier(0);
#pragma unroll
                      for (int bi = 0; bi < 2; ++bi) { f32x16 T2;
#pragma unroll
                          for (int q4 = 0; q4 < 4; ++q4) { const f32x4 ed = edv[bi][q4];
#pragma unroll
                              for (int e = 0; e < 4; ++e) T2[4 * q4 + e] = Vn[bi][4 * q4 + e] * ed[e]; }
                          Vs[bi][0] = pka(T2, 0); Vs[bi][1] = pka(T2, 8); }
#pragma unroll
                      for (int kb = 0; kb < 4; ++kb)
#pragma unroll
                          for (int reg = 0; reg < 16; ++reg) S[kb][reg] *= gl;
                      asm volatile("s_waitcnt lgkmcnt(0)" ::: "memory"); __builtin_amdgcn_sched_barrier(0);
                      S2_KT_MMA(0);
                      __builtin_amdgcn_sched_barrier(0);
                      S2_KT_ISSUE(2);
                      asm volatile("s_waitcnt lgkmcnt(0)" ::: "memory"); __builtin_amdgcn_sched_barrier(0);
                      S2_KT_MMA(2); }
#undef S2_KT_ISSUE
#undef S2_KT_MMA
                    asm volatile("s_waitcnt lgkmcnt(0)" ::: "memory");
                }
                __builtin_amdgcn_s_barrier(); asm volatile("" ::: "memory");
            }
        }
        asm volatile("s_waitcnt vmcnt(0)" ::: "memory");
#undef S2_CK
#undef S2_FILL
#undef S2_TLOAD
    }
}
__device__ __forceinline__ void delta_out(Frame& F) {
    const Args& A = *F.a; const bf16_t* OF = RG(F, 0); const bf16_t* OBk = RG(F, 3); const bf16_t* Z = RG(F, 4); bf16_t* Y = RG(F, 5);
    const int per = (TT + F.G - 1) / F.G, r0 = F.bid * per, r1 = (r0 + per < TT) ? r0 + per : TT;
    float ng[8];
#pragma unroll
    for (int e = 0; e < 8; ++e) ng[e] = A.in[I_CNG][((8 * F.lane) & 127) + e];
    u32x4 ac[2], bc[2], zc[2], an[2], bn[2], zn[2];
#define DO_LOAD(AA, BB, ZZ, t_) do { _Pragma("unroll") for (int j = 0; j < 2; ++j) { const size_t off_ = (size_t)(t_) * D + j * 512 + 8 * F.lane; \
        AA[j] = *(const u32x4*)(OF + off_); BB[j] = *(const u32x4*)(OBk + off_); ZZ[j] = *(const u32x4*)(Z + off_); } } while (0)
    if (r0 + F.wave < r1) DO_LOAD(ac, bc, zc, r0 + F.wave);
    for (int t = r0 + F.wave; t < r1; t += NWAVES) {
        FRAME_REFRESH(F);
        if (t + NWAVES < r1) DO_LOAD(an, bn, zn, t + NWAVES);
#pragma unroll
        for (int j = 0; j < 2; ++j) { const int col = j * 512 + 8 * F.lane; const size_t off = (size_t)t * D + col;
            const u32x4 a = ac[j], bq = bc[j], z = zc[j];
            float o[8] = {bflo(a.x) + bflo(bq.x), bfhi(a.x) + bfhi(bq.x), bflo(a.y) + bflo(bq.y), bfhi(a.y) + bfhi(bq.y), bflo(a.z) + bflo(bq.z), bfhi(a.z) + bfhi(bq.z), bflo(a.w) + bflo(bq.w), bfhi(a.w) + bfhi(bq.w)};
            const float zz[8] = {bflo(z.x), bfhi(z.x), bflo(z.y), bfhi(z.y), bflo(z.z), bfhi(z.z), bflo(z.w), bfhi(z.w)};
            float ss = 0.f;
#pragma unroll
            for (int e = 0; e < 8; ++e) ss += o[e] * o[e];
            ss = sum16(ss); const float rs = 1.f / sqrtf(ss * (1.f / 128.f) + EPS);
#pragma unroll
            for (int e = 0; e < 8; ++e) o[e] = o[e] * rs * ng[e] * siluf_(zz[e]);
            *(u32x4*)(Y + off) = (u32x4){pk2(o[0], o[1]), pk2(o[2], o[3]), pk2(o[4], o[5]), pk2(o[6], o[7])}; }
#pragma unroll
        for (int j = 0; j < 2; ++j) { ac[j] = an[j]; bc[j] = bn[j]; zc[j] = zn[j]; }
    }
#undef DO_LOAD
}

__global__ void __launch_bounds__(NTHR, 2) hybrid_fwd(Args args) {
    extern __shared__ __attribute__((aligned(16))) unsigned char lds[];
    Frame F;
    F.lds = (LAS unsigned char*)lds; F.ldsg = (char*)lds;
    F.wave = __builtin_amdgcn_readfirstlane((int)threadIdx.x >> 6);
#define REFRESH() FRAME_REFRESH(F)
    REFRESH();
    F.bid = blockIdx.x; F.G = gridDim.x; F.gw = F.bid * NWAVES + F.wave; F.NGW = F.G * NWAVES;
    F.a = &args; F.ws = args.ws; F.out = args.out;
    volatile LAS unsigned* MISC = (volatile LAS unsigned*)(F.lds + MISC_OFF);
    if (F.tid < 4) MISC[F.tid] = 0u;
    __syncthreads();
    const int lo = args.ph_lo, hi = args.ph_hi;
    XcdBarrier bar; bar.bar = (unsigned*)(args.ws + WS_CTL) + CW_BAR; bar.x = 0; bar.st = MISC;
    if (hi - lo > 1) bar = xcd_barrier_post((unsigned*)(args.ws + WS_CTL) + CW_BAR, MISC, F.tid);
    int ph = 0;
#ifndef PHMASK
#define PHMASK 0xFFFFFFFFu
#endif
#ifndef REPMASK
#define REPMASK 0u
#endif
#define PHASE_BEGIN(cls) if (((PHMASK >> (cls)) & 1u) && ph >= lo && ph < hi) { PH_T0(cls); for (int rep_ = 0; rep_ < 1 + (int)((REPMASK >> (cls)) & 1u); ++rep_) { REFRESH();
#if PROBE_T == 4
    unsigned long long pht0_ = 0; int phc_ = -1;
#define PH_T0(cls) do { phc_ = (cls); if ((cls) == PROBE_SITE) pht0_ = __builtin_amdgcn_s_memrealtime(); } while (0)
#define PH_T1() do { if (phc_ == PROBE_SITE) { asm volatile("s_waitcnt vmcnt(0) lgkmcnt(0)" ::: "memory"); __syncthreads(); if (blockIdx.x == 7 && F.wave == 0 && F.lane == 0) { unsigned long long* dg_ = (unsigned long long*)(F.ws + WS_CTL + 512 * 1024); dg_[3] += __builtin_amdgcn_s_memrealtime() - pht0_; dg_[2] += 1ull; } } } while (0)
#else
#define PH_T0(cls) do { } while (0)
#define PH_T1() do { } while (0)
#endif
#if PROBE_T == 5
#define BAR_T(stmt) do { const unsigned long long b0_ = __builtin_amdgcn_s_memrealtime(); stmt; if (blockIdx.x == PROBE_SITE && F.wave == 0 && F.lane == 0) { unsigned long long* dg_ = (unsigned long long*)(F.ws + WS_CTL + 512 * 1024); dg_[3] += __builtin_amdgcn_s_memrealtime() - b0_; dg_[2] = 1ull; } } while (0)
#else
#define BAR_T(stmt) do { stmt; } while (0)
#endif
#define PHASE_END   } PH_T1(); if (ph + 1 < hi) { REFRESH(); BAR_T(xcd_barrier(bar, F.tid)); } } ++ph;
    const Args& A = args;
    bf16_t* hctx = (bf16_t*)(F.ws + WS_HCTX); bf16_t* hlat = hlat_base(F);

    PHASE_BEGIN(0) p0_prologue(F); PHASE_END
    PHASE_BEGIN(1) p1_init(F); PHASE_END

#define DBGP(site) ((PROBE_T && (site) == PROBE_SITE) ? (unsigned long long*)(F.ws + WS_CTL + 512 * 1024) : (unsigned long long*)nullptr)
#define GEMM_DENSE(EPI, Aptr, Bptr, M_, N_, K_, SITE_) do { pg8::Gemm g_{(Aptr), (Bptr), (M_), (N_), (K_), 0, DBGP(SITE_)}; pg8::StaticOrder S_; S_.init((M_), (N_), F.G, F.bid); \
        pg8::gemm_phase(F.lds, g_, S_, EPI, F.tid); } while (0)
#define MOE_LAYER(layer, last) do { const int nrows_ = (last) ? TLAT : TT; \
        PHASE_BEGIN(5) moe_route(F, (layer), nrows_, (last)); PHASE_END \
        PHASE_BEGIN(7) if (!(rep_ && (last))) { moe_tables(F, (layer)); pg8::Gemm g_{RG(F, 0), (const bf16_t*)(F.ws + WS_WE1), TT, 1024, D, (size_t)D * D * 2, DBGP(40 + (layer))}; \
            pg8::GroupedOrder S_{(const LAS int*)(F.lds + GTAB_OFF), (const LAS int*)(F.lds + GTAB_OFF) + 32, F.G, F.bid}; moe_toktable(F, S_); EpiGateUp E_{rep_ ? RG(F, 6) : (bf16_t*)(F.ws + WS_HID)}; \
            pg8::gemm_phase_gather(F.lds, g_, S_, E_, F.tid, (const LAS int*)(F.lds + GTOK_OFF)); } PHASE_END \
        PHASE_BEGIN(8) if (!(rep_ && (last))) { moe_tables(F, (layer)); pg8::Gemm g_{(const bf16_t*)(F.ws + WS_HID), (const bf16_t*)(F.ws + WS_WE2), XS_ROWS, 1024, DE, (size_t)D * DE * 2, DBGP(50 + (layer))}; \
            pg8::GroupedOrder S_{(const LAS int*)(F.lds + GTAB_OFF), (const LAS int*)(F.lds + GTAB_OFF) + 32, F.G, F.bid}; moe_dsttable(F, S_); EpiDown E_{rep_ ? RG(F, 6) : (bf16_t*)(F.ws + WS_Y2), (const LAS int*)(F.lds + GTOK_OFF), (const LAS float*)(F.lds + GTOK_OFF + GTOK_MAXU * 1024)}; pg8::gemm_phase(F.lds, g_, S_, E_, F.tid); } PHASE_END \
        PHASE_BEGIN(9) moe_ln2(F, (layer), nrows_, (last)); PHASE_END } while (0)
#define ATTN_LAYER(layer, j, last) do { \
        PHASE_BEGIN(2) { pg8::Gemm g_{RG(F, 0), (const bf16_t*)(F.ws + WS_WQKV) + (size_t)(j) * 1536 * D, TT, 1536, D, 0, DBGP(10 + (layer))}; pg8::StaticOrder S_; S_.init(TT, 1536, F.G, F.bid); \
            EpiQKV E_{RG(F, 1), RG(F, 2), (bf16_t*)((char*)RG(F, 2) + 17 * MiB)}; pg8::gemm_phase(F.lds, g_, S_, E_, F.tid); VM_WAIT(); __syncthreads(); qk_norm_rope(F, (j), S_); } PHASE_END \
        PHASE_BEGIN(3) attn_phase(F, !(last), rep_ ? RG(F, 5) : RG(F, 1), (j)); PHASE_END \
        PHASE_BEGIN(4) { EpiResid E_{rep_ ? RG(F, 6) : hlat, rep_ ? RG(F, 3) : hctx, modrow(F, (layer), 0) + 2048}; GEMM_DENSE(E_, RG(F, 1), (const bf16_t*)(F.ws + WS_WO) + (size_t)(j) * D * D, (last) ? TLAT : TT, D, D, 20 + (layer)); if (!rep_) moe_convert(F, (layer), (last) ? 0 : 16); } PHASE_END } while (0)

    ATTN_LAYER(0, 0, false);
    MOE_LAYER(0, false);
    PHASE_BEGIN(10) { EpiGelu E_{RG(F, 1), (f32x2*)(F.ws + WS_AB)}; GEMM_DENSE(E_, RG(F, 0), (const bf16_t*)(F.ws + WS_BWIN), TT, 2048, D, 30); } PHASE_END
    PHASE_BEGIN(11) gmlp_spatial(F); PHASE_END
    PHASE_BEGIN(4) { EpiResid E_{rep_ ? RG(F, 6) : hlat, rep_ ? RG(F, 3) : hctx, modrow(F, 1, 0) + 2048}; GEMM_DENSE(E_, RG(F, 0), (const bf16_t*)(F.ws + WS_BWOUT), TT, D, D, 21); if (!rep_) moe_convert(F, 1, 16); } PHASE_END
    MOE_LAYER(1, false);
    PHASE_BEGIN(12) { EpiDeltaIn E_{RG(F, 1), (float*)(F.ws + WS_AB)}; GEMM_DENSE(E_, RG(F, 0), (const bf16_t*)(F.ws + WS_CWIN), TT, CW_NPAD, D, 31); } PHASE_END
    PHASE_BEGIN(13) delta_prep(F); PHASE_END
    PHASE_BEGIN(14) delta_local(F); PHASE_END
    PHASE_BEGIN(15) delta_scan2(F); PHASE_END
    PHASE_BEGIN(16) delta_out(F); PHASE_END
    PHASE_BEGIN(4) { EpiResid E_{rep_ ? RG(F, 6) : hlat, rep_ ? RG(F, 3) : hctx, modrow(F, 2, 0) + 2048}; GEMM_DENSE(E_, RG(F, 5), (const bf16_t*)(F.ws + WS_CWOUT), TT, D, D, 22); if (!rep_) moe_convert(F, 2, 16); } PHASE_END
    MOE_LAYER(2, false);
    ATTN_LAYER(3, 1, true);
    MOE_LAYER(3, true);
    (void)A;
}
constexpr int NPHASES = 2 + (3 + 4) + (3 + 4) + (6 + 4) + (3 + 4);

extern "C" void kernel_launch(void* const* d_in, const int* in_sizes, int n_in, void* d_out, int out_size, void* d_ws, size_t ws_size, hipStream_t stream) {
    static int grid = 0;
    if (grid == 0) {
        if (n_in != 29 || out_size != TLAT * D || ws_size < WS_END) { fprintf(stderr, "kernel_launch: unexpected shapes: n_in %d out %d ws %zu (need %zu)\n", n_in, out_size, ws_size, (size_t)WS_END); grid = -1; return; }
        int dev = 0, cus = 0, per_cu = 0;
        if (hipGetDevice(&dev) != hipSuccess || hipDeviceGetAttribute(&cus, hipDeviceAttributeMultiprocessorCount, dev) != hipSuccess) { grid = -1; return; }
        if (hipFuncSetAttribute((const void*)hybrid_fwd, hipFuncAttributeMaxDynamicSharedMemorySize, LDS_BYTES) != hipSuccess) { fprintf(stderr, "kernel_launch: hipFuncSetAttribute failed\n"); grid = -1; return; }
        if (hipOccupancyMaxActiveBlocksPerMultiprocessor(&per_cu, (const void*)hybrid_fwd, NTHR, LDS_BYTES) != hipSuccess || per_cu < 1) fprintf(stderr, "kernel_launch: occupancy query says %d\n", per_cu);
        (void)hipGetLastError();
        grid = cus < 256 ? cus : 256;
    }
    if (grid < 0) return;
    (void)hipMemsetAsync((char*)d_ws + WS_CTL, 0, CTL_ZERO_BYTES, stream);
    Args a{};
    for (int i = 0; i < 29; ++i) a.in[i] = (const float*)d_in[i];
    a.out = (float*)d_out; a.ws = (unsigned char*)d_ws;
#if MK_ONE_LAUNCH
    a.ph_lo = 0; a.ph_hi = NPHASES;
    hipLaunchKernelGGL(hybrid_fwd, dim3(grid), dim3(NTHR), LDS_BYTES, stream, a);
#else
    for (int p = 0; p < NPHASES; ++p) { a.ph_lo = p; a.ph_hi = p + 1; hipLaunchKernelGGL(hybrid_fwd, dim3(grid), dim3(NTHR), LDS_BYTES, stream, a); }
#endif
    const hipError_t le = hipPeekAtLastError();
    if (le != hipSuccess) fprintf(stderr, "kernel_launch: launch failed: %s\n", hipGetErrorName(le));
}
```

```cpp
#include <hip/hip_runtime.h>
#include <cstdio>
#include <cstdint>

#ifndef PROBE_T
#define PROBE_T 0
#endif
#ifndef PROBE_SITE
#define PROBE_SITE 0
#endif
#ifndef MK_ONE_LAUNCH
#define MK_ONE_LAUNCH 1
#endif

#define GAS __attribute__((address_space(1)))
#define LAS __attribute__((address_space(3)))
typedef unsigned short bf16_t;
typedef short bf16x8 __attribute__((ext_vector_type(8)));
typedef short s16x4 __attribute__((ext_vector_type(4)));
typedef float f32x2 __attribute__((ext_vector_type(2)));
typedef float f32x4 __attribute__((ext_vector_type(4)));
typedef float f32x8 __attribute__((ext_vector_type(8)));
typedef float f32x16 __attribute__((ext_vector_type(16)));
typedef unsigned u32x2 __attribute__((ext_vector_type(2)));
typedef unsigned u32x4 __attribute__((ext_vector_type(4)));
typedef int i32x2 __attribute__((ext_vector_type(2)));
typedef __bf16 bf16x2_t __attribute__((ext_vector_type(2)));

constexpr int D = 1024, NBATCH = 4, SEQ = 8192, CTXL = 256;
constexpr int TLAT = NBATCH * SEQ, TCTX = NBATCH * CTXL, TT = TLAT + TCTX;
constexpr int KVLEN = CTXL + SEQ;
constexpr int NE = 16, DE = 512, NLAYER = 4;
constexpr int CW_N = 4128, CW_NPAD = 4352;
constexpr float DN_ALPHA = 1.6817928305074292f;
constexpr float EPS = 1e-6f;
constexpr int XS_ROWS = 2 * TT + NE * 256;
constexpr int NWAVES = 8, NTHR = 512;

constexpr size_t MiB = 1u << 20;
constexpr size_t WS_CTL = 0, CTL_ZERO_BYTES = 1 * MiB;
constexpr size_t WS_MOD = 1 * MiB;
constexpr size_t WS_ROPE = 2 * MiB;
constexpr size_t WS_HCTX = 6 * MiB;
constexpr size_t WS_ASG = 10 * MiB;
constexpr size_t WS_ASGW = WS_ASG + 512 * 1024;
constexpr size_t WS_POS = WS_ASGW + 512 * 1024;
constexpr size_t WS_ROWMAP = WS_POS + 512 * 1024;
constexpr size_t WS_ROWW = WS_ROWMAP + 512 * 1024;
constexpr size_t WS_WLIST = 10 * MiB;
constexpr size_t WS_LIST = 23 * MiB + 512 * 1024;
constexpr size_t WS_AB = 13 * MiB;
constexpr size_t WS_GC = 18 * MiB;
constexpr size_t WS_BETA = 21 * MiB;
constexpr size_t WS_WQKV = 26 * MiB;
constexpr size_t WS_WO = 32 * MiB;
constexpr size_t WS_BWIN = 36 * MiB;
constexpr size_t WS_BWOUT = 40 * MiB;
constexpr size_t WS_BWS = 42 * MiB;
constexpr size_t WS_CWIN = 43 * MiB;
constexpr size_t WS_CWOUT = 52 * MiB;
constexpr size_t WS_WE1 = 54 * MiB;
constexpr size_t WS_WE2 = 86 * MiB;
constexpr size_t WS_R0 = 102 * MiB, RSZ = 66 * MiB;
constexpr size_t WS_END = WS_R0 + 8 * RSZ;
constexpr size_t WS_XS = WS_R0, WS_HID = WS_R0 + 140 * MiB, WS_Y2 = WS_R0 + 4 * RSZ;
static_assert((size_t)XS_ROWS * 2048 <= 140 * MiB && (size_t)XS_ROWS * 1024 <= 70 * MiB && WS_HID + 70 * MiB <= WS_Y2, "moe overlay");
static_assert((size_t)TT * D * 2 == RSZ, "region size");

constexpr int CW_BAR = 4096;
constexpr int CW_CNT = 16384;

constexpr int LDS_BYTES = 155648;
constexpr int MISC_OFF = LDS_BYTES - 512;
constexpr int GTAB_OFF = 131072;   constexpr int GTOK_OFF = GTAB_OFF + 1024, GTOK_MAXU = 10;
static_assert(GTOK_OFF + GTOK_MAXU * 2048 <= MISC_OFF, "token / destination tables");
constexpr int XX_DUMMY = 0;

#define RLX_AGENT __ATOMIC_RELAXED, __HIP_MEMORY_SCOPE_AGENT
#define LDS_WAIT() asm volatile("s_waitcnt lgkmcnt(0)" ::: "memory")
#define VM_WAIT() asm volatile("s_waitcnt vmcnt(0)" ::: "memory")
__device__ __forceinline__ unsigned pk2(float lo, float hi) { f32x2 v = {lo, hi}; bf16x2_t b = __builtin_convertvector(v, bf16x2_t); return __builtin_bit_cast(unsigned, b); }
__device__ __forceinline__ float bflo(unsigned w) { return __uint_as_float(w << 16); }
__device__ __forceinline__ float bfhi(unsigned w) { return __uint_as_float(w & 0xffff0000u); }
__device__ __forceinline__ float bf1(bf16_t b) { return __uint_as_float((unsigned)b << 16); }
__device__ __forceinline__ float wave_sum(float v) {
#pragma unroll
    for (int o = 1; o < 64; o <<= 1) v += __shfl_xor(v, o);
    return v;
}
__device__ __forceinline__ float sum16(float v) {
#pragma unroll
    for (int o = 1; o < 16; o <<= 1) v += __shfl_xor(v, o);
    return v;
}
__device__ __forceinline__ float sigmoidf_(float x) { return 1.f / (1.f + __expf(-x)); }
__device__ __forceinline__ float siluf_(float x) { return x * __builtin_amdgcn_rcpf(1.f + __builtin_amdgcn_exp2f(-1.4426950408889634f * x)); }
__device__ __forceinline__ int crow(int r, int hi) { return (r & 3) + 8 * (r >> 2) + 4 * hi; }
__device__ __forceinline__ bf16x8 mk8(u32x2 lo, u32x2 hi) { u32x4 w = {lo.x, lo.y, hi.x, hi.y}; return __builtin_bit_cast(bf16x8, w); }
__device__ __forceinline__ bf16x8 mk8w(unsigned a, unsigned b, unsigned c, unsigned d) { u32x4 w = {a, b, c, d}; return __builtin_bit_cast(bf16x8, w); }
#define MFMA32(a, b, c) __builtin_amdgcn_mfma_f32_32x32x16_bf16((a), (b), (c), 0, 0, 0)

#define XB_TMO      128
#define XB_XCNT(j)  (256  + 64 * (j))
#define XB_XSUB(j)  (1280 + 64 * (j))
#define XB_XGEN(j)  (2304 + 64 * (j))
#define XB_TOP      3328
#define XB_TOPGEN   3392
#define XCD_BAR_WORDS 3456
#define XB_SPIN_CAP (1u << 18)

__device__ __forceinline__ unsigned xb_ld(unsigned* p)              { return __hip_atomic_load(p, __ATOMIC_RELAXED, __HIP_MEMORY_SCOPE_AGENT); }
__device__ __forceinline__ unsigned xb_add(unsigned* p, unsigned v) { return __hip_atomic_fetch_add(p, v, __ATOMIC_RELAXED, __HIP_MEMORY_SCOPE_AGENT); }
__device__ __forceinline__ unsigned xb_xcc_id() { return (unsigned)__builtin_amdgcn_s_getreg((3 << 11) | 20) & 0xFu; }
#define XB_SPIN(cond, bar) do { unsigned _sp = 0; while (cond) { __builtin_amdgcn_s_sleep(1); \
    if ((++_sp & 255u) == 0u) { if (xb_ld(&(bar)[XB_TMO])) break; if (_sp > XB_SPIN_CAP) { atomicAdd(&(bar)[XB_TMO], 1u); break; } } } } while (0)

struct XcdBarrier {
    unsigned* bar; unsigned x;
    volatile LAS unsigned* st;
};
__device__ __forceinline__ XcdBarrier xcd_barrier_post(unsigned* bar, volatile LAS unsigned* st, int tid) {
    XcdBarrier b; b.bar = bar; b.x = xb_xcc_id(); b.st = st;
    if (tid == 0) (void)xb_add(&bar[XB_XCNT(b.x)], 1u);
    return b;
}
__device__ __forceinline__ void xcd_barrier_complete(unsigned* bar, unsigned x, unsigned& nloc, unsigned& nx) {
    const unsigned G = gridDim.x * gridDim.y * gridDim.z;
    unsigned sum, cnt, mine, sp = 0u;
    for (;;) {
        sum = 0u; cnt = 0u; mine = 0u;
#pragma unroll
        for (unsigned j = 0; j < 16; ++j) { const unsigned c = xb_ld(&bar[XB_XCNT(j)]); sum += c; cnt += (c > 0u) ? 1u : 0u; mine = (j == x) ? c : mine; }
        if (sum == G) break;
        __builtin_amdgcn_s_sleep(1);
        if ((++sp & 255u) == 0u) { if (xb_ld(&bar[XB_TMO])) break; if (sp > XB_SPIN_CAP) { atomicAdd(&bar[XB_TMO], 1u); break; } }
    }
    nloc = mine > 0u ? mine : 1u; nx = cnt > 0u ? cnt : 1u;
}
__device__ __forceinline__ void xcd_barrier(const XcdBarrier& b, int tid) {
    asm volatile("s_waitcnt vmcnt(0)" ::: "memory");
    __syncthreads();
    if (tid == 0) {
        unsigned* bar = b.bar;
        __builtin_amdgcn_s_waitcnt(0);
        unsigned nloc = b.st[0], nx = b.st[1];
        if (nloc == 0u) { xcd_barrier_complete(bar, b.x, nloc, nx); b.st[0] = nloc; b.st[1] = nx; }
        const unsigned old = xb_add(&bar[XB_XSUB(b.x)], 1u);
        const unsigned gen = old / nloc;
        if (old + 1u == (gen + 1u) * nloc) {
            __builtin_amdgcn_fence(__ATOMIC_RELEASE, "agent");
            asm volatile("s_waitcnt vmcnt(0)" ::: "memory");
            const unsigned og = xb_add(&bar[XB_TOP], 1u);
            const unsigned tg = og / nx;
            if (og + 1u == (tg + 1u) * nx) xb_add(&bar[XB_TOPGEN], 1u);
            else XB_SPIN(xb_ld(&bar[XB_TOPGEN]) == tg, bar);
            __builtin_amdgcn_fence(__ATOMIC_ACQUIRE, "agent");
            xb_add(&bar[XB_XGEN(b.x)], 1u);
            asm volatile("s_waitcnt vmcnt(0)" ::: "memory");
        } else {
            XB_SPIN(xb_ld(&bar[XB_XGEN(b.x)]) == gen, bar);
            __builtin_amdgcn_fence(__ATOMIC_ACQUIRE, "agent");
            asm volatile("s_waitcnt vmcnt(0)" ::: "memory");
        }
    }
    __syncthreads();
}

namespace pg8 {
constexpr int BM = 256, BK = 64, HALF = 128, HTB = HALF * BK * 2, STAGE_BYTES = 8 * HTB, NXCD = 8, WGM = 8;
__host__ __device__ __forceinline__ int lds_byte(int r, int c) { const int st = (r >> 4) * 2 + (c >> 5), rr = r & 15, cc = c & 31, ob = rr * 64 + cc * 2; return st * 1024 + (ob ^ (((ob >> 9) & 1) << 5)); }
__host__ __device__ __forceinline__ void stage_rc(int b, int& R, int& C) { const int st = b / 1024, sb = b % 1024, swz = sb ^ (((sb >> 9) & 1) << 5); R = (st >> 1) * 16 + swz / 64; C = (st & 1) * 32 + (swz % 64) / 2; }
__host__ __device__ __forceinline__ int perm32(int rho) { const int n = rho >> 4, i = rho & 15; return 8 * (i >> 2) + 4 * n + (i & 3); }

struct Unit { int pm, pn, e, nvalid, lbase, ord; };
struct Gemm { const bf16_t* A; const bf16_t* Bt; int M, N, K; size_t bstride; unsigned long long* dbg; };

struct StaticOrder {
    int nM, nN, nwg, G, c;
    __device__ void init(int M, int N, int G_, int c_) { nM = M / BM; nN = N / BM; nwg = nM * nN; G = G_; c = c_; }
    __device__ bool next(int i, Unit& u) const {
        const long L = (long)i * G + c; if (L >= nwg) return false;
        int wgid = (int)L; { const int q = nwg / NXCD, r = nwg % NXCD, xcd = wgid % NXCD, off = wgid / NXCD; wgid = (xcd < r ? xcd * (q + 1) : r * (q + 1) + (xcd - r) * q) + off; }
        const int nig = WGM * nN, gid = wgid / nig, fm = gid * WGM, gsz = (nM - fm) < WGM ? (nM - fm) : WGM;
        u.pm = fm + ((wgid % nig) % gsz); u.pn = (wgid % nig) / gsz; u.e = 0; u.nvalid = 256; u.lbase = 0; u.ord = i; return true;
    }
};
struct GroupedOrder {
    const LAS int* TS; const LAS int* CNT; int G, c;
    __device__ bool next(int i, Unit& u) const {
        int rt, pnn;
        if ((G & 7) == 0) { const int x = c & 7, q = i * (G >> 3) + (c >> 3); rt = (q >> 2) * 8 + x; pnn = q & 3; }
        else { const int L = i * G + c; rt = L >> 2; pnn = L & 3; }
        if (rt >= TS[NE]) return false;
        const int L = pnn; int e = 0;
#pragma unroll 1
        while (rt >= TS[e + 1]) ++e;
        u.pm = rt; u.pn = L & 3; u.e = e; const int tin = rt - TS[e]; u.nvalid = CNT[e] - tin * 256; u.lbase = e * TT + tin * 256; u.ord = i; return true;
    }
};

template <class Epi, class Sched>
__device__ __forceinline__ void gemm_phase(LAS unsigned char* lds, const Gemm g, const Sched& S, const Epi& E, const int tid) {
    const int wid = __builtin_amdgcn_readfirstlane(tid >> 6), lane = tid & 63, wr = wid >> 2, wc = wid & 3, fr = lane & 15, fq = lane >> 4;
    const int K = g.K, nt = K / BK;
    unsigned voffA[2], voffB[2];
#pragma unroll
    for (int i = 0; i < 2; ++i) { int R, C; stage_rc(tid * 16 + i * 8192, R, C); const int Rb = Epi::PERM ? ((R & ~31) + perm32(R & 31)) : R;
        voffA[i] = (unsigned)(R * K + C) * 2u; voffB[i] = (unsigned)(Rb * K + C) * 2u; }
    const size_t kstep = (size_t)(BK * 2);
    const size_t hstep = (size_t)HALF * K * 2;
    const size_t tstep = 2 * hstep;
    const unsigned ldsw = (unsigned)wid * 1024u;
    const int aoff = lds_byte(wr * 64 + fr, fq * 8), boff = lds_byte(wc * 32 + fr, fq * 8);
#define PG8_SA(b, h) (((b) * 2 + (h)) * HTB)
#define PG8_SB(b, h) ((4 + (b) * 2 + (h)) * HTB)
#define PG8_STAGE(bufoff, gbase, voff) do { _Pragma("unroll") for (int _i = 0; _i < 2; ++_i) \
        __builtin_amdgcn_global_load_lds((const unsigned*)((const char*)(gbase) + (voff)[_i]), (LAS unsigned*)(lds + (bufoff) + ldsw + _i * 8192), 16, 0, 0); } while (0)
#define PG8_LDA(dst, b, h) do { _Pragma("unroll") for (int m = 0; m < 4; ++m) _Pragma("unroll") for (int k = 0; k < 2; ++k) dst[m][k] = *(const LAS bf16x8*)(lds + PG8_SA(b, h) + aoff + m * 2048 + k * 1024); } while (0)
#define PG8_LDB(dst, b, h) do { _Pragma("unroll") for (int n = 0; n < 2; ++n) _Pragma("unroll") for (int k = 0; k < 2; ++k) dst[n][k] = *(const LAS bf16x8*)(lds + PG8_SB(b, h) + boff + n * 2048 + k * 1024); } while (0)
#define PG8_MMA(ai, bj, At, Bt) do { __builtin_amdgcn_s_setprio(1); _Pragma("unroll") for (int m = 0; m < 4; ++m) _Pragma("unroll") for (int n = 0; n < 2; ++n) _Pragma("unroll") for (int k = 0; k < 2; ++k) \
        acc[ai][bj][m][n] = __builtin_amdgcn_mfma_f32_16x16x32_bf16(Bt[n][k], At[m][k], acc[ai][bj][m][n], 0, 0, 0); __builtin_amdgcn_s_setprio(0); } while (0)
#define PG8_WAIT_V(n) asm volatile("s_waitcnt vmcnt(" #n ")" ::: "memory")
#define PG8_WAIT_L(n) asm volatile("s_waitcnt lgkmcnt(" #n ")" ::: "memory")
#define PG8_BAR __builtin_amdgcn_s_barrier()
#define PG8_SCHED __builtin_amdgcn_sched_barrier(0)
    Unit cur, nxt; int ui = 0;
#if PROBE_T
    unsigned long long tk_ = 0, te_ = 0, tt0_ = __builtin_amdgcn_s_memrealtime(), ta_ = 0, tb_ = 0; int nu_ = 0;
#endif
    if (!S.next(0, cur)) return;
    f32x4 acc[2][2][4][2];
#pragma unroll
    for (int a = 0; a < 2; ++a)
#pragma unroll
        for (int b = 0; b < 2; ++b)
#pragma unroll
            for (int m = 0; m < 4; ++m)
#pragma unroll
                for (int n = 0; n < 2; ++n) acc[a][b][m][n] = (f32x4){0.f, 0.f, 0.f, 0.f};
    bf16x8 At[4][2], B0[2][2], B1[2][2];
    const char* cA = (const char*)g.A + (size_t)cur.pm * tstep; const char* cB = (const char*)g.Bt + (size_t)cur.e * g.bstride + (size_t)cur.pn * tstep;
    PG8_STAGE(PG8_SB(0, 0), cB, voffB); PG8_STAGE(PG8_SB(0, 1), cB + hstep, voffB); PG8_STAGE(PG8_SA(0, 0), cA, voffA); PG8_STAGE(PG8_SA(0, 1), cA + hstep, voffA);
    if (wr == 1) PG8_BAR;
    PG8_WAIT_V(2); PG8_BAR;
    PG8_STAGE(PG8_SB(1, 0), cB + kstep, voffB); PG8_STAGE(PG8_SA(1, 0), cA + kstep, voffA); PG8_STAGE(PG8_SB(1, 1), cB + hstep + kstep, voffB);
    PG8_WAIT_V(6); PG8_BAR;
    for (;;) {
        const bool has_next = S.next(ui + 1, nxt);
        const char* nA = has_next ? (const char*)g.A + (size_t)nxt.pm * tstep : cA; const char* nB = has_next ? (const char*)g.Bt + (size_t)nxt.e * g.bstride + (size_t)nxt.pn * tstep : cB;
#if PROBE_T
        ta_ = __builtin_amdgcn_s_memrealtime();
#endif
        for (int t = 0; t < nt; t += 2) {
            const bool last = (t == nt - 2);
            const char* a1 = cA + (size_t)(t + 1) * kstep;
            const char* a2 = last ? nA : cA + (size_t)(t + 2) * kstep; const char* b2 = last ? nB : cB + (size_t)(t + 2) * kstep;
            const char* a3 = a2 + kstep; const char* b3 = b2 + kstep;
            PG8_LDB(B0, 0, 0); PG8_LDB(B1, 0, 1); PG8_SCHED; PG8_LDA(At, 0, 0); PG8_STAGE(PG8_SA(1, 1), a1 + hstep, voffA);
            PG8_WAIT_V(8); PG8_WAIT_L(0); PG8_BAR; PG8_MMA(0, 0, At, B0); PG8_MMA(0, 1, At, B1); PG8_BAR; PG8_SCHED;
            PG8_LDA(At, 0, 1); PG8_STAGE(PG8_SB(0, 0), b2, voffB); PG8_STAGE(PG8_SB(0, 1), b2 + hstep, voffB); PG8_STAGE(PG8_SA(0, 0), a2, voffA);
            PG8_WAIT_V(8); PG8_WAIT_L(0); PG8_BAR; PG8_MMA(1, 0, At, B0); PG8_MMA(1, 1, At, B1); PG8_BAR; PG8_SCHED;
            PG8_LDB(B0, 1, 0); PG8_LDB(B1, 1, 1); PG8_SCHED; PG8_LDA(At, 1, 0); PG8_STAGE(PG8_SA(0, 1), a2 + hstep, voffA);
            PG8_WAIT_V(8); PG8_WAIT_L(0); PG8_BAR; PG8_MMA(0, 0, At, B0); PG8_MMA(0, 1, At, B1); PG8_BAR; PG8_SCHED;
            PG8_LDA(At, 1, 1); PG8_STAGE(PG8_SB(1, 0), b3, voffB); PG8_STAGE(PG8_SB(1, 1), b3 + hstep, voffB); PG8_STAGE(PG8_SA(1, 0), a3, voffA);
            PG8_WAIT_V(8); PG8_WAIT_L(0); PG8_BAR; PG8_MMA(1, 0, At, B0); PG8_MMA(1, 1, At, B1); PG8_BAR; PG8_SCHED;
        }
#if PROBE_T
        tb_ = __builtin_amdgcn_s_memrealtime();
#endif
        if (wr == 0) PG8_BAR;
        E(acc, cur, wr, wc, fr, fq);
#if PROBE_T
        { const unsigned long long tc_ = __builtin_amdgcn_s_memrealtime(); tk_ += tb_ - ta_; te_ += tc_ - tb_; ++nu_; }
#endif
        if (!has_next) break;
#pragma unroll
        for (int a = 0; a < 2; ++a)
#pragma unroll
            for (int b = 0; b < 2; ++b)
#pragma unroll
                for (int m = 0; m < 4; ++m)
#pragma unroll
                    for (int n = 0; n < 2; ++n) acc[a][b][m][n] = (f32x4){0.f, 0.f, 0.f, 0.f};
        cur = nxt; cA = nA; cB = nB; ++ui;
        if (wr == 1) PG8_BAR;
    }
    PG8_WAIT_V(0);
    PG8_BAR;
#if PROBE_T
    if (g.dbg && blockIdx.x == 7 && tid == 0) { g.dbg[0] = tk_; g.dbg[1] = te_; g.dbg[2] = (unsigned long long)nu_; g.dbg[3] = __builtin_amdgcn_s_memrealtime() - tt0_; }
#endif
#undef PG8_SA
#undef PG8_SB
#undef PG8_STAGE
#undef PG8_LDA
#undef PG8_LDB
#undef PG8_MMA
#undef PG8_WAIT_V
#undef PG8_WAIT_L
#undef PG8_BAR
#undef PG8_SCHED
}
template <class Epi, class Sched>
__device__ __forceinline__ void gemm_phase_gather(LAS unsigned char* lds, const Gemm g, const Sched& S, const Epi& E, const int tid, const LAS int* toks) {
    const int wid = __builtin_amdgcn_readfirstlane(tid >> 6), lane = tid & 63, wr = wid >> 2, wc = wid & 3, fr = lane & 15, fq = lane >> 4;
    const int K = g.K, nt = K / BK;
    unsigned voffB[2]; int RA[2]; unsigned CA[2];
#pragma unroll
    for (int i = 0; i < 2; ++i) { int R, C; stage_rc(tid * 16 + i * 8192, R, C); const int Rb = Epi::PERM ? ((R & ~31) + perm32(R & 31)) : R;
        RA[i] = R; CA[i] = (unsigned)C * 2u; voffB[i] = (unsigned)(Rb * K + C) * 2u; }
    unsigned roC[2][2], roN[2][2];
#define PG8_TOKS(ro, ui_) do { _Pragma("unroll") for (int hf_ = 0; hf_ < 2; ++hf_) _Pragma("unroll") for (int i_ = 0; i_ < 2; ++i_) \
        ro[hf_][i_] = (unsigned)toks[(ui_) * 256 + hf_ * 128 + RA[i_]] * (unsigned)(K * 2) + CA[i_]; } while (0)
#define PG8_STAGE_AG(bufoff, ktb, ro) do { _Pragma("unroll") for (int _i = 0; _i < 2; ++_i) \
        __builtin_amdgcn_global_load_lds((const unsigned*)((const char*)g.A + (ktb) + (ro)[_i]), (LAS unsigned*)(lds + (bufoff) + ldsw + _i * 8192), 16, 0, 0); } while (0)
    const size_t kstep = (size_t)(BK * 2);
    const size_t hstep = (size_t)HALF * K * 2;
    const size_t tstep = 2 * hstep;
    const unsigned ldsw = (unsigned)wid * 1024u;
    const int aoff = lds_byte(wr * 64 + fr, fq * 8), boff = lds_byte(wc * 32 + fr, fq * 8);
#define PG8_SA(b, h) (((b) * 2 + (h)) * HTB)
#define PG8_SB(b, h) ((4 + (b) * 2 + (h)) * HTB)
#define PG8_STAGE(bufoff, gbase, voff) do { _Pragma("unroll") for (int _i = 0; _i < 2; ++_i) \
        __builtin_amdgcn_global_load_lds((const unsigned*)((const char*)(gbase) + (voff)[_i]), (LAS unsigned*)(lds + (bufoff) + ldsw + _i * 8192), 16, 0, 0); } while (0)
#define PG8_LDA(dst, b, h) do { _Pragma("unroll") for (int m = 0; m < 4; ++m) _Pragma("unroll") for (int k = 0; k < 2; ++k) dst[m][k] = *(const LAS bf16x8*)(lds + PG8_SA(b, h) + aoff + m * 2048 + k * 1024); } while (0)
#define PG8_LDB(dst, b, h) do { _Pragma("unroll") for (int n = 0; n < 2; ++n) _Pragma("unroll") for (int k = 0; k < 2; ++k) dst[n][k] = *(const LAS bf16x8*)(lds + PG8_SB(b, h) + boff + n * 2048 + k * 1024); } while (0)
#define PG8_MMA(ai, bj, At, Bt) do { __builtin_amdgcn_s_setprio(1); _Pragma("unroll") for (int m = 0; m < 4; ++m) _Pragma("unroll") for (int n = 0; n < 2; ++n) _Pragma("unroll") for (int k = 0; k < 2; ++k) \
        acc[ai][bj][m][n] = __builtin_amdgcn_mfma_f32_16x16x32_bf16(Bt[n][k], At[m][k], acc[ai][bj][m][n], 0, 0, 0); __builtin_amdgcn_s_setprio(0); } while (0)
#define PG8_WAIT_V(n) asm volatile("s_waitcnt vmcnt(" #n ")" ::: "memory")
#define PG8_WAIT_L(n) asm volatile("s_waitcnt lgkmcnt(" #n ")" ::: "memory")
#define PG8_BAR __builtin_amdgcn_s_barrier()
#define PG8_SCHED __builtin_amdgcn_sched_barrier(0)
    Unit cur, nxt; int ui = 0;
#if PROBE_T
    unsigned long long tk_ = 0, te_ = 0, tt0_ = __builtin_amdgcn_s_memrealtime(), ta_ = 0, tb_ = 0; int nu_ = 0;
#endif
    if (!S.next(0, cur)) return;
    f32x4 acc[2][2][4][2];
#pragma unroll
    for (int a = 0; a < 2; ++a)
#pragma unroll
        for (int b = 0; b < 2; ++b)
#pragma unroll
            for (int m = 0; m < 4; ++m)
#pragma unroll
                for (int n = 0; n < 2; ++n) acc[a][b][m][n] = (f32x4){0.f, 0.f, 0.f, 0.f};
    bf16x8 At[4][2], B0[2][2], B1[2][2];
    const char* cB = (const char*)g.Bt + (size_t)cur.e * g.bstride + (size_t)cur.pn * tstep;
    PG8_TOKS(roC, 0);
    PG8_STAGE(PG8_SB(0, 0), cB, voffB); PG8_STAGE(PG8_SB(0, 1), cB + hstep, voffB); PG8_STAGE_AG(PG8_SA(0, 0), 0, roC[0]); PG8_STAGE_AG(PG8_SA(0, 1), 0, roC[1]);
    if (wr == 1) PG8_BAR;
    PG8_WAIT_V(2); PG8_BAR;
    PG8_STAGE(PG8_SB(1, 0), cB + kstep, voffB); PG8_STAGE_AG(PG8_SA(1, 0), kstep, roC[0]); PG8_STAGE(PG8_SB(1, 1), cB + hstep + kstep, voffB);
    PG8_WAIT_V(6); PG8_BAR;
    for (;;) {
        const bool has_next = S.next(ui + 1, nxt);
        const char* nB = has_next ? (const char*)g.Bt + (size_t)nxt.e * g.bstride + (size_t)nxt.pn * tstep : cB;
        if (has_next) { PG8_TOKS(roN, ui + 1); } else {
#pragma unroll
            for (int hf_ = 0; hf_ < 2; ++hf_)
#pragma unroll
                for (int i_ = 0; i_ < 2; ++i_) roN[hf_][i_] = roC[hf_][i_]; }
#if PROBE_T
        ta_ = __builtin_amdgcn_s_memrealtime();
#endif
        for (int t = 0; t < nt; t += 2) {
            const bool last = (t == nt - 2);
            const size_t k1 = (size_t)(t + 1) * kstep, k2 = last ? (size_t)0 : (size_t)(t + 2) * kstep, k3 = k2 + kstep;
            const char* b2 = last ? nB : cB + (size_t)(t + 2) * kstep; const char* b3 = b2 + kstep;
            unsigned r20[2], r21[2];
#pragma unroll
            for (int i_ = 0; i_ < 2; ++i_) { r20[i_] = last ? roN[0][i_] : roC[0][i_]; r21[i_] = last ? roN[1][i_] : roC[1][i_]; }
            PG8_LDB(B0, 0, 0); PG8_LDB(B1, 0, 1); PG8_SCHED; PG8_LDA(At, 0, 0); PG8_STAGE_AG(PG8_SA(1, 1), k1, roC[1]);
            PG8_WAIT_V(8); PG8_WAIT_L(0); PG8_BAR; PG8_MMA(0, 0, At, B0); PG8_MMA(0, 1, At, B1); PG8_BAR; PG8_SCHED;
            PG8_LDA(At, 0, 1); PG8_STAGE(PG8_SB(0, 0), b2, voffB); PG8_STAGE(PG8_SB(0, 1), b2 + hstep, voffB); PG8_STAGE_AG(PG8_SA(0, 0), k2, r20);
            PG8_WAIT_V(8); PG8_WAIT_L(0); PG8_BAR; PG8_MMA(1, 0, At, B0); PG8_MMA(1, 1, At, B1); PG8_BAR; PG8_SCHED;
            PG8_LDB(B0, 1, 0); PG8_LDB(B1, 1, 1); PG8_SCHED; PG8_LDA(At, 1, 0); PG8_STAGE_AG(PG8_SA(0, 1), k2, r21);
            PG8_WAIT_V(8); PG8_WAIT_L(0); PG8_BAR; PG8_MMA(0, 0, At, B0); PG8_MMA(0, 1, At, B1); PG8_BAR; PG8_SCHED;
            PG8_LDA(At, 1, 1); PG8_STAGE(PG8_SB(1, 0), b3, voffB); PG8_STAGE(PG8_SB(1, 1), b3 + hstep, voffB); PG8_STAGE_AG(PG8_SA(1, 0), k3, r20);
            PG8_WAIT_V(8); PG8_WAIT_L(0); PG8_BAR; PG8_MMA(1, 0, At, B0); PG8_MMA(1, 1, At, B1); PG8_BAR; PG8_SCHED;
        }
#if PROBE_T
        tb_ = __builtin_amdgcn_s_memrealtime();
#endif
        if (wr == 0) PG8_BAR;
        E(acc, cur, wr, wc, fr, fq);
#if PROBE_T
        { const unsigned long long tc_ = __builtin_amdgcn_s_memrealtime(); tk_ += tb_ - ta_; te_ += tc_ - tb_; ++nu_; }
#endif
        if (!has_next) break;
#pragma unroll
        for (int a = 0; a < 2; ++a)
#pragma unroll
            for (int b = 0; b < 2; ++b)
#pragma unroll
                for (int m = 0; m < 4; ++m)
#pragma unroll
                    for (int n = 0; n < 2; ++n) acc[a][b][m][n] = (f32x4){0.f, 0.f, 0.f, 0.f};
        cur = nxt; cB = nB; ++ui;
#pragma unroll
        for (int hf_ = 0; hf_ < 2; ++hf_)
#pragma unroll
            for (int i_ = 0; i_ < 2; ++i_) roC[hf_][i_] = roN[hf_][i_];
        if (wr == 1) PG8_BAR;
    }
    PG8_WAIT_V(0);
    PG8_BAR;
#if PROBE_T
    if (g.dbg && blockIdx.x == 7 && tid == 0) { g.dbg[0] = tk_; g.dbg[1] = te_; g.dbg[2] = (unsigned long long)nu_; g.dbg[3] = __builtin_amdgcn_s_memrealtime() - tt0_; }
#endif
#undef PG8_TOKS
#undef PG8_STAGE_AG
#undef PG8_SA
#undef PG8_SB
#undef PG8_STAGE
#undef PG8_LDA
#undef PG8_LDB
#undef PG8_MMA
#undef PG8_WAIT_V
#undef PG8_WAIT_L
#undef PG8_BAR
#undef PG8_SCHED
}
}
using pg8::Unit;

typedef f32x4 AccT[2][2][4][2];

__device__ __forceinline__ u32x4 pack8(const f32x4 a, const f32x4 b) { u32x4 w; w.x = pk2(a[0], a[1]); w.y = pk2(a[2], a[3]); w.z = pk2(b[0], b[1]); w.w = pk2(b[2], b[3]); return w; }
struct EpiResid {
    static constexpr bool PERM = true;
    bf16_t* hlat; bf16_t* hctx; const float* gate;
    __device__ __forceinline__ void operator()(const AccT& acc, const Unit& u, int wr, int wc, int fr, int fq) const {
        const int mi = u.pm < 128 ? (u.pm >> 5) : 4;
        bf16_t* hb = u.pm < 128 ? hlat + (size_t)u.pm * 256 * D : hctx + (size_t)(u.pm - 128) * 256 * D;
        const int col0 = u.pn * 256 + wc * 32 + 8 * fq;
        const float* g = gate + mi * 6144 + col0;
        f32x4 gv[2][2];
#pragma unroll
        for (int bj = 0; bj < 2; ++bj)
#pragma unroll
            for (int n = 0; n < 2; ++n) gv[bj][n] = *(const f32x4*)(g + bj * 128 + n * 4);
#pragma unroll
        for (int ai = 0; ai < 2; ++ai)
#pragma unroll
            for (int m = 0; m < 4; ++m) { bf16_t* rowp = hb + (size_t)(ai * 128 + wr * 64 + m * 16 + fr) * D + col0;
#pragma unroll
                for (int bj = 0; bj < 2; ++bj) { const u32x4 hw = *(const u32x4*)(rowp + bj * 128);
                    const f32x4 h0 = {bflo(hw.x), bfhi(hw.x), bflo(hw.y), bfhi(hw.y)}, h1 = {bflo(hw.z), bfhi(hw.z), bflo(hw.w), bfhi(hw.w)};
                    *(u32x4*)(rowp + bj * 128) = pack8(h0 * DN_ALPHA + gv[bj][0] * acc[ai][bj][m][0], h1 * DN_ALPHA + gv[bj][1] * acc[ai][bj][m][1]); } }
    }
};

struct EpiQKV {
    static constexpr bool PERM = true;
    bf16_t* Q; bf16_t* Kb; bf16_t* Vb;
    __device__ __forceinline__ void operator()(const AccT& acc, const Unit& u, int wr, int wc, int fr, int fq) const {
        const int cw = wc * 32 + 8 * fq;
        bf16_t* base; size_t ld; size_t r0;
        if (u.pn < 4) { base = Q + u.pn * 256; ld = D; r0 = (size_t)u.pm * 256; }
        else { base = (u.pn == 4) ? Kb : Vb; ld = 256; r0 = u.pm < 128 ? (size_t)(u.pm >> 5) * KVLEN + CTXL + (size_t)(u.pm & 31) * 256 : (size_t)(u.pm - 128) * KVLEN; }
#pragma unroll
        for (int ai = 0; ai < 2; ++ai)
#pragma unroll
            for (int m = 0; m < 4; ++m) { bf16_t* rowp = base + (r0 + ai * 128 + wr * 64 + m * 16 + fr) * ld + cw;
#pragma unroll
                for (int bj = 0; bj < 2; ++bj) *(u32x4*)(rowp + bj * 128) = pack8(acc[ai][bj][m][0], acc[ai][bj][m][1]); }
    }
};
__device__ __forceinline__ float gelu_tanh(float x) { const float x2 = x * x; const float e = __builtin_amdgcn_exp2f(x * fmaf(x2, -0.10294324f, -2.30220820f)); return x * __builtin_amdgcn_rcpf(1.f + e); }
struct EpiGelu {
    static constexpr bool PERM = true;
    bf16_t* O; f32x2* SP;
    __device__ __forceinline__ void operator()(const AccT& acc, const Unit& u, int wr, int wc, int fr, int fq) const {
        const int col0 = u.pn * 256 + wc * 32 + 8 * fq;
#pragma unroll
        for (int ai = 0; ai < 2; ++ai)
#pragma unroll
            for (int m = 0; m < 4; ++m) { const int row = u.pm * 256 + ai * 128 + wr * 64 + m * 16 + fr; bf16_t* rowp = O + (size_t)row * 2048 + col0;
                float s1 = 0.f, s2 = 0.f;
#pragma unroll
                for (int bj = 0; bj < 2; ++bj) { f32x4 a = acc[ai][bj][m][0], b = acc[ai][bj][m][1];
#pragma unroll
                    for (int i = 0; i < 4; ++i) { a[i] = gelu_tanh(a[i]); b[i] = gelu_tanh(b[i]); s1 += a[i] + b[i]; s2 += a[i] * a[i] + b[i] * b[i]; }
                    *(u32x4*)(rowp + bj * 128) = pack8(a, b); }
                if (u.pn >= 4) { s1 += __shfl_xor(s1, 16); s1 += __shfl_xor(s1, 32); s2 += __shfl_xor(s2, 16); s2 += __shfl_xor(s2, 32);
                    if (fq == 0) SP[(size_t)row * 16 + (u.pn - 4) * 4 + wc] = (f32x2){s1, s2}; } }
    }
};
struct EpiDeltaIn {
    static constexpr bool PERM = true;
    bf16_t* R1; float* AB;
    __device__ __forceinline__ void operator()(const AccT& acc, const Unit& u, int wr, int wc, int fr, int fq) const {
        if (u.pn < 16) {
            bf16_t* base = R1 + (size_t)(u.pn >> 2) * (RSZ / 2) + (u.pn & 3) * 256 + wc * 32 + 8 * fq;
#pragma unroll
            for (int ai = 0; ai < 2; ++ai)
#pragma unroll
                for (int m = 0; m < 4; ++m) { bf16_t* rowp = base + (size_t)(u.pm * 256 + ai * 128 + wr * 64 + m * 16 + fr) * D;
#pragma unroll
                    for (int bj = 0; bj < 2; ++bj) *(u32x4*)(rowp + bj * 128) = pack8(acc[ai][bj][m][0], acc[ai][bj][m][1]); }
        } else if (wc == 0) {
#pragma unroll
            for (int ai = 0; ai < 2; ++ai)
#pragma unroll
                for (int m = 0; m < 4; ++m) { float* rowp = AB + (size_t)(u.pm * 256 + ai * 128 + wr * 64 + m * 16 + fr) * 32 + 8 * fq;
                    *(f32x4*)(rowp) = acc[ai][0][m][0]; *(f32x4*)(rowp + 4) = acc[ai][0][m][1]; }
        }
    }
};
struct EpiGateUp {
    static constexpr bool PERM = true;
    bf16_t* H;
    __device__ __forceinline__ void operator()(const AccT& acc, const Unit& u, int wr, int wc, int fr, int fq) const {
        const int col0 = u.pn * 128 + wc * 32 + 8 * fq;
#pragma unroll
        for (int ai = 0; ai < 2; ++ai)
#pragma unroll
            for (int m = 0; m < 4; ++m) { bf16_t* rowp = H + (size_t)(u.pm * 256 + ai * 128 + wr * 64 + m * 16 + fr) * DE + col0;
                f32x4 a, b;
#pragma unroll
                for (int i = 0; i < 4; ++i) { a[i] = siluf_(acc[ai][0][m][0][i]) * acc[ai][1][m][0][i]; b[i] = siluf_(acc[ai][0][m][1][i]) * acc[ai][1][m][1][i]; }
                *(u32x4*)(rowp) = pack8(a, b); }
    }
};
struct EpiDown {
    static constexpr bool PERM = true;
    bf16_t* Y2; const LAS int* dstl; const LAS float* wl;
    __device__ __forceinline__ void operator()(const AccT& acc, const Unit& u, int wr, int wc, int fr, int fq) const {
        const int col0 = u.pn * 256 + wc * 32 + 8 * fq;
#pragma unroll
        for (int ai = 0; ai < 2; ++ai)
#pragma unroll
            for (int m = 0; m < 4; ++m) { const int r = ai * 128 + wr * 64 + m * 16 + fr;
                if (r < u.nvalid) { const int dst = dstl[u.ord * 256 + r]; const float w = wl[u.ord * 256 + r]; bf16_t* rowp = Y2 + (size_t)dst * D + col0;
#pragma unroll
                    for (int bj = 0; bj < 2; ++bj) *(u32x4*)(rowp + bj * 128) = pack8(acc[ai][bj][m][0] * w, acc[ai][bj][m][1] * w); } }
    }
};

namespace att {
constexpr int DH = 128, NW = 8, QBLK = 32, KVBLK = 64;
constexpr float SCALE = 0.088388347648318440f;
constexpr float THR = 8.f;
constexpr int LDQ = D, LDK = 256, LDO = D;
constexpr size_t SHM_V = KVBLK * DH * 2, SHM_K = KVBLK * DH * 2, SHM_ATTN = 2 * SHM_V + 2 * SHM_K + NW * 64 * 4;
#define KSWZ(row, colB) ((row) * 256 + ((colB) ^ (((row) & 7) << 4)))
#define SBAR() __builtin_amdgcn_sched_barrier(0)
__device__ __forceinline__ unsigned cvtpk(float lo, float hi) { unsigned r; asm volatile("v_cvt_pk_bf16_f32 %0, %1, %2" : "=v"(r) : "v"(lo), "v"(hi)); return r; }
template <bool FAST> __device__ __forceinline__ void partialSM(f32x16& p0, f32x16& p1, float& m_reg, float& mn, float& alpha) {
  if constexpr (FAST) { for (int r = 0; r < 16; ++r) p0[r] = __builtin_amdgcn_exp2f(p0[r]); alpha = 1.f; mn = 0.f; return; }
  constexpr float C = SCALE * 1.4426950408889634f;
  float pmax = p0[0]; for (int r = 1; r < 16; ++r) pmax = fmaxf(pmax, p0[r]); for (int r = 0; r < 16; ++r) pmax = fmaxf(pmax, p1[r]);
  { auto rr = __builtin_amdgcn_permlane32_swap(__float_as_uint(pmax), __float_as_uint(pmax), false, false);
    pmax = fmaxf(__uint_as_float(rr[0]), __uint_as_float(rr[1])); }
  if (__builtin_expect(__all(pmax - m_reg <= THR / SCALE), 1)) { mn = m_reg; alpha = 1.f; }
  else { mn = fmaxf(m_reg, pmax); alpha = __builtin_amdgcn_exp2f((m_reg - mn) * C); m_reg = mn; }
  float mnC = -mn * C;
  for (int r = 0; r < 16; ++r) p0[r] = fmaf(p0[r], C, mnC); for (int r = 0; r < 16; ++r) p1[r] = fmaf(p1[r], C, mnC);
  for (int r = 0; r < 16; ++r) p0[r] = __builtin_amdgcn_exp2f(p0[r]);
}
__device__ __forceinline__ void finishSM(f32x16& p0, f32x16& p1, float alpha, float& l_reg, bf16x8& pa0, bf16x8& pa1, bf16x8& pa2, bf16x8& pa3) {
  for (int r = 0; r < 16; ++r) p1[r] = __builtin_amdgcn_exp2f(p1[r]);
  float ps = 0; for (int r = 0; r < 16; ++r) ps += p0[r]; for (int r = 0; r < 16; ++r) ps += p1[r];
  { auto rr = __builtin_amdgcn_permlane32_swap(__float_as_uint(ps), __float_as_uint(ps), false, false);
    ps = __uint_as_float(rr[0]) + __uint_as_float(rr[1]); }
  l_reg = l_reg * alpha + ps;
#define PK4(P, BASE, OUT) do { unsigned a0 = cvtpk(P[BASE + 0], P[BASE + 1]), a1 = cvtpk(P[BASE + 2], P[BASE + 3]);   \
    unsigned b0 = cvtpk(P[BASE + 4], P[BASE + 5]), b1 = cvtpk(P[BASE + 6], P[BASE + 7]);                              \
    auto r0 = __builtin_amdgcn_permlane32_swap(a0, b0, false, false); auto r1 = __builtin_amdgcn_permlane32_swap(a1, b1, false, false); \
    u32x4 w = {r0[0], r1[0], r0[1], r1[1]}; OUT = *reinterpret_cast<bf16x8*>(&w); } while (0)
  PK4(p0, 0, pa0); PK4(p0, 8, pa1); PK4(p1, 0, pa2); PK4(p1, 8, pa3);
#undef PK4
}
__device__ __forceinline__ void qkt(f32x16& p0, f32x16& p1, const bf16_t* Ks, const bf16x8* qr, int r32, int hi) {
  p0 = f32x16{}; p1 = f32x16{};
  for (int d0 = 0; d0 < 8; ++d0) { int cb = (d0 * 16 + hi * 8) * 2;
    bf16x8 b0 = *reinterpret_cast<const bf16x8*>((const char*)Ks + KSWZ(r32, cb));
    bf16x8 b1 = *reinterpret_cast<const bf16x8*>((const char*)Ks + KSWZ(32 + r32, cb));
    p0 = __builtin_amdgcn_mfma_f32_32x32x16_bf16(b0, qr[d0], p0, 0, 0, 0);
    p1 = __builtin_amdgcn_mfma_f32_32x32x16_bf16(b1, qr[d0], p1, 0, 0, 0); }
}
__device__ __forceinline__ int v_st(int k, int c) { const int kk = (k & ~0xC) | ((k & 4) << 1) | ((k & 8) >> 1); return ((kk >> 3) * 4 + (c >> 5)) * 512 + ((kk & 7) * 32 + (c & 31)) * 2; }
__device__ __forceinline__ int v_rd_base(int lane) { return ((lane & 3) << 3) | (((lane >> 2) & 3) << 6) | (((lane >> 4) & 1) << 5) | (((lane >> 5) & 1) << 8); }
constexpr int v_rd_off(int d0, int ks, int half) { return d0 * 512 + ks * 4096 + half * 2048; }
template <int OFF> __device__ __forceinline__ s16x4 tr_read(int vb) {
  s16x4 r; asm volatile("ds_read_b64_tr_b16 %0, %1 offset:%2" : "=&v"(r) : "v"(vb), "i"(OFF) : "memory"); return r;
}
template <int D0> __device__ __forceinline__ void pv_one(f32x16& od, int vb, bf16x8 pa0, bf16x8 pa1, bf16x8 pa2, bf16x8 pa3) {
  const s16x4 l0 = tr_read<v_rd_off(D0, 0, 0)>(vb), h0 = tr_read<v_rd_off(D0, 0, 1)>(vb), l1 = tr_read<v_rd_off(D0, 1, 0)>(vb), h1 = tr_read<v_rd_off(D0, 1, 1)>(vb);
  const s16x4 l2 = tr_read<v_rd_off(D0, 2, 0)>(vb), h2 = tr_read<v_rd_off(D0, 2, 1)>(vb), l3 = tr_read<v_rd_off(D0, 3, 0)>(vb), h3 = tr_read<v_rd_off(D0, 3, 1)>(vb);
  asm volatile("s_waitcnt lgkmcnt(0)" ::: "memory"); SBAR();
#define PK(L, H) (bf16x8){L[0], L[1], L[2], L[3], H[0], H[1], H[2], H[3]}
  od = __builtin_amdgcn_mfma_f32_32x32x16_bf16(pa0, PK(l0, h0), od, 0, 0, 0);
  od = __builtin_amdgcn_mfma_f32_32x32x16_bf16(pa1, PK(l1, h1), od, 0, 0, 0);
  od = __builtin_amdgcn_mfma_f32_32x32x16_bf16(pa2, PK(l2, h2), od, 0, 0, 0);
  od = __builtin_amdgcn_mfma_f32_32x32x16_bf16(pa3, PK(l3, h3), od, 0, 0, 0);
#undef PK
}
__device__ __forceinline__ void pv_d0(f32x16* o, int vb, bf16x8 pa0, bf16x8 pa1, bf16x8 pa2, bf16x8 pa3) {
  pv_one<0>(o[0], vb, pa0, pa1, pa2, pa3); pv_one<1>(o[1], vb, pa0, pa1, pa2, pa3); pv_one<2>(o[2], vb, pa0, pa1, pa2, pa3); pv_one<3>(o[3], vb, pa0, pa1, pa2, pa3);
}
template <int D0> __device__ __forceinline__ void pv_two(f32x16& oa, f32x16& ob, int vb, bf16x8 pa0, bf16x8 pa1, bf16x8 pa2, bf16x8 pa3) {
  const s16x4 al0 = tr_read<v_rd_off(D0, 0, 0)>(vb), ah0 = tr_read<v_rd_off(D0, 0, 1)>(vb), bl0 = tr_read<v_rd_off(D0 + 1, 0, 0)>(vb), bh0 = tr_read<v_rd_off(D0 + 1, 0, 1)>(vb);
  const s16x4 al1 = tr_read<v_rd_off(D0, 1, 0)>(vb), ah1 = tr_read<v_rd_off(D0, 1, 1)>(vb), bl1 = tr_read<v_rd_off(D0 + 1, 1, 0)>(vb), bh1 = tr_read<v_rd_off(D0 + 1, 1, 1)>(vb);
  const s16x4 al2 = tr_read<v_rd_off(D0, 2, 0)>(vb), ah2 = tr_read<v_rd_off(D0, 2, 1)>(vb), bl2 = tr_read<v_rd_off(D0 + 1, 2, 0)>(vb), bh2 = tr_read<v_rd_off(D0 + 1, 2, 1)>(vb);
  const s16x4 al3 = tr_read<v_rd_off(D0, 3, 0)>(vb), ah3 = tr_read<v_rd_off(D0, 3, 1)>(vb), bl3 = tr_read<v_rd_off(D0 + 1, 3, 0)>(vb), bh3 = tr_read<v_rd_off(D0 + 1, 3, 1)>(vb);
  asm volatile("s_waitcnt lgkmcnt(0)" ::: "memory"); SBAR();
#define PK(L, H) (bf16x8){L[0], L[1], L[2], L[3], H[0], H[1], H[2], H[3]}
  oa = __builtin_amdgcn_mfma_f32_32x32x16_bf16(pa0, PK(al0, ah0), oa, 0, 0, 0); ob = __builtin_amdgcn_mfma_f32_32x32x16_bf16(pa0, PK(bl0, bh0), ob, 0, 0, 0);
  oa = __builtin_amdgcn_mfma_f32_32x32x16_bf16(pa1, PK(al1, ah1), oa, 0, 0, 0); ob = __builtin_amdgcn_mfma_f32_32x32x16_bf16(pa1, PK(bl1, bh1), ob, 0, 0, 0);
  oa = __builtin_amdgcn_mfma_f32_32x32x16_bf16(pa2, PK(al2, ah2), oa, 0, 0, 0); ob = __builtin_amdgcn_mfma_f32_32x32x16_bf16(pa2, PK(bl2, bh2), ob, 0, 0, 0);
  oa = __builtin_amdgcn_mfma_f32_32x32x16_bf16(pa3, PK(al3, ah3), oa, 0, 0, 0); ob = __builtin_amdgcn_mfma_f32_32x32x16_bf16(pa3, PK(bl3, bh3), ob, 0, 0, 0);
#undef PK
}
__device__ __forceinline__ void pv_d0x2(f32x16* o, int vb, bf16x8 pa0, bf16x8 pa1, bf16x8 pa2, bf16x8 pa3) {
  pv_two<0>(o[0], o[1], vb, pa0, pa1, pa2, pa3); pv_two<2>(o[2], o[3], vb, pa0, pa1, pa2, pa3);
}
template <bool FAST> __device__ __forceinline__ void attn_dense_body(const bf16_t* Qb, const bf16_t* __restrict__ Kh, const bf16_t* __restrict__ Vh, bf16_t* Ob, int seq, char* lds, const int tid) {
  constexpr int SDEPTH = 2;
  const int wid = tid >> 6, lane = tid & 63, r32 = lane & 31, hi = lane >> 5;
  bf16_t* V_lds = (bf16_t*)lds; bf16_t* K_lds = (bf16_t*)(lds + 2 * SHM_V);
  float* ws = (float*)(lds + 2 * SHM_V + 2 * SHM_K) + wid * 64; float* li_l = ws; float* al_l = ws + 32;
  float m_reg = -1e30f, l_reg = 0; f32x16 o[4] = {}; bf16x8 qr[8];
  const bf16_t* Qw = Qb + (long)(wid * QBLK + r32) * LDQ + hi * 8;
#pragma unroll
  for (int d0 = 0; d0 < 8; ++d0) qr[d0] = *reinterpret_cast<const bf16x8*>(Qw + d0 * 16);
  const int sr = tid >> 4, sc = (tid & 15) * 8, vst0 = v_st(sr, sc), vst1 = v_st(32 + sr, sc);
  const int vb0 = (int)(uintptr_t)V_lds + v_rd_base(lane);
  struct { bf16x8 vs0, vs1, ks0, ks1; } sr_[SDEPTH];
#define SLOAD(i, k0) do { sr_[i].vs0 = *reinterpret_cast<const bf16x8*>(&Vh[(long)((k0) + sr) * LDK + sc]); sr_[i].vs1 = *reinterpret_cast<const bf16x8*>(&Vh[(long)((k0) + 32 + sr) * LDK + sc]); \
    sr_[i].ks0 = *reinterpret_cast<const bf16x8*>(&Kh[(long)((k0) + sr) * LDK + sc]); sr_[i].ks1 = *reinterpret_cast<const bf16x8*>(&Kh[(long)((k0) + 32 + sr) * LDK + sc]); } while (0)
#define SWRITE(b, i) do { *(bf16x8*)((char*)V_lds + (b) * SHM_V + vst0) = sr_[i].vs0;          \
    *(bf16x8*)((char*)V_lds + (b) * SHM_V + vst1) = sr_[i].vs1; int kc = sc * 2;               \
    *(bf16x8*)((char*)K_lds + (b) * SHM_K + KSWZ(sr, kc)) = sr_[i].ks0;                       \
    *(bf16x8*)((char*)K_lds + (b) * SHM_K + KSWZ(32 + sr, kc)) = sr_[i].ks1; } while (0)
#define SWAIT() do { asm volatile("s_waitcnt vmcnt(4)" ::: "memory"); } while (0)
#define RESC(a) do { if constexpr (!FAST) if (__any((a) < 1.f)) { if (hi == 0) al_l[r32] = (a); asm volatile("s_waitcnt lgkmcnt(0)" ::: "memory"); \
    for (int d = 0; d < 4; ++d) for (int r = 0; r < 16; ++r) o[d][r] *= al_l[crow(r, hi)]; } } while (0)
  f32x16 pA0, pA1, pB0, pB1; float mnA, mnB, alA, alB; bf16x8 pa0, pa1, pa2, pa3; const int NT = seq / KVBLK;
  constexpr int SE = 0, SO = SDEPTH - 1;
  SLOAD(SE, 0); asm volatile("s_waitcnt vmcnt(0)" ::: "memory"); SWRITE(0, SE); __syncthreads();
  qkt(pA0, pA1, K_lds, qr, r32, hi); partialSM<FAST>(pA0, pA1, m_reg, mnA, alA);
  SLOAD(SO, KVBLK); if (2 < NT) SLOAD(SE, 2 * KVBLK);
  SWAIT(); SWRITE(1, SO); __syncthreads();
  for (int j = 1; j + 1 < NT; j += 2) {
    SBAR(); qkt(pB0, pB1, (bf16_t*)((char*)K_lds + SHM_K), qr, r32, hi);
    finishSM(pA0, pA1, alA, l_reg, pa0, pa1, pa2, pa3); SBAR();
    SLOAD(SO, (j + SDEPTH) * KVBLK); SBAR();
    pv_d0(o, vb0, pa0, pa1, pa2, pa3); partialSM<FAST>(pB0, pB1, m_reg, mnB, alB);
    __syncthreads(); SWAIT(); SWRITE(0, SE);
    RESC(alB); __syncthreads();
    SBAR(); qkt(pA0, pA1, K_lds, qr, r32, hi);
    finishSM(pB0, pB1, alB, l_reg, pa0, pa1, pa2, pa3); SBAR();
    if (j + 3 < NT) SLOAD(SE, (j + 1 + SDEPTH) * KVBLK); SBAR();
    pv_d0(o, vb0 + (int)SHM_V, pa0, pa1, pa2, pa3); partialSM<FAST>(pA0, pA1, m_reg, mnA, alA);
    __syncthreads(); SWAIT(); SWRITE(1, SO);
    RESC(alA); __syncthreads();
  }
  SBAR(); qkt(pB0, pB1, (bf16_t*)((char*)K_lds + SHM_K), qr, r32, hi);
  finishSM(pA0, pA1, alA, l_reg, pa0, pa1, pa2, pa3); SBAR();
  pv_d0(o, vb0, pa0, pa1, pa2, pa3); partialSM<FAST>(pB0, pB1, m_reg, mnB, alB);
  __syncthreads(); RESC(alB);
  finishSM(pB0, pB1, alB, l_reg, pa0, pa1, pa2, pa3); SBAR();
  pv_d0(o, vb0 + (int)SHM_V, pa0, pa1, pa2, pa3);
  if (hi == 0) li_l[r32] = l_reg; asm volatile("s_waitcnt lgkmcnt(0)" ::: "memory");
  float rli[16];
#pragma unroll
  for (int r = 0; r < 16; ++r) rli[r] = __builtin_amdgcn_rcpf(li_l[crow(r, hi)]);
  bf16_t* Ow = Ob + (long)(wid * QBLK) * LDO;
#pragma unroll
  for (int r = 0; r < 16; ++r) { int orow = crow(r, hi);
#pragma unroll
    for (int d0 = 0; d0 < 4; ++d0) Ow[(long)orow * LDO + d0 * 32 + r32] = (bf16_t)(pk2(o[d0][r] * rli[r], 0.f) & 0xffffu); }
  asm volatile("s_waitcnt vmcnt(0) lgkmcnt(0)" ::: "memory"); __syncthreads();
#undef SLOAD
#undef SWRITE
#undef SWAIT
#undef RESC
}
constexpr size_t SHM_ATTN3 = 3 * SHM_V + 3 * SHM_K + NW * 64 * 4;
__device__ __forceinline__ void attn_fast3_body(const bf16_t* Qb, const bf16_t* __restrict__ Kh, const bf16_t* __restrict__ Vh, bf16_t* Ob, int seq, char* lds, const int tid) {
  const int wid = tid >> 6, lane = tid & 63, r32 = lane & 31, hi = lane >> 5;
  char* V_lds = lds; char* K_lds = lds + 3 * SHM_V;
  float l_reg = 0; f32x16 o[4] = {}; bf16x8 qr[8];
  const bf16_t* Qw = Qb + (long)(wid * QBLK + r32) * LDQ + hi * 8;
#pragma unroll
  for (int d0 = 0; d0 < 8; ++d0) qr[d0] = *reinterpret_cast<const bf16x8*>(Qw + d0 * 16);
  const int sr = tid >> 4, sc = (tid & 15) * 8, vst0 = v_st(sr, sc), vst1 = v_st(32 + sr, sc);
  const int vb0 = (int)(uintptr_t)V_lds + v_rd_base(lane);
  struct { bf16x8 vs0, vs1, ks0, ks1; } sr_[1];
#define SLOAD(i, k0) do { sr_[i].vs0 = *reinterpret_cast<const bf16x8*>(&Vh[(long)((k0) + sr) * LDK + sc]); sr_[i].vs1 = *reinterpret_cast<const bf16x8*>(&Vh[(long)((k0) + 32 + sr) * LDK + sc]); \
    sr_[i].ks0 = *reinterpret_cast<const bf16x8*>(&Kh[(long)((k0) + sr) * LDK + sc]); sr_[i].ks1 = *reinterpret_cast<const bf16x8*>(&Kh[(long)((k0) + 32 + sr) * LDK + sc]); } while (0)
#define SWRITE(bo, i) do { *(bf16x8*)(V_lds + (bo) + vst0) = sr_[i].vs0; *(bf16x8*)(V_lds + (bo) + vst1) = sr_[i].vs1; const int kc = sc * 2; \
    *(bf16x8*)(K_lds + (bo) + KSWZ(sr, kc)) = sr_[i].ks0; *(bf16x8*)(K_lds + (bo) + KSWZ(32 + sr, kc)) = sr_[i].ks1; } while (0)
#define SWAIT() do { asm volatile("s_waitcnt vmcnt(4)" ::: "memory"); } while (0)
  f32x16 pA0, pA1, pB0, pB1; bf16x8 pa0, pa1, pa2, pa3; const int NT = seq / KVBLK;
  int bprev = 0, bcur = (int)SHM_K, bnext = 2 * (int)SHM_K;
  SLOAD(0, 0); asm volatile("s_waitcnt vmcnt(0)" ::: "memory"); SWRITE(0, 0);
  SLOAD(0, KVBLK);
  __syncthreads();
  qkt(pA0, pA1, (const bf16_t*)K_lds, qr, r32, hi);
  { float mr = 0.f, mn = 0.f, al = 1.f; partialSM<true>(pA0, pA1, mr, mn, al); }
  SWRITE((int)SHM_K, 0); if (2 < NT) SLOAD(0, 2 * KVBLK);
  __syncthreads();
  for (int j = 1; j + 1 < NT; j += 2) {
    SBAR(); qkt(pB0, pB1, (const bf16_t*)(K_lds + bcur), qr, r32, hi);
    finishSM(pA0, pA1, 1.f, l_reg, pa0, pa1, pa2, pa3); SBAR();
    pv_d0x2(o, vb0 + bprev, pa0, pa1, pa2, pa3);
    { float mr = 0.f, mn = 0.f, al = 1.f; partialSM<true>(pB0, pB1, mr, mn, al); }
    SWRITE(bnext, 0); if (j + 2 < NT) SLOAD(0, (j + 2) * KVBLK);
    __syncthreads();
    { const int t_ = bprev; bprev = bcur; bcur = bnext; bnext = t_; }
    SBAR(); qkt(pA0, pA1, (const bf16_t*)(K_lds + bcur), qr, r32, hi);
    finishSM(pB0, pB1, 1.f, l_reg, pa0, pa1, pa2, pa3); SBAR();
    pv_d0x2(o, vb0 + bprev, pa0, pa1, pa2, pa3);
    { float mr = 0.f, mn = 0.f, al = 1.f; partialSM<true>(pA0, pA1, mr, mn, al); }
    if (j + 2 < NT) { SWRITE(bnext, 0); if (j + 3 < NT) SLOAD(0, (j + 3) * KVBLK); }
    __syncthreads();
    { const int t_ = bprev; bprev = bcur; bcur = bnext; bnext = t_; }
  }
  SBAR(); qkt(pB0, pB1, (const bf16_t*)(K_lds + bcur), qr, r32, hi);
  finishSM(pA0, pA1, 1.f, l_reg, pa0, pa1, pa2, pa3); SBAR();
  pv_d0x2(o, vb0 + bprev, pa0, pa1, pa2, pa3);
  { float mr = 0.f, mn = 0.f, al = 1.f; partialSM<true>(pB0, pB1, mr, mn, al); }
  finishSM(pB0, pB1, 1.f, l_reg, pa0, pa1, pa2, pa3); SBAR();
  pv_d0x2(o, vb0 + bcur, pa0, pa1, pa2, pa3);
  { int l2; asm volatile("v_mbcnt_lo_u32_b32 %0, -1, 0\n\tv_mbcnt_hi_u32_b32 %0, -1, %0" : "=v"(l2));
    const int r2 = l2 & 31, h2 = l2 >> 5; float* li_l = (float*)(lds + 3 * SHM_V + 3 * SHM_K) + wid * 64;
    if (h2 == 0) li_l[r2] = l_reg; asm volatile("s_waitcnt lgkmcnt(0)" ::: "memory");
    bf16_t* Ow = Ob + (long)(wid * QBLK) * LDO;
#pragma unroll
    for (int r = 0; r < 16; ++r) { const int orow = crow(r, h2); const float rl = __builtin_amdgcn_rcpf(li_l[orow]);
#pragma unroll
      for (int d0 = 0; d0 < 4; ++d0) Ow[(long)orow * LDO + d0 * 32 + r2] = (bf16_t)(pk2(o[d0][r] * rl, 0.f) & 0xffffu); } }
  asm volatile("s_waitcnt vmcnt(0) lgkmcnt(0)" ::: "memory"); __syncthreads();
#undef SLOAD
#undef SWRITE
#undef SWAIT
}
#define MFMA16(a, b, c) __builtin_amdgcn_mfma_f32_16x16x32_bf16((a), (b), (c), 0, 0, 0)
template <int OFF> __device__ __forceinline__ bf16x8 ldr_o(int addr) { bf16x8 r; asm volatile("ds_read_b128 %0, %1 offset:%2" : "=&v"(r) : "v"(addr), "i"(OFF) : "memory"); return r; }
template <int OFF> __device__ __forceinline__ s16x4 trr_o(int addr) { s16x4 r; asm volatile("ds_read_b64_tr_b16 %0, %1 offset:%2" : "=&v"(r) : "v"(addr), "i"(OFF) : "memory"); return r; }
__device__ __forceinline__ void attn_fast16_body(const bf16_t* Qb, const bf16_t* __restrict__ Kh, const bf16_t* __restrict__ Vh, bf16_t* Ob, int seq, char* lds, const int tid) {
  const int wid = tid >> 6, lane = tid & 63, n = lane & 15, g = lane >> 4;
  constexpr int VB = 3 * (int)SHM_K;
  f32x4 o[2][8], lacc[2]; bf16x8 qf[2][4];
  lacc[0] = (f32x4){0.f, 0.f, 0.f, 0.f}; lacc[1] = (f32x4){0.f, 0.f, 0.f, 0.f};
  const bf16x8 ones_ = (bf16x8){0x3F80, 0x3F80, 0x3F80, 0x3F80, 0x3F80, 0x3F80, 0x3F80, 0x3F80};
#pragma unroll
  for (int qb = 0; qb < 2; ++qb)
#pragma unroll
    for (int db = 0; db < 8; ++db) o[qb][db] = (f32x4){0.f, 0.f, 0.f, 0.f};
#pragma unroll
  for (int qb = 0; qb < 2; ++qb)
#pragma unroll
    for (int ds = 0; ds < 4; ++ds) qf[qb][ds] = *reinterpret_cast<const bf16x8*>(Qb + (long)(wid * QBLK + 16 * qb + n) * LDQ + 32 * ds + 8 * g);
  const int srow = 4 * wid + g, sxk = n ^ (srow & 15), sxv = (((n >> 1) ^ (srow & 7)) << 1) | (n & 1);
  const unsigned koff = (unsigned)(srow * LDK + sxk * 8) * 2u, voff = (unsigned)(srow * LDK + sxv * 8) * 2u;
  char* const sdst = lds + __builtin_amdgcn_readfirstlane(wid) * 1024;
  int kx[4];
#pragma unroll
  for (int ds = 0; ds < 4; ++ds) kx[ds] = (int)(uintptr_t)lds + n * 256 + (((4 * ds + g) ^ n) << 4);
  int vx[8];
  { const int vq = n >> 2, vp = n & 3, vrx = 4 * (g & 1) + vq;
#pragma unroll
    for (int db = 0; db < 8; ++db) vx[db] = (int)(uintptr_t)lds + VB + (4 * g + vq) * 256 + 8 * vp + ((db ^ vrx) << 5); }
#define ADMA(k0, BO) do { const char* kg_ = (const char*)Kh + (size_t)(k0) * (LDK * 2); const char* vg_ = (const char*)Vh + (size_t)(k0) * (LDK * 2); \
    __builtin_amdgcn_global_load_lds((const unsigned*)(kg_ + koff), (LAS unsigned*)(sdst + (BO)), 16, 0, 0); \
    __builtin_amdgcn_global_load_lds((const unsigned*)(kg_ + koff + 32 * LDK * 2), (LAS unsigned*)(sdst + (BO) + 8192), 16, 0, 0); \
    __builtin_amdgcn_global_load_lds((const unsigned*)(vg_ + voff), (LAS unsigned*)(sdst + VB + (BO)), 16, 0, 0); \
    __builtin_amdgcn_global_load_lds((const unsigned*)(vg_ + voff + 32 * LDK * 2), (LAS unsigned*)(sdst + VB + (BO) + 8192), 16, 0, 0); } while (0)
#define AWAIT() asm volatile("s_waitcnt vmcnt(0)" ::: "memory")
#define LW(n_) asm volatile("s_waitcnt lgkmcnt(" #n_ ")" ::: "memory")
#define EXPK(P, kb) do { _Pragma("unroll") for (int qb = 0; qb < 2; ++qb) _Pragma("unroll") for (int r = 0; r < 4; ++r) P[kb][qb][r] = __builtin_amdgcn_exp2f(P[kb][qb][r]); } while (0)
#define KRD1(BO, t) ldr_o<(BO) + ((t) & 3) * 4096>(kx[(t) >> 2])
#define LWR(n_, R) asm volatile("s_waitcnt lgkmcnt(" #n_ ")" : "+v"(R) :: "memory")
#define LWK(t) do { if ((t) <= 12) LW(3); else if ((t) == 13) LW(2); else if ((t) == 14) LW(1); else LW(0); } while (0)
#define MFZ(D, A, B) asm volatile("v_mfma_f32_16x16x32_bf16 %0, %1, %2, 0" : "=&v"(D) : "v"(A), "v"(B))
#define MFA(D, A, B) asm volatile("v_mfma_f32_16x16x32_bf16 %0, %1, %2, %0" : "+v"(D) : "v"(A), "v"(B))
#define QKMM(P, t) do { if ((t) < 4) { MFZ(P[(t) & 3][0], kw_[(t) & 3], qf[0][(t) >> 2]); MFZ(P[(t) & 3][1], kw_[(t) & 3], qf[1][(t) >> 2]); } \
    else { MFA(P[(t) & 3][0], kw_[(t) & 3], qf[0][(t) >> 2]); MFA(P[(t) & 3][1], kw_[(t) & 3], qf[1][(t) >> 2]); } } while (0)
#define QKSTEP(P, BO, t) do { LWK(t); QKMM(P, t); if ((t) + 4 < 16) kw_[(t) & 3] = KRD1(BO, (t) + 4); } while (0)
#define QK4(P, BO, t0) do { QKSTEP(P, BO, t0); QKSTEP(P, BO, (t0) + 1); QKSTEP(P, BO, (t0) + 2); QKSTEP(P, BO, (t0) + 3); } while (0)
#define QKT16(P, BO) do { bf16x8 kw_[4]; \
    kw_[0] = KRD1(BO, 0); kw_[1] = KRD1(BO, 1); kw_[2] = KRD1(BO, 2); kw_[3] = KRD1(BO, 3); QK4(P, BO, 0); QK4(P, BO, 4); QK4(P, BO, 8); QK4(P, BO, 12); SBAR(); } while (0)
#define QKSTEPV(P, BO, t, W_) do { LW(W_); QKMM(P, t); } while (0)
#define QKT16V(P, BO, PRE) do { bf16x8 kw_[4]; \
    kw_[0] = KRD1(BO, 0); kw_[1] = KRD1(BO, 1); kw_[2] = KRD1(BO, 2); kw_[3] = KRD1(BO, 3); QK4(P, BO, 0); QK4(P, BO, 4); QK4(P, BO, 8); \
    QKSTEP(P, BO, 12); PRE; QKSTEPV(P, BO, 13, 10); QKSTEPV(P, BO, 14, 9); QKSTEPV(P, BO, 15, 8); SBAR(); } while (0)
#define VISS(TA, TB, S_, BO, D0) do { _Pragma("unroll") for (int db = 0; db < 4; ++db) { TA[db] = trr_o<(BO) + (S_) * 8192>(vx[(D0) + db]); TB[db] = trr_o<(BO) + (S_) * 8192 + 4096>(vx[(D0) + db]); } } while (0)
#define VMMA(TA, TB, S_, D0) do { _Pragma("unroll") for (int db = 0; db < 4; ++db) { const bf16x8 vf_ = (bf16x8){TA[db][0], TA[db][1], TA[db][2], TA[db][3], TB[db][0], TB[db][1], TB[db][2], TB[db][3]}; \
      o[0][(D0) + db] = MFMA16(pf[0][S_], vf_, o[0][(D0) + db]); o[1][(D0) + db] = MFMA16(pf[1][S_], vf_, o[1][(D0) + db]); } \
    if ((D0) == 0) { lacc[0] = MFMA16(pf[0][S_], ones_, lacc[0]); lacc[1] = MFMA16(pf[1][S_], ones_, lacc[1]); } } while (0)
#define PACKS(P, s_) do { _Pragma("unroll") for (int qb = 0; qb < 2; ++qb) \
      pf[qb][s_] = mk8w(pk2(P[2 * (s_)][qb][0], P[2 * (s_)][qb][1]), pk2(P[2 * (s_)][qb][2], P[2 * (s_)][qb][3]), pk2(P[2 * (s_) + 1][qb][0], P[2 * (s_) + 1][qb][1]), pk2(P[2 * (s_) + 1][qb][2], P[2 * (s_) + 1][qb][3])); } while (0)
#define LWV(n_, TA, TB) asm volatile("s_waitcnt lgkmcnt(" #n_ ")" : "+v"(TA[0]), "+v"(TA[1]), "+v"(TA[2]), "+v"(TA[3]), "+v"(TB[0]), "+v"(TB[1]), "+v"(TB[2]), "+v"(TB[3]) :: "memory")
#define PVX(BO, X0, X1, X2, X3) do { s16x4 ua_[4], ub_[4], uc_[4], ud_[4]; PVXI(BO); PVXB(BO, X0, X1, X2, X3); } while (0)
#define PVXI(BO) do { VISS(ua_, ub_, 0, BO, 0); } while (0)
#define PVXB(BO, X0, X1, X2, X3) do { \
    VISS(uc_, ud_, 0, BO, 4); LW(8); SBAR(); VMMA(ua_, ub_, 0, 0); X0; SBAR(); \
    VISS(ua_, ub_, 1, BO, 0); LW(8); SBAR(); VMMA(uc_, ud_, 0, 4); X1; SBAR(); \
    VISS(uc_, ud_, 1, BO, 4); LW(8); SBAR(); VMMA(ua_, ub_, 1, 0); X2; SBAR(); \
    LW(0); SBAR(); VMMA(uc_, ud_, 1, 4); X3; SBAR(); } while (0)
#define ITER(jj, SC, SP, SN) do { s16x4 ua_[4], ub_[4], uc_[4], ud_[4]; if ((jj) + 1 < NT) ADMA(((jj) + 1) * KVBLK, SN); \
    SBAR(); QKT16V(pS, SC, PVXI(SP)); \
    PVXB(SP, EXPK(pS, 0), EXPK(pS, 1), do { EXPK(pS, 2); PACKS(pS, 0); } while (0), EXPK(pS, 3)); \
    PACKS(pS, 1); AWAIT(); __syncthreads(); } while (0)
#define TAILPV(SP) do { SBAR(); PVX(SP, (void)0, (void)0, (void)0, (void)0); } while (0)
  f32x4 pS[4][2]; bf16x8 pf[2][2]; const int NT = seq / KVBLK;
  ADMA(0, 0); ADMA(KVBLK, 16384);
  asm volatile("s_waitcnt vmcnt(4)" ::: "memory"); __syncthreads();
  QKT16(pS, 0); asm volatile("s_nop 15" ::: "memory"); SBAR(); EXPK(pS, 0); EXPK(pS, 1); EXPK(pS, 2); EXPK(pS, 3); PACKS(pS, 0); PACKS(pS, 1);
  AWAIT(); __syncthreads();
  int j = 1;
  for (; j + 2 < NT; j += 3) { ITER(j, 16384, 0, 32768); ITER(j + 1, 32768, 16384, 0); ITER(j + 2, 0, 32768, 16384); }
  if (j < NT) { ITER(j, 16384, 0, 32768);
    if (j + 1 < NT) { ITER(j + 1, 32768, 16384, 0); TAILPV(32768); } else TAILPV(16384); }
  else TAILPV(0);
  {
    int l2; asm volatile("v_mbcnt_lo_u32_b32 %0, -1, 0\n\tv_mbcnt_hi_u32_b32 %0, -1, %0" : "=v"(l2));
    const int n2 = l2 & 15, g2 = l2 >> 4;
    bf16_t* Ow = Ob + (long)(wid * QBLK) * LDO + n2;
#pragma unroll
    for (int qb = 0; qb < 2; ++qb)
#pragma unroll
      for (int r = 0; r < 4; ++r) { const int row = 16 * qb + 4 * g2 + r; const float rl = __builtin_amdgcn_rcpf(lacc[qb][r]);
#pragma unroll
        for (int db = 0; db < 8; ++db) Ow[(long)row * LDO + 16 * db] = (bf16_t)(pk2(o[qb][db][r] * rl, 0.f) & 0xffffu); } }
  asm volatile("s_waitcnt vmcnt(0) lgkmcnt(0)" ::: "memory"); __syncthreads();
#undef ADMA
#undef AWAIT
#undef EXPK
#undef KRD1
#undef QKSTEP
#undef QK4
#undef LWK
#undef LWR
#undef LWV
#undef QKT16
#undef VISS
#undef VMMA
#undef PACKS
#undef LW
#undef PVX
#undef PVXI
#undef PVXB
#undef QKSTEPV
#undef MFZ
#undef MFA
#undef QKMM
#undef QKT16V
#undef ITER
#undef TAILPV
}
__device__ __forceinline__ void attn_fast16s_body(const bf16_t* Qb, const bf16_t* __restrict__ Kh, const bf16_t* __restrict__ Vh, bf16_t* Ob, int seq, char* lds, const int tid) {
  const int wid = tid >> 6, lane = tid & 63, n = lane & 15, g = lane >> 4;
  constexpr int VB = 4 * (int)SHM_K;
  f32x4 o[2][8], lacc[2]; bf16x8 qf[2][4];
  lacc[0] = (f32x4){0.f, 0.f, 0.f, 0.f}; lacc[1] = (f32x4){0.f, 0.f, 0.f, 0.f};
  const bf16x8 ones_ = (bf16x8){0x3F80, 0x3F80, 0x3F80, 0x3F80, 0x3F80, 0x3F80, 0x3F80, 0x3F80};
#pragma unroll
  for (int qb = 0; qb < 2; ++qb)
#pragma unroll
    for (int db = 0; db < 8; ++db) o[qb][db] = (f32x4){0.f, 0.f, 0.f, 0.f};
#pragma unroll
  for (int qb = 0; qb < 2; ++qb)
#pragma unroll
    for (int ds = 0; ds < 4; ++ds) qf[qb][ds] = *reinterpret_cast<const bf16x8*>(Qb + (long)(wid * QBLK + 16 * qb + n) * LDQ + 32 * ds + 8 * g);
  const int srow = 4 * wid + g, sxk = n ^ (srow & 15), sxv = (((n >> 1) ^ (srow & 7)) << 1) | (n & 1);
  const unsigned koff = (unsigned)(srow * LDK + sxk * 8) * 2u, voff = (unsigned)(srow * LDK + sxv * 8) * 2u;
  char* const sdst = lds + __builtin_amdgcn_readfirstlane(wid) * 1024;
  int kx[4];
#pragma unroll
  for (int ds = 0; ds < 4; ++ds) kx[ds] = (int)(uintptr_t)lds + n * 256 + (((4 * ds + g) ^ n) << 4);
  int vx[8];
  { const int vq = n >> 2, vp = n & 3, vrx = 4 * (g & 1) + vq;
#pragma unroll
    for (int db = 0; db < 8; ++db) vx[db] = (int)(uintptr_t)lds + VB + (4 * g + vq) * 256 + 8 * vp + ((db ^ vrx) << 5); }
  s16x4 ua_[4], ub_[4], uc_[4], ud_[4]; bf16x8 kw_[4];
  const __amdgpu_buffer_rsrc_t rK = __builtin_amdgcn_make_buffer_rsrc((void*)Kh, 0, 0x7fffffff, 0x00020000), rV = __builtin_amdgcn_make_buffer_rsrc((void*)Vh, 0, 0x7fffffff, 0x00020000);
#define ADMA(k0, BO) do { const int so_ = (k0) * (LDK * 2); \
    __builtin_amdgcn_raw_ptr_buffer_load_lds(rK, (LAS void*)(sdst + (BO)), 16, koff, so_, 0, 0); \
    __builtin_amdgcn_raw_ptr_buffer_load_lds(rK, (LAS void*)(sdst + (BO) + 8192), 16, koff, so_ + 32 * LDK * 2, 0, 0); \
    __builtin_amdgcn_raw_ptr_buffer_load_lds(rV, (LAS void*)(sdst + VB + (BO)), 16, voff, so_, 0, 0); \
    __builtin_amdgcn_raw_ptr_buffer_load_lds(rV, (LAS void*)(sdst + VB + (BO) + 8192), 16, voff, so_ + 32 * LDK * 2, 0, 0); } while (0)
#define AWAIT() asm volatile("s_waitcnt vmcnt(0)" ::: "memory")
  const int wsc = __builtin_amdgcn_readfirstlane(wid);
#define PREF(k0) do { int l_; asm volatile("v_mbcnt_lo_u32_b32 %0, -1, 0\n\tv_mbcnt_hi_u32_b32 %0, -1, %0" : "=v"(l_)); const unsigned pfo = (unsigned)((l_ >> 2) * (LDK * 2) + (l_ & 3) * 64); \
    __builtin_amdgcn_raw_ptr_buffer_load_lds(wsc < 4 ? rK : rV, (LAS void*)(lds + 140 * 1024 + wsc * 256), 4, pfo, ((k0) + 16 * (wsc & 3)) * (LDK * 2), 0, 0); } while (0)
#define XBARP() do { asm volatile("s_waitcnt vmcnt(1)" ::: "memory"); __builtin_amdgcn_s_barrier(); asm volatile("" ::: "memory"); } while (0)
#define LW(n_) asm volatile("s_waitcnt lgkmcnt(" #n_ ")" ::: "memory")
#define EXPK(P, kb) do { _Pragma("unroll") for (int qb = 0; qb < 2; ++qb) _Pragma("unroll") for (int r = 0; r < 4; ++r) P[kb][qb][r] = __builtin_amdgcn_exp2f(P[kb][qb][r]); } while (0)
#define KRD1(BO, t) ldr_o<(BO) + ((t) & 3) * 4096>(kx[(t) >> 2])
#define LWR(n_, R) asm volatile("s_waitcnt lgkmcnt(" #n_ ")" : "+v"(R) :: "memory")
#define LWK(t) do { if ((t) <= 12) LW(3); else if ((t) == 13) LW(2); else if ((t) == 14) LW(1); else LW(0); } while (0)
#define MFZ(D, A, B) asm volatile("v_mfma_f32_16x16x32_bf16 %0, %1, %2, 0" : "=&v"(D) : "v"(A), "v"(B))
#define MFA(D, A, B) asm volatile("v_mfma_f32_16x16x32_bf16 %0, %1, %2, %0" : "+v"(D) : "v"(A), "v"(B))
#define QKMM(P, t) do { if ((t) < 4) { MFZ(P[(t) & 3][0], kw_[(t) & 3], qf[0][(t) >> 2]); MFZ(P[(t) & 3][1], kw_[(t) & 3], qf[1][(t) >> 2]); } \
    else { MFA(P[(t) & 3][0], kw_[(t) & 3], qf[0][(t) >> 2]); MFA(P[(t) & 3][1], kw_[(t) & 3], qf[1][(t) >> 2]); } } while (0)
#define QKSTEP(P, BO, t) do { LWK(t); QKMM(P, t); if ((t) + 4 < 16) kw_[(t) & 3] = KRD1(BO, (t) + 4); } while (0)
#define QK4(P, BO, t0) do { QKSTEP(P, BO, t0); QKSTEP(P, BO, (t0) + 1); QKSTEP(P, BO, (t0) + 2); QKSTEP(P, BO, (t0) + 3); } while (0)
#define QKT16(P, BO) do { \
    kw_[0] = KRD1(BO, 0); kw_[1] = KRD1(BO, 1); kw_[2] = KRD1(BO, 2); kw_[3] = KRD1(BO, 3); QK4(P, BO, 0); QK4(P, BO, 4); QK4(P, BO, 8); QK4(P, BO, 12); SBAR(); } while (0)
#define QKSTEPV(P, BO, t, W_) do { LW(W_); QKMM(P, t); } while (0)
#define QKT16V(P, BO, PRE) do { \
    kw_[0] = KRD1(BO, 0); kw_[1] = KRD1(BO, 1); kw_[2] = KRD1(BO, 2); kw_[3] = KRD1(BO, 3); QK4(P, BO, 0); QK4(P, BO, 4); QK4(P, BO, 8); \
    QKSTEP(P, BO, 12); PRE; QKSTEPV(P, BO, 13, 10); QKSTEPV(P, BO, 14, 9); QKSTEPV(P, BO, 15, 8); SBAR(); } while (0)
#define VISS(TA, TB, S_, BO, D0) do { _Pragma("unroll") for (int db = 0; db < 4; ++db) { TA[db] = trr_o<(BO) + (S_) * 8192>(vx[(D0) + db]); TB[db] = trr_o<(BO) + (S_) * 8192 + 4096>(vx[(D0) + db]); } } while (0)
#define VMMA(TA, TB, S_, D0) do { _Pragma("unroll") for (int db = 0; db < 4; ++db) { const bf16x8 vf_ = (bf16x8){TA[db][0], TA[db][1], TA[db][2], TA[db][3], TB[db][0], TB[db][1], TB[db][2], TB[db][3]}; \
      o[0][(D0) + db] = MFMA16(pf[0][S_], vf_, o[0][(D0) + db]); o[1][(D0) + db] = MFMA16(pf[1][S_], vf_, o[1][(D0) + db]); } \
    if ((D0) == 0) { lacc[0] = MFMA16(pf[0][S_], ones_, lacc[0]); lacc[1] = MFMA16(pf[1][S_], ones_, lacc[1]); } } while (0)
#define PACKS(P, s_) do { _Pragma("unroll") for (int qb = 0; qb < 2; ++qb) \
      pf[qb][s_] = mk8w(pk2(P[2 * (s_)][qb][0], P[2 * (s_)][qb][1]), pk2(P[2 * (s_)][qb][2], P[2 * (s_)][qb][3]), pk2(P[2 * (s_) + 1][qb][0], P[2 * (s_) + 1][qb][1]), pk2(P[2 * (s_) + 1][qb][2], P[2 * (s_) + 1][qb][3])); } while (0)
#define LWV(n_, TA, TB) asm volatile("s_waitcnt lgkmcnt(" #n_ ")" : "+v"(TA[0]), "+v"(TA[1]), "+v"(TA[2]), "+v"(TA[3]), "+v"(TB[0]), "+v"(TB[1]), "+v"(TB[2]), "+v"(TB[3]) :: "memory")
#define PVXI(BO) do { VISS(ua_, ub_, 0, BO, 0); } while (0)
#define PVXB(BO, X0, X1, X2, X3) do { \
    VISS(uc_, ud_, 0, BO, 4); LW(8); SBAR(); VMMA(ua_, ub_, 0, 0); X0; SBAR(); \
    VISS(ua_, ub_, 1, BO, 0); LW(8); SBAR(); VMMA(uc_, ud_, 0, 4); X1; SBAR(); \
    VISS(uc_, ud_, 1, BO, 4); LW(8); SBAR(); VMMA(ua_, ub_, 1, 0); X2; SBAR(); \
    LW(0); SBAR(); VMMA(uc_, ud_, 1, 4); X3; SBAR(); } while (0)
#define PVXK(BO, SK, X0, X1, X2, X3) do { \
    VISS(uc_, ud_, 0, BO, 4); LW(8); SBAR(); VMMA(ua_, ub_, 0, 0); X0; SBAR(); \
    VISS(ua_, ub_, 1, BO, 0); LW(8); SBAR(); VMMA(uc_, ud_, 0, 4); X1; SBAR(); \
    VISS(uc_, ud_, 1, BO, 4); LW(8); SBAR(); VMMA(ua_, ub_, 1, 0); X2; SBAR(); \
    kw_[0] = KRD1(SK, 0); kw_[1] = KRD1(SK, 1); kw_[2] = KRD1(SK, 2); kw_[3] = KRD1(SK, 3); LW(4); SBAR(); VMMA(uc_, ud_, 1, 4); X3; SBAR(); } while (0)
#define QKTU(P, BO, PRE) do { QK4(P, BO, 0); QK4(P, BO, 4); QK4(P, BO, 8); \
    QKSTEP(P, BO, 12); PRE; QKSTEPV(P, BO, 13, 10); QKSTEPV(P, BO, 14, 9); QKSTEPV(P, BO, 15, 8); SBAR(); } while (0)
#define XBAR() do { AWAIT(); __builtin_amdgcn_s_barrier(); asm volatile("" ::: "memory"); } while (0)
#define EXPS4(XS) EXPK(pS, 0), EXPK(pS, 1), do { EXPK(pS, 2); PACKS(pS, 0); } while (0), EXPK(pS, 3)
#define L_INT(jj, SK, SD, S1, PF) do { if ((jj) + 1 < NT) ADMA(((jj) + 1) * KVBLK, SD); if (PF) PREF(((jj) + 2) * KVBLK); SBAR(); \
    kw_[0] = KRD1(SK, 0); kw_[1] = KRD1(SK, 1); kw_[2] = KRD1(SK, 2); kw_[3] = KRD1(SK, 3); QKTU(pS, SK, PVXI(S1)); \
    __builtin_amdgcn_s_setprio(1); PVXB(S1, EXPK(pS, 0), EXPK(pS, 1), do { EXPK(pS, 2); PACKS(pS, 0); } while (0), EXPK(pS, 3)); PACKS(pS, 1); __builtin_amdgcn_s_setprio(0); } while (0)
#define U_INT(jj, SK, SD, S1, S2, PF) do { if ((jj) + 1 < NT) ADMA(((jj) + 1) * KVBLK, SD); if (PF) PREF(((jj) + 2) * KVBLK); SBAR(); \
    __builtin_amdgcn_s_setprio(1); PVXK(S2, SK, EXPK(pS, 0), EXPK(pS, 1), do { EXPK(pS, 2); PACKS(pS, 0); } while (0), EXPK(pS, 3)); PACKS(pS, 1); __builtin_amdgcn_s_setprio(0); \
    QKTU(pS, SK, PVXI(S1)); } while (0)
#define S0_ 0
#define S1_ 16384
#define S2_ 32768
#define S3_ 49152
  f32x4 pS[4][2]; bf16x8 pf[2][2]; const int NT = seq / KVBLK;
  ADMA(0, S0_); ADMA(KVBLK, S1_);
  asm volatile("s_waitcnt vmcnt(4)" ::: "memory"); __builtin_amdgcn_s_barrier(); asm volatile("" ::: "memory");
  if (__builtin_amdgcn_readfirstlane(wid) < 4) {
    QKT16(pS, S0_); asm volatile("s_nop 15" ::: "memory"); SBAR(); EXPK(pS, 0); EXPK(pS, 1); EXPK(pS, 2); EXPK(pS, 3); PACKS(pS, 0); PACKS(pS, 1);
    XBAR();
    L_INT(1, S1_, S2_, S0_, 0); XBAR();
    for (int j = 2; j + 3 < NT; j += 4) { L_INT(j, S2_, S3_, S1_, 0); XBAR(); L_INT(j + 1, S3_, S0_, S2_, 0); XBAR(); L_INT(j + 2, S0_, S1_, S3_, 0); XBAR(); L_INT(j + 3, S1_, S2_, S0_, 0); XBAR(); }
    L_INT(NT - 2, S2_, S3_, S1_, 0); XBAR();
    L_INT(NT - 1, S3_, S0_, S2_, 0);
    SBAR(); PVXI(S3_); PVXB(S3_, (void)0, (void)0, (void)0, (void)0);
  } else {
    QKT16(pS, S0_);
    XBAR();
    ADMA(2 * KVBLK, S2_); asm volatile("s_nop 15" ::: "memory"); SBAR(); EXPK(pS, 0); EXPK(pS, 1); EXPK(pS, 2); EXPK(pS, 3); PACKS(pS, 0); PACKS(pS, 1);
    kw_[0] = KRD1(S1_, 0); kw_[1] = KRD1(S1_, 1); kw_[2] = KRD1(S1_, 2); kw_[3] = KRD1(S1_, 3); QKTU(pS, S1_, PVXI(S0_));
    XBAR();
    for (int j = 2; j + 3 < NT; j += 4) { U_INT(j, S2_, S3_, S1_, S0_, 0); XBAR(); U_INT(j + 1, S3_, S0_, S2_, S1_, 0); XBAR(); U_INT(j + 2, S0_, S1_, S3_, S2_, 0); XBAR(); U_INT(j + 3, S1_, S2_, S0_, S3_, 0); XBAR(); }
    U_INT(NT - 2, S2_, S3_, S1_, S0_, 0); XBAR();
    U_INT(NT - 1, S3_, S0_, S2_, S1_, 0);
    PVXB(S2_, EXPK(pS, 0), EXPK(pS, 1), do { EXPK(pS, 2); PACKS(pS, 0); } while (0), EXPK(pS, 3)); PACKS(pS, 1);
    SBAR(); PVXI(S3_); PVXB(S3_, (void)0, (void)0, (void)0, (void)0);
  }
  {
    int l2; asm volatile("v_mbcnt_lo_u32_b32 %0, -1, 0\n\tv_mbcnt_hi_u32_b32 %0, -1, %0" : "=v"(l2));
    const int n2 = l2 & 15, g2 = l2 >> 4;
    LAS unsigned char* pw = (LAS unsigned char*)(lds + __builtin_amdgcn_readfirstlane(wid) * 4352);
    bf16_t* Og = Ob + (long)(wid * QBLK + g2) * LDO + n2 * 8;
#pragma unroll
    for (int qb = 0; qb < 2; ++qb) {
#pragma unroll
      for (int r = 0; r < 4; ++r) { const float rl = __builtin_amdgcn_rcpf(lacc[qb][r]);
#pragma unroll
        for (int db = 0; db < 8; ++db) *(LAS bf16_t*)(pw + (4 * g2 + r) * 272 + (16 * db + n2) * 2) = (bf16_t)(pk2(o[qb][db][r] * rl, 0.f) & 0xffffu); }
      asm volatile("s_waitcnt lgkmcnt(0)" ::: "memory");
      u32x4 rowv[4];
#pragma unroll
      for (int i = 0; i < 4; ++i) rowv[i] = *(const LAS u32x4*)(pw + (4 * i + g2) * 272 + n2 * 16);
#pragma unroll
      for (int i = 0; i < 4; ++i) *(u32x4*)(Og + (long)(16 * qb + 4 * i) * LDO) = rowv[i];
      asm volatile("s_waitcnt lgkmcnt(0)" ::: "memory"); } }
  asm volatile("s_waitcnt vmcnt(0) lgkmcnt(0)" ::: "memory"); __syncthreads();
#undef ADMA
#undef AWAIT
#undef EXPK
#undef KRD1
#undef QKSTEP
#undef QK4
#undef LWK
#undef LWR
#undef LWV
#undef QKT16
#undef VISS
#undef VMMA
#undef PACKS
#undef LW
#undef PVXK
#undef QKTU
#undef XBAR
#undef XBARP
#undef PREF
#undef EXPS4
#undef L_INT
#undef U_INT
#undef S0_
#undef S1_
#undef S2_
#undef S3_
#undef PVXI
#undef PVXB
#undef QKSTEPV
#undef MFZ
#undef MFA
#undef QKMM
#undef QKT16V
}
}

struct Args {
    const float* in[29]; float* out; unsigned char* ws; int ph_lo, ph_hi;
};
enum { I_X = 0, I_C, I_CTX, I_CCTX, I_WADA, I_BADA, I_LNG, I_LNB, I_AWQKV, I_AQG, I_AKG, I_AWO, I_BWIN, I_BVG, I_BVB, I_BWS, I_BBS, I_BWOUT,
       I_CWIN, I_CCONV, I_CALOG, I_CDTB, I_CNG, I_CWOUT, I_WROUTER, I_RBIAS, I_EGATE, I_EUP, I_EDOWN };

struct Frame {
    LAS unsigned char* lds; char* ldsg;
    int tid, lane, wave, bid, G, gw, NGW;
    const Args* a;
    unsigned char* ws; float* out;
};
#define FRAME_REFRESH(F) do { int l_; asm volatile("v_mbcnt_lo_u32_b32 %0, -1, 0\n\tv_mbcnt_hi_u32_b32 %0, -1, %0" : "=v"(l_)); (F).lane = l_; (F).tid = (F).wave * 64 + l_; } while (0)
__device__ __forceinline__ bf16_t* hlat_base(const Frame& F) { return (bf16_t*)((char*)F.out + 64 * MiB); }
__device__ __forceinline__ bf16_t* hrow(const Frame& F, int t) { return t < TLAT ? hlat_base(F) + (size_t)t * D : (bf16_t*)(F.ws + WS_HCTX) + (size_t)(t - TLAT) * D; }
__device__ __forceinline__ bf16_t* RG(const Frame& F, int i) { return (bf16_t*)(F.ws + WS_R0 + (size_t)i * RSZ); }
__device__ __forceinline__ const float* modrow(const Frame& F, int layer, int mi) { return (const float*)(F.ws + WS_MOD) + (size_t)(layer * 5 + mi) * 6144; }

__device__ __forceinline__ void transpose_item(const float* W, size_t sld, bf16_t* WT, size_t dld, int drow0, int k0, int n0, LAS float* scr, int lane) {
#pragma unroll 8
    for (int i = 0; i < 32; ++i) { const int kk = 2 * i + (lane >> 5); scr[kk * 33 + (lane & 31)] = W[(size_t)(k0 + kk) * sld + n0 + (lane & 31)]; }
    LDS_WAIT(); asm volatile("" ::: "memory");
    const int c = lane & 7;
#pragma unroll
    for (int j = 0; j < 4; ++j) { const int n = (lane >> 3) + 8 * j; const LAS float* s = scr + (8 * c) * 33 + n;
        u32x4 o; o.x = pk2(s[0 * 33], s[1 * 33]); o.y = pk2(s[2 * 33], s[3 * 33]); o.z = pk2(s[4 * 33], s[5 * 33]); o.w = pk2(s[6 * 33], s[7 * 33]);
        *(u32x4*)(WT + (size_t)(drow0 + n) * dld + k0 + 8 * c) = o; }
    LDS_WAIT(); asm volatile("" ::: "memory");
}
__device__ __forceinline__ bool dense_item(int& r, const float* W, int K, int N, bf16_t* WT, LAS float* scr, int lane) {
    const int nblk = N / 32, items = (K / 64) * nblk;
    if (r >= items) { r -= items; return false; }
    const int kb = r / nblk, nb = r % nblk;
    transpose_item(W, (size_t)N, WT, (size_t)K, 32 * nb, 64 * kb, 32 * nb, scr, lane);
    return true;
}
__device__ __forceinline__ void p0_prologue(Frame& F) {
    const Args& A = *F.a;
    LAS float* scr = (LAS float*)(F.lds + F.wave * 16384);
    const int ngv = (F.G >= 256) ? 192 : F.G / 2;
    constexpr int NITEMS = 2 * (16 * 48) + 2 * (16 * 32) + 16 * 64 + 16 * 32 + 16 * 129 + 16 * 32;
    if (F.bid >= ngv)
    for (int it = (F.bid - ngv) * NWAVES + F.wave; it < NITEMS; it += (F.G - ngv) * NWAVES) {
        int r = it;
        if (dense_item(r, A.in[I_AWQKV], D, 1536, (bf16_t*)(F.ws + WS_WQKV), scr, F.lane)) continue;
        if (dense_item(r, A.in[I_AWQKV] + (size_t)D * 1536, D, 1536, (bf16_t*)(F.ws + WS_WQKV) + (size_t)1536 * D, scr, F.lane)) continue;
        if (dense_item(r, A.in[I_AWO], D, D, (bf16_t*)(F.ws + WS_WO), scr, F.lane)) continue;
        if (dense_item(r, A.in[I_AWO] + (size_t)D * D, D, D, (bf16_t*)(F.ws + WS_WO) + (size_t)D * D, scr, F.lane)) continue;
        if (dense_item(r, A.in[I_BWIN], D, 2048, (bf16_t*)(F.ws + WS_BWIN), scr, F.lane)) continue;
        if (dense_item(r, A.in[I_BWOUT], D, D, (bf16_t*)(F.ws + WS_BWOUT), scr, F.lane)) continue;
        if (dense_item(r, A.in[I_CWIN], D, CW_N, (bf16_t*)(F.ws + WS_CWIN), scr, F.lane)) continue;
        dense_item(r, A.in[I_CWOUT], D, D, (bf16_t*)(F.ws + WS_CWOUT), scr, F.lane);
    }
    FRAME_REFRESH(F);
    const int gt = F.bid * NTHR + F.tid, NGT = F.G * NTHR;
    { u32x4* z = (u32x4*)((bf16_t*)(F.ws + WS_CWIN) + (size_t)CW_N * D); const int n16 = (CW_NPAD - CW_N) * D * 2 / 16;
      for (int i = gt; i < n16; i += NGT) z[i] = (u32x4){0u, 0u, 0u, 0u}; }
    { const float* s = A.in[I_BWS]; unsigned* d = (unsigned*)(F.ws + WS_BWS);
      for (int i = gt; i < 8 * 128 * 128 / 2; i += NGT) d[i] = pk2(s[2 * i], s[2 * i + 1]); }
    { f32x2* rt = (f32x2*)(F.ws + WS_ROPE);
      for (int i = gt; i < SEQ * 64; i += NGT) { const int n = i >> 6, p = i & 63; const int pp = p & 31;
        const float inv = 1.0f / powf(10000.0f, (float)(2 * pp) / 64.0f);
        const float pos = (p < 32) ? (float)(n >> 6) : (float)(n & 63);
        const float ang = pos * inv; float sn, cs; sincosf(ang, &sn, &cs); rt[i] = (f32x2){cs, sn}; } }
    __syncthreads();
    FRAME_REFRESH(F);
    if (F.bid < ngv) {
        LAS float* sc = (LAS float*)F.lds;
        LAS f32x4* red = (LAS f32x4*)(F.lds + 32768);
        for (int i = F.tid; i < 5 * D; i += NTHR) { const float v = (i < 4 * D) ? A.in[I_C][i] : A.in[I_CCTX][i - 4 * D]; sc[i] = siluf_(v); }
        __syncthreads();
        for (int item = F.bid; item < 192; item += ngv) {
            const int l = item / 48, cb = item % 48, half = F.lane >> 5, cl = F.lane & 31, col0 = cb * 128 + 4 * cl;
            const float* wp = A.in[I_WADA] + ((size_t)l * D + F.wave * 128 + half) * 6144 + col0;
            f32x4 acc[5];
#pragma unroll
            for (int mi = 0; mi < 5; ++mi) acc[mi] = (f32x4){0.f, 0.f, 0.f, 0.f};
#pragma unroll 8
            for (int k = 0; k < 64; ++k) { const f32x4 w = *(const f32x4*)(wp + (size_t)(2 * k) * 6144);
#pragma unroll
                for (int mi = 0; mi < 5; ++mi) acc[mi] += w * sc[mi * D + F.wave * 128 + 2 * k + half]; }
#pragma unroll
            for (int mi = 0; mi < 5; ++mi) red[((F.wave * 2 + half) * 5 + mi) * 32 + cl] = acc[mi];
            __syncthreads();
            for (int o = F.tid; o < 5 * 128; o += NTHR) { const int mi = o >> 7, c = o & 127; float s = A.in[I_BADA][l * 6144 + cb * 128 + c];
                const LAS float* rf = (const LAS float*)red;
#pragma unroll
                for (int w = 0; w < 16; ++w) s += rf[((w * 5 + mi) * 32 + (c >> 2)) * 4 + (c & 3)];
                ((float*)(F.ws + WS_MOD))[(size_t)(l * 5 + mi) * 6144 + cb * 128 + c] = s; }
            __syncthreads();
        }
    }
}
__device__ __forceinline__ void p1_init(Frame& F) {
    const Args& A = *F.a; bf16_t* U = RG(F, 0);
    const int per = (TT + F.G - 1) / F.G, r0 = F.bid * per, r1 = (r0 + per < TT) ? r0 + per : TT;
    f32x4 scv[4], shv[4], xc[4], xn[4]; int cur_mi = -1;
#pragma unroll
    for (int j = 0; j < 4; ++j) { scv[j] = (f32x4){0.f, 0.f, 0.f, 0.f}; shv[j] = scv[j]; xc[j] = scv[j]; xn[j] = scv[j]; }
#define P1_LOAD(X, t_) do { const float* src_ = (t_) < TLAT ? A.in[I_X] + (size_t)(t_) * D : A.in[I_CTX] + (size_t)((t_) - TLAT) * D; \
        _Pragma("unroll") for (int j = 0; j < 4; ++j) X[j] = *(const f32x4*)(src_ + 256 * j + 4 * F.lane); } while (0)
    if (r0 + F.wave < r1) P1_LOAD(xc, r0 + F.wave);
    for (int t = r0 + F.wave; t < r1; t += NWAVES) {
        FRAME_REFRESH(F);
        if (t + NWAVES < r1) P1_LOAD(xn, t + NWAVES);
        bf16_t* hp = hrow(F, t); const int mi = t < TLAT ? (t >> 13) : 4;
        if (mi != cur_mi) { cur_mi = mi; const float* mp = modrow(F, 0, mi);
#pragma unroll
            for (int j = 0; j < 4; ++j) { shv[j] = *(const f32x4*)(mp + 256 * j + 4 * F.lane); scv[j] = *(const f32x4*)(mp + 1024 + 256 * j + 4 * F.lane) + 1.0f; } }
#pragma unroll
        for (int j = 0; j < 4; ++j) { const int col = 256 * j + 4 * F.lane; const f32x4 v = xc[j];
            *(u32x2*)(hp + col) = (u32x2){pk2(v[0], v[1]), pk2(v[2], v[3])};
            const f32x4 u = v * scv[j] + shv[j];
            *(u32x2*)(U + (size_t)t * D + col) = (u32x2){pk2(u[0], u[1]), pk2(u[2], u[3])}; }
#pragma unroll
        for (int j = 0; j < 4; ++j) xc[j] = xn[j];
    }
#undef P1_LOAD
}

__device__ __forceinline__ void moe_convert(Frame& F, int layer, int first) {
    const Args& A = *F.a;
    if (F.G <= 2 * first) first = 0;
    const int nw = (F.G - first) * NWAVES, gw = (F.bid - first) * NWAVES + F.wave;
    if (F.bid >= first) {
      LAS float* scr = (LAS float*)(F.lds + F.wave * 16384);
      const float* eg = A.in[I_EGATE] + (size_t)layer * NE * D * DE; const float* eu = A.in[I_EUP] + (size_t)layer * NE * D * DE; const float* ed = A.in[I_EDOWN] + (size_t)layer * NE * DE * D;
      bf16_t* W1 = (bf16_t*)(F.ws + WS_WE1); bf16_t* W2 = (bf16_t*)(F.ws + WS_WE2);
      for (int it = gw; it < NE * 768; it += nw) { const int e = it / 768, r = it % 768;
        if (r < 512) { const int up = r >> 8, q = r & 255, kb = q >> 4, nb = q & 15, n0 = 32 * nb;
            transpose_item((up ? eu : eg) + (size_t)e * D * DE, DE, W1 + (size_t)e * D * D, D, (n0 >> 7) * 256 + (n0 & 127) + up * 128, 64 * kb, n0, scr, F.lane); }
        else { const int q = r - 512, kb = q >> 5, nb = q & 31;
            transpose_item(ed + (size_t)e * DE * D, D, W2 + (size_t)e * D * DE, DE, 32 * nb, 64 * kb, 32 * nb, scr, F.lane); } }
    }
}
__device__ __forceinline__ void moe_route(Frame& F, int layer, int nrows, bool last) {
    const Args& A = *F.a;
    LAS float* WR = (LAS float*)F.lds;
    LAS int* CNT = (LAS int*)(F.lds + 65536); LAS int* BASE = CNT + 16; LAS int* EID = CNT + 64; LAS int* RK = EID + 2 * 272; LAS float* WT = (LAS float*)(RK + 2 * 272); LAS float* LG = (LAS float*)(F.lds + 65536 + 8192);
    for (int idx = F.tid; idx < D * NE; idx += NTHR) { const int k = idx >> 4, e = idx & 15, j = k >> 8, ln = (k >> 2) & 63, i = k & 3, q = e >> 2;
        WR[((((j * 4 + i) * 4 + q) * 64 + ln) << 2) + (e & 3)] = A.in[I_WROUTER][idx]; }
    if (F.tid < 16) CNT[F.tid] = 0;
    __syncthreads();
    const int per = (nrows + F.G - 1) / F.G, r0 = F.bid * per, r1 = (r0 + per < nrows) ? r0 + per : nrows;
    const float* lg = A.in[I_LNG] + (size_t)(layer * 2 + 0) * D; const float* lb = A.in[I_LNB] + (size_t)(layer * 2 + 0) * D;
    bf16_t* U2 = RG(F, 0); int* LIST = (int*)(F.ws + WS_LIST); float* WLIST = (float*)(F.ws + WS_WLIST);
    float rb[16];
#pragma unroll
    for (int e = 0; e < 16; ++e) rb[e] = A.in[I_RBIAS][e];
    u32x2 zc[4], zn[4];
    f32x4 lgv[4], lbv[4], scv[4], shv[4]; int cur_mi = -1;
#pragma unroll
    for (int j = 0; j < 4; ++j) { lgv[j] = *(const f32x4*)(lg + 256 * j + 4 * F.lane); lbv[j] = *(const f32x4*)(lb + 256 * j + 4 * F.lane); scv[j] = lgv[j]; shv[j] = lgv[j]; }
    { const int t = r0 + F.wave; if (t < r1) { const bf16_t* zp = hrow(F, t);
#pragma unroll
        for (int j = 0; j < 4; ++j) zc[j] = *(const u32x2*)(zp + 256 * j + 4 * F.lane); } }
    for (int t = r0 + F.wave; t < r1; t += NWAVES) {
        FRAME_REFRESH(F);
        if (t + NWAVES < r1) { const bf16_t* zq = hrow(F, t + NWAVES);
#pragma unroll
            for (int j = 0; j < 4; ++j) zn[j] = *(const u32x2*)(zq + 256 * j + 4 * F.lane); }
        bf16_t* hp = last ? RG(F, 6) + (size_t)t * D : hrow(F, t); const int mi = t < TLAT ? (t >> 13) : 4;
        if (mi != cur_mi) { cur_mi = mi; const float* mp = modrow(F, layer, mi);
#pragma unroll
            for (int j = 0; j < 4; ++j) { scv[j] = *(const f32x4*)(mp + 4096 + 256 * j + 4 * F.lane) + 1.0f; shv[j] = *(const f32x4*)(mp + 3072 + 256 * j + 4 * F.lane); } }
        f32x4 v[4]; float s = 0.f;
#pragma unroll
        for (int j = 0; j < 4; ++j) { const u32x2 zw = zc[j]; v[j] = (f32x4){bflo(zw.x), bfhi(zw.x), bflo(zw.y), bfhi(zw.y)}; s += (v[j][0] + v[j][1]) + (v[j][2] + v[j][3]); }
        const float mean = wave_sum(s) * (1.f / D); float s2 = 0.f;
#pragma unroll
        for (int j = 0; j < 4; ++j) { v[j] = v[j] - mean; s2 += (v[j][0] * v[j][0] + v[j][1] * v[j][1]) + (v[j][2] * v[j][2] + v[j][3] * v[j][3]); }
        const float rstd = 1.f / sqrtf(wave_sum(s2) * (1.f / D) + EPS);
        f32x2 acc2[8];
#pragma unroll
        for (int e = 0; e < 8; ++e) acc2[e] = (f32x2){0.f, 0.f};
#pragma unroll
        for (int j = 0; j < 4; ++j) { const int col = 256 * j + 4 * F.lane;
            const f32x4 hn = v[j] * rstd * lgv[j] + lbv[j];
            *(u32x2*)(hp + col) = (u32x2){pk2(hn[0], hn[1]), pk2(hn[2], hn[3])};
            const f32x4 u2 = hn * scv[j] + shv[j];
            *(u32x2*)(U2 + (size_t)t * D + col) = (u32x2){pk2(u2[0], u2[1]), pk2(u2[2], u2[3])};
#pragma unroll
            for (int i = 0; i < 4; ++i)
#pragma unroll
                for (int q = 0; q < 4; ++q) { const f32x4 w = *(const LAS f32x4*)(WR + ((((j * 4 + i) * 4 + q) * 64 + F.lane) << 2));
                    const f32x2 uu = {u2[i], u2[i]};
                    acc2[2 * q] += uu * (f32x2){w[0], w[1]}; acc2[2 * q + 1] += uu * (f32x2){w[2], w[3]}; } }
        float a8[8], a4[4], a2[2], lg1;
        { const bool hi5 = (F.lane & 32) != 0, hi4 = (F.lane & 16) != 0, hi3 = (F.lane & 8) != 0, hi2 = (F.lane & 4) != 0;
#pragma unroll
          for (int e = 0; e < 8; ++e) { const float lo = acc2[e >> 1][e & 1], hi = acc2[4 + (e >> 1)][e & 1]; a8[e] = (hi5 ? hi : lo) + __shfl_xor(hi5 ? lo : hi, 32); }
#pragma unroll
          for (int e = 0; e < 4; ++e) a4[e] = (hi4 ? a8[e + 4] : a8[e]) + __shfl_xor(hi4 ? a8[e] : a8[e + 4], 16);
#pragma unroll
          for (int e = 0; e < 2; ++e) a2[e] = (hi3 ? a4[e + 2] : a4[e]) + __shfl_xor(hi3 ? a4[e] : a4[e + 2], 8);
          lg1 = (hi2 ? a2[1] : a2[0]) + __shfl_xor(hi2 ? a2[0] : a2[1], 4);
          lg1 += __shfl_xor(lg1, 2); lg1 += __shfl_xor(lg1, 1); }
        if ((F.lane & 3) == 0) LG[(t - r0) * 16 + (F.lane >> 2)] = lg1;
#pragma unroll
        for (int j = 0; j < 4; ++j) zc[j] = zn[j];
    }
    FRAME_REFRESH(F);
    __syncthreads();
    for (int rl = F.tid; rl < r1 - r0; rl += NTHR) {
        float sc[16], sel[16];
#pragma unroll
        for (int q = 0; q < 4; ++q) { const f32x4 l4 = *(const LAS f32x4*)(LG + rl * 16 + 4 * q);
#pragma unroll
            for (int i = 0; i < 4; ++i) { sc[4 * q + i] = 1.f / (1.f + expf(-l4[i])); sel[4 * q + i] = sc[4 * q + i] + rb[4 * q + i]; } }
        float gs[4];
#pragma unroll
        for (int g = 0; g < 4; ++g) { const float a = sel[4 * g], b = sel[4 * g + 1], c = sel[4 * g + 2], d = sel[4 * g + 3];
            const float hi1 = fmaxf(a, b), lo1 = fminf(a, b), hi2 = fmaxf(c, d), lo2 = fminf(c, d);
            const float m1 = fmaxf(hi1, hi2), m2 = fmaxf(fminf(hi1, hi2), fmaxf(lo1, lo2)); gs[g] = m1 + m2; }
        int bg = 0; float bgs = gs[0];
#pragma unroll
        for (int g = 1; g < 4; ++g) if (gs[g] > bgs) { bgs = gs[g]; bg = g; }
        float s4[4], c4[4];
#pragma unroll
        for (int i = 0; i < 4; ++i) { s4[i] = bg == 0 ? sel[i] : bg == 1 ? sel[4 + i] : bg == 2 ? sel[8 + i] : sel[12 + i]; c4[i] = bg == 0 ? sc[i] : bg == 1 ? sc[4 + i] : bg == 2 ? sc[8 + i] : sc[12 + i]; }
        int i1 = 0; float b1 = s4[0], w1 = c4[0];
#pragma unroll
        for (int i = 1; i < 4; ++i) if (s4[i] > b1) { b1 = s4[i]; i1 = i; w1 = c4[i]; }
        int i2 = -1; float b2 = -3.0e38f, w2 = 0.f;
#pragma unroll
        for (int i = 0; i < 4; ++i) if (i != i1 && s4[i] > b2) { b2 = s4[i]; i2 = i; w2 = c4[i]; }
        const int e1 = bg * 4 + i1, e2 = bg * 4 + i2; const float wn = 1.f / (w1 + w2);
        const int k1 = __hip_atomic_fetch_add(CNT + e1, 1, __ATOMIC_RELAXED, __HIP_MEMORY_SCOPE_WORKGROUP);
        const int k2 = __hip_atomic_fetch_add(CNT + e2, 1, __ATOMIC_RELAXED, __HIP_MEMORY_SCOPE_WORKGROUP);
        EID[2 * rl] = e1; EID[2 * rl + 1] = e2; RK[2 * rl] = k1; RK[2 * rl + 1] = k2; WT[2 * rl] = w1 * wn; WT[2 * rl + 1] = w2 * wn;
    }
    __syncthreads();
    if (F.tid < 16) BASE[F.tid] = (int)__hip_atomic_fetch_add((unsigned*)(F.ws + WS_CTL) + CW_CNT + layer * 16 + F.tid, (unsigned)CNT[F.tid], RLX_AGENT);
    __syncthreads();
    for (int rl = F.tid; rl < r1 - r0; rl += NTHR) { const int t = r0 + rl; const int e1 = EID[2 * rl], e2 = EID[2 * rl + 1];
        const int p1 = e1 * TT + BASE[e1] + RK[2 * rl], p2 = e2 * TT + BASE[e2] + RK[2 * rl + 1];
        LIST[p1] = 2 * t; WLIST[p1] = WT[2 * rl]; LIST[p2] = 2 * t + 1; WLIST[p2] = WT[2 * rl + 1]; }
}
__device__ __forceinline__ void moe_tables(Frame& F, int layer) {
    LAS int* TS = (LAS int*)(F.lds + GTAB_OFF); LAS int* CN = TS + 32;
    if (F.tid == 0) { const unsigned* gc = (const unsigned*)(F.ws + WS_CTL) + CW_CNT + layer * 16; int acc = 0;
        for (int e = 0; e < NE; ++e) { const int c = (int)gc[e]; TS[e] = acc; CN[e] = c; acc += (c + 255) >> 8; } TS[NE] = acc; }
    __syncthreads();
}
__device__ __forceinline__ void moe_toktable(Frame& F, const pg8::GroupedOrder& S) {
    const int* LIST = (const int*)(F.ws + WS_LIST); LAS int* TOK = (LAS int*)(F.lds + GTOK_OFF);
    Unit u;
    for (int i = 0; i < GTOK_MAXU && S.next(i, u); ++i)
        if (F.tid < 256) TOK[i * 256 + F.tid] = (F.tid < u.nvalid) ? (LIST[u.lbase + F.tid] >> 1) : 0;
    __syncthreads();
}
__device__ __forceinline__ void moe_dsttable(Frame& F, const pg8::GroupedOrder& S) {
    const int* LIST = (const int*)(F.ws + WS_LIST); const float* WLIST = (const float*)(F.ws + WS_WLIST);
    LAS int* DSTL = (LAS int*)(F.lds + GTOK_OFF); LAS float* WL = (LAS float*)(F.lds + GTOK_OFF + GTOK_MAXU * 1024);
    Unit u;
    for (int i = 0; i < GTOK_MAXU && S.next(i, u); ++i)
        if (F.tid < 256) { const bool ok = F.tid < u.nvalid; DSTL[i * 256 + F.tid] = ok ? LIST[u.lbase + F.tid] : 0; WL[i * 256 + F.tid] = ok ? WLIST[u.lbase + F.tid] : 0.f; }
    __syncthreads();
}
__device__ __forceinline__ void moe_scatter(Frame& F, int layer, int nrows, bool last) {
    moe_tables(F, layer);
    const LAS int* TS = (const LAS int*)(F.lds + GTAB_OFF);
    bf16_t* XS = (bf16_t*)(F.ws + WS_XS); int* rowmap = (int*)(F.ws + WS_ROWMAP); float* roww = (float*)(F.ws + WS_ROWW);
    for (int t = F.gw; t < nrows; t += F.NGW) {
        const bf16_t* hp = last ? RG(F, 6) + (size_t)t * D : hrow(F, t); const int mi = t < TLAT ? (t >> 13) : 4; const float* mp = modrow(F, layer, mi);
        const i32x2 ee = ((const i32x2*)(F.ws + WS_ASG))[t]; const i32x2 pp = ((const i32x2*)(F.ws + WS_POS))[t]; const f32x2 ww = ((const f32x2*)(F.ws + WS_ASGW))[t];
        const int d0 = TS[ee.x] * 256 + pp.x, d1 = TS[ee.y] * 256 + pp.y;
#pragma unroll
        for (int j = 0; j < 4; ++j) { const int col = 256 * j + 4 * F.lane; const u32x2 hw = *(const u32x2*)(hp + col); const f32x4 hn = {bflo(hw.x), bfhi(hw.x), bflo(hw.y), bfhi(hw.y)};
            const f32x4 u = hn * (*(const f32x4*)(mp + 4096 + col) + 1.0f) + *(const f32x4*)(mp + 3072 + col);
            const u32x2 w = {pk2(u[0], u[1]), pk2(u[2], u[3])};
            *(u32x2*)(XS + (size_t)d0 * D + col) = w; *(u32x2*)(XS + (size_t)d1 * D + col) = w; }
        if (F.lane == 0) { rowmap[d0] = 2 * t; rowmap[d1] = 2 * t + 1; roww[d0] = ww.x; roww[d1] = ww.y; }
    }
}
__device__ __forceinline__ void moe_ln2(Frame& F, int layer, int nrows, bool last) {
    const Args& A = *F.a; const bf16_t* Y2 = (const bf16_t*)(F.ws + WS_Y2); bf16_t* U = RG(F, 0);
    const float* lg = A.in[I_LNG] + (size_t)(layer * 2 + 1) * D; const float* lb = A.in[I_LNB] + (size_t)(layer * 2 + 1) * D;
    const int per = (nrows + F.G - 1) / F.G, r0 = F.bid * per, r1 = (r0 + per < nrows) ? r0 + per : nrows;
    f32x4 lgv[4], lbv[4], g2v[4], scv[4], shv[4]; int cur_mi = -1;
#pragma unroll
    for (int j = 0; j < 4; ++j) { lgv[j] = *(const f32x4*)(lg + 256 * j + 4 * F.lane); lbv[j] = *(const f32x4*)(lb + 256 * j + 4 * F.lane); g2v[j] = lgv[j]; scv[j] = lgv[j]; shv[j] = lgv[j]; }
    u32x2 hc[4], ya[4], yb[4], hn_[4], yan[4], ybn[4];
#define LN2_LOAD(H, YA, YB, t_) do { const bf16_t* hin_ = last ? RG(F, 6) + (size_t)(t_) * D : hrow(F, (t_)); \
        _Pragma("unroll") for (int j = 0; j < 4; ++j) { const int col = 256 * j + 4 * F.lane; H[j] = *(const u32x2*)(hin_ + col); \
            YA[j] = *(const u32x2*)(Y2 + (size_t)(2 * (t_)) * D + col); YB[j] = *(const u32x2*)(Y2 + (size_t)(2 * (t_) + 1) * D + col); } } while (0)
    if (r0 + F.wave < r1) LN2_LOAD(hc, ya, yb, r0 + F.wave);
    for (int t = r0 + F.wave; t < r1; t += NWAVES) {
        FRAME_REFRESH(F);
        if (t + NWAVES < r1) LN2_LOAD(hn_, yan, ybn, t + NWAVES);
        bf16_t* hp = hrow(F, t); const int mi = t < TLAT ? (t >> 13) : 4;
        if (mi != cur_mi) { cur_mi = mi; const float* mp = modrow(F, layer, mi); const float* mn = modrow(F, last ? layer : layer + 1, mi);
#pragma unroll
            for (int j = 0; j < 4; ++j) { const int col = 256 * j + 4 * F.lane; g2v[j] = *(const f32x4*)(mp + 5120 + col); scv[j] = *(const f32x4*)(mn + 1024 + col) + 1.0f; shv[j] = *(const f32x4*)(mn + col); } }
        f32x4 v[4]; float s = 0.f;
#pragma unroll
        for (int j = 0; j < 4; ++j) { const f32x4 hv = {bflo(hc[j].x), bfhi(hc[j].x), bflo(hc[j].y), bfhi(hc[j].y)};
            const f32x4 y = {bflo(ya[j].x) + bflo(yb[j].x), bfhi(ya[j].x) + bfhi(yb[j].x), bflo(ya[j].y) + bflo(yb[j].y), bfhi(ya[j].y) + bfhi(yb[j].y)};
            v[j] = hv * DN_ALPHA + g2v[j] * y; s += (v[j][0] + v[j][1]) + (v[j][2] + v[j][3]); }
        const float mean = wave_sum(s) * (1.f / D); float s2 = 0.f;
#pragma unroll
        for (int j = 0; j < 4; ++j) { v[j] = v[j] - mean; s2 += (v[j][0] * v[j][0] + v[j][1] * v[j][1]) + (v[j][2] * v[j][2] + v[j][3] * v[j][3]); }
        const float rstd = 1.f / sqrtf(wave_sum(s2) * (1.f / D) + EPS);
#pragma unroll
        for (int j = 0; j < 4; ++j) { const int col = 256 * j + 4 * F.lane;
            const f32x4 hn = v[j] * rstd * lgv[j] + lbv[j];
#if PROBE_T
            if (last) { const unsigned long long* dg = (const unsigned long long*)(F.ws + WS_CTL + 512 * 1024); const float nu = (float)(dg[2] ? dg[2] : 1ull);
                float c = PROBE_T == 1 ? (float)dg[0] / nu * 0.01f : PROBE_T == 2 ? (float)dg[1] / nu * 0.01f : (PROBE_T == 4 ? (float)dg[3] / nu * 0.0025f : PROBE_T == 5 ? (float)dg[3] * 0.000625f : (float)dg[3] * 0.0025f); c = floorf((c + 1.0f) * 0.5f) * 2.0f; *(f32x4*)(F.out + (size_t)t * D + col) = (f32x4){c, c, c, c}; } else
#else
            if (last) *(f32x4*)(F.out + (size_t)t * D + col) = hn; else
#endif
            *(u32x2*)(hp + col) = (u32x2){pk2(hn[0], hn[1]), pk2(hn[2], hn[3])};
            if (!last) { const f32x4 u = hn * scv[j] + shv[j];
                *(u32x2*)(U + (size_t)t * D + col) = (u32x2){pk2(u[0], u[1]), pk2(u[2], u[3])}; } }
#pragma unroll
        for (int j = 0; j < 4; ++j) { hc[j] = hn_[j]; ya[j] = yan[j]; yb[j] = ybn[j]; }
    }
#undef LN2_LOAD
}

__device__ __forceinline__ bool attn_fast_ok(const Frame& F, int j) {
    const float* qg = F.a->in[I_AQG] + j * 128; const float* kg = F.a->in[I_AKG] + j * 128; float mq = 0.f, mk = 0.f;
    for (int i = 0; i < 128; ++i) { mq = fmaxf(mq, fabsf(qg[i])); mk = fmaxf(mk, fabsf(kg[i])); }
    return att::SCALE * 1.4426950408889634f * 128.f * mq * mk < 96.f;
}
__device__ __forceinline__ void qk_norm_rope(Frame& F, int j, const pg8::StaticOrder& S) {
    const Args& A = *F.a; const float* qg = A.in[I_AQG] + j * 128; const float* kg = A.in[I_AKG] + j * 128;
    bf16_t* Q = RG(F, 1); bf16_t* Kb = RG(F, 2); const f32x2* rope = (const f32x2*)(F.ws + WS_ROPE);
    const int sub = F.lane >> 4, l16 = F.lane & 15; const bool fast = attn_fast_ok(F, j);
    Unit u;
    for (int i = 0; S.next(i, u); ++i) {
        if (u.pn >= 5) continue;
        const float* gn = u.pn < 4 ? qg : kg; const float qs = (u.pn < 4 && fast) ? att::SCALE * 1.4426950408889634f : 1.f;
        float gv[8];
#pragma unroll
        for (int e = 0; e < 8; ++e) gv[e] = gn[l16 * 8 + e] * qs;
        bf16_t* base; size_t ld; size_t r0;
        if (u.pn < 4) { base = Q + u.pn * 256; ld = D; r0 = (size_t)u.pm * 256; }
        else { base = Kb; ld = 256; r0 = u.pm < 128 ? (size_t)(u.pm >> 5) * KVLEN + CTXL + (size_t)(u.pm & 31) * 256 : (size_t)(u.pm - 128) * KVLEN; }
        const bool lat = u.pm < 128;
#pragma unroll 1
        for (int it0 = 0; it0 < 16; it0 += 8) {
            u32x4 wv[8]; f32x2 cs[8][4];
#pragma unroll
            for (int k = 0; k < 8; ++k) { const int pi = (it0 + k) * 32 + F.wave * 4 + sub, row = pi >> 1, hh = pi & 1;
                wv[k] = *(const u32x4*)(base + (r0 + row) * ld + hh * 128 + l16 * 8);
                if (lat) { const int n = (u.pm & 31) * 256 + row;
#pragma unroll
                    for (int e = 0; e < 4; ++e) cs[k][e] = rope[(size_t)n * 64 + l16 * 4 + e]; } }
#pragma unroll
            for (int k = 0; k < 8; ++k) { const int pi = (it0 + k) * 32 + F.wave * 4 + sub, row = pi >> 1, hh = pi & 1;
                bf16_t* p = base + (r0 + row) * ld + hh * 128 + l16 * 8; const u32x4 w = wv[k];
                float x[8] = {bflo(w.x), bfhi(w.x), bflo(w.y), bfhi(w.y), bflo(w.z), bfhi(w.z), bflo(w.w), bfhi(w.w)};
                float ss = 0.f;
#pragma unroll
                for (int e = 0; e < 8; ++e) ss += x[e] * x[e];
                ss = sum16(ss);
                const float rs = 1.f / sqrtf(ss * (1.f / 128.f) + EPS);
#pragma unroll
                for (int e = 0; e < 8; ++e) x[e] = x[e] * rs * gv[e];
                if (lat) {
#pragma unroll
                    for (int e = 0; e < 4; ++e) { const float a = x[2 * e], bb = x[2 * e + 1]; x[2 * e] = a * cs[k][e].x - bb * cs[k][e].y; x[2 * e + 1] = a * cs[k][e].y + bb * cs[k][e].x; } }
                *(u32x4*)p = (u32x4){pk2(x[0], x[1]), pk2(x[2], x[3]), pk2(x[4], x[5]), pk2(x[6], x[7])}; }
        }
    }
}
template <bool FAST> __device__ __forceinline__ void attn_units(Frame& F, bool need_ctx, bf16_t* Oout) {
    const bf16_t* Q = RG(F, 1); const bf16_t* Kb = RG(F, 2); const bf16_t* Vb = (const bf16_t*)((const char*)RG(F, 2) + 17 * MiB);
    const int nunits = 1024 + (need_ctx ? 32 : 0);
    FRAME_REFRESH(F);
    for (int L = F.bid; L < nunits; L += F.G) {
        int b, h, t0, seq;
        if (L < 1024) { int qb;
            if (F.G == 256) { b = L >> 8; h = F.bid & 7; qb = F.bid >> 3; }
            else { qb = L & 31; h = (L >> 5) & 7; b = L >> 8; }
            t0 = b * SEQ + qb * 256; seq = KVLEN; }
        else { const int i = L - 1024; b = i >> 3; h = i & 7; t0 = TLAT + b * CTXL; seq = CTXL; }
        const bf16_t* Qp = Q + (size_t)t0 * D + h * 128;
        const size_t kvo = (size_t)b * KVLEN * 256 + (h >> 2) * 128;
        int tid_; { int l_; asm volatile("v_mbcnt_lo_u32_b32 %0, -1, 0\n\tv_mbcnt_hi_u32_b32 %0, -1, %0" : "=v"(l_)); tid_ = F.wave * 64 + l_; }
        if constexpr (FAST) { if (((seq >> 6) & 3) == 0) att::attn_fast16s_body(Qp, Kb + kvo, Vb + kvo, Oout + (size_t)t0 * D + h * 128, seq, F.ldsg, tid_);
                              else att::attn_fast16_body(Qp, Kb + kvo, Vb + kvo, Oout + (size_t)t0 * D + h * 128, seq, F.ldsg, tid_); }
        else att::attn_dense_body<false>(Qp, Kb + kvo, Vb + kvo, Oout + (size_t)t0 * D + h * 128, seq, F.ldsg, F.tid);
    }
}
__device__ __forceinline__ void attn_phase(Frame& F, bool need_ctx, bf16_t* Oout, int j) {
    if (attn_fast_ok(F, j)) attn_units<true>(F, need_ctx, Oout); else attn_units<false>(F, need_ctx, Oout);
}

__device__ __forceinline__ unsigned off_b2(unsigned row, unsigned ch) { return 256u * row + 16u * (ch ^ (((row & 3) << 2) | ((row >> 2) & 3))); }
__device__ __forceinline__ void gmlp_spatial(Frame& F) {
    const Args& A = *F.a; const bf16_t* ZB = RG(F, 1); bf16_t* P = RG(F, 0); const bf16_t* WS_ = (const bf16_t*)(F.ws + WS_BWS); const f32x2* SP = (const f32x2*)(F.ws + WS_AB);
    LAS float* ST = (LAS float*)(F.lds + 32768);
    LAS unsigned char* VT = F.lds;
    const unsigned vbase = (unsigned)(uintptr_t)F.ldsg;
    for (int un = F.bid; un < 264 * 8; un += F.G) {
        FRAME_REFRESH(F);
        const int lane = F.lane, r = lane & 31, hh = lane >> 5, wr = F.wave >> 1, wc = F.wave & 1;
        const int ck = un >> 3, g = un & 7, t0 = ck * 128;
        if (F.tid < 128) { const f32x4* sp = (const f32x4*)(SP + (size_t)(t0 + F.tid) * 16); float s1 = 0.f, s2 = 0.f;
#pragma unroll
            for (int i = 0; i < 8; ++i) { const f32x4 v = sp[i]; s1 += v[0] + v[2]; s2 += v[1] + v[3]; }
            const float mean = s1 * (1.f / 1024.f), var = fmaxf(s2 * (1.f / 1024.f) - mean * mean, 0.f);
            ST[2 * F.tid] = mean; ST[2 * F.tid + 1] = 1.f / sqrtf(var + EPS); }
        u32x4 vraw[4];
#pragma unroll
        for (int e = 0; e < 4; ++e) { const int id = F.tid + 512 * e, row = id >> 4, ch = id & 15; vraw[e] = *(const u32x4*)(ZB + (size_t)(t0 + row) * 2048 + 1024 + g * 128 + ch * 8); }
        bf16x8 afr[8];
        { const bf16_t* wp0 = WS_ + ((size_t)g * 128 + wr * 32 + r) * 128 + hh * 8;
#pragma unroll
          for (int ks = 0; ks < 8; ++ks) afr[ks] = *(const bf16x8*)(wp0 + ks * 16); }
        __syncthreads();
#pragma unroll
        for (int e = 0; e < 4; ++e) { const int id = F.tid + 512 * e, row = id >> 4, ch = id & 15; const float mean = ST[2 * row], rstd = ST[2 * row + 1];
            const u32x4 w = vraw[e]; const float x[8] = {bflo(w.x), bfhi(w.x), bflo(w.y), bfhi(w.y), bflo(w.z), bfhi(w.z), bflo(w.w), bfhi(w.w)};
            const float* vg = A.in[I_BVG] + g * 128 + ch * 8; const float* vb = A.in[I_BVB] + g * 128 + ch * 8; float y[8];
#pragma unroll
            for (int c = 0; c < 8; ++c) y[c] = (x[c] - mean) * rstd * vg[c] + vb[c];
            *(LAS u32x4*)(VT + off_b2(row, ch)) = (u32x4){pk2(y[0], y[1]), pk2(y[2], y[3]), pk2(y[4], y[5]), pk2(y[6], y[7])}; }
        __syncthreads();
        f32x16 acc[2] = {};
        bf16_t uval[2][16]; float bsv[16];
#pragma unroll
        for (int reg = 0; reg < 16; ++reg) { const int tl = wr * 32 + crow(reg, hh); bsv[reg] = A.in[I_BBS][g * 128 + tl];
#pragma unroll
            for (int cb = 0; cb < 2; ++cb) uval[cb][reg] = ZB[(size_t)(t0 + tl) * 2048 + g * 128 + wc * 64 + cb * 32 + r]; }
        { const unsigned blk = (lane >> 4) & 1, q = (lane & 15) >> 2, p = lane & 3;
#pragma unroll
          for (int ks = 0; ks < 8; ++ks) { const bf16x8 af = afr[ks];
              s16x4 bt[2][2];
#pragma unroll
              for (int cb = 0; cb < 2; ++cb)
#pragma unroll
                  for (int t = 0; t < 2; ++t) { s16x4 rr; const unsigned addr = vbase + off_b2(16 * ks + 8 * hh + 4 * t + q, 4 * (2 * wc + cb) + 2 * blk + (p >> 1)) + 8 * (p & 1);
                      asm volatile("ds_read_b64_tr_b16 %0, %1" : "=&v"(rr) : "v"(addr) : "memory"); bt[cb][t] = rr; }
              asm volatile("s_waitcnt lgkmcnt(0)" ::: "memory"); __builtin_amdgcn_sched_barrier(0);
#pragma unroll
              for (int cb = 0; cb < 2; ++cb) { const bf16x8 bfr = (bf16x8){bt[cb][0][0], bt[cb][0][1], bt[cb][0][2], bt[cb][0][3], bt[cb][1][0], bt[cb][1][1], bt[cb][1][2], bt[cb][1][3]};
                  acc[cb] = MFMA32(af, bfr, acc[cb]); } } }
#pragma unroll
        for (int cb = 0; cb < 2; ++cb)
#pragma unroll
            for (int reg = 0; reg < 16; ++reg) { const int tl = wr * 32 + crow(reg, hh), c = g * 128 + wc * 64 + cb * 32 + r;
                const float mixed = acc[cb][reg] + bsv[reg];
                const float uu = bf1(uval[cb][reg]);
                P[(size_t)(t0 + tl) * D + c] = (bf16_t)(pk2(uu * mixed, 0.f) & 0xffffu); }
        __syncthreads();
    }
}

__device__ __forceinline__ void delta_prep(Frame& F) {
    const Args& A = *F.a; const float* cw = A.in[I_CCONV];
    for (int wu = F.gw; wu < 528 * 6; wu += F.NGW) {
        const int ck = wu / 6, slab = wu % 6, buf = slab >> 1, ch = (slab & 1) * 512 + 8 * F.lane, t0 = ck * 64;
        const bf16_t* src = RG(F, 1 + buf) + ch; bf16_t* dst = RG(F, 5 + buf) + ch;
        float w0[8], w1[8], w2[8];
#pragma unroll
        for (int e = 0; e < 8; ++e) { const int cg = buf * 1024 + ch + e; w0[e] = cw[cg]; w1[e] = cw[3072 + cg]; w2[e] = cw[6144 + cg]; }
        const int seqlen = t0 < TLAT ? SEQ : CTXL, n0 = t0 < TLAT ? (t0 & (SEQ - 1)) : ((t0 - TLAT) & (CTXL - 1));
        u32x4 prev = {0u, 0u, 0u, 0u}, cur;
        if (n0 > 0) prev = *(const u32x4*)(src + (size_t)(t0 - 1) * D);
        cur = *(const u32x4*)(src + (size_t)t0 * D);
#pragma unroll 1
        for (int r8 = 0; r8 < 64; r8 += 8) {
            u32x4 nx[8];
#pragma unroll
            for (int e = 0; e < 8; ++e) { nx[e] = (u32x4){0u, 0u, 0u, 0u}; if (n0 + r8 + e + 1 < seqlen) nx[e] = *(const u32x4*)(src + (size_t)(t0 + r8 + e + 1) * D); }
#pragma unroll
            for (int e = 0; e < 8; ++e) {
                const int t = t0 + r8 + e; const u32x4 nxt = nx[e];
                const float xp[8] = {bflo(prev.x), bfhi(prev.x), bflo(prev.y), bfhi(prev.y), bflo(prev.z), bfhi(prev.z), bflo(prev.w), bfhi(prev.w)};
                const float xc[8] = {bflo(cur.x), bfhi(cur.x), bflo(cur.y), bfhi(cur.y), bflo(cur.z), bfhi(cur.z), bflo(cur.w), bfhi(cur.w)};
                const float xn[8] = {bflo(nxt.x), bfhi(nxt.x), bflo(nxt.y), bfhi(nxt.y), bflo(nxt.z), bfhi(nxt.z), bflo(nxt.w), bfhi(nxt.w)};
                float y[8]; float ss = 0.f;
#pragma unroll
                for (int c = 0; c < 8; ++c) { y[c] = siluf_(w0[c] * xp[c] + w1[c] * xc[c] + w2[c] * xn[c]); ss += y[c] * y[c]; }
                if (buf < 2) { ss = sum16(ss); const float rs = (1.f / sqrtf(ss + EPS)) * (buf == 0 ? 0.08838834764831845f : 1.f);
#pragma unroll
                    for (int c = 0; c < 8; ++c) y[c] *= rs; }
                *(u32x4*)(dst + (size_t)t * D) = (u32x4){pk2(y[0], y[1]), pk2(y[2], y[3]), pk2(y[4], y[5]), pk2(y[6], y[7])};
                prev = cur; cur = nxt;
            }
        }
    }
}
__device__ __forceinline__ void delta_local(Frame& F) {
    const Args& A = *F.a; const float* AB = (const float*)(F.ws + WS_AB); float* GC = (float*)(F.ws + WS_GC); float* BETA = (float*)(F.ws + WS_BETA);
    const bf16_t* QN = RG(F, 5); const bf16_t* KN = RG(F, 6); bf16_t* TB = RG(F, 1); bf16_t* ATT = RG(F, 2);
    LAS float* Aw = (LAS float*)(F.lds + F.wave * 17408);
    for (int wu = F.gw; wu < 528 * 16; wu += F.NGW) {
        int lane = F.lane; asm volatile("" : "+v"(lane));
        const int r = lane & 31, hh = lane >> 5;
        const int dir = wu & 1, h = (wu >> 1) & 7, ck = wu >> 4, t0 = ck * 64;
        const int tok = dir ? t0 + 63 - lane : t0 + lane;
        const float a = AB[(size_t)tok * 32 + dir * 8 + h], bb = AB[(size_t)tok * 32 + 16 + dir * 8 + h];
        const float x = a + A.in[I_CDTB][dir * 8 + h];
        const float sp = fmaxf(x, 0.f) + log1pf(expf(-fabsf(x)));
        const float g = -expf(A.in[I_CALOG][dir * 8 + h]) * sp;
        const float beta = 1.f / (1.f + expf(-bb));
        float gc = g;
#pragma unroll
        for (int o = 1; o < 64; o <<= 1) { const float tv = __shfl_up(gc, o); if (lane >= o) gc += tv; }
        GC[(size_t)(dir * 8 + h) * TT + tok] = gc; BETA[(size_t)(dir * 8 + h) * TT + tok] = beta;
        const int tk0 = dir ? t0 + 63 - r : t0 + r, tk1 = dir ? t0 + 31 - r : t0 + 32 + r;
        const bf16_t* kp0 = KN + (size_t)tk0 * D + h * 128 + hh * 8; const bf16_t* kp1 = KN + (size_t)tk1 * D + h * 128 + hh * 8;
        const bf16_t* qp0 = QN + (size_t)tk0 * D + h * 128 + hh * 8; const bf16_t* qp1 = QN + (size_t)tk1 * D + h * 128 + hh * 8;
        bf16x8 kf0[8], kf1[8];
#pragma unroll
        for (int ks = 0; ks < 8; ++ks) { kf0[ks] = *(const bf16x8*)(kp0 + ks * 16); kf1[ks] = *(const bf16x8*)(kp1 + ks * 16); }
        const float gcj0 = __shfl(gc, r), gcj1 = __shfl(gc, 32 + r);
        bf16_t* attp = ATT + (size_t)wu * 4096;
        {   f32x16 s00 = {}, s10 = {}, s11 = {};
#pragma unroll
            for (int ks = 0; ks < 8; ++ks) { s00 = MFMA32(kf0[ks], kf0[ks], s00); s10 = MFMA32(kf1[ks], kf0[ks], s10); s11 = MFMA32(kf1[ks], kf1[ks], s11); }
#pragma unroll
            for (int reg = 0; reg < 16; ++reg) { const int il = crow(reg, hh);
                const float gci0 = __shfl(gc, il), gci1 = __shfl(gc, 32 + il), bt0 = __shfl(beta, il), bt1 = __shfl(beta, 32 + il);
                const float d00 = (il > r) ? __expf(gci0 - gcj0) : 0.f, d10 = __expf(gci1 - gcj0), d11 = (il > r) ? __expf(gci1 - gcj1) : 0.f;
                Aw[r * 68 + il] = bt0 * s00[reg] * d00;
                Aw[r * 68 + 32 + il] = bt1 * s10[reg] * d10;
                Aw[(32 + r) * 68 + 32 + il] = bt1 * s11[reg] * d11; }
        }
        asm volatile("" ::: "memory"); __builtin_amdgcn_sched_barrier(0);
        {   f32x16 q00 = {}, q10 = {}, q11 = {};
#pragma unroll
            for (int ks = 0; ks < 8; ++ks) { const bf16x8 q0 = *(const bf16x8*)(qp0 + ks * 16), q1 = *(const bf16x8*)(qp1 + ks * 16);
                q00 = MFMA32(q0, kf0[ks], q00); q10 = MFMA32(q1, kf0[ks], q10); q11 = MFMA32(q1, kf1[ks], q11); }
#pragma unroll
            for (int reg = 0; reg < 16; ++reg) { const int il = crow(reg, hh);
                const float gci0 = __shfl(gc, il), gci1 = __shfl(gc, 32 + il);
                const float d00 = (il >= r) ? __expf(gci0 - gcj0) : 0.f, d10 = __expf(gci1 - gcj0), d11 = (il >= r) ? __expf(gci1 - gcj1) : 0.f;
                attp[il * 64 + r] = (bf16_t)(pk2(q00[reg] * d00, 0.f) & 0xffffu);
                attp[il * 64 + 32 + r] = 0;
                attp[(32 + il) * 64 + r] = (bf16_t)(pk2(q10[reg] * d10, 0.f) & 0xffffu);
                attp[(32 + il) * 64 + 32 + r] = (bf16_t)(pk2(q11[reg] * d11, 0.f) & 0xffffu); }
        }
        asm volatile("" ::: "memory"); __builtin_amdgcn_sched_barrier(0);
        LDS_WAIT(); asm volatile("" ::: "memory");
        float Tc[64]; bf16_t* tp = TB + (size_t)wu * 4096 + lane;
#pragma unroll
        for (int i = 0; i < 64; ++i) Tc[i] = (i == lane) ? 1.f : 0.f;
        f32x4 cur[16], nxt[16];
#pragma unroll
        for (int p4 = 0; p4 < 16; ++p4) cur[p4] = *(const LAS f32x4*)(Aw + 4 * p4);
#pragma unroll
        for (int j = 0; j < 64; ++j) {
            if (j + 1 < 64) {
#pragma unroll
                for (int p4 = (j + 2) / 4; p4 < 16; ++p4) nxt[p4] = *(const LAS f32x4*)(Aw + (j + 1) * 68 + 4 * p4); }
            const float tj = Tc[j]; tp[j * 64] = (bf16_t)(pk2(tj, 0.f) & 0xffffu);
#pragma unroll
            for (int p4 = (j + 1) / 4; p4 < 16; ++p4)
#pragma unroll
                for (int e2 = 0; e2 < 4; ++e2) if (4 * p4 + e2 > j) Tc[4 * p4 + e2] -= cur[p4][e2] * tj;
#pragma unroll
            for (int p4 = 0; p4 < 16; ++p4) cur[p4] = nxt[p4];
            asm volatile("" ::: "memory"); __builtin_amdgcn_sched_barrier(0); }
        LDS_WAIT(); asm volatile("" ::: "memory");
    }
}
constexpr int SC_QT = 0, SC_KT = 16896, SC_KTT = 33792, SC_TT = 51200, SC_AT = 59904, SC_VT = 68608, SC_TAB = 76800, SC_XP = 77824, SC_OP = 110592;
static_assert(SC_OP + 32768 <= MISC_OFF, "scan LDS");
__device__ __forceinline__ bf16x8 lds_frag(const LAS unsigned char* p) { return mk8(*(const LAS u32x2*)p, *(const LAS u32x2*)(p + 16)); }
__device__ __forceinline__ bf16x8 pack_acc(const f32x16& v, int s) { return mk8w(pk2(v[8 * s], v[8 * s + 1]), pk2(v[8 * s + 2], v[8 * s + 3]), pk2(v[8 * s + 4], v[8 * s + 5]), pk2(v[8 * s + 6], v[8 * s + 7])); }
__device__ __forceinline__ void delta_scan(Frame& F) {
    const bf16_t* QN = RG(F, 5); const bf16_t* KN = RG(F, 6); const bf16_t* VN = RG(F, 7); const bf16_t* TB = RG(F, 1); const bf16_t* ATT = RG(F, 2);
    const float* GC = (const float*)(F.ws + WS_GC); const float* BETA = (const float*)(F.ws + WS_BETA);
    LAS unsigned char* L = F.lds; const int w = F.wave;
    LAS float* TAB = (LAS float*)(L + SC_TAB); LAS float* XP = (LAS float*)(L + SC_XP); LAS float* OP = (LAS float*)(L + SC_OP); LAS float* VT = (LAS float*)(L + SC_VT);
    for (int item = F.bid; item < 256; item += F.G) {
        const int ch = item >> 2, dvs = item & 3, b = ch >> 4, h = (ch >> 1) & 7, dir = ch & 1;
        bf16_t* OB = RG(F, dir ? 3 : 0);
        f32x16 S = {};
        u32x4 sq[2], sk[2], st, sa, sv; float sgc = 0.f, sbt = 0.f;
#define SCAN_CK(step) ((step) < 4 ? 512 + b * 4 + (dir ? 3 - (step) : (step)) : b * 128 + (dir ? 131 - (step) : (step) - 4))
#define SCAN_LOAD(step) do { const int ck_ = SCAN_CK(step); const int t0_ = ck_ * 64; const size_t un_ = ((size_t)ck_ * 8 + h) * 2 + dir; \
        _Pragma("unroll") for (int e_ = 0; e_ < 2; ++e_) { const int id_ = tid + 512 * e_, row_ = id_ >> 4, c16_ = id_ & 15; const int tk_ = dir ? t0_ + 63 - row_ : t0_ + row_; \
            sq[e_] = *(const u32x4*)(QN + (size_t)tk_ * D + h * 128 + c16_ * 8); sk[e_] = *(const u32x4*)(KN + (size_t)tk_ * D + h * 128 + c16_ * 8); } \
        st = *(const u32x4*)(TB + un_ * 4096 + tid * 8); sa = *(const u32x4*)(ATT + un_ * 4096 + tid * 8); \
        if (tid < 256) { const int row_ = tid >> 2, c_ = tid & 3; const int tk_ = dir ? t0_ + 63 - row_ : t0_ + row_; sv = *(const u32x4*)(VN + (size_t)tk_ * D + h * 128 + dvs * 32 + c_ * 8); } \
        if (tid < 64) { const int tk_ = dir ? t0_ + 63 - tid : t0_ + tid; sgc = GC[(size_t)(dir * 8 + h) * TT + tk_]; sbt = BETA[(size_t)(dir * 8 + h) * TT + tk_]; } } while (0)
#define SCAN_STORE() do { \
        _Pragma("unroll") for (int e_ = 0; e_ < 2; ++e_) { const int id_ = tid + 512 * e_, row_ = id_ >> 4, c16_ = id_ & 15; \
            *(LAS u32x2*)(L + SC_QT + row_ * 264 + c16_ * 16) = (u32x2){sq[e_].x, sq[e_].y}; *(LAS u32x2*)(L + SC_QT + row_ * 264 + c16_ * 16 + 8) = (u32x2){sq[e_].z, sq[e_].w}; \
            *(LAS u32x2*)(L + SC_KT + row_ * 264 + c16_ * 16) = (u32x2){sk[e_].x, sk[e_].y}; *(LAS u32x2*)(L + SC_KT + row_ * 264 + c16_ * 16 + 8) = (u32x2){sk[e_].z, sk[e_].w}; \
            LAS bf16_t* kt_ = (LAS bf16_t*)(L + SC_KTT) + (c16_ * 8) * 68 + row_; \
            kt_[0 * 68] = (bf16_t)(sk[e_].x & 0xffffu); kt_[1 * 68] = (bf16_t)(sk[e_].x >> 16); kt_[2 * 68] = (bf16_t)(sk[e_].y & 0xffffu); kt_[3 * 68] = (bf16_t)(sk[e_].y >> 16); \
            kt_[4 * 68] = (bf16_t)(sk[e_].z & 0xffffu); kt_[5 * 68] = (bf16_t)(sk[e_].z >> 16); kt_[6 * 68] = (bf16_t)(sk[e_].w & 0xffffu); kt_[7 * 68] = (bf16_t)(sk[e_].w >> 16); } \
        { const int row_ = tid >> 3, c16_ = tid & 7; \
          *(LAS u32x2*)(L + SC_TT + row_ * 136 + c16_ * 16) = (u32x2){st.x, st.y}; *(LAS u32x2*)(L + SC_TT + row_ * 136 + c16_ * 16 + 8) = (u32x2){st.z, st.w}; \
          *(LAS u32x2*)(L + SC_AT + row_ * 136 + c16_ * 16) = (u32x2){sa.x, sa.y}; *(LAS u32x2*)(L + SC_AT + row_ * 136 + c16_ * 16 + 8) = (u32x2){sa.z, sa.w}; } \
        if (tid < 256) { const int row_ = tid >> 2, c_ = tid & 3; LAS f32x4* vp_ = (LAS f32x4*)(VT + row_ * 32 + c_ * 8); \
            vp_[0] = (f32x4){bflo(sv.x), bfhi(sv.x), bflo(sv.y), bfhi(sv.y)}; vp_[1] = (f32x4){bflo(sv.z), bfhi(sv.z), bflo(sv.w), bfhi(sv.w)}; } \
        if (tid < 64) { const float gl_ = __shfl(sgc, 63); TAB[tid] = expf(sgc); TAB[64 + tid] = expf(gl_ - sgc); TAB[128 + tid] = sbt; if (tid == 0) TAB[192] = expf(gl_); } } while (0)
        int tid = F.tid; asm volatile("" : "+v"(tid));
        SCAN_LOAD(0); VM_WAIT(); SCAN_STORE(); __syncthreads();
#pragma unroll 1
        for (int step = 0; step < 132; ++step) {
            tid = F.tid; asm volatile("" : "+v"(tid));
            const int lane = tid & 63, r = lane & 31, hh = lane >> 5;
            const int ck = SCAN_CK(step), t0 = ck * 64;
            if (step + 1 < 132) SCAN_LOAD(step + 1);
            if (w < 4) {
                const bf16x8 Sb0 = pack_acc(S, 0), Sb1 = pack_acc(S, 1);
#pragma unroll
                for (int bi = 0; bi < 2; ++bi) { const int off = (32 * bi + r) * 264 + (32 * w + 4 * hh) * 2;
                    { f32x16 X = {}; const bf16x8 k0 = lds_frag(L + SC_KT + off), k1 = lds_frag(L + SC_KT + off + 32);
                      X = MFMA32(k0, Sb0, X); X = MFMA32(k1, Sb1, X);
#pragma unroll
                      for (int reg = 0; reg < 16; ++reg) XP[((w * 2 + bi) * 16 + reg) * 64 + lane] = X[reg]; }
                    { f32x16 X = {}; const bf16x8 q0 = lds_frag(L + SC_QT + off), q1 = lds_frag(L + SC_QT + off + 32);
                      X = MFMA32(q0, Sb0, X); X = MFMA32(q1, Sb1, X);
#pragma unroll
                      for (int reg = 0; reg < 16; ++reg) OP[((w * 2 + bi) * 16 + reg) * 64 + lane] = X[reg]; }
                    asm volatile("" ::: "memory"); }
            }
            __syncthreads();
            if (w < 4) {
                bf16x8 Rp[2][2];
#pragma unroll
                for (int bi = 0; bi < 2; ++bi)
#pragma unroll
                    for (int sh = 0; sh < 2; ++sh) { float R[8];
#pragma unroll
                        for (int e = 0; e < 8; ++e) { const int reg = 8 * sh + e; const int i = 32 * bi + crow(reg, hh);
                            const float X = (XP[((0 * 2 + bi) * 16 + reg) * 64 + lane] + XP[((1 * 2 + bi) * 16 + reg) * 64 + lane]) + (XP[((2 * 2 + bi) * 16 + reg) * 64 + lane] + XP[((3 * 2 + bi) * 16 + reg) * 64 + lane]);
                            R[e] = TAB[128 + i] * (VT[i * 32 + r] - TAB[i] * X); }
                        Rp[bi][sh] = mk8w(pk2(R[0], R[1]), pk2(R[2], R[3]), pk2(R[4], R[5]), pk2(R[6], R[7]));
                        asm volatile("" ::: "memory"); __builtin_amdgcn_sched_barrier(0); }
                f32x16 Vn0 = {}, Vn1 = {};
                { const int o0 = r * 136 + (4 * hh) * 2, o1 = (32 + r) * 136 + (4 * hh) * 2;
                  Vn0 = MFMA32(lds_frag(L + SC_TT + o0), Rp[0][0], Vn0); Vn0 = MFMA32(lds_frag(L + SC_TT + o0 + 32), Rp[0][1], Vn0);
                  Vn1 = MFMA32(lds_frag(L + SC_TT + o1), Rp[0][0], Vn1); Vn1 = MFMA32(lds_frag(L + SC_TT + o1 + 32), Rp[0][1], Vn1);
                  Vn1 = MFMA32(lds_frag(L + SC_TT + o1 + 64), Rp[1][0], Vn1); Vn1 = MFMA32(lds_frag(L + SC_TT + o1 + 96), Rp[1][1], Vn1); }
                asm volatile("" ::: "memory");
                bf16x8 Vsp[2][2];
                { f32x16 Vs;
#pragma unroll
                  for (int reg = 0; reg < 16; ++reg) Vs[reg] = Vn0[reg] * TAB[64 + crow(reg, hh)];
                  Vsp[0][0] = pack_acc(Vs, 0); Vsp[0][1] = pack_acc(Vs, 1);
#pragma unroll
                  for (int reg = 0; reg < 16; ++reg) Vs[reg] = Vn1[reg] * TAB[64 + 32 + crow(reg, hh)];
                  Vsp[1][0] = pack_acc(Vs, 0); Vsp[1][1] = pack_acc(Vs, 1); }
                const float gl = TAB[192];
#pragma unroll
                for (int reg = 0; reg < 16; ++reg) S[reg] *= gl;
                { const int o = (32 * w + r) * 136 + (4 * hh) * 2;
                  S = MFMA32(lds_frag(L + SC_KTT + o), Vsp[0][0], S); S = MFMA32(lds_frag(L + SC_KTT + o + 32), Vsp[0][1], S);
                  S = MFMA32(lds_frag(L + SC_KTT + o + 64), Vsp[1][0], S); S = MFMA32(lds_frag(L + SC_KTT + o + 96), Vsp[1][1], S); }
                asm volatile("" ::: "memory");
                if (w < 2) { f32x16 O = {};
                    const int o = (32 * w + r) * 136 + (4 * hh) * 2;
                    O = MFMA32(lds_frag(L + SC_AT + o), pack_acc(Vn0, 0), O); O = MFMA32(lds_frag(L + SC_AT + o + 32), pack_acc(Vn0, 1), O);
                    if (w == 1) { O = MFMA32(lds_frag(L + SC_AT + o + 64), pack_acc(Vn1, 0), O); O = MFMA32(lds_frag(L + SC_AT + o + 96), pack_acc(Vn1, 1), O); }
#pragma unroll
                    for (int sh = 0; sh < 2; ++sh) {
#pragma unroll
                        for (int e = 0; e < 8; ++e) { const int reg = 8 * sh + e; const int i = 32 * w + crow(reg, hh);
                            const float o1 = (OP[((0 * 2 + w) * 16 + reg) * 64 + lane] + OP[((1 * 2 + w) * 16 + reg) * 64 + lane]) + (OP[((2 * 2 + w) * 16 + reg) * 64 + lane] + OP[((3 * 2 + w) * 16 + reg) * 64 + lane]);
                            const float ov = O[reg] + TAB[i] * o1; const int tk = dir ? t0 + 63 - i : t0 + i;
                            OB[(size_t)tk * D + h * 128 + dvs * 32 + r] = (bf16_t)(pk2(ov, 0.f) & 0xffffu); }
                        asm volatile("" ::: "memory"); __builtin_amdgcn_sched_barrier(0); } }
            }
            __syncthreads();
            if (step + 1 < 132) { VM_WAIT(); SCAN_STORE(); }
            __syncthreads();
        }
#undef SCAN_CK
#undef SCAN_LOAD
#undef SCAN_STORE
    }
}
constexpr int S2_QT = 0, S2_KT = 16384, S2_VT = 32768, S2_TT = 49152, S2_AT = 57344, S2_TAB = 65536, S2_BUF = 66560;
static_assert(2 * S2_BUF <= MISC_OFF, "scan2 LDS");
__device__ __forceinline__ unsigned off_b(unsigned row, unsigned ch) { return 256u * row + 16u * (ch ^ (((row & 3) << 2) | ((row >> 2) & 3))); }
__device__ __forceinline__ bf16x8 pka(const f32x16& P, const int BASE) {
    const unsigned a0 = pk2(P[BASE + 0], P[BASE + 1]), a1 = pk2(P[BASE + 2], P[BASE + 3]), b0 = pk2(P[BASE + 4], P[BASE + 5]), b1 = pk2(P[BASE + 6], P[BASE + 7]);
    auto r0 = __builtin_amdgcn_permlane32_swap(a0, b0, false, false); auto r1 = __builtin_amdgcn_permlane32_swap(a1, b1, false, false);
    return mk8w(r0[0], r1[0], r0[1], r1[1]);
}
__device__ __forceinline__ s16x4 trr(unsigned addr) { s16x4 r; asm volatile("ds_read_b64_tr_b16 %0, %1" : "=&v"(r) : "v"(addr) : "memory"); return r; }
#define GLDS16(gp, lp) __builtin_amdgcn_global_load_lds((const unsigned*)(gp), (LAS unsigned*)(lp), 16, 0, 0)
__device__ __forceinline__ void delta_scan2(Frame& F) {
    const bf16_t* QN = RG(F, 5); const bf16_t* KN = RG(F, 6); const bf16_t* VN = RG(F, 7); const bf16_t* TB = RG(F, 1); const bf16_t* ATT = RG(F, 2);
    const float* GC = (const float*)(F.ws + WS_GC); const float* BETA = (const float*)(F.ws + WS_BETA);
    LAS unsigned char* L = F.lds; const int w = F.wave;
    const unsigned lbase = (unsigned)(uintptr_t)F.ldsg;
    for (int ch = F.bid; ch < 64; ch += F.G) {
        const int b = ch >> 4, h = (ch >> 1) & 7, dir = ch & 1;
        bf16_t* OB = RG(F, dir ? 3 : 0);
        const float* gcp = GC + (size_t)(dir * 8 + h) * TT; const float* btp = BETA + (size_t)(dir * 8 + h) * TT;
#define S2_CK(step) ((step) < 4 ? 512 + b * 4 + (dir ? 3 - (step) : (step)) : b * 128 + (dir ? 131 - (step) : (step) - 4))
        const __amdgpu_buffer_rsrc_t rQ = __builtin_amdgcn_make_buffer_rsrc((void*)QN, 0, 0x7fffffff, 0x00020000), rK = __builtin_amdgcn_make_buffer_rsrc((void*)KN, 0, 0x7fffffff, 0x00020000),
            rV = __builtin_amdgcn_make_buffer_rsrc((void*)VN, 0, 0x7fffffff, 0x00020000), rT = __builtin_amdgcn_make_buffer_rsrc((void*)TB, 0, 0x7fffffff, 0x00020000), rA = __builtin_amdgcn_make_buffer_rsrc((void*)ATT, 0, 0x7fffffff, 0x00020000);
        unsigned vq_[4], vt_[2];
        { const int lane_ = F.lane, lw_ = (w - 4) & 3;
#pragma unroll
          for (int e_ = 0; e_ < 4; ++e_) { const int pc_ = 4 * lw_ + e_; const unsigned row_ = 4 * pc_ + (lane_ >> 4), ch_ = (lane_ & 15) ^ (((row_ & 3) << 2) | ((row_ >> 2) & 3));
              vq_[e_] = ((dir ? 63u - row_ : row_) * (unsigned)D + ch_ * 8u) * 2u; }
#pragma unroll
          for (int e_ = 0; e_ < 2; ++e_) { const int pc_ = 2 * lw_ + e_; const unsigned R_ = 4 * pc_ + (lane_ >> 4), c_ = (lane_ & 15) ^ (((R_ & 3) << 2) | ((R_ >> 2) & 3));
              vt_[e_] = ((32u * (c_ >> 3) + R_) * 64u + (c_ & 7u) * 8u) * 2u; } }
#define BLDS16(rs, voff, soff, lp) __builtin_amdgcn_raw_ptr_buffer_load_lds((rs), (LAS void*)(lp), 16, (voff), (soff), 0, 0)
#define S2_FILL(step, buf) do { const int lane_ = F.lane, lw_ = w - 4; const int ck_ = S2_CK(step), t0_ = ck_ * 64; \
        LAS unsigned char* Bf_ = L + (buf) * S2_BUF; const int sq_ = (t0_ * D + h * 128) * 2, st_ = (int)((((unsigned)ck_ * 8u + (unsigned)h) * 2u + (unsigned)dir) * 8192u); \
        _Pragma("unroll") for (int e_ = 0; e_ < 4; ++e_) { const int pc_ = 4 * lw_ + e_; \
            BLDS16(rQ, vq_[e_], sq_, Bf_ + S2_QT + pc_ * 1024); BLDS16(rK, vq_[e_], sq_, Bf_ + S2_KT + pc_ * 1024); BLDS16(rV, vq_[e_], sq_, Bf_ + S2_VT + pc_ * 1024); } \
        _Pragma("unroll") for (int e_ = 0; e_ < 2; ++e_) { const int pc_ = 2 * lw_ + e_; \
            BLDS16(rT, vt_[e_], st_, Bf_ + S2_TT + pc_ * 1024); BLDS16(rA, vt_[e_], st_, Bf_ + S2_AT + pc_ * 1024); } \
        if (lw_ == 0) { LAS float* tb_ = (LAS float*)(Bf_ + S2_TAB); tb_[lane_] = expf(pg_); tb_[64 + lane_] = expf(pl_ - pg_); tb_[128 + lane_] = pb_; if (lane_ == 0) tb_[192] = expf(pl_); } } while (0)
#define S2_TLOAD(step) do { if (w == 4) { const int ck_ = S2_CK(step), t0_ = ck_ * 64, tk_ = dir ? t0_ + 63 - F.lane : t0_ + F.lane; pg_ = gcp[tk_]; pb_ = btp[tk_]; pl_ = gcp[dir ? t0_ : t0_ + 63]; } } while (0)
        float pg_ = 0.f, pb_ = 0.f, pl_ = 0.f;
        f32x16 S[4];
#pragma unroll
        for (int kb = 0; kb < 4; ++kb) S[kb] = (f32x16){};
        FRAME_REFRESH(F);
        if (w >= 4) { S2_TLOAD(0); __builtin_amdgcn_s_waitcnt(0x0070); S2_FILL(0, 0); S2_TLOAD(1); __builtin_amdgcn_s_waitcnt(0x0070); }
        asm volatile("s_waitcnt vmcnt(0) lgkmcnt(0)" ::: "memory"); __builtin_amdgcn_s_barrier(); asm volatile("" ::: "memory");
#pragma unroll 1
        for (int s2 = 0; s2 < 132; s2 += 2) {
#pragma unroll
            for (int par = 0; par < 2; ++par) {
                const int step = s2 + par;
                FRAME_REFRESH(F);
                if (w >= 4) { if (step + 1 < 132) { S2_FILL(step + 1, par ^ 1); if (step + 2 < 132) S2_TLOAD(step + 2); } __builtin_amdgcn_s_waitcnt(0x0070); asm volatile("" ::: "memory"); }
                else {
                    const int lane = F.lane, r = lane & 31, hh = lane >> 5;
                    LAS unsigned char* Bf = L + par * S2_BUF; const unsigned ab = lbase + par * S2_BUF;
                    const LAS float* tab = (const LAS float*)(Bf + S2_TAB);
                    const int ck = S2_CK(step), t0 = ck * 64;
                    bf16x8 Sb[4][2];
#pragma unroll
                    for (int kb = 0; kb < 4; ++kb) { Sb[kb][0] = pka(S[kb], 0); Sb[kb][1] = pka(S[kb], 8); }
                    f32x16 X[2] = {}, O1[2] = {};
                    { bf16x8 kc[2], qc[2], kn[2], qn[2];
#pragma unroll
                      for (int bi = 0; bi < 2; ++bi) { const unsigned o = off_b(32 * bi + r, hh); kc[bi] = *(const LAS bf16x8*)(Bf + S2_KT + o); qc[bi] = *(const LAS bf16x8*)(Bf + S2_QT + o); }
#pragma unroll
                      for (int ks = 0; ks < 8; ++ks) {
                          if (ks < 7) {
#pragma unroll
                              for (int bi = 0; bi < 2; ++bi) { const unsigned o = off_b(32 * bi + r, 2 * (ks + 1) + hh); kn[bi] = *(const LAS bf16x8*)(Bf + S2_KT + o); qn[bi] = *(const LAS bf16x8*)(Bf + S2_QT + o); } }
                          __builtin_amdgcn_sched_barrier(0);
#pragma unroll
                          for (int bi = 0; bi < 2; ++bi) { X[bi] = MFMA32(kc[bi], Sb[ks >> 1][ks & 1], X[bi]); O1[bi] = MFMA32(qc[bi], Sb[ks >> 1][ks & 1], O1[bi]); }
#pragma unroll
                          for (int bi = 0; bi < 2; ++bi) { kc[bi] = kn[bi]; qc[bi] = qn[bi]; }
                          __builtin_amdgcn_sched_barrier(0); } }
                    bf16x8 tf0[2], tf1[4];
#pragma unroll
                    for (int ks = 0; ks < 4; ++ks) { if (ks < 2) tf0[ks] = *(const LAS bf16x8*)(Bf + S2_TT + off_b(r, 2 * ks + hh)); tf1[ks] = *(const LAS bf16x8*)(Bf + S2_TT + off_b(r, 8 + 2 * ks + hh)); }
                    bf16x8 Rp[2][2];
                    { const int ql = (lane & 15) >> 2, p = lane & 3, rh = (lane >> 4) & 1;
                      s16x4 vv[2][4];
#pragma unroll
                      for (int bi = 0; bi < 2; ++bi)
#pragma unroll
                          for (int q4 = 0; q4 < 4; ++q4) vv[bi][q4] = trr(ab + S2_VT + off_b(32 * bi + 8 * q4 + 4 * hh + ql, 4 * w + 2 * rh + (p >> 1)) + 8 * (p & 1));
                      asm volatile("s_waitcnt lgkmcnt(0)" ::: "memory"); __builtin_amdgcn_sched_barrier(0);
#pragma unroll
                      for (int bi = 0; bi < 2; ++bi) { f32x16 R;
                          f32x4 egv[4], btv[4];
#pragma unroll
                          for (int q4 = 0; q4 < 4; ++q4) { egv[q4] = *(const LAS f32x4*)(tab + 32 * bi + 8 * q4 + 4 * hh); btv[q4] = *(const LAS f32x4*)(tab + 128 + 32 * bi + 8 * q4 + 4 * hh); }
                          __builtin_amdgcn_sched_barrier(0);
#pragma unroll
                          for (int q4 = 0; q4 < 4; ++q4) { const f32x4 eg = egv[q4], bt = btv[q4];
#pragma unroll
                              for (int e = 0; e < 4; ++e) R[4 * q4 + e] = bt[e] * (bf1((bf16_t)vv[bi][q4][e]) - eg[e] * X[bi][4 * q4 + e]); }
                          Rp[bi][0] = pka(R, 0); Rp[bi][1] = pka(R, 8); } }
                    f32x16 Vn[2] = {};
#pragma unroll
                    for (int ks = 0; ks < 4; ++ks) {
                        if (ks < 2) Vn[0] = MFMA32(tf0[ks], Rp[ks >> 1][ks & 1], Vn[0]);
                        Vn[1] = MFMA32(tf1[ks], Rp[ks >> 1][ks & 1], Vn[1]); }
                    const unsigned blk = (lane >> 4) & 1, q = (lane & 15) >> 2, p = lane & 3;
                    s16x4 kt[2][4][2];
#define S2_KT_ISSUE(kb0) do { _Pragma("unroll") for (int kk_ = 0; kk_ < 2; ++kk_) _Pragma("unroll") for (int ks_ = 0; ks_ < 4; ++ks_) _Pragma("unroll") for (int t_ = 0; t_ < 2; ++t_) \
                        kt[kk_][ks_][t_] = trr(ab + S2_KT + off_b(16 * ks_ + 8 * hh + 4 * t_ + q, 4 * ((kb0) + kk_) + 2 * blk + (p >> 1)) + 8 * (p & 1)); } while (0)
#define S2_KT_MMA(kb0) do { _Pragma("unroll") for (int ks_ = 0; ks_ < 4; ++ks_) _Pragma("unroll") for (int kk_ = 0; kk_ < 2; ++kk_) { \
                        const bf16x8 kf_ = (bf16x8){kt[kk_][ks_][0][0], kt[kk_][ks_][0][1], kt[kk_][ks_][0][2], kt[kk_][ks_][0][3], kt[kk_][ks_][1][0], kt[kk_][ks_][1][1], kt[kk_][ks_][1][2], kt[kk_][ks_][1][3]}; \
                        S[(kb0) + kk_] = MFMA32(kf_, Vs[ks_ >> 1][ks_ & 1], S[(kb0) + kk_]); } } while (0)
                    S2_KT_ISSUE(0);
                    { bf16x8 af0[2], af1[4];
#pragma unroll
                      for (int ks = 0; ks < 4; ++ks) { if (ks < 2) af0[ks] = *(const LAS bf16x8*)(Bf + S2_AT + off_b(r, 2 * ks + hh)); af1[ks] = *(const LAS bf16x8*)(Bf + S2_AT + off_b(r, 8 + 2 * ks + hh)); }
                      __builtin_amdgcn_sched_barrier(0);
                      bf16x8 Vp[2][2];
#pragma unroll
                      for (int bi = 0; bi < 2; ++bi) { Vp[bi][0] = pka(Vn[bi], 0); Vp[bi][1] = pka(Vn[bi], 8); }
                      f32x16 O2[2] = {};
#pragma unroll
                      for (int ks = 0; ks < 4; ++ks) {
                          if (ks < 2) O2[0] = MFMA32(af0[ks], Vp[ks >> 1][ks & 1], O2[0]);
                          O2[1] = MFMA32(af1[ks], Vp[ks >> 1][ks & 1], O2[1]); }
                      const unsigned ob32 = (unsigned)(((dir ? t0 + 63 - 4 * hh : t0 + 4 * hh) * D + h * 128 + 32 * w + r) * 2);
#pragma unroll
                      for (int bi = 0; bi < 2; ++bi) { f32x4 ego[4];
#pragma unroll
                          for (int q4 = 0; q4 < 4; ++q4) ego[q4] = *(const LAS f32x4*)(tab + 32 * bi + 8 * q4 + 4 * hh);
                          __builtin_amdgcn_sched_barrier(0);
#pragma unroll
                          for (int q4 = 0; q4 < 4; ++q4) { const f32x4 eg = ego[q4];
#pragma unroll
                              for (int e = 0; e < 4; ++e) { const unsigned ro = (unsigned)((32 * bi + 8 * q4 + e) * D * 2);
                                  *(bf16_t*)((char*)OB + (dir ? ob32 - ro : ob32 + ro)) = (bf16_t)(pk2(O2[bi][4 * q4 + e] + eg[e] * O1[bi][4 * q4 + e], 0.f) & 0xffffu); } } } }
                    { bf16x8 Vs[2][2];
                      f32x4 edv[2][4]; const float gl = tab[192];
#pragma unroll
                      for (int bi = 0; bi < 2; ++bi)
#pragma unroll
                          for (int q4 = 0; q4 < 4; ++q4) edv[bi][q4] = *(const LAS f32x4*)(tab + 64 + 32 * bi + 8 * q4 + 4 * hh);
                      __builtin_amdgcn_sched_barrier(0);
#pragma unroll
                      for (int bi = 0; bi < 2; ++bi) { f32x16 T2;
#pragma unroll
                          for (int q4 = 0; q4 < 4; ++q4) { const f32x4 ed = edv[bi][q4];
#pragma unroll
                              for (int e = 0; e < 4; ++e) T2[4 * q4 + e] = Vn[bi][4 * q4 + e] * ed[e]; }
                          Vs[bi][0] = pka(T2, 0); Vs[bi][1] = pka(T2, 8); }
#pragma unroll
                      for (int kb = 0; kb < 4; ++kb)
#pragma unroll
                          for (int reg = 0; reg < 16; ++reg) S[kb][reg] *= gl;
                      asm volatile("s_waitcnt lgkmcnt(0)" ::: "memory"); __builtin_amdgcn_sched_barrier(0);
                      S2_KT_MMA(0);
                      __builtin_amdgcn_sched_barrier(0);
                      S2_KT_ISSUE(2);
                      asm volatile("s_waitcnt lgkmcnt(0)" ::: "memory"); __builtin_amdgcn_sched_barrier(0);
                      S2_KT_MMA(2); }
#undef S2_KT_ISSUE
#undef S2_KT_MMA
                    asm volatile("s_waitcnt lgkmcnt(0)" ::: "memory");
                }
                __builtin_amdgcn_s_barrier(); asm volatile("" ::: "memory");
            }
        }
        asm volatile("s_waitcnt vmcnt(0)" ::: "memory");
#undef S2_CK
#undef S2_FILL
#undef BLDS16
#undef S2_TLOAD
    }
}
__device__ __forceinline__ void delta_out(Frame& F) {
    const Args& A = *F.a; const bf16_t* OF = RG(F, 0); const bf16_t* OBk = RG(F, 3); const bf16_t* Z = RG(F, 4); bf16_t* Y = RG(F, 5);
    const int per = (TT + F.G - 1) / F.G, r0 = F.bid * per, r1 = (r0 + per < TT) ? r0 + per : TT;
    float ng[8];
#pragma unroll
    for (int e = 0; e < 8; ++e) ng[e] = A.in[I_CNG][((8 * F.lane) & 127) + e];
    u32x4 ac[2], bc[2], zc[2], an[2], bn[2], zn[2];
#define DO_LOAD(AA, BB, ZZ, t_) do { _Pragma("unroll") for (int j = 0; j < 2; ++j) { const size_t off_ = (size_t)(t_) * D + j * 512 + 8 * F.lane; \
        AA[j] = *(const u32x4*)(OF + off_); BB[j] = *(const u32x4*)(OBk + off_); ZZ[j] = *(const u32x4*)(Z + off_); } } while (0)
    if (r0 + F.wave < r1) DO_LOAD(ac, bc, zc, r0 + F.wave);
    for (int t = r0 + F.wave; t < r1; t += NWAVES) {
        FRAME_REFRESH(F);
        if (t + NWAVES < r1) DO_LOAD(an, bn, zn, t + NWAVES);
#pragma unroll
        for (int j = 0; j < 2; ++j) { const int col = j * 512 + 8 * F.lane; const size_t off = (size_t)t * D + col;
            const u32x4 a = ac[j], bq = bc[j], z = zc[j];
            float o[8] = {bflo(a.x) + bflo(bq.x), bfhi(a.x) + bfhi(bq.x), bflo(a.y) + bflo(bq.y), bfhi(a.y) + bfhi(bq.y), bflo(a.z) + bflo(bq.z), bfhi(a.z) + bfhi(bq.z), bflo(a.w) + bflo(bq.w), bfhi(a.w) + bfhi(bq.w)};
            const float zz[8] = {bflo(z.x), bfhi(z.x), bflo(z.y), bfhi(z.y), bflo(z.z), bfhi(z.z), bflo(z.w), bfhi(z.w)};
            float ss = 0.f;
#pragma unroll
            for (int e = 0; e < 8; ++e) ss += o[e] * o[e];
            ss = sum16(ss); const float rs = 1.f / sqrtf(ss * (1.f / 128.f) + EPS);
#pragma unroll
            for (int e = 0; e < 8; ++e) o[e] = o[e] * rs * ng[e] * siluf_(zz[e]);
            *(u32x4*)(Y + off) = (u32x4){pk2(o[0], o[1]), pk2(o[2], o[3]), pk2(o[4], o[5]), pk2(o[6], o[7])}; }
#pragma unroll
        for (int j = 0; j < 2; ++j) { ac[j] = an[j]; bc[j] = bn[j]; zc[j] = zn[j]; }
    }
#undef DO_LOAD
}

__global__ void __launch_bounds__(NTHR, 2) hybrid_fwd(Args args) {
    extern __shared__ __attribute__((aligned(16))) unsigned char lds[];
    Frame F;
    F.lds = (LAS unsigned char*)lds; F.ldsg = (char*)lds;
    F.wave = __builtin_amdgcn_readfirstlane((int)threadIdx.x >> 6);
#define REFRESH() FRAME_REFRESH(F)
    REFRESH();
    F.bid = blockIdx.x; F.G = gridDim.x; F.gw = F.bid * NWAVES + F.wave; F.NGW = F.G * NWAVES;
    F.a = &args; F.ws = args.ws; F.out = args.out;
    volatile LAS unsigned* MISC = (volatile LAS unsigned*)(F.lds + MISC_OFF);
    if (F.tid < 4) MISC[F.tid] = 0u;
    __syncthreads();
    const int lo = args.ph_lo, hi = args.ph_hi;
    XcdBarrier bar; bar.bar = (unsigned*)(args.ws + WS_CTL) + CW_BAR; bar.x = 0; bar.st = MISC;
    if (hi - lo > 1) bar = xcd_barrier_post((unsigned*)(args.ws + WS_CTL) + CW_BAR, MISC, F.tid);
    int ph = 0;
#ifndef PHMASK
#define PHMASK 0xFFFFFFFFu
#endif
#ifndef REPMASK
#define REPMASK 0u
#endif
#define PHASE_BEGIN(cls) if (((PHMASK >> (cls)) & 1u) && ph >= lo && ph < hi) { PH_T0(cls); for (int rep_ = 0; rep_ < 1 + (int)((REPMASK >> (cls)) & 1u); ++rep_) { REFRESH();
#if PROBE_T == 4
    unsigned long long pht0_ = 0; int phc_ = -1;
#define PH_T0(cls) do { phc_ = (cls); if ((cls) == PROBE_SITE) pht0_ = __builtin_amdgcn_s_memrealtime(); } while (0)
#define PH_T1() do { if (phc_ == PROBE_SITE) { asm volatile("s_waitcnt vmcnt(0) lgkmcnt(0)" ::: "memory"); __syncthreads(); if (blockIdx.x == 7 && F.wave == 0 && F.lane == 0) { unsigned long long* dg_ = (unsigned long long*)(F.ws + WS_CTL + 512 * 1024); dg_[3] += __builtin_amdgcn_s_memrealtime() - pht0_; dg_[2] += 1ull; } } } while (0)
#else
#define PH_T0(cls) do { } while (0)
#define PH_T1() do { } while (0)
#endif
#if PROBE_T == 5
#define BAR_T(stmt) do { const unsigned long long b0_ = __builtin_amdgcn_s_memrealtime(); stmt; if (blockIdx.x == PROBE_SITE && F.wave == 0 && F.lane == 0) { unsigned long long* dg_ = (unsigned long long*)(F.ws + WS_CTL + 512 * 1024); dg_[3] += __builtin_amdgcn_s_memrealtime() - b0_; dg_[2] = 1ull; } } while (0)
#else
#define BAR_T(stmt) do { stmt; } while (0)
#endif
#define PHASE_END   } PH_T1(); if (ph + 1 < hi) { REFRESH(); BAR_T(xcd_barrier(bar, F.tid)); } } ++ph;
    const Args& A = args;
    bf16_t* hctx = (bf16_t*)(F.ws + WS_HCTX); bf16_t* hlat = hlat_base(F);

    PHASE_BEGIN(0) p0_prologue(F); PHASE_END
    PHASE_BEGIN(1) p1_init(F); PHASE_END

#define DBGP(site) ((PROBE_T && (site) == PROBE_SITE) ? (unsigned long long*)(F.ws + WS_CTL + 512 * 1024) : (unsigned long long*)nullptr)
#define GEMM_DENSE(EPI, Aptr, Bptr, M_, N_, K_, SITE_) do { pg8::Gemm g_{(Aptr), (Bptr), (M_), (N_), (K_), 0, DBGP(SITE_)}; pg8::StaticOrder S_; S_.init((M_), (N_), F.G, F.bid); \
        pg8::gemm_phase(F.lds, g_, S_, EPI, F.tid); } while (0)
#define MOE_LAYER(layer, last) do { const int nrows_ = (last) ? TLAT : TT; \
        PHASE_BEGIN(5) moe_route(F, (layer), nrows_, (last)); PHASE_END \
        PHASE_BEGIN(7) if (!(rep_ && (last))) { moe_tables(F, (layer)); pg8::Gemm g_{RG(F, 0), (const bf16_t*)(F.ws + WS_WE1), TT, 1024, D, (size_t)D * D * 2, DBGP(40 + (layer))}; \
            pg8::GroupedOrder S_{(const LAS int*)(F.lds + GTAB_OFF), (const LAS int*)(F.lds + GTAB_OFF) + 32, F.G, F.bid}; moe_toktable(F, S_); EpiGateUp E_{rep_ ? RG(F, 6) : (bf16_t*)(F.ws + WS_HID)}; \
            pg8::gemm_phase_gather(F.lds, g_, S_, E_, F.tid, (const LAS int*)(F.lds + GTOK_OFF)); } PHASE_END \
        PHASE_BEGIN(8) if (!(rep_ && (last))) { moe_tables(F, (layer)); pg8::Gemm g_{(const bf16_t*)(F.ws + WS_HID), (const bf16_t*)(F.ws + WS_WE2), XS_ROWS, 1024, DE, (size_t)D * DE * 2, DBGP(50 + (layer))}; \
            pg8::GroupedOrder S_{(const LAS int*)(F.lds + GTAB_OFF), (const LAS int*)(F.lds + GTAB_OFF) + 32, F.G, F.bid}; moe_dsttable(F, S_); EpiDown E_{rep_ ? RG(F, 6) : (bf16_t*)(F.ws + WS_Y2), (const LAS int*)(F.lds + GTOK_OFF), (const LAS float*)(F.lds + GTOK_OFF + GTOK_MAXU * 1024)}; pg8::gemm_phase(F.lds, g_, S_, E_, F.tid); } PHASE_END \
        PHASE_BEGIN(9) moe_ln2(F, (layer), nrows_, (last)); PHASE_END } while (0)
#define ATTN_LAYER(layer, j, last) do { \
        PHASE_BEGIN(2) { pg8::Gemm g_{RG(F, 0), (const bf16_t*)(F.ws + WS_WQKV) + (size_t)(j) * 1536 * D, TT, 1536, D, 0, DBGP(10 + (layer))}; pg8::StaticOrder S_; S_.init(TT, 1536, F.G, F.bid); \
            EpiQKV E_{RG(F, 1), RG(F, 2), (bf16_t*)((char*)RG(F, 2) + 17 * MiB)}; pg8::gemm_phase(F.lds, g_, S_, E_, F.tid); VM_WAIT(); __syncthreads(); qk_norm_rope(F, (j), S_); } PHASE_END \
        PHASE_BEGIN(3) attn_phase(F, !(last), rep_ ? RG(F, 5) : RG(F, 1), (j)); PHASE_END \
        PHASE_BEGIN(4) { EpiResid E_{rep_ ? RG(F, 6) : hlat, rep_ ? RG(F, 3) : hctx, modrow(F, (layer), 0) + 2048}; GEMM_DENSE(E_, RG(F, 1), (const bf16_t*)(F.ws + WS_WO) + (size_t)(j) * D * D, (last) ? TLAT : TT, D, D, 20 + (layer)); if (!rep_) moe_convert(F, (layer), (last) ? 0 : 16); } PHASE_END } while (0)

    ATTN_LAYER(0, 0, false);
    MOE_LAYER(0, false);
    PHASE_BEGIN(10) { EpiGelu E_{RG(F, 1), (f32x2*)(F.ws + WS_AB)}; GEMM_DENSE(E_, RG(F, 0), (const bf16_t*)(F.ws + WS_BWIN), TT, 2048, D, 30); } PHASE_END
    PHASE_BEGIN(11) gmlp_spatial(F); PHASE_END
    PHASE_BEGIN(4) { EpiResid E_{rep_ ? RG(F, 6) : hlat, rep_ ? RG(F, 3) : hctx, modrow(F, 1, 0) + 2048}; GEMM_DENSE(E_, RG(F, 0), (const bf16_t*)(F.ws + WS_BWOUT), TT, D, D, 21); if (!rep_) moe_convert(F, 1, 16); } PHASE_END
    MOE_LAYER(1, false);
    PHASE_BEGIN(12) { EpiDeltaIn E_{RG(F, 1), (float*)(F.ws + WS_AB)}; GEMM_DENSE(E_, RG(F, 0), (const bf16_t*)(F.ws + WS_CWIN), TT, CW_NPAD, D, 31); } PHASE_END
    PHASE_BEGIN(13) delta_prep(F); PHASE_END
    PHASE_BEGIN(14) delta_local(F); PHASE_END
    PHASE_BEGIN(15) delta_scan2(F); PHASE_END
    PHASE_BEGIN(16) delta_out(F); PHASE_END
    PHASE_BEGIN(4) { EpiResid E_{rep_ ? RG(F, 6) : hlat, rep_ ? RG(F, 3) : hctx, modrow(F, 2, 0) + 2048}; GEMM_DENSE(E_, RG(F, 5), (const bf16_t*)(F.ws + WS_CWOUT), TT, D, D, 22); if (!rep_) moe_convert(F, 2, 16); } PHASE_END
    MOE_LAYER(2, false);
    ATTN_LAYER(3, 1, true);
    MOE_LAYER(3, true);
    (void)A;
}
constexpr int NPHASES = 2 + (3 + 4) + (3 + 4) + (6 + 4) + (3 + 4);

extern "C" void kernel_launch(void* const* d_in, const int* in_sizes, int n_in, void* d_out, int out_size, void* d_ws, size_t ws_size, hipStream_t stream) {
    static int grid = 0;
    if (grid == 0) {
        if (n_in != 29 || out_size != TLAT * D || ws_size < WS_END) { fprintf(stderr, "kernel_launch: unexpected shapes: n_in %d out %d ws %zu (need %zu)\n", n_in, out_size, ws_size, (size_t)WS_END); grid = -1; return; }
        int dev = 0, cus = 0, per_cu = 0;
        if (hipGetDevice(&dev) != hipSuccess || hipDeviceGetAttribute(&cus, hipDeviceAttributeMultiprocessorCount, dev) != hipSuccess) { grid = -1; return; }
        if (hipFuncSetAttribute((const void*)hybrid_fwd, hipFuncAttributeMaxDynamicSharedMemorySize, LDS_BYTES) != hipSuccess) { fprintf(stderr, "kernel_launch: hipFuncSetAttribute failed\n"); grid = -1; return; }
        if (hipOccupancyMaxActiveBlocksPerMultiprocessor(&per_cu, (const void*)hybrid_fwd, NTHR, LDS_BYTES) != hipSuccess || per_cu < 1) fprintf(stderr, "kernel_launch: occupancy query says %d\n", per_cu);
        (void)hipGetLastError();
        grid = cus < 256 ? cus : 256;
    }
    if (grid < 0) return;
    (void)hipMemsetAsync((char*)d_ws + WS_CTL, 0, CTL_ZERO_BYTES, stream);
    Args a{};
    for (int i = 0; i < 29; ++i) a.in[i] = (const float*)d_in[i];
    a.out = (float*)d_out; a.ws = (unsigned char*)d_ws;
#if MK_ONE_LAUNCH
    a.ph_lo = 0; a.ph_hi = NPHASES;
    hipLaunchKernelGGL(hybrid_fwd, dim3(grid), dim3(NTHR), LDS_BYTES, stream, a);
#else
    for (int p = 0; p < NPHASES; ++p) { a.ph_lo = p; a.ph_hi = p + 1; hipLaunchKernelGGL(hybrid_fwd, dim3(grid), dim3(NTHR), LDS_BYTES, stream, a); }
#endif
    const hipError_t le = hipPeekAtLastError();
    if (le != hipSuccess) fprintf(stderr, "kernel_launch: launch failed: %s\n", hipGetErrorName(le));
}
```
